# Optimizing an MI355X kernel written in HIP

```python
import math
import jax, jax.numpy as jnp
from jax import lax
import numpy as np

D_MODEL = 1024
BATCH = 8
SEQ = 2048
DEPTH = 4
DEC_BATCH = 2
DEC_SEQ = 16384
PAST_LEN = 128

N_MIXERS = 2
N_MLA_LAYERS = (DEPTH + N_MIXERS - 1) // N_MIXERS
N_NA_LAYERS = DEPTH // N_MIXERS
RMS_EPS = 1e-6
GRID_W = 64
MLA_HEADS = 8
MLA_NOPE = 128
MLA_ROPE = 64
MLA_V = 128
MLA_Q_LORA = 384
MLA_KV_LORA = 256
ROPE_THETA = 10000.0
ATTN_Q_BLOCK = 128
NA_HEADS = 16
NA_HEAD_DIM = D_MODEL // NA_HEADS
NA_KH_MAX = 8
NA_KW = 16
NA_RPB_H = 2 * NA_KH_MAX - 1
NA_RPB_W = 2 * NA_KW - 1
PEER_HEADS = 8
PEER_NKEYS = 128
PEER_N_EXPERTS = PEER_NKEYS * PEER_NKEYS
PEER_QDIM = 256
PEER_TOPK = 16
PEER_CHUNK_MAX = 512

kernel_name = "mla_natten_peer_interleaved_encoder"


def rmsnorm(x, g):
    xf = x.astype(jnp.float32)
    y = xf * lax.rsqrt(jnp.mean(xf * xf, axis=-1, keepdims=True) + RMS_EPS)
    return (y * g.astype(jnp.float32)).astype(x.dtype)


def rope_tables(t_len):
    inv = ROPE_THETA ** (-jnp.arange(0, MLA_ROPE, 2, dtype=jnp.float32) / MLA_ROPE)
    ang = jnp.arange(t_len, dtype=jnp.float32)[:, None] * inv[None, :]
    return jnp.cos(ang), jnp.sin(ang)


def apply_rope(x, cos, sin):
    xf = x.astype(jnp.float32)
    x1, x2 = xf[..., : MLA_ROPE // 2], xf[..., MLA_ROPE // 2:]
    return jnp.concatenate([x1 * cos - x2 * sin, x1 * sin + x2 * cos], axis=-1).astype(x.dtype)


def mla(h, w_dq, q_norm, w_uq, w_dkv, kv_norm, w_ukv, w_o):
    B, T, _ = h.shape
    cq = rmsnorm(h @ w_dq, q_norm)
    q = (cq @ w_uq).reshape(B, T, MLA_HEADS, MLA_NOPE + MLA_ROPE)
    q_nope, q_pe = q[..., :MLA_NOPE], q[..., MLA_NOPE:]
    kv_a = h @ w_dkv
    c_kv = rmsnorm(kv_a[..., :MLA_KV_LORA], kv_norm)
    k_pe = kv_a[..., MLA_KV_LORA:]
    cos, sin = rope_tables(T)
    q_pe = apply_rope(q_pe, cos[:, None, :], sin[:, None, :])
    k_pe = apply_rope(k_pe, cos, sin)
    kv = (c_kv @ w_ukv).reshape(B, T, MLA_HEADS, MLA_NOPE + MLA_V)
    k_nope, v = kv[..., :MLA_NOPE], kv[..., MLA_NOPE:]
    nb = T // ATTN_Q_BLOCK
    scale = (MLA_NOPE + MLA_ROPE) ** -0.5

    def to_blocks(a):
        return a.reshape(B, nb, ATTN_Q_BLOCK, *a.shape[2:]).swapaxes(0, 1)

    def step(args):
        qn, qp = args
        s = (jnp.einsum('bqhd,bkhd->bhqk', qn, k_nope)
             + jnp.einsum('bqhr,bkr->bhqk', qp, k_pe))
        p = jax.nn.softmax(s.astype(jnp.float32) * scale, axis=-1).astype(v.dtype)
        return jnp.einsum('bhqk,bkhd->bqhd', p, v)

    o = lax.map(step, (to_blocks(q_nope), to_blocks(q_pe)))
    o = o.swapaxes(0, 1).reshape(B, T, MLA_HEADS * MLA_V)
    return o @ w_o


def na_indices(rows):
    t_len = rows * GRID_W
    kh = min(NA_KH_MAX, rows)
    t = jnp.arange(t_len, dtype=jnp.int32)
    r, c = t // GRID_W, t % GRID_W
    r0 = jnp.clip(r - kh // 2, 0, rows - kh)
    c0 = jnp.clip(c - NA_KW // 2, 0, GRID_W - NA_KW)
    kr = r0[:, None, None] + jnp.arange(kh, dtype=jnp.int32)[None, :, None]
    kc = c0[:, None, None] + jnp.arange(NA_KW, dtype=jnp.int32)[None, None, :]
    idx = (kr * GRID_W + kc).reshape(t_len, kh * NA_KW)
    rel = ((kr - r[:, None, None] + NA_KH_MAX - 1) * NA_RPB_W
           + (kc - c[:, None, None] + NA_KW - 1)).reshape(t_len, kh * NA_KW)
    return idx, rel


def neighbourhood_attention(h, w_qkv, b_qkv, rpb, w_o):
    B, T, D = h.shape
    rows = T // GRID_W
    qkv = (h @ w_qkv + b_qkv).reshape(B, T, 3, NA_HEADS, NA_HEAD_DIM)
    q = qkv[:, :, 0] * (NA_HEAD_DIM ** -0.5)
    k, v = qkv[:, :, 1], qkv[:, :, 2]
    idx, rel = na_indices(rows)
    rpb_flat = rpb.reshape(NA_HEADS, NA_RPB_H * NA_RPB_W)
    q_rows = q.reshape(B, rows, GRID_W, NA_HEADS, NA_HEAD_DIM).swapaxes(0, 1)

    def step(args):
        q_r, idx_r, rel_r = args
        kg = k[:, idx_r]
        vg = v[:, idx_r]
        s = (jnp.einsum('bqhd,bqkhd->bhqk', q_r, kg).astype(jnp.float32)
             + rpb_flat[:, rel_r].astype(jnp.float32)[None])
        p = jax.nn.softmax(s, axis=-1).astype(vg.dtype)
        return jnp.einsum('bhqk,bqkhd->bqhd', p, vg)

    o = lax.map(step, (q_rows, idx.reshape(rows, GRID_W, -1), rel.reshape(rows, GRID_W, -1)))
    o = o.swapaxes(0, 1).reshape(B, T, D)
    return o @ w_o


def peer(h, w_q, sub_keys, u_tab, v_tab):
    B, T, D = h.shape
    n = B * T
    chunk = math.gcd(n, PEER_CHUNK_MAX)
    xf = h.reshape(n // chunk, chunk, D)

    def step(xc):
        q = (xc @ w_q).reshape(chunk, PEER_HEADS, 2, PEER_QDIM // 2)
        s = jnp.einsum('chpd,hpkd->chpk', q, sub_keys).astype(jnp.float32)
        sv, si = lax.top_k(s, PEER_TOPK)
        cand = (sv[:, :, 0, :, None] + sv[:, :, 1, None, :]).reshape(chunk, PEER_HEADS, PEER_TOPK * PEER_TOPK)
        fv, fi = lax.top_k(cand, PEER_TOPK)
        ia = jnp.take_along_axis(si[:, :, 0], fi // PEER_TOPK, axis=-1)
        ib = jnp.take_along_axis(si[:, :, 1], fi % PEER_TOPK, axis=-1)
        expert = ia * PEER_NKEYS + ib
        g = jax.nn.softmax(fv, axis=-1)
        a = jnp.einsum('cd,chkd->chk', xc, u_tab[expert])
        w = (g * jax.nn.gelu(a.astype(jnp.float32), approximate=False)).astype(xc.dtype)
        return jnp.einsum('chk,chkd->cd', w, v_tab[expert])

    return lax.map(step, xf).reshape(B, T, D)


def trunk(x, norm_mix, norm_ffn, norm_final,
          mla_w_dq, mla_q_norm, mla_w_uq, mla_w_dkv, mla_kv_norm, mla_w_ukv, mla_w_o,
          na_w_qkv, na_b_qkv, na_rpb, na_w_o,
          peer_w_q, peer_sub_keys, peer_u, peer_v):
    for i in range(DEPTH):
        h = rmsnorm(x, norm_mix[i])
        j = i // N_MIXERS
        if i % N_MIXERS == 0:
            mix = mla(h, mla_w_dq[j], mla_q_norm[j], mla_w_uq[j], mla_w_dkv[j],
                      mla_kv_norm[j], mla_w_ukv[j], mla_w_o[j])
        else:
            mix = neighbourhood_attention(h, na_w_qkv[j], na_b_qkv[j], na_rpb[j], na_w_o[j])
        x = x + mix
        h = rmsnorm(x, norm_ffn[i])
        x = x + peer(h, peer_w_q[i], peer_sub_keys[i], peer_u[i], peer_v[i])
    return rmsnorm(x, norm_final)


def setup_inputs(seed: int = 0) -> dict:
    key = jax.random.key(seed)
    ks = jax.random.split(key, 24)
    f32 = jnp.float32

    def nrm(k, shape, scale):
        return jax.random.normal(k, shape, f32) * scale

    def gain(k, shape):
        return 1.0 + 0.02 * jax.random.normal(k, shape, f32)

    D = D_MODEL
    Lm, Ln = N_MLA_LAYERS, N_NA_LAYERS
    return {
        "x_prompt": nrm(ks[0], (BATCH, SEQ, D), 1.0),
        "x_sample": nrm(ks[1], (DEC_BATCH, DEC_SEQ, D), 1.0),
        "norm_mix": gain(ks[2], (DEPTH, D)),
        "norm_ffn": gain(ks[3], (DEPTH, D)),
        "norm_final": gain(ks[4], (D,)),
        "mla_w_dq": nrm(ks[5], (Lm, D, MLA_Q_LORA), D ** -0.5),
        "mla_q_norm": gain(ks[6], (Lm, MLA_Q_LORA)),
        "mla_w_uq": nrm(ks[7], (Lm, MLA_Q_LORA, MLA_HEADS * (MLA_NOPE + MLA_ROPE)), MLA_Q_LORA ** -0.5),
        "mla_w_dkv": nrm(ks[8], (Lm, D, MLA_KV_LORA + MLA_ROPE), D ** -0.5),
        "mla_kv_norm": gain(ks[9], (Lm, MLA_KV_LORA)),
        "mla_w_ukv": nrm(ks[10], (Lm, MLA_KV_LORA, MLA_HEADS * (MLA_NOPE + MLA_V)), MLA_KV_LORA ** -0.5),
        "mla_w_o": nrm(ks[11], (Lm, MLA_HEADS * MLA_V, D), (MLA_HEADS * MLA_V) ** -0.5),
        "na_w_qkv": nrm(ks[12], (Ln, D, 3 * D), D ** -0.5),
        "na_b_qkv": nrm(ks[13], (Ln, 3 * D), 0.02),
        "na_rpb": nrm(ks[14], (Ln, NA_HEADS, NA_RPB_H, NA_RPB_W), 0.1),
        "na_w_o": nrm(ks[15], (Ln, D, D), D ** -0.5),
        "peer_w_q": nrm(ks[16], (DEPTH, D, PEER_HEADS * PEER_QDIM), D ** -0.5),
        "peer_sub_keys": nrm(ks[17], (DEPTH, PEER_HEADS, 2, PEER_NKEYS, PEER_QDIM // 2), (PEER_QDIM // 2) ** -0.5),
        "peer_u": nrm(ks[18], (DEPTH, PEER_N_EXPERTS, D), D ** -0.5),
        "peer_v": nrm(ks[19], (DEPTH, PEER_N_EXPERTS, D), (PEER_HEADS * PEER_TOPK) ** -0.5),
    }


def reference(x_prompt, x_sample, norm_mix, norm_ffn, norm_final,
              mla_w_dq, mla_q_norm, mla_w_uq, mla_w_dkv, mla_kv_norm, mla_w_ukv, mla_w_o,
              na_w_qkv, na_b_qkv, na_rpb, na_w_o,
              peer_w_q, peer_sub_keys, peer_u, peer_v):
    y_prompt = trunk(x_prompt, norm_mix, norm_ffn, norm_final,
                     mla_w_dq, mla_q_norm, mla_w_uq, mla_w_dkv, mla_kv_norm, mla_w_ukv, mla_w_o,
                     na_w_qkv, na_b_qkv, na_rpb, na_w_o,
                     peer_w_q, peer_sub_keys, peer_u, peer_v)
    y_sample = trunk(x_sample, norm_mix, norm_ffn, norm_final,
                     mla_w_dq, mla_q_norm, mla_w_uq, mla_w_dkv, mla_kv_norm, mla_w_ukv, mla_w_o,
                     na_w_qkv, na_b_qkv, na_rpb, na_w_o,
                     peer_w_q, peer_sub_keys, peer_u, peer_v)
    return (y_prompt, y_sample)
```

```cpp
#include <hip/hip_runtime.h>
#include <hip/hip_cooperative_groups.h>
#include <stdint.h>
#include <string.h>
#include <math.h>
#include <cstdio>
namespace cg = cooperative_groups;

#ifndef COOP
#define COOP 1
#endif
#ifndef PHMASK
#define PHMASK 0xFFFF
#endif
#ifndef LB2
#define LB2 2
#endif
#define PHON(t) ((PHMASK >> (t)) & 1)

typedef unsigned short u16;
typedef unsigned int u32;
using bf16x8 = __attribute__((ext_vector_type(8))) short;
using s16x4  = __attribute__((ext_vector_type(4))) short;
using f32x16 = __attribute__((ext_vector_type(16))) float;
using f32x4  = __attribute__((ext_vector_type(4))) float;
using u32x4  = __attribute__((ext_vector_type(4))) unsigned;
using u32x2  = __attribute__((ext_vector_type(2))) unsigned;
typedef __attribute__((ext_vector_type(2))) __bf16 v2bf;

constexpr int T_TOK = 49152, T_PROMPT = 16384, DM = 1024;
constexpr int NTHR = 256;
constexpr float LOG2E = 1.4426950408889634f;
constexpr float RMS_EPS = 1e-6f;

enum { PH_PREP = 0, PH_MLA_A, PH_MLA_B, PH_MLA_ATT, PH_MLA_O, PH_NA_QKV, PH_NA_ATT, PH_NA_O, PH_PEER_Q, PH_PEER_C, PH_FINAL };

struct PrepJob { const float* src; u16* dst; const float* gain; int K, N, tile0, scale_cols; float scale; int pad; };

struct Params {
  const float* xin0; const float* xin1;
  float* x; u16* xb;
  const float* norm_final;
  u16* wa_t[2]; u16* wuq_t[2]; u16* wukv_t[2]; u16* mla_wo_t[2];
  u16* na_wqkv_t[2]; u16* na_wo_t[2]; float* na_bias_s; float* na_rpb_s;
  u16* peer_wq_t[4]; u16* peer_sk; unsigned char* peer_u8; unsigned char* peer_v8;
  u16* cqkv; u16* q; u16* kv; u16* o; u16* qkv; u32* pkeys;
  unsigned char* q8; unsigned char* k8; unsigned char* kpe8; unsigned char* vT8;
  float* ropeC; float* ropeS; unsigned* bar;
  const float* in_sub_keys; const float* in_peer_u; const float* in_peer_v; const float* in_norm_ffn; const float* in_na_bias; const float* in_na_rpb;
  PrepJob jobs[24];
  double inv_freq[32];
  int njobs, ntiles_prep;
  int prog_type[48]; int prog_layer[48];
  int nprog, pad0;
};

typedef const __attribute__((address_space(4))) Params& KP;

__device__ __forceinline__ int crow(int r, int hi) { return (r & 3) + 8 * (r >> 2) + 4 * hi; }
__device__ __forceinline__ u32 cvtpk(float lo, float hi) { u32 r; asm("v_cvt_pk_bf16_f32 %0, %1, %2" : "=v"(r) : "v"(lo), "v"(hi)); return r; }
__device__ __forceinline__ float bf_lo(u32 v) { return __uint_as_float(v << 16); }
__device__ __forceinline__ float bf_hi(u32 v) { return __uint_as_float(v & 0xffff0000u); }
__device__ __forceinline__ int tok_pos(int t) { return t < T_PROMPT ? (t & 2047) : (t & 16383); }
__device__ __forceinline__ f32x16 mfma32(bf16x8 a, bf16x8 b, f32x16 c) { return __builtin_amdgcn_mfma_f32_32x32x16_bf16(a, b, c, 0, 0, 0); }
__device__ __forceinline__ float shx(float v, int m) { return __shfl_xor(v, m, 64); }

constexpr int BK = 64;
constexpr int OPB = 16384;
constexpr int GEMM_LDS = 4 * OPB;
constexpr int SMEM_BYTES = 81920;
constexpr int RSTD_OFF = 73728;

enum { EPI_A = 0, EPI_UQ, EPI_UK, EPI_UV, EPI_O, EPI_QKV, EPI_PEER };
constexpr float KEY_BIAS = 16.f;
constexpr float Q8_SCALE = 16.f, K8_SCALE = 4.f, V8_SCALE = 4.f, P8_SCALE = 128.f;
__device__ __forceinline__ u32 pack4_fp8(float a, float b, float c, float d) { int v = 0; v = __builtin_amdgcn_cvt_pk_fp8_f32(a, b, v, false); v = __builtin_amdgcn_cvt_pk_fp8_f32(c, d, v, true); return (u32)v; }

__device__ __forceinline__ float dot2bf(u32 a, u32 b, float c) { return __builtin_amdgcn_fdot2_f32_bf16(__builtin_bit_cast(v2bf, a), __builtin_bit_cast(v2bf, b), c, false); }

template <int EPI, bool NORM>
__device__ __forceinline__ void gemm_tile(KP p, int layer, const u16* Ap, int lda, const u16* Bt, int K, int m0, int n0, char* lds) {
  int tid_ = threadIdx.x; asm volatile("" : "+v"(tid_));
  const int tid = tid_, lane = tid & 63, w = tid >> 6;
  const int wm = w >> 1, wn = w & 1, r32 = lane & 31, hi = lane >> 5;
  float* rstd_l = (float*)(lds + RSTD_OFF);
  const int srow = w * 32 + (lane >> 2);
  const int scol = ((lane & 3) ^ ((lane >> 4) & 3)) * 8;
  const u16* Ag = Ap + (long)(m0 + srow) * lda + scol;
  const u16* Bg = Bt + (long)(n0 + srow) * K + scol;
#define GSTAGE(st, kt) do { _Pragma("unroll") for (int j = 0; j < 2; ++j) { \
    __builtin_amdgcn_global_load_lds((const unsigned*)(Ag + (long)j * 16 * lda + (kt) * 32), (unsigned*)(lds + (st) * 16384 + (w * 2 + j) * 1024), 16, 0, 0); \
    __builtin_amdgcn_global_load_lds((const unsigned*)(Bg + (long)j * 16 * K + (kt) * 32), (unsigned*)(lds + (st) * 16384 + 8192 + (w * 2 + j) * 1024), 16, 0, 0); } } while (0)
  f32x16 acc[2][2];
#pragma unroll
  for (int i = 0; i < 2; ++i)
#pragma unroll
    for (int j = 0; j < 2; ++j)
#pragma unroll
      for (int r = 0; r < 16; ++r) acc[i][j][r] = 0.f;
  float ssq0 = 0.f, ssq1 = 0.f;
  bf16x8 skr[8];
  const int sw = (r32 >> 2) & 3;
  const int arow = (wm * 64 + r32) * 64, brow = 8192 + (wn * 64 + r32) * 64;
  const int co0 = ((0 + hi) ^ sw) << 4, co1 = ((2 + hi) ^ sw) << 4;
  const int nk = K / 32;

#ifndef KREP
#define KREP 1
#endif
  for (int rep_ = 0; rep_ < KREP; ++rep_) {
  if (KREP > 1) {
#pragma unroll
    for (int i = 0; i < 2; ++i)
#pragma unroll
      for (int j = 0; j < 2; ++j)
#pragma unroll
        for (int r = 0; r < 16; ++r) acc[i][j][r] = 0.f;
    ssq0 = 0.f; ssq1 = 0.f; }
  __syncthreads();
  GSTAGE(0, 0); GSTAGE(1, 1); GSTAGE(2, 2);
  if constexpr (EPI == EPI_PEER) {
    const u16* sk = p.peer_sk + ((long)layer * 16 + (n0 >> 7)) * 16384;
#pragma unroll
    for (int i = 0; i < 8; ++i) { const int c = tid + 256 * i; skr[i] = *(const bf16x8*)(sk + (c >> 4) * 128 + (c & 15) * 8); }
  }
  for (int kt = 0; kt < nk; ++kt) {
    if (kt + 2 < nk) asm volatile("s_waitcnt vmcnt(8)" ::: "memory");
    else if (kt + 1 < nk) asm volatile("s_waitcnt vmcnt(4)" ::: "memory");
    else asm volatile("s_waitcnt vmcnt(0)" ::: "memory");
    asm volatile("s_waitcnt lgkmcnt(0)" ::: "memory");
    __builtin_amdgcn_s_barrier();
    if (kt + 3 < nk) GSTAGE((kt + 3) & 3, kt + 3);
    const char* base = lds + (kt & 3) * 16384;
    {
      const bf16x8 a0 = *(const bf16x8*)(base + arow + co0), a1 = *(const bf16x8*)(base + arow + 32 * 64 + co0);
      const bf16x8 b0 = *(const bf16x8*)(base + brow + co0), b1 = *(const bf16x8*)(base + brow + 32 * 64 + co0);
      const bf16x8 c0 = *(const bf16x8*)(base + arow + co1), c1 = *(const bf16x8*)(base + arow + 32 * 64 + co1);
      const bf16x8 d0 = *(const bf16x8*)(base + brow + co1), d1 = *(const bf16x8*)(base + brow + 32 * 64 + co1);
      if constexpr (EPI != EPI_UV) {
        acc[0][0] = mfma32(b0, a0, acc[0][0]); acc[0][1] = mfma32(b1, a0, acc[0][1]);
        acc[1][0] = mfma32(b0, a1, acc[1][0]); acc[1][1] = mfma32(b1, a1, acc[1][1]);
        acc[0][0] = mfma32(d0, c0, acc[0][0]); acc[0][1] = mfma32(d1, c0, acc[0][1]);
        acc[1][0] = mfma32(d0, c1, acc[1][0]); acc[1][1] = mfma32(d1, c1, acc[1][1]);
      } else {
        acc[0][0] = mfma32(a0, b0, acc[0][0]); acc[0][1] = mfma32(a0, b1, acc[0][1]);
        acc[1][0] = mfma32(a1, b0, acc[1][0]); acc[1][1] = mfma32(a1, b1, acc[1][1]);
        acc[0][0] = mfma32(c0, d0, acc[0][0]); acc[0][1] = mfma32(c0, d1, acc[0][1]);
        acc[1][0] = mfma32(c1, d0, acc[1][0]); acc[1][1] = mfma32(c1, d1, acc[1][1]);
      }
      if constexpr (NORM) {
        const u32x4 x0 = __builtin_bit_cast(u32x4, a0), x1 = __builtin_bit_cast(u32x4, a1), y0 = __builtin_bit_cast(u32x4, c0), y1 = __builtin_bit_cast(u32x4, c1);
#pragma unroll
        for (int q = 0; q < 4; ++q) { ssq0 = dot2bf(x0[q], x0[q], ssq0); ssq1 = dot2bf(x1[q], x1[q], ssq1); ssq0 = dot2bf(y0[q], y0[q], ssq0); ssq1 = dot2bf(y1[q], y1[q], ssq1); }
      }
    }
  }
  }
#undef GSTAGE
  __syncthreads();
  float rs[2] = {1.f, 1.f};
  if constexpr (NORM) {
    ssq0 += shx(ssq0, 32); ssq1 += shx(ssq1, 32);
    rs[0] = rsqrtf(ssq0 / (float)K + RMS_EPS); rs[1] = rsqrtf(ssq1 / (float)K + RMS_EPS);
  }
  const int rowb = wm * 64, colb = wn * 64;
  if constexpr (EPI == EPI_A || EPI == EPI_QKV) {
    constexpr int OROW = 272;
    u16* outp; int ldo; bool rope = false;
    if constexpr (EPI == EPI_A) { outp = p.cqkv; ldo = 768; rope = (n0 + colb == 640); }
    else { outp = p.qkv; ldo = 3072; }
#pragma unroll
    for (int mi = 0; mi < 2; ++mi) {
      const int rl = rowb + mi * 32 + r32; const int pos = tok_pos(m0 + rl);
#pragma unroll
      for (int g = 0; g < 4; ++g) {
        f32x4 v0, v1;
#pragma unroll
        for (int e = 0; e < 4; ++e) { v0[e] = acc[mi][0][4 * g + e] * rs[mi]; v1[e] = acc[mi][1][4 * g + e] * rs[mi]; }
        if constexpr (EPI == EPI_QKV) {
          const f32x4 b0 = *(const f32x4*)(p.na_bias_s + layer * 3072 + n0 + colb + 8 * g + 4 * hi), b1 = *(const f32x4*)(p.na_bias_s + layer * 3072 + n0 + colb + 32 + 8 * g + 4 * hi);
          v0 += b0; v1 += b1;
        }
        if (rope) {
          const f32x4 c = *(const f32x4*)(p.ropeC + pos * 32 + 8 * g + 4 * hi), sn = *(const f32x4*)(p.ropeS + pos * 32 + 8 * g + 4 * hi);
          const f32x4 t0 = (v0 * c - v1 * sn) * K8_SCALE, t1 = (v0 * sn + v1 * c) * K8_SCALE;
          unsigned char* kp_ = p.k8 + (long)(m0 + rl) * 1088 + 1024 + 8 * g + 4 * hi;
          *(u32*)kp_ = pack4_fp8(t0[0], t0[1], t0[2], t0[3]); *(u32*)(kp_ + 32) = pack4_fp8(t1[0], t1[1], t1[2], t1[3]);
        }
        char* e_ = lds + rl * OROW + (colb + 8 * g + 4 * hi) * 2;
        *(u32x2*)e_ = (u32x2){cvtpk(v0[0], v0[1]), cvtpk(v0[2], v0[3])};
        *(u32x2*)(e_ + 64) = (u32x2){cvtpk(v1[0], v1[1]), cvtpk(v1[2], v1[3])};
      }
    }
    __syncthreads();
#pragma unroll
    for (int i = 0; i < 8; ++i) { const int c = tid + 256 * i, row = c >> 4, ch = c & 15;
      *(u32x4*)(outp + (long)(m0 + row) * ldo + n0 + ch * 8) = *(const u32x4*)(lds + row * OROW + ch * 16); }
  } else if constexpr (EPI == EPI_UQ || EPI == EPI_UK) {
    constexpr int BROW = 144;
    const bool rope = (EPI == EPI_UQ) && ((n0 + colb) % 192 == 128);
    const float sc = (EPI == EPI_UQ) ? Q8_SCALE : K8_SCALE;
#pragma unroll
    for (int mi = 0; mi < 2; ++mi) {
      const int rl = rowb + mi * 32 + r32; const int pos = tok_pos(m0 + rl);
#pragma unroll
      for (int g = 0; g < 4; ++g) {
        f32x4 v0, v1;
#pragma unroll
        for (int e = 0; e < 4; ++e) { v0[e] = acc[mi][0][4 * g + e] * rs[mi] * sc; v1[e] = acc[mi][1][4 * g + e] * rs[mi] * sc; }
        if (rope) {
          const f32x4 c = *(const f32x4*)(p.ropeC + pos * 32 + 8 * g + 4 * hi), sn = *(const f32x4*)(p.ropeS + pos * 32 + 8 * g + 4 * hi);
          const f32x4 t0 = v0 * c - v1 * sn, t1 = v0 * sn + v1 * c; v0 = t0; v1 = t1;
        }
        char* e_ = lds + rl * BROW + (colb + 8 * g + 4 * hi);
        *(u32*)e_ = pack4_fp8(v0[0], v0[1], v0[2], v0[3]); *(u32*)(e_ + 32) = pack4_fp8(v1[0], v1[1], v1[2], v1[3]);
      }
    }
    __syncthreads();
    unsigned char* outb; long ldo;
    if constexpr (EPI == EPI_UQ) { outb = p.q8 + n0; ldo = 1536; } else { outb = p.k8 + (n0 >> 8) * 128; ldo = 1088; }
#pragma unroll
    for (int i = 0; i < 4; ++i) { const int c = tid + 256 * i, row = c >> 3, ch = c & 7;
      *(u32x4*)(outb + (long)(m0 + row) * ldo + ch * 16) = *(const u32x4*)(lds + row * BROW + ch * 16); }
  } else if constexpr (EPI == EPI_UV) {
    constexpr int BROW = 144;
#pragma unroll
    for (int mi = 0; mi < 2; ++mi) {
#pragma unroll
      for (int g = 0; g < 4; ++g) {
        float rr[4];
#pragma unroll
        for (int e = 0; e < 4; ++e) rr[e] = __int_as_float(__builtin_amdgcn_ds_bpermute((8 * g + 4 * hi + e) << 2, __float_as_int(rs[mi]))) * V8_SCALE;
#pragma unroll
        for (int ni = 0; ni < 2; ++ni) {
          char* e_ = lds + (colb + ni * 32 + r32) * BROW + rowb + mi * 32 + 8 * g + 4 * hi;
          *(u32*)e_ = pack4_fp8(acc[mi][ni][4 * g] * rr[0], acc[mi][ni][4 * g + 1] * rr[1], acc[mi][ni][4 * g + 2] * rr[2], acc[mi][ni][4 * g + 3] * rr[3]);
        }
      }
    }
    __syncthreads();
    unsigned char* outb = p.vT8 + (long)((n0 >> 8) * 128) * T_TOK + m0;
#pragma unroll
    for (int i = 0; i < 4; ++i) { const int c = tid + 256 * i, d = c >> 3, ch = c & 7;
      *(u32x4*)(outb + (long)d * T_TOK + ch * 16) = *(const u32x4*)(lds + d * BROW + ch * 16); }
  } else if constexpr (EPI == EPI_O) {
    constexpr int FROW = 528;
#pragma unroll
    for (int mi = 0; mi < 2; ++mi) {
      const int rl = rowb + mi * 32 + r32;
#pragma unroll
      for (int ni = 0; ni < 2; ++ni)
#pragma unroll
        for (int g = 0; g < 4; ++g)
          *(f32x4*)(lds + rl * FROW + (colb + ni * 32 + 8 * g + 4 * hi) * 4) = (f32x4){acc[mi][ni][4 * g], acc[mi][ni][4 * g + 1], acc[mi][ni][4 * g + 2], acc[mi][ni][4 * g + 3]};
    }
    __syncthreads();
#pragma unroll 4
    for (int i = 0; i < 16; ++i) { const int c = tid + 256 * i, row = c >> 5, ch = c & 31;
      const f32x4 a = *(const f32x4*)(lds + row * FROW + ch * 16);
      float* xp = p.x + (long)(m0 + row) * DM + n0 + ch * 4;
      f32x4 xv = *(const f32x4*)xp; xv += a; *(f32x4*)xp = xv;
      *(u32x2*)(p.xb + (long)(m0 + row) * DM + n0 + ch * 4) = (u32x2){cvtpk(xv[0], xv[1]), cvtpk(xv[2], xv[3])}; }
  } else {
    constexpr int QROW = 272;
    char* Qs = lds; char* Ss = lds + 128 * QROW;
    const int hp = n0 >> 7;
#pragma unroll
    for (int mi = 0; mi < 2; ++mi) {
      const int rl = rowb + mi * 32 + r32;
#pragma unroll
      for (int g = 0; g < 4; ++g) {
        char* e_ = Qs + rl * QROW + (colb + 8 * g + 4 * hi) * 2;
        *(u32x2*)e_ = (u32x2){cvtpk(acc[mi][0][4 * g] * rs[mi], acc[mi][0][4 * g + 1] * rs[mi]), cvtpk(acc[mi][0][4 * g + 2] * rs[mi], acc[mi][0][4 * g + 3] * rs[mi])};
        *(u32x2*)(e_ + 64) = (u32x2){cvtpk(acc[mi][1][4 * g] * rs[mi], acc[mi][1][4 * g + 1] * rs[mi]), cvtpk(acc[mi][1][4 * g + 2] * rs[mi], acc[mi][1][4 * g + 3] * rs[mi])};
      }
    }
#pragma unroll
    for (int i = 0; i < 8; ++i) { const int c = tid + 256 * i, kr = c >> 4, ch = c & 15; *(bf16x8*)(Ss + kr * QROW + ch * 16) = skr[i]; }
    __syncthreads();
    f32x16 a2[2][2];
#pragma unroll
    for (int i = 0; i < 2; ++i)
#pragma unroll
      for (int j = 0; j < 2; ++j)
#pragma unroll
        for (int r = 0; r < 16; ++r) a2[i][j][r] = 0.f;
    { const char* Ar = Qs + (rowb + r32) * QROW + hi * 16; const char* Br = Ss + (colb + r32) * QROW + hi * 16;
#pragma unroll
      for (int ks = 0; ks < 8; ++ks) {
        bf16x8 a0 = *(const bf16x8*)(Ar + ks * 32), a1 = *(const bf16x8*)(Ar + 32 * QROW + ks * 32);
        bf16x8 b0 = *(const bf16x8*)(Br + ks * 32), b1 = *(const bf16x8*)(Br + 32 * QROW + ks * 32);
        a2[0][0] = mfma32(b0, a0, a2[0][0]); a2[0][1] = mfma32(b1, a0, a2[0][1]);
        a2[1][0] = mfma32(b0, a1, a2[1][0]); a2[1][1] = mfma32(b1, a1, a2[1][1]);
      } }
    __syncthreads();
    constexpr int SROW = 544;
    char* Sc = lds;
#pragma unroll
    for (int mi = 0; mi < 2; ++mi) {
      const int rl = rowb + mi * 32 + r32;
#pragma unroll
      for (int ni = 0; ni < 2; ++ni)
#pragma unroll
        for (int g = 0; g < 4; ++g)
          *(f32x4*)(Sc + rl * SROW + (colb + ni * 32 + 8 * g + 4 * hi) * 4) = (f32x4){a2[mi][ni][4 * g], a2[mi][ni][4 * g + 1], a2[mi][ni][4 * g + 2], a2[mi][ni][4 * g + 3]};
    }
    __syncthreads();
    { const int row = tid >> 1, hf = tid & 1;
      u32 kv[64];
#pragma unroll
      for (int i = 0; i < 16; ++i) {
        const f32x4 v = *(const f32x4*)(Sc + row * SROW + (2 * i + hf) * 16);
#pragma unroll
        for (int e = 0; e < 4; ++e) { const u32 b = __float_as_uint(v[e] + KEY_BIAS);
          kv[i * 4 + e] = (b & ~127u) | (u32)((2 * i + hf) * 4 + e); }
      }
      u32 mprev = 0xffffffffu;
      u32* outk = p.pkeys + (long)(m0 + row) * 256 + hp * 16;
#pragma unroll 1
      for (int ps = 0; ps < 16; ++ps) {
        u32 best = 0;
#pragma unroll
        for (int i = 0; i < 64; ++i) { const u32 d = kv[i] - mprev; best = d > best ? d : best; }
        u32 cand = mprev + best;
        if (best < (0u - mprev)) cand = 0u;
        const u32 oth = (u32)__shfl_xor((int)cand, 1, 64);
        mprev = cand > oth ? cand : oth;
        if (hf == 0) outk[ps] = mprev;
      }
    }
  }
}

template <int OFF> __device__ __forceinline__ s16x4 tr_read(int vb) {
  s16x4 r; asm volatile("ds_read_b64_tr_b16 %0, %1 offset:%2" : "=&v"(r) : "v"(vb), "i"(OFF) : "memory"); return r;
}
__device__ __forceinline__ int v_st(int k, int c) { const int kk = (k & ~0xC) | ((k & 4) << 1) | ((k & 8) >> 1); return ((kk >> 3) * 4 + (c >> 5)) * 512 + ((kk & 7) * 32 + (c & 31)) * 2; }
__device__ __forceinline__ int v_rd_base(int lane) { return ((lane & 3) << 3) | (((lane >> 2) & 3) << 6) | (((lane >> 4) & 1) << 5) | (((lane >> 5) & 1) << 8); }
constexpr int v_rd_off(int d0, int ks, int half) { return d0 * 512 + ks * 4096 + half * 2048; }
template <int D0> __device__ __forceinline__ void pv_one(f32x16& od, int vb, bf16x8 pa0, bf16x8 pa1, bf16x8 pa2, bf16x8 pa3) {
  const s16x4 l0 = tr_read<v_rd_off(D0, 0, 0)>(vb), h0 = tr_read<v_rd_off(D0, 0, 1)>(vb), l1 = tr_read<v_rd_off(D0, 1, 0)>(vb), h1 = tr_read<v_rd_off(D0, 1, 1)>(vb);
  const s16x4 l2 = tr_read<v_rd_off(D0, 2, 0)>(vb), h2 = tr_read<v_rd_off(D0, 2, 1)>(vb), l3 = tr_read<v_rd_off(D0, 3, 0)>(vb), h3 = tr_read<v_rd_off(D0, 3, 1)>(vb);
  asm volatile("s_waitcnt lgkmcnt(0)" ::: "memory"); __builtin_amdgcn_sched_barrier(0);
#define PKV(L, H) (bf16x8){L[0], L[1], L[2], L[3], H[0], H[1], H[2], H[3]}
  od = mfma32(pa0, PKV(l0, h0), od); od = mfma32(pa1, PKV(l1, h1), od); od = mfma32(pa2, PKV(l2, h2), od); od = mfma32(pa3, PKV(l3, h3), od);
#undef PKV
}

constexpr float THR_L2 = 11.5f;

__device__ __forceinline__ void partialSM(f32x16& p0, f32x16& p1, float& m_reg, float& alpha) {
  float pmax = p0[0];
#pragma unroll
  for (int r = 1; r < 16; ++r) pmax = fmaxf(pmax, p0[r]);
#pragma unroll
  for (int r = 0; r < 16; ++r) pmax = fmaxf(pmax, p1[r]);
  { auto rr = __builtin_amdgcn_permlane32_swap(__float_as_uint(pmax), __float_as_uint(pmax), false, false);
    pmax = fmaxf(__uint_as_float(rr[0]), __uint_as_float(rr[1])); }
  float mn;
  if (__all(pmax - m_reg <= THR_L2)) { mn = m_reg; alpha = 1.f; }
  else { mn = fmaxf(m_reg, pmax); alpha = __builtin_amdgcn_exp2f(m_reg - mn); m_reg = mn; }
#pragma unroll
  for (int r = 0; r < 16; ++r) { p0[r] = __builtin_amdgcn_exp2f(p0[r] - mn); p1[r] = __builtin_amdgcn_exp2f(p1[r] - mn); }
}
__device__ __forceinline__ void finishSM(f32x16& p0, f32x16& p1, float alpha, float& l_reg, bf16x8& pa0, bf16x8& pa1, bf16x8& pa2, bf16x8& pa3) {
  float ps = 0.f;
#pragma unroll
  for (int r = 0; r < 16; ++r) ps += p0[r];
#pragma unroll
  for (int r = 0; r < 16; ++r) ps += p1[r];
  { auto rr = __builtin_amdgcn_permlane32_swap(__float_as_uint(ps), __float_as_uint(ps), false, false);
    ps = __uint_as_float(rr[0]) + __uint_as_float(rr[1]); }
  l_reg = l_reg * alpha + ps;
#define PK4(P, BASE, OUT) do { unsigned a0 = cvtpk(P[BASE + 0], P[BASE + 1]), a1 = cvtpk(P[BASE + 2], P[BASE + 3]);   \
    unsigned b0 = cvtpk(P[BASE + 4], P[BASE + 5]), b1 = cvtpk(P[BASE + 6], P[BASE + 7]);                              \
    auto r0 = __builtin_amdgcn_permlane32_swap(a0, b0, false, false); auto r1 = __builtin_amdgcn_permlane32_swap(a1, b1, false, false); \
    u32x4 w_ = {r0[0], r1[0], r0[1], r1[1]}; OUT = __builtin_bit_cast(bf16x8, w_); } while (0)
  PK4(p0, 0, pa0); PK4(p0, 8, pa1); PK4(p1, 0, pa2); PK4(p1, 8, pa3);
#undef PK4
}

constexpr int ATT_K_OFF = 0, ATT_V_OFF = 25600, ATT_WS_OFF = 41984, ATT_RPB_OFF = 43008;

template <int MODE>
__device__ __forceinline__ void attn_item(KP p, int layer, int item, char* lds) {
  constexpr int KST = MODE == 0 ? 12 : 4;
  constexpr int KROW = MODE == 0 ? 400 : 272;
  constexpr int ND0 = MODE == 0 ? 4 : 2;
  int tid_ = threadIdx.x; asm volatile("" : "+v"(tid_));
  const int tid = tid_, lane = tid & 63, w = tid >> 6, r32 = lane & 31, hi = lane >> 5;
  char* Kl = lds + ATT_K_OFF; char* Vl = lds + ATT_V_OFF;
  float* wsl = (float*)(lds + ATT_WS_OFF) + w * 64; float* al_l = wsl; float* li_l = wsl + 32;
  float* rpbl = (float*)(lds + ATT_RPB_OFF);

  int NT, qtok, ktok0, head, kcolB = 0; long obase;
  int na_c = 0, na_c0 = 0, na_relrow0 = 0, na_hl = 0;
  const u16* Qp;
  if constexpr (MODE == 0) {
    int seq, qb;
    if (item < 2048) { const int sh = item >> 7; seq = 8 + (sh >> 3); head = sh & 7; qb = item & 127; ktok0 = T_PROMPT + (seq - 8) * 16384; NT = 256; }
    else { const int it = item - 2048; const int sh = it >> 4; seq = sh >> 3; head = sh & 7; qb = it & 15; ktok0 = seq * 2048; NT = 32; }
    qtok = ktok0 + qb * 128 + w * 32 + r32;
    Qp = p.q + (long)qtok * 1536 + head * 192 + hi * 8;
    obase = (long)(ktok0 + qb * 128 + w * 32) * 1024 + head * 128;
  } else {
    const int Rg = item >> 3, hpair = item & 7;
    int grow0, r, rows;
    if (Rg < 256) { grow0 = (Rg >> 5) << 5; r = Rg & 31; rows = 32; } else { grow0 = 256 + (((Rg - 256) >> 8) << 8); r = (Rg - 256) & 255; rows = 256; }
    int r0 = r - 4; r0 = r0 < 0 ? 0 : r0; r0 = r0 > rows - 8 ? rows - 8 : r0;
    ktok0 = (grow0 + r0) * 64; NT = 8;
    na_hl = w >> 1; head = hpair * 2 + na_hl;
    na_c = (w & 1) * 32 + r32; na_c0 = na_c - 8; na_c0 = na_c0 < 0 ? 0 : na_c0; na_c0 = na_c0 > 48 ? 48 : na_c0;
    na_relrow0 = r0 - r + 7;
    qtok = Rg * 64 + na_c;
    Qp = p.qkv + (long)qtok * 3072 + head * 64 + hi * 8;
    obase = (long)(Rg * 64 + (w & 1) * 32) * 1024 + head * 64;
    kcolB = na_hl * 128;
    __syncthreads();
    { const float* src = p.na_rpb_s + ((long)layer * 16 + hpair * 2) * 465;
      for (int e = tid; e < 930; e += 256) rpbl[e] = src[e]; }
  }
  bf16x8 qr[KST];
#pragma unroll
  for (int d = 0; d < KST; ++d) qr[d] = *(const bf16x8*)(Qp + d * 16);

  bf16x8 sk[MODE == 0 ? 6 : 4], sv[4];
  const int s_key = tid >> 4, s_ch = tid & 15;
  const int s_key8 = tid >> 3, s_ch8 = tid & 7;
#define ALOAD(j) do { const long kt_ = (long)ktok0 + (j) * 64; \
    if constexpr (MODE == 0) { \
      _Pragma("unroll") for (int i = 0; i < 4; ++i) { const u16* b_ = p.kv + (kt_ + s_key + 16 * i) * 2048 + head * 256 + s_ch * 8; sk[i] = *(const bf16x8*)b_; sv[i] = *(const bf16x8*)(b_ + 128); } \
      _Pragma("unroll") for (int i = 0; i < 2; ++i) sk[4 + i] = *(const bf16x8*)(p.cqkv + (kt_ + s_key8 + 32 * i) * 768 + 640 + s_ch8 * 8); \
    } else { \
      _Pragma("unroll") for (int i = 0; i < 4; ++i) { const u16* b_ = p.qkv + (kt_ + s_key + 16 * i) * 3072 + 1024 + (head & ~1) * 64 + s_ch * 8; sk[i] = *(const bf16x8*)b_; sv[i] = *(const bf16x8*)(b_ + 1024); } \
    } } while (0)
#define AWRITE() do { \
    _Pragma("unroll") for (int i = 0; i < 4; ++i) { *(bf16x8*)(Kl + (s_key + 16 * i) * KROW + s_ch * 16) = sk[i]; *(bf16x8*)(Vl + v_st(s_key + 16 * i, s_ch * 8)) = sv[i]; } \
    if constexpr (MODE == 0) { _Pragma("unroll") for (int i = 0; i < 2; ++i) *(bf16x8*)(Kl + (s_key8 + 32 * i) * KROW + 256 + s_ch8 * 16) = sk[4 + i]; } } while (0)

  float m_reg = -1e30f, l_reg = 0.f;
  f32x16 o[ND0];
#pragma unroll
  for (int d = 0; d < ND0; ++d)
#pragma unroll
    for (int r = 0; r < 16; ++r) o[d][r] = 0.f;
  const int vb0 = (int)(uintptr_t)Vl + v_rd_base(lane) + (MODE == 1 ? na_hl * 1024 : 0);

  ALOAD(0);
  for (int j = 0; j < NT; ++j) {
    __syncthreads();
    AWRITE();
    __syncthreads();
    if (j + 1 < NT) ALOAD(j + 1);
    f32x16 p0, p1;
#pragma unroll
    for (int r = 0; r < 16; ++r) { p0[r] = 0.f; p1[r] = 0.f; }
#pragma unroll
    for (int d = 0; d < KST; ++d) {
      const int cb = kcolB + (d * 16 + hi * 8) * 2;
      bf16x8 b0 = *(const bf16x8*)(Kl + r32 * KROW + cb), b1 = *(const bf16x8*)(Kl + (32 + r32) * KROW + cb);
      p0 = mfma32(b0, qr[d], p0); p1 = mfma32(b1, qr[d], p1);
    }
    if constexpr (MODE == 1) {
      const float* rb = rpbl + (na_hl * 15 + na_relrow0 + j) * 31;
#pragma unroll
      for (int r = 0; r < 16; ++r) {
        const int kc0 = crow(r, hi), kc1 = 32 + kc0;
        int i0 = kc0 - na_c + 15, i1 = kc1 - na_c + 15;
        i0 = i0 < 0 ? 0 : (i0 > 30 ? 30 : i0); i1 = i1 < 0 ? 0 : (i1 > 30 ? 30 : i1);
        const float b0 = rb[i0], b1 = rb[i1];
        p0[r] = ((unsigned)(kc0 - na_c0) < 16u) ? p0[r] + b0 : -1e30f;
        p1[r] = ((unsigned)(kc1 - na_c0) < 16u) ? p1[r] + b1 : -1e30f;
      }
    }
    float alpha;
    partialSM(p0, p1, m_reg, alpha);
    if (__any(alpha < 1.f)) {
      if (hi == 0) al_l[r32] = alpha;
      __builtin_amdgcn_wave_barrier();
#pragma unroll
      for (int r = 0; r < 16; ++r) { const float a = al_l[crow(r, hi)];
#pragma unroll
        for (int d = 0; d < ND0; ++d) o[d][r] *= a; }
      __builtin_amdgcn_wave_barrier();
    }
    bf16x8 pa0, pa1, pa2, pa3;
    finishSM(p0, p1, alpha, l_reg, pa0, pa1, pa2, pa3);
    pv_one<0>(o[0], vb0, pa0, pa1, pa2, pa3); pv_one<1>(o[1], vb0, pa0, pa1, pa2, pa3);
    if constexpr (MODE == 0) { pv_one<2>(o[2], vb0, pa0, pa1, pa2, pa3); pv_one<3>(o[3], vb0, pa0, pa1, pa2, pa3); }
  }
#undef ALOAD
#undef AWRITE
  if (hi == 0) li_l[r32] = l_reg;
  __builtin_amdgcn_wave_barrier();
#pragma unroll
  for (int r = 0; r < 16; ++r) {
    const int qrow = crow(r, hi); const float rl = 1.f / li_l[qrow];
    u16* o_ = p.o + obase + (long)qrow * 1024 + r32;
#pragma unroll
    for (int d = 0; d < ND0; ++d) o_[d * 32] = (u16)(cvtpk(o[d][r] * rl, 0.f) & 0xffffu);
  }
  __builtin_amdgcn_wave_barrier();
}

__device__ __forceinline__ float lane_bcast(float v, int src_lane) { return __int_as_float(__builtin_amdgcn_ds_bpermute(src_lane << 2, __float_as_int(v))); }
__device__ __forceinline__ float rowmax32(const f32x16& p0, const f32x16& p1) {
  float pmax = p0[0];
#pragma unroll
  for (int r = 1; r < 16; ++r) pmax = fmaxf(pmax, p0[r]);
#pragma unroll
  for (int r = 0; r < 16; ++r) pmax = fmaxf(pmax, p1[r]);
  auto rr = __builtin_amdgcn_permlane32_swap(__float_as_uint(pmax), __float_as_uint(pmax), false, false);
  return fmaxf(__uint_as_float(rr[0]), __uint_as_float(rr[1]));
}

typedef __attribute__((ext_vector_type(8))) int i32x8;
#define MFMA8(A, B, C, SA, SB_) __builtin_amdgcn_mfma_scale_f32_32x32x64_f8f6f4(A, B, C, 0, 0, 0, SA, 0, SB_)
constexpr int SC_K = 0x7D7D7D7D, SC_Q = 0x7B7B7B7B, SC_P = 0x7F7F7F7F, SC_V = 0x7D7D7D7D;
constexpr float THR8_L2 = 1.5f;

__device__ __forceinline__ void attn_mla(KP p, int item, char* lds) {
  constexpr int KSTAGE = 64 * 192, VSTAGE = 128 * 64, VOFF = 2 * KSTAGE;
  int tid_ = threadIdx.x; asm volatile("" : "+v"(tid_));
  const int tid = tid_, lane = tid & 63, w = tid >> 6, r32 = lane & 31, hi = lane >> 5;
  int NT, ktok0, head, seq, qb;
  if (item < 2048) { const int sh = item >> 7; seq = 8 + (sh >> 3); head = sh & 7; qb = item & 127; ktok0 = T_PROMPT + (seq - 8) * 16384; NT = 256; }
  else { const int it = item - 2048; const int sh = it >> 4; seq = sh >> 3; head = sh & 7; qb = it & 15; ktok0 = seq * 2048; NT = 32; }
  const int qtok = ktok0 + qb * 128 + w * 32 + r32;
  const long obase = (long)(ktok0 + qb * 128 + w * 32) * 1024 + head * 128;
  i32x8 qf[3];
  { const unsigned char* Qp = p.q8 + (long)qtok * 1536 + head * 192 + hi * 32;
#pragma unroll
    for (int s3 = 0; s3 < 3; ++s3) { const u32x4 a = *(const u32x4*)(Qp + s3 * 64), b = *(const u32x4*)(Qp + s3 * 64 + 16);
      qf[s3] = (i32x8){(int)a[0], (int)a[1], (int)a[2], (int)a[3], (int)b[0], (int)b[1], (int)b[2], (int)b[3]}; } }
  unsigned ko[3], vo[2];
#pragma unroll
  for (int i = 0; i < 3; ++i) {
    const int g = (w * 3 + i) * 64 + lane, key = g / 12, pc = g - key * 12, c = pc ^ ((key >> 2) & 3);
    ko[i] = (c < 8) ? (unsigned)(key * 1088 + head * 128 + c * 16) : (unsigned)(key * 1088 + 1024 + (c - 8) * 16);
  }
#pragma unroll
  for (int i = 0; i < 2; ++i) {
    const int g = (w * 2 + i) * 64 + lane, d = g >> 2, pc = g & 3, c = pc ^ ((d >> 2) & 3);
    vo[i] = (unsigned)(d * T_TOK + c * 16);
  }
  const unsigned char* k8b = p.k8 + (long)ktok0 * 1088;
  const unsigned char* vtb = p.vT8 + (long)head * 128 * T_TOK + ktok0;
#define GLK(st, jt) do { const unsigned char* kt_ = k8b + (long)(jt) * (64 * 1088); int w_ = w; asm volatile("" : "+v"(w_)); \
    _Pragma("unroll") for (int i = 0; i < 3; ++i) { unsigned k_ = ko[i]; asm volatile("" : "+v"(k_)); \
    __builtin_amdgcn_global_load_lds((const unsigned*)(kt_ + k_), (unsigned*)(lds + (st) * KSTAGE + (w_ * 3 + i) * 1024), 16, 0, 0); } } while (0)
#define GLV(st, jt) do { const unsigned char* vt_ = vtb + (long)(jt) * 64; int w_ = w; asm volatile("" : "+v"(w_)); \
    _Pragma("unroll") for (int i = 0; i < 2; ++i) { unsigned v_ = vo[i]; asm volatile("" : "+v"(v_)); \
    __builtin_amdgcn_global_load_lds((const unsigned*)(vt_ + v_), (unsigned*)(lds + VOFF + (st) * VSTAGE + (w_ * 2 + i) * 1024), 16, 0, 0); } } while (0)
#define QK8(P0, P1, st) do { const int r_ = r32, h_ = hi, sw_ = (r_ >> 2) & 3; const char* Kr_ = lds + (st) * KSTAGE + r_ * 192; \
    const f32x16 z_ = {0.f, 0.f, 0.f, 0.f, 0.f, 0.f, 0.f, 0.f, 0.f, 0.f, 0.f, 0.f, 0.f, 0.f, 0.f, 0.f}; \
    _Pragma("unroll") for (int s3 = 0; s3 < 3; ++s3) { const int c0_ = ((s3 * 4 + h_ * 2) ^ sw_) << 4, c1_ = ((s3 * 4 + h_ * 2 + 1) ^ sw_) << 4; \
      const u32x4 a0_ = *(const u32x4*)(Kr_ + c0_), a1_ = *(const u32x4*)(Kr_ + c1_), b0_ = *(const u32x4*)(Kr_ + 32 * 192 + c0_), b1_ = *(const u32x4*)(Kr_ + 32 * 192 + c1_); \
      const i32x8 ka_ = {(int)a0_[0], (int)a0_[1], (int)a0_[2], (int)a0_[3], (int)a1_[0], (int)a1_[1], (int)a1_[2], (int)a1_[3]}; \
      const i32x8 kb_ = {(int)b0_[0], (int)b0_[1], (int)b0_[2], (int)b0_[3], (int)b1_[0], (int)b1_[1], (int)b1_[2], (int)b1_[3]}; \
      P0 = MFMA8(ka_, qf[s3], (s3 == 0 ? z_ : P0), SC_K, SC_Q); P1 = MFMA8(kb_, qf[s3], (s3 == 0 ? z_ : P1), SC_K, SC_Q); } } while (0)
#define PZERO(P0, P1) do { _Pragma("unroll") for (int r = 0; r < 16; ++r) { P0[r] = 0.f; P1[r] = 0.f; } } while (0)
#define EXPC(P, mn, R0, R1) do { _Pragma("unroll") for (int r = (R0); r < (R1); ++r) P[r] = __builtin_amdgcn_exp2f(P[r] - (mn)); } while (0)
#define SB() do {} while (0)

  float m_reg = -1e30f, l_reg = 0.f;
  f32x16 o[4];
#pragma unroll
  for (int d = 0; d < 4; ++d)
#pragma unroll
    for (int r = 0; r < 16; ++r) o[d][r] = 0.f;
  f32x16 pA0, pA1, pB0, pB1; float pmaxA, pmaxB;

  __syncthreads();
  GLK(0, 0); GLV(0, 0); GLK(1, 1);
  asm volatile("s_waitcnt vmcnt(0)" ::: "memory");
  __syncthreads();
  QK8(pA0, pA1, 0); pmaxA = rowmax32(pA0, pA1);

#define STEP(j, PX0, PX1, PMX, PY0, PY1, PMY, LAST) do { \
    asm volatile("s_waitcnt lgkmcnt(0)" ::: "memory"); __builtin_amdgcn_s_barrier(); \
    if ((j) + 2 < NT) GLK((j) & 1, (j) + 2); \
    if (!(LAST)) GLV(((j) + 1) & 1, (j) + 1); \
    const bool keep_ = __all(PMX - m_reg <= THR8_L2); \
    const float mn_ = keep_ ? m_reg : fmaxf(m_reg, PMX); \
    const float alpha_ = keep_ ? 1.f : __builtin_amdgcn_exp2f(m_reg - mn_); m_reg = mn_; \
    if (!keep_) { _Pragma("unroll") for (int r = 0; r < 16; ++r) { const float a_ = lane_bcast(alpha_, crow(r, hi)); \
      _Pragma("unroll") for (int d = 0; d < 4; ++d) o[d][r] *= a_; } } \
    SB(); \
    if (!(LAST)) { QK8(PY0, PY1, ((j) + 1) & 1); } \
    { const float mnp_ = mn_ - 7.f; EXPC(PX0, mnp_, 0, 16); EXPC(PX1, mnp_, 0, 16); }     \
    SB(); \
    { float ps_ = 0.f; \
      _Pragma("unroll") for (int r = 0; r < 16; ++r) ps_ += PX0[r] + PX1[r]; \
      auto rr_ = __builtin_amdgcn_permlane32_swap(__float_as_uint(ps_), __float_as_uint(ps_), false, false); \
      l_reg = l_reg * alpha_ + __uint_as_float(rr_[0]) + __uint_as_float(rr_[1]); } \
    i32x8 pf_; \
    _Pragma("unroll") for (int g = 0; g < 4; ++g) { \
      const u32 x_ = pack4_fp8(PX0[4 * g], PX0[4 * g + 1], PX0[4 * g + 2], PX0[4 * g + 3]); \
      const u32 y_ = pack4_fp8(PX1[4 * g], PX1[4 * g + 1], PX1[4 * g + 2], PX1[4 * g + 3]); \
      auto sw_ = __builtin_amdgcn_permlane32_swap(x_, y_, false, false); pf_[2 * g] = (int)sw_[0]; pf_[2 * g + 1] = (int)sw_[1]; } \
    SB(); \
    { const int r_ = r32, h_ = hi, sw2_ = (r_ >> 2) & 3; \
      const char* Vr_ = lds + VOFF + ((j) & 1) * VSTAGE + r_ * 64; const int c0_ = ((h_ * 2) ^ sw2_) << 4, c1_ = ((h_ * 2 + 1) ^ sw2_) << 4; \
      _Pragma("unroll") for (int d0 = 0; d0 < 4; ++d0) { \
        const u32x4 a0_ = *(const u32x4*)(Vr_ + d0 * 2048 + c0_), a1_ = *(const u32x4*)(Vr_ + d0 * 2048 + c1_); \
        const i32x8 vf_ = {(int)a0_[0], (int)a0_[1], (int)a0_[2], (int)a0_[3], (int)a1_[0], (int)a1_[1], (int)a1_[2], (int)a1_[3]}; \
        o[d0] = MFMA8(pf_, vf_, o[d0], SC_P, SC_V); } } \
    if (!(LAST)) PMY = rowmax32(PY0, PY1); \
    asm volatile("s_waitcnt vmcnt(0)" ::: "memory"); } while (0)

  for (int j = 0; j < NT - 2; j += 2) {
    STEP(j, pA0, pA1, pmaxA, pB0, pB1, pmaxB, false);
    STEP(j + 1, pB0, pB1, pmaxB, pA0, pA1, pmaxA, false);
  }
  STEP(NT - 2, pA0, pA1, pmaxA, pB0, pB1, pmaxB, false);
  STEP(NT - 1, pB0, pB1, pmaxB, pA0, pA1, pmaxA, true);
#undef STEP
#undef QK8
#undef PZERO
#undef EXPC
#undef SB
#undef GLK
#undef GLV
#pragma unroll
  for (int r = 0; r < 16; ++r) {
    const int qrow = crow(r, hi); const float rl = 1.f / lane_bcast(l_reg, qrow);
    u16* o_ = p.o + obase + (long)qrow * 1024 + r32;
#pragma unroll
    for (int d = 0; d < 4; ++d) o_[d * 32] = (u16)(cvtpk(o[d][r] * rl, 0.f) & 0xffffu);
  }
}

typedef __attribute__((ext_vector_type(2))) float f32x2;
constexpr float U_SCALE = 256.f, V_SCALE = 64.f;
__device__ __forceinline__ float keyval(u32 k) { return __uint_as_float(k & ~127u) - KEY_BIAS; }
template <int CTRL> __device__ __forceinline__ float dppf(float v) { return __int_as_float(__builtin_amdgcn_update_dpp(0, __float_as_int(v), CTRL, 0xF, 0xF, true)); }
__device__ __forceinline__ float red16(float v) { v += dppf<0xB1>(v); v += dppf<0x4E>(v); v += dppf<0x141>(v); v += dppf<0x140>(v); return v; }
__device__ __forceinline__ void fp8dot(u32 dw, const f32x4& x, f32x2& acc) {
  const f32x2 lo = __builtin_amdgcn_cvt_pk_f32_fp8((int)dw, false), hi = __builtin_amdgcn_cvt_pk_f32_fp8((int)dw, true);
  acc = __builtin_elementwise_fma(lo, (f32x2){x[0], x[1]}, acc); acc = __builtin_elementwise_fma(hi, (f32x2){x[2], x[3]}, acc);
}

#ifndef PEER_FP4
#define PEER_FP4 1
#endif
#if PEER_FP4
constexpr float U4_SCALE = 96.f, V4_SCALE = 22.f;
__device__ __forceinline__ void fp4dot(u32 dw, const f32x4& x0, const f32x4& x1, f32x2& acc) {
  acc = __builtin_elementwise_fma(__builtin_amdgcn_cvt_scalef32_pk_f32_fp4(dw, 1.0f, 0), (f32x2){x0[0], x0[1]}, acc);
  acc = __builtin_elementwise_fma(__builtin_amdgcn_cvt_scalef32_pk_f32_fp4(dw, 1.0f, 1), (f32x2){x0[2], x0[3]}, acc);
  acc = __builtin_elementwise_fma(__builtin_amdgcn_cvt_scalef32_pk_f32_fp4(dw, 1.0f, 2), (f32x2){x1[0], x1[1]}, acc);
  acc = __builtin_elementwise_fma(__builtin_amdgcn_cvt_scalef32_pk_f32_fp4(dw, 1.0f, 3), (f32x2){x1[2], x1[3]}, acc);
}
__device__ __forceinline__ void phase_peer_combine(KP p, int layer, char* lds, unsigned* ctr) {
  const bool last = (layer == 3);
  int tid_ = threadIdx.x; asm volatile("" : "+v"(tid_));
  const int tid = tid_, lane = tid & 63, w = tid >> 6;
  int* eL = (int*)(lds + w * 1536); float* gL = (float*)(lds + w * 1536 + 512); float* wL = (float*)(lds + w * 1536 + 1024);
  int ci = 0, cj = 0; bool cvalid = false;
  { int cnt = 0;
#pragma unroll
    for (int i = 0; i < 16; ++i) { const int n = 16 / (i + 1); if (!cvalid && lane < cnt + n) { ci = i; cj = lane - cnt; cvalid = true; } cnt += n; } }
  const unsigned char* U = p.peer_u8 + (long)layer * 16384 * 512; const unsigned char* V = p.peer_v8 + (long)layer * 16384 * 512;
  const int sub = lane & 15, grp = lane >> 4, l32 = lane & 31, hf = lane >> 5;
  __syncthreads();
  for (;;) {
   int base_ = 0; if (lane == 0) base_ = (int)atomicAdd(ctr, 4u);
   base_ = __builtin_amdgcn_readfirstlane(base_);
   if (base_ >= T_TOK) break;
#pragma unroll 1
   for (int t = base_; t < base_ + 4; ++t) {
    float* xr = p.x + (long)t * DM;
    const u32* pk = p.pkeys + (long)t * 256;
    u32 ka[8], kb[8];
#pragma unroll
    for (int hd = 0; hd < 8; ++hd) { ka[hd] = pk[hd * 32 + ci]; kb[hd] = pk[hd * 32 + 16 + cj]; }
    u32 xe[2][4], xo[2][4]; int sumx = 0; float rstd, sx;
    f32x4 xs[2][8];
#pragma unroll
    for (int j = 0; j < 2; ++j)
#pragma unroll
      for (int q = 0; q < 8; ++q) xs[j][q] = *(const f32x4*)(xr + (sub + 16 * j) * 32 + q * 4);
#pragma unroll
    for (int hd = 0; hd < 8; ++hd) {
      const float cand = cvalid ? keyval(ka[hd]) + keyval(kb[hd]) : -3.0e38f;
      u32 ck = __float_as_uint(cand); ck = (ck & 0x80000000u) ? ~ck : (ck | 0x80000000u); ck = (ck & ~63u) | (u32)(63 - lane);
      int rank = 0;
#pragma unroll
      for (int m = 0; m < 50; ++m) { const u32 c = __builtin_amdgcn_readlane(ck, m); rank += (c > ck) ? 1 : 0; }
      const float cmax = __uint_as_float(__builtin_amdgcn_readlane(__float_as_uint(cand), 0));
      if (cvalid && rank < 16) { eL[hd * 16 + rank] = (int)((ka[hd] & 127u) * 128u + (kb[hd] & 127u)); gL[hd * 16 + rank] = __expf(cand - cmax); }
    }
    __builtin_amdgcn_wave_barrier();
    { const float g0 = gL[lane], g1 = gL[lane + 64]; const float s0 = red16(g0), s1 = red16(g1);
      __builtin_amdgcn_wave_barrier();
      gL[lane] = g0 / s0; gL[lane + 64] = g1 / s1; }
    __builtin_amdgcn_wave_barrier();
    u32x4 cA[8], cB[8];
#define LOADU(C, it) do { const int k0_ = (it) * 16 + grp * 4; \
      _Pragma("unroll") for (int rr = 0; rr < 4; ++rr) { const int e_ = eL[k0_ + rr]; const unsigned char* u_ = U + (long)e_ * 512 + sub * 16; \
        C[rr * 2] = *(const u32x4*)u_; C[rr * 2 + 1] = *(const u32x4*)(u_ + 256); } } while (0)
#define COMPU(C, it) do { const int k0_ = (it) * 16 + grp * 4; \
      _Pragma("unroll") for (int rr = 0; rr < 4; ++rr) { int a_ = 0; \
        _Pragma("unroll") for (int j = 0; j < 2; ++j) { _Pragma("unroll") for (int d = 0; d < 4; ++d) { const u32 dw_ = C[rr * 2 + j][d]; \
          a_ = __builtin_amdgcn_sdot4((int)(dw_ & 0x0F0F0F0Fu), (int)xe[j][d], a_, false); a_ = __builtin_amdgcn_sdot4((int)((dw_ >> 4) & 0x0F0F0F0Fu), (int)xo[j][d], a_, false); } } \
        const float r_ = red16((float)(a_ - 8 * sumx)); \
        if (sub == 0) wL[k0_ + rr] = r_; } } while (0)
#define LOADV(C, g) do { _Pragma("unroll") for (int i = 0; i < 8; ++i) { const int e_ = eL[(g) * 16 + 2 * i + hf]; \
      C[i] = *(const u32x4*)(V + (long)e_ * 512 + l32 * 16); } } while (0)
#define COMPV(C, g) do { _Pragma("unroll") for (int i = 0; i < 8; ++i) { const float wk_ = wL[(g) * 16 + 2 * i + hf]; const f32x2 w2_ = {wk_, wk_}; \
      _Pragma("unroll") for (int d = 0; d < 4; ++d) { const u32 dw_ = C[i][d]; \
        out[d * 4 + 0] = __builtin_elementwise_fma(__builtin_amdgcn_cvt_scalef32_pk_f32_fp4(dw_, 1.0f, 0), w2_, out[d * 4 + 0]); \
        out[d * 4 + 1] = __builtin_elementwise_fma(__builtin_amdgcn_cvt_scalef32_pk_f32_fp4(dw_, 1.0f, 1), w2_, out[d * 4 + 1]); \
        out[d * 4 + 2] = __builtin_elementwise_fma(__builtin_amdgcn_cvt_scalef32_pk_f32_fp4(dw_, 1.0f, 2), w2_, out[d * 4 + 2]); \
        out[d * 4 + 3] = __builtin_elementwise_fma(__builtin_amdgcn_cvt_scalef32_pk_f32_fp4(dw_, 1.0f, 3), w2_, out[d * 4 + 3]); } } } while (0)
    LOADU(cA, 0);
    { float ss = 0.f, am = 0.f;
#pragma unroll
      for (int j = 0; j < 2; ++j)
#pragma unroll
        for (int q = 0; q < 8; ++q) { const f32x4 a = xs[j][q]; ss += a[0] * a[0] + a[1] * a[1] + a[2] * a[2] + a[3] * a[3];
          am = fmaxf(fmaxf(am, fmaxf(fabsf(a[0]), fabsf(a[1]))), fmaxf(fabsf(a[2]), fabsf(a[3]))); }
      ss = red16(ss);
      am = fmaxf(am, dppf<0xB1>(am)); am = fmaxf(am, dppf<0x4E>(am)); am = fmaxf(am, dppf<0x141>(am)); am = fmaxf(am, dppf<0x140>(am));
      rstd = rsqrtf(ss * (1.f / DM) + RMS_EPS);
      am = fmaxf(am, 1e-20f); sx = am * (1.f / 127.f); const float inv = 127.f / am;
#pragma unroll
      for (int j = 0; j < 2; ++j)
#pragma unroll
        for (int d = 0; d < 4; ++d) {
          const f32x4 lo4 = xs[j][2 * d], hi4 = xs[j][2 * d + 1];
          const int i0 = (int)__builtin_rintf(lo4[0] * inv), i1 = (int)__builtin_rintf(lo4[1] * inv), i2 = (int)__builtin_rintf(lo4[2] * inv), i3 = (int)__builtin_rintf(lo4[3] * inv);
          const int i4 = (int)__builtin_rintf(hi4[0] * inv), i5 = (int)__builtin_rintf(hi4[1] * inv), i6 = (int)__builtin_rintf(hi4[2] * inv), i7 = (int)__builtin_rintf(hi4[3] * inv);
          sumx += i0 + i1 + i2 + i3 + i4 + i5 + i6 + i7;
          xe[j][d] = (u32)(i0 & 0xFF) | ((u32)(i2 & 0xFF) << 8) | ((u32)(i4 & 0xFF) << 16) | ((u32)i6 << 24);
          xo[j][d] = (u32)(i1 & 0xFF) | ((u32)(i3 & 0xFF) << 8) | ((u32)(i5 & 0xFF) << 16) | ((u32)i7 << 24);
        } }
#pragma unroll 1
    for (int it = 0; it < 6; it += 2) { LOADU(cB, it + 1); COMPU(cA, it); LOADU(cA, it + 2); COMPU(cB, it + 1); }
    LOADU(cB, 7); COMPU(cA, 6);
    LOADV(cA, 0);
    COMPU(cB, 7);
    __builtin_amdgcn_wave_barrier();
    { const float sc_ = rstd * sx * (1.f / U4_SCALE); const float a0 = wL[lane] * sc_, a1 = wL[lane + 64] * sc_;
      const float w0 = gL[lane] * 0.5f * a0 * (1.f + erff(a0 * 0.70710678118654752f)), w1 = gL[lane + 64] * 0.5f * a1 * (1.f + erff(a1 * 0.70710678118654752f));
      __builtin_amdgcn_wave_barrier();
      wL[lane] = w0; wL[lane + 64] = w1; }
    __builtin_amdgcn_wave_barrier();
    f32x2 out[16];
#pragma unroll
    for (int i = 0; i < 16; ++i) out[i] = (f32x2){0.f, 0.f};
#pragma unroll 1
    for (int g = 0; g < 6; g += 2) { LOADV(cB, g + 1); COMPV(cA, g); LOADV(cA, g + 2); COMPV(cB, g + 1); }
    LOADV(cB, 7); COMPV(cA, 6); COMPV(cB, 7);
#undef LOADU
#undef COMPU
#undef LOADV
#undef COMPV
    {
      f32x4 v[4];
#pragma unroll
      for (int q = 0; q < 4; ++q) {
        const f32x2 m0 = hf ? out[8 + 2 * q] : out[2 * q], o0 = hf ? out[2 * q] : out[8 + 2 * q];
        const f32x2 m1 = hf ? out[8 + 2 * q + 1] : out[2 * q + 1], o1 = hf ? out[2 * q + 1] : out[8 + 2 * q + 1];
        v[q] = (f32x4){m0[0] + shx(o0[0], 32), m0[1] + shx(o0[1], 32), m1[0] + shx(o1[0], 32), m1[1] + shx(o1[1], 32)};
      }
      f32x4* xo = (f32x4*)(xr + l32 * 32 + hf * 16);
#pragma unroll
      for (int q = 0; q < 4; ++q) { const f32x4 xv = xo[q]; v[q] = xv + v[q] * (1.f / V4_SCALE); }
      __builtin_amdgcn_wave_barrier();
      if (last) {
        float s2 = 0.f;
#pragma unroll
        for (int q = 0; q < 4; ++q) s2 += v[q][0] * v[q][0] + v[q][1] * v[q][1] + v[q][2] * v[q][2] + v[q][3] * v[q][3];
        s2 = red16(s2); s2 += shx(s2, 16); s2 += shx(s2, 32);
        const float rf = rsqrtf(s2 * (1.f / DM) + RMS_EPS);
#pragma unroll
        for (int q = 0; q < 4; ++q) { const f32x4 gf = *(const f32x4*)(p.norm_final + l32 * 32 + hf * 16 + q * 4); v[q] = v[q] * rf * gf; }
      }
#pragma unroll
      for (int q = 0; q < 4; ++q) xo[q] = v[q];
      u32x4* xbo = (u32x4*)(p.xb + (long)t * DM + l32 * 32 + hf * 16);
      xbo[0] = (u32x4){cvtpk(v[0][0], v[0][1]), cvtpk(v[0][2], v[0][3]), cvtpk(v[1][0], v[1][1]), cvtpk(v[1][2], v[1][3])};
      xbo[1] = (u32x4){cvtpk(v[2][0], v[2][1]), cvtpk(v[2][2], v[2][3]), cvtpk(v[3][0], v[3][1]), cvtpk(v[3][2], v[3][3])}; }
    __builtin_amdgcn_wave_barrier();
   }
  }
}
#else
__device__ __forceinline__ void phase_peer_combine(KP p, int layer, char* lds, unsigned*) {
  const bool last = (layer == 3);
  int tid_ = threadIdx.x; asm volatile("" : "+v"(tid_));
  const int tid = tid_, lane = tid & 63, w = tid >> 6;
  int* eL = (int*)(lds + w * 1536); float* gL = (float*)(lds + w * 1536 + 512); float* wL = (float*)(lds + w * 1536 + 1024);
  int ci = 0, cj = 0; bool cvalid = false;
  { int cnt = 0;
#pragma unroll
    for (int i = 0; i < 16; ++i) { const int n = 16 / (i + 1); if (!cvalid && lane < cnt + n) { ci = i; cj = lane - cnt; cvalid = true; } cnt += n; } }
  const unsigned char* U = p.peer_u8 + (long)layer * 16384 * 1024; const unsigned char* V = p.peer_v8 + (long)layer * 16384 * 1024;
  const int sub = lane & 15, grp = lane >> 4;
  __syncthreads();
  for (int t = blockIdx.x * 4 + w; t < T_TOK; t += gridDim.x * 4) {
    float* xr = p.x + (long)t * DM;
    const u32* pk = p.pkeys + (long)t * 256;
    u32 ka[8], kb[8];
#pragma unroll
    for (int hd = 0; hd < 8; ++hd) { ka[hd] = pk[hd * 32 + ci]; kb[hd] = pk[hd * 32 + 16 + cj]; }
    f32x4 xs[4][4]; float ss = 0.f;
#pragma unroll
    for (int i = 0; i < 4; ++i)
#pragma unroll
      for (int q = 0; q < 4; ++q) { const f32x4 a = *(const f32x4*)(xr + (sub + 16 * i) * 16 + q * 4); xs[i][q] = a; ss += a[0] * a[0] + a[1] * a[1] + a[2] * a[2] + a[3] * a[3]; }
    ss = red16(ss);
    const float rstd = rsqrtf(ss * (1.f / DM) + RMS_EPS);
#pragma unroll
    for (int hd = 0; hd < 8; ++hd) {
      const float cand = cvalid ? keyval(ka[hd]) + keyval(kb[hd]) : -3.0e38f;
      u32 ck = __float_as_uint(cand); ck = (ck & 0x80000000u) ? ~ck : (ck | 0x80000000u); ck = (ck & ~63u) | (u32)(63 - lane);
      int rank = 0;
#pragma unroll
      for (int m = 0; m < 50; ++m) { const u32 c = __builtin_amdgcn_readlane(ck, m); rank += (c > ck) ? 1 : 0; }
      const float cmax = __uint_as_float(__builtin_amdgcn_readlane(__float_as_uint(cand), 0));
      if (cvalid && rank < 16) { eL[hd * 16 + rank] = (int)((ka[hd] & 127u) * 128u + (kb[hd] & 127u)); gL[hd * 16 + rank] = __expf(cand - cmax); }
    }
    __builtin_amdgcn_wave_barrier();
    { const float g0 = gL[lane], g1 = gL[lane + 64]; const float s0 = red16(g0), s1 = red16(g1);
      __builtin_amdgcn_wave_barrier();
      gL[lane] = g0 / s0; gL[lane + 64] = g1 / s1; }
    __builtin_amdgcn_wave_barrier();
    u32x4 cA[8], cB[8];
#define LOADU(C, it) do { const int k0_ = (it) * 8 + grp * 2; const int e0_ = eL[k0_], e1_ = eL[k0_ + 1]; \
      const unsigned char* u0_ = U + (long)e0_ * 1024 + sub * 16; const unsigned char* u1_ = U + (long)e1_ * 1024 + sub * 16; \
      _Pragma("unroll") for (int i = 0; i < 4; ++i) { C[i] = *(const u32x4*)(u0_ + i * 256); C[4 + i] = *(const u32x4*)(u1_ + i * 256); } } while (0)
#define COMPU(C, it) do { const int k0_ = (it) * 8 + grp * 2; f32x2 a0_ = {0.f, 0.f}, a1_ = {0.f, 0.f}; \
      _Pragma("unroll") for (int i = 0; i < 4; ++i) { _Pragma("unroll") for (int q = 0; q < 4; ++q) { fp8dot(C[i][q], xs[i][q], a0_); fp8dot(C[4 + i][q], xs[i][q], a1_); } } \
      const float r0_ = red16(a0_[0] + a0_[1]), r1_ = red16(a1_[0] + a1_[1]); \
      if (sub == 0) { const float aa_ = r0_ * rstd * (1.f / U_SCALE), ab_ = r1_ * rstd * (1.f / U_SCALE); \
        wL[k0_] = gL[k0_] * 0.5f * aa_ * (1.f + erff(aa_ * 0.70710678118654752f)); \
        wL[k0_ + 1] = gL[k0_ + 1] * 0.5f * ab_ * (1.f + erff(ab_ * 0.70710678118654752f)); } } while (0)
#define LOADV(C, g) do { _Pragma("unroll") for (int i = 0; i < 8; ++i) { const int e_ = eL[(g) * 8 + i]; C[i] = *(const u32x4*)(V + (long)e_ * 1024 + lane * 16); } } while (0)
#define COMPV(C, g) do { _Pragma("unroll") for (int i = 0; i < 8; ++i) { const float wk_ = wL[(g) * 8 + i]; const f32x2 w2_ = {wk_, wk_}; \
      _Pragma("unroll") for (int q = 0; q < 4; ++q) { \
        const f32x2 lo_ = __builtin_amdgcn_cvt_pk_f32_fp8((int)C[i][q], false), hi_ = __builtin_amdgcn_cvt_pk_f32_fp8((int)C[i][q], true); \
        out[2 * q] = __builtin_elementwise_fma(lo_, w2_, out[2 * q]); out[2 * q + 1] = __builtin_elementwise_fma(hi_, w2_, out[2 * q + 1]); } } } while (0)
    LOADU(cA, 0);
#pragma unroll 1
    for (int it = 0; it < 14; it += 2) { LOADU(cB, it + 1); COMPU(cA, it); LOADU(cA, it + 2); COMPU(cB, it + 1); }
    LOADU(cB, 15); COMPU(cA, 14);
    LOADV(cA, 0);
    COMPU(cB, 15);
    __builtin_amdgcn_wave_barrier();
    f32x2 out[8];
#pragma unroll
    for (int i = 0; i < 8; ++i) out[i] = (f32x2){0.f, 0.f};
#pragma unroll 1
    for (int g = 0; g < 14; g += 2) { LOADV(cB, g + 1); COMPV(cA, g); LOADV(cA, g + 2); COMPV(cB, g + 1); }
    LOADV(cB, 15); COMPV(cA, 14); COMPV(cB, 15);
#undef LOADU
#undef COMPU
#undef LOADV
#undef COMPV
    { f32x4* xo = (f32x4*)(xr + lane * 16);
      f32x4 v[4];
#pragma unroll
      for (int q = 0; q < 4; ++q) { v[q] = xo[q]; v[q][0] += out[2 * q][0] * (1.f / V_SCALE); v[q][1] += out[2 * q][1] * (1.f / V_SCALE); v[q][2] += out[2 * q + 1][0] * (1.f / V_SCALE); v[q][3] += out[2 * q + 1][1] * (1.f / V_SCALE); }
      __builtin_amdgcn_wave_barrier();
      if (last) {
        float s2 = 0.f;
#pragma unroll
        for (int q = 0; q < 4; ++q) s2 += v[q][0] * v[q][0] + v[q][1] * v[q][1] + v[q][2] * v[q][2] + v[q][3] * v[q][3];
        s2 = red16(s2); s2 += shx(s2, 16); s2 += shx(s2, 32);
        const float rf = rsqrtf(s2 * (1.f / DM) + RMS_EPS);
#pragma unroll
        for (int q = 0; q < 4; ++q) { const f32x4 gf = *(const f32x4*)(p.norm_final + lane * 16 + q * 4); v[q] = v[q] * rf * gf; }
      }
#pragma unroll
      for (int q = 0; q < 4; ++q) xo[q] = v[q];
      u32x4* xbo = (u32x4*)(p.xb + (long)t * DM + lane * 16);
      xbo[0] = (u32x4){cvtpk(v[0][0], v[0][1]), cvtpk(v[0][2], v[0][3]), cvtpk(v[1][0], v[1][1]), cvtpk(v[1][2], v[1][3])};
      xbo[1] = (u32x4){cvtpk(v[2][0], v[2][1]), cvtpk(v[2][2], v[2][3]), cvtpk(v[3][0], v[3][1]), cvtpk(v[3][2], v[3][3])}; }
    __builtin_amdgcn_wave_barrier();
  }
}

#endif

__device__ __forceinline__ void phase_prep(KP p, char* lds) {
  int tid_ = threadIdx.x; asm volatile("" : "+v"(tid_));
  const int tid = tid_;
  const long gtid = (long)blockIdx.x * NTHR + tid, gsz = (long)gridDim.x * NTHR;
  float* tl = (float*)lds;
  for (int t = blockIdx.x; t < p.ntiles_prep; t += gridDim.x) {
    int j = 0;
    while (j + 1 < p.njobs && t >= p.jobs[j + 1].tile0) ++j;
    const float* src = p.jobs[j].src; u16* dst = p.jobs[j].dst; const float* gain = p.jobs[j].gain;
    const int K = p.jobs[j].K, N = p.jobs[j].N, scale_cols = p.jobs[j].scale_cols; const float scale = p.jobs[j].scale;
    const int lt = t - p.jobs[j].tile0, ntn = N >> 6, kt = lt / ntn, nt = lt - kt * ntn;
    __syncthreads();
    for (int e = tid; e < 4096; e += 256) { const int kk = e >> 6, nn = e & 63, k = kt * 64 + kk; const float g = gain ? gain[k] : 1.f; tl[kk * 65 + nn] = src[(long)k * N + nt * 64 + nn] * g; }
    __syncthreads();
    for (int e = tid; e < 2048; e += 256) { const int nn = e >> 5, kp = (e & 31) * 2, n = nt * 64 + nn; const float s = (n < scale_cols) ? scale : 1.f;
      *(u32*)(dst + (long)n * K + kt * 64 + kp) = cvtpk(tl[kp * 65 + nn] * s, tl[(kp + 1) * 65 + nn] * s); }
  }
  for (long i = gtid; i < (long)T_TOK * DM / 4; i += gsz) {
    const long e = i * 4; const f32x4 v = e < (long)T_PROMPT * DM ? *(const f32x4*)(p.xin0 + e) : *(const f32x4*)(p.xin1 + (e - (long)T_PROMPT * DM));
    *(f32x4*)(p.x + e) = v; *(u32*)(p.xb + e) = cvtpk(v[0], v[1]); *(u32*)(p.xb + e + 2) = cvtpk(v[2], v[3]); }
  for (long i = gtid; i < 4L * 8 * 2 * 128 * 128 / 2; i += gsz) { const float a = p.in_sub_keys[2 * i], b = p.in_sub_keys[2 * i + 1]; *(u32*)(p.peer_sk + 2 * i) = cvtpk(a, b); }
#if PEER_FP4
#define Q4(val) ((u32)(int)(fminf(fmaxf(__builtin_rintf((val) * U4_SCALE), -8.f), 7.f) + 8.f))
  for (long i = gtid; i < 4L * 16384 * 1024 / 16; i += gsz) {
    const long e = i * 16; const int layer = (int)(e >> 24); const int d = (int)(e & 1023);
    u32 uo[2], vo[2];
#pragma unroll
    for (int h = 0; h < 2; ++h) {
      u32 a = 0, b = 0;
#pragma unroll
      for (int q = 0; q < 2; ++q) {
        const f32x4 g = *(const f32x4*)(p.in_norm_ffn + layer * 1024 + d + h * 8 + q * 4);
        const f32x4 u = *(const f32x4*)(p.in_peer_u + e + h * 8 + q * 4), v = *(const f32x4*)(p.in_peer_v + e + h * 8 + q * 4);
        if (q == 0) {
          a |= Q4(u[0] * g[0]) | (Q4(u[1] * g[1]) << 4) | (Q4(u[2] * g[2]) << 8) | (Q4(u[3] * g[3]) << 12);
          b = __builtin_amdgcn_cvt_scalef32_pk_fp4_f32(b, v[0] * V4_SCALE, v[1] * V4_SCALE, 1.0f, 0); b = __builtin_amdgcn_cvt_scalef32_pk_fp4_f32(b, v[2] * V4_SCALE, v[3] * V4_SCALE, 1.0f, 1);
        } else {
          a |= (Q4(u[0] * g[0]) << 16) | (Q4(u[1] * g[1]) << 20) | (Q4(u[2] * g[2]) << 24) | (Q4(u[3] * g[3]) << 28);
          b = __builtin_amdgcn_cvt_scalef32_pk_fp4_f32(b, v[0] * V4_SCALE, v[1] * V4_SCALE, 1.0f, 2); b = __builtin_amdgcn_cvt_scalef32_pk_fp4_f32(b, v[2] * V4_SCALE, v[3] * V4_SCALE, 1.0f, 3);
        }
      }
      uo[h] = a; vo[h] = b;
    }
    *(u32x2*)(p.peer_u8 + (e >> 1)) = (u32x2){uo[0], uo[1]}; *(u32x2*)(p.peer_v8 + (e >> 1)) = (u32x2){vo[0], vo[1]};
  }
#else
  for (long i = gtid; i < 4L * 16384 * 1024 / 16; i += gsz) {
    const long e = i * 16; const int layer = (int)(e >> 24); const int d = (int)(e & 1023);
    u32x4 uo, vo;
#pragma unroll
    for (int q = 0; q < 4; ++q) {
      const f32x4 g = *(const f32x4*)(p.in_norm_ffn + layer * 1024 + d + q * 4);
      const f32x4 u = *(const f32x4*)(p.in_peer_u + e + q * 4), v = *(const f32x4*)(p.in_peer_v + e + q * 4);
      int a = 0, b = 0;
      a = __builtin_amdgcn_cvt_pk_fp8_f32(u[0] * g[0] * U_SCALE, u[1] * g[1] * U_SCALE, a, false); a = __builtin_amdgcn_cvt_pk_fp8_f32(u[2] * g[2] * U_SCALE, u[3] * g[3] * U_SCALE, a, true);
      b = __builtin_amdgcn_cvt_pk_fp8_f32(v[0] * V_SCALE, v[1] * V_SCALE, b, false); b = __builtin_amdgcn_cvt_pk_fp8_f32(v[2] * V_SCALE, v[3] * V_SCALE, b, true);
      uo[q] = (u32)a; vo[q] = (u32)b;
    }
    *(u32x4*)(p.peer_u8 + e) = uo; *(u32x4*)(p.peer_v8 + e) = vo;
  }
#endif
  for (long i = gtid; i < 2 * 3072; i += gsz) { const int c = (int)(i % 3072); p.na_bias_s[i] = p.in_na_bias[i] * (c < 1024 ? 0.125f * LOG2E : 1.f); }
  for (long i = gtid; i < 2 * 16 * 465; i += gsz) p.na_rpb_s[i] = p.in_na_rpb[i] * LOG2E;
  for (long i = gtid; i < 16384L * 32; i += gsz) {
    const int pos = (int)(i >> 5), jf = (int)(i & 31);
    const double a = (double)pos * p.inv_freq[jf] * 0.15915494309189535;
    const double fr = a - rint(a);
    const float f = (float)fr;
    p.ropeC[i] = __builtin_amdgcn_cosf(f); p.ropeS[i] = __builtin_amdgcn_sinf(f);
  }
  for (long i = gtid; i < 2L * 64 * 1024 / 2; i += gsz) { const int l = (int)(i >> 15); const long e = (i & 32767) * 2; *(u32*)(p.wa_t[l] + 704L * 1024 + e) = 0u; }
}

__device__ __forceinline__ void phase_final(KP p) {
  int tid_ = threadIdx.x; asm volatile("" : "+v"(tid_));
  const int lane = tid_ & 63, w = tid_ >> 6;
  for (int t = blockIdx.x * 4 + w; t < T_TOK; t += gridDim.x * 4) {
    float* xr = p.x + (long)t * DM;
    f32x4 v[4]; float ss = 0.f;
#pragma unroll
    for (int i = 0; i < 4; ++i) { v[i] = *(const f32x4*)(xr + i * 256 + lane * 4); ss += v[i][0] * v[i][0] + v[i][1] * v[i][1] + v[i][2] * v[i][2] + v[i][3] * v[i][3]; }
    ss += shx(ss, 1); ss += shx(ss, 2); ss += shx(ss, 4); ss += shx(ss, 8); ss += shx(ss, 16); ss += shx(ss, 32);
    const float rs = rsqrtf(ss * (1.f / DM) + RMS_EPS);
#pragma unroll
    for (int i = 0; i < 4; ++i) { const f32x4 g = *(const f32x4*)(p.norm_final + i * 256 + lane * 4); f32x4 o_ = {v[i][0] * rs * g[0], v[i][1] * rs * g[1], v[i][2] * rs * g[2], v[i][3] * rs * g[3]}; *(f32x4*)(xr + i * 256 + lane * 4) = o_; }
  }
}

template <int EPI>
__device__ __forceinline__ void gemm_big(KP p, int layer, const u16* Ap, int lda, const u16* Bt, int K, int m0, int n0, char* lds) {
  int tid_ = threadIdx.x; asm volatile("" : "+v"(tid_));
  const int tid = tid_, lane = tid & 63, w = tid >> 6;
  const int wm = w >> 1, wn = w & 1, r32 = lane & 31, hi = lane >> 5;
  constexpr int STG = 24576;
  const int scol = ((lane & 3) ^ ((lane >> 4) & 3)) * 8;
  const u16* Ag = Ap + (long)(m0 + w * 64 + (lane >> 2)) * lda + scol;
  const u16* Bg = Bt + (long)(n0 + w * 32 + (lane >> 2)) * K + scol;
#define GST(st, kt) do { int w_ = w; asm volatile("" : "+v"(w_)); \
    _Pragma("unroll") for (int i = 0; i < 4; ++i) __builtin_amdgcn_global_load_lds((const unsigned*)(Ag + (long)i * 16 * lda + (kt) * 32), (unsigned*)(lds + (st) * STG + (w_ * 4 + i) * 1024), 16, 0, 0); \
    _Pragma("unroll") for (int i = 0; i < 2; ++i) __builtin_amdgcn_global_load_lds((const unsigned*)(Bg + (long)i * 16 * K + (kt) * 32), (unsigned*)(lds + (st) * STG + 16384 + (w_ * 2 + i) * 1024), 16, 0, 0); } while (0)
  f32x16 acc[4][2];
#pragma unroll
  for (int i = 0; i < 4; ++i)
#pragma unroll
    for (int j = 0; j < 2; ++j)
#pragma unroll
      for (int r = 0; r < 16; ++r) acc[i][j][r] = 0.f;
  float ssq[4] = {0.f, 0.f, 0.f, 0.f};
  const int sw = (r32 >> 2) & 3;
  const int arow = (wm * 128 + r32) * 64, brow = 16384 + (wn * 64 + r32) * 64;
  const int nk = K / 32;
  __syncthreads();
  GST(0, 0); GST(1, 1);
  int st = 0;
  for (int kt = 0; kt < nk; ++kt) {
    if (kt + 1 < nk) asm volatile("s_waitcnt vmcnt(6)" ::: "memory"); else asm volatile("s_waitcnt vmcnt(0)" ::: "memory");
    asm volatile("s_waitcnt lgkmcnt(0)" ::: "memory");
    __builtin_amdgcn_s_barrier();
    if (kt + 2 < nk) { const int s2 = st + 2 >= 3 ? st - 1 : st + 2; GST(s2, kt + 2); }
    const char* base = lds + st * STG;
#pragma unroll
    for (int ks = 0; ks < 2; ++ks) {
      const int co = ((ks * 2 + hi) ^ sw) << 4;
      bf16x8 a[4], b[2];
#pragma unroll
      for (int mi = 0; mi < 4; ++mi) a[mi] = *(const bf16x8*)(base + arow + mi * 2048 + co);
#pragma unroll
      for (int ni = 0; ni < 2; ++ni) b[ni] = *(const bf16x8*)(base + brow + ni * 2048 + co);
#pragma unroll
      for (int mi = 0; mi < 4; ++mi) { acc[mi][0] = mfma32(b[0], a[mi], acc[mi][0]); acc[mi][1] = mfma32(b[1], a[mi], acc[mi][1]); }
#pragma unroll
      for (int mi = 0; mi < 4; ++mi) { const u32x4 x = __builtin_bit_cast(u32x4, a[mi]);
#pragma unroll
        for (int q = 0; q < 4; ++q) ssq[mi] = dot2bf(x[q], x[q], ssq[mi]); }
    }
    st = st == 2 ? 0 : st + 1;
  }
#undef GST
  __syncthreads();
  float rs[4];
#pragma unroll
  for (int mi = 0; mi < 4; ++mi) { const float t = ssq[mi] + shx(ssq[mi], 32); rs[mi] = rsqrtf(t / (float)K + RMS_EPS); }
  const int rowb = wm * 128, colb = wn * 64;
  if constexpr (EPI == EPI_A || EPI == EPI_QKV) {
    constexpr int OROW = 272;
    u16* outp; int ldo; bool rope = false;
    if constexpr (EPI == EPI_A) { outp = p.cqkv; ldo = 768; rope = (n0 + colb == 640); }
    else { outp = p.qkv; ldo = 3072; }
#pragma unroll
    for (int mi = 0; mi < 4; ++mi) {
      const int rl = rowb + mi * 32 + r32; const int pos = tok_pos(m0 + rl);
#pragma unroll
      for (int g = 0; g < 4; ++g) {
        f32x4 v0, v1;
#pragma unroll
        for (int e = 0; e < 4; ++e) { v0[e] = acc[mi][0][4 * g + e] * rs[mi]; v1[e] = acc[mi][1][4 * g + e] * rs[mi]; }
        if constexpr (EPI == EPI_QKV) {
          const f32x4 b0 = *(const f32x4*)(p.na_bias_s + layer * 3072 + n0 + colb + 8 * g + 4 * hi), b1 = *(const f32x4*)(p.na_bias_s + layer * 3072 + n0 + colb + 32 + 8 * g + 4 * hi);
          v0 += b0; v1 += b1;
        }
        if (rope) {
          const f32x4 c = *(const f32x4*)(p.ropeC + pos * 32 + 8 * g + 4 * hi), sn = *(const f32x4*)(p.ropeS + pos * 32 + 8 * g + 4 * hi);
          const f32x4 t0 = (v0 * c - v1 * sn) * K8_SCALE, t1 = (v0 * sn + v1 * c) * K8_SCALE;
          unsigned char* kp_ = p.k8 + (long)(m0 + rl) * 1088 + 1024 + 8 * g + 4 * hi;
          *(u32*)kp_ = pack4_fp8(t0[0], t0[1], t0[2], t0[3]); *(u32*)(kp_ + 32) = pack4_fp8(t1[0], t1[1], t1[2], t1[3]);
        }
        char* e_ = lds + rl * OROW + (colb + 8 * g + 4 * hi) * 2;
        *(u32x2*)e_ = (u32x2){cvtpk(v0[0], v0[1]), cvtpk(v0[2], v0[3])};
        *(u32x2*)(e_ + 64) = (u32x2){cvtpk(v1[0], v1[1]), cvtpk(v1[2], v1[3])};
      }
    }
    __syncthreads();
#pragma unroll 4
    for (int i = 0; i < 16; ++i) { const int c = tid + 256 * i, row = c >> 4, ch = c & 15;
      *(u32x4*)(outp + (long)(m0 + row) * ldo + n0 + ch * 8) = *(const u32x4*)(lds + row * OROW + ch * 16); }
  } else {
    constexpr int BROW = 144;
    const bool rope = (EPI == EPI_UQ) && ((n0 + colb) % 192 == 128);
    const float sc = (EPI == EPI_UQ) ? Q8_SCALE : K8_SCALE;
#pragma unroll
    for (int mi = 0; mi < 4; ++mi) {
      const int rl = rowb + mi * 32 + r32; const int pos = tok_pos(m0 + rl);
#pragma unroll
      for (int g = 0; g < 4; ++g) {
        f32x4 v0, v1;
#pragma unroll
        for (int e = 0; e < 4; ++e) { v0[e] = acc[mi][0][4 * g + e] * rs[mi] * sc; v1[e] = acc[mi][1][4 * g + e] * rs[mi] * sc; }
        if (rope) {
          const f32x4 c = *(const f32x4*)(p.ropeC + pos * 32 + 8 * g + 4 * hi), sn = *(const f32x4*)(p.ropeS + pos * 32 + 8 * g + 4 * hi);
          const f32x4 t0 = v0 * c - v1 * sn, t1 = v0 * sn + v1 * c; v0 = t0; v1 = t1;
        }
        char* e_ = lds + rl * BROW + (colb + 8 * g + 4 * hi);
        *(u32*)e_ = pack4_fp8(v0[0], v0[1], v0[2], v0[3]); *(u32*)(e_ + 32) = pack4_fp8(v1[0], v1[1], v1[2], v1[3]);
      }
    }
    __syncthreads();
    unsigned char* outb; long ldo;
    if constexpr (EPI == EPI_UQ) { outb = p.q8 + n0; ldo = 1536; } else { outb = p.k8 + (n0 >> 8) * 128; ldo = 1088; }
#pragma unroll 2
    for (int i = 0; i < 8; ++i) { const int c = tid + 256 * i, row = c >> 3, ch = c & 7;
      *(u32x4*)(outb + (long)(m0 + row) * ldo + ch * 16) = *(const u32x4*)(lds + row * BROW + ch * 16); }
  }
}

__device__ __forceinline__ void ukv_tile(KP p, int j, int mt, int nt, char* lds) {
  if (nt & 1) gemm_tile<EPI_UV, true>(p, j, p.cqkv + 384, 768, p.wukv_t[j], 256, mt * 128, nt * 128, lds);
  else gemm_tile<EPI_UK, true>(p, j, p.cqkv + 384, 768, p.wukv_t[j], 256, mt * 128, nt * 128, lds);
}
#define XB_TMO      128
#define XB_XCNT(j)  (256  + 64 * (j))
#define XB_XSUB(j)  (1280 + 64 * (j))
#define XB_XGEN(j)  (2304 + 64 * (j))
#define XB_TOP      3328
#define XB_TOPGEN   3392
#define XCD_BAR_WORDS 3456
#define XB_SPIN_CAP (1u << 18)
#define LAS __attribute__((address_space(3)))
__device__ __forceinline__ unsigned xb_ld(unsigned* p)              { return __hip_atomic_load(p, __ATOMIC_RELAXED, __HIP_MEMORY_SCOPE_AGENT); }
__device__ __forceinline__ unsigned xb_add(unsigned* p, unsigned v) { return __hip_atomic_fetch_add(p, v, __ATOMIC_RELAXED, __HIP_MEMORY_SCOPE_AGENT); }
__device__ __forceinline__ unsigned xb_xcc_id() { return (unsigned)__builtin_amdgcn_s_getreg((3 << 11) | 20) & 0xFu; }
#define XB_SPIN(cond, bar) do { unsigned _sp = 0; while (cond) { __builtin_amdgcn_s_sleep(1); \
    if ((++_sp & 255u) == 0u) { if (xb_ld(&(bar)[XB_TMO])) break; if (_sp > XB_SPIN_CAP) { atomicAdd(&(bar)[XB_TMO], 1u); break; } } } } while (0)
struct XcdBarrier { unsigned* bar; unsigned x; volatile LAS unsigned* st; };
__device__ __forceinline__ XcdBarrier xcd_barrier_post(unsigned* bar, volatile LAS unsigned* st) {
    XcdBarrier b; b.bar = bar; b.x = xb_xcc_id(); b.st = st;
    if (threadIdx.x == 0) (void)xb_add(&bar[XB_XCNT(b.x)], 1u);
    return b;
}
__device__ __forceinline__ void xcd_barrier_complete(unsigned* bar, unsigned x, unsigned& nloc, unsigned& nx) {
    const unsigned G = gridDim.x * gridDim.y * gridDim.z;
    unsigned sum, cnt, mine, sp = 0u;
    for (;;) {
        sum = 0u; cnt = 0u; mine = 0u;
#pragma unroll
        for (unsigned j = 0; j < 16; ++j) { const unsigned c = xb_ld(&bar[XB_XCNT(j)]); sum += c; cnt += (c > 0u) ? 1u : 0u; mine = (j == x) ? c : mine; }
        if (sum == G) break;
        __builtin_amdgcn_s_sleep(1);
        if ((++sp & 255u) == 0u) { if (xb_ld(&bar[XB_TMO])) break; if (sp > XB_SPIN_CAP) { atomicAdd(&bar[XB_TMO], 1u); break; } }
    }
    nloc = mine > 0u ? mine : 1u; nx = cnt > 0u ? cnt : 1u;
}
__device__ __forceinline__ void xcd_barrier(const XcdBarrier& b) {
    asm volatile("s_waitcnt vmcnt(0)" ::: "memory");
    __syncthreads();
    if (threadIdx.x == 0) {
        unsigned* bar = b.bar;
        __builtin_amdgcn_s_waitcnt(0);
        unsigned nloc = b.st[0], nx = b.st[1];
        if (nloc == 0u) { xcd_barrier_complete(bar, b.x, nloc, nx); b.st[0] = nloc; b.st[1] = nx; }
        const unsigned old = xb_add(&bar[XB_XSUB(b.x)], 1u);
        const unsigned gen = old / nloc;
        if (old + 1u == (gen + 1u) * nloc) {
            __builtin_amdgcn_fence(__ATOMIC_RELEASE, "agent");
            asm volatile("s_waitcnt vmcnt(0)" ::: "memory");
            const unsigned og = xb_add(&bar[XB_TOP], 1u);
            const unsigned tg = og / nx;
            if (og + 1u == (tg + 1u) * nx) xb_add(&bar[XB_TOPGEN], 1u);
            else XB_SPIN(xb_ld(&bar[XB_TOPGEN]) == tg, bar);
            __builtin_amdgcn_fence(__ATOMIC_ACQUIRE, "agent");
            xb_add(&bar[XB_XGEN(b.x)], 1u);
            asm volatile("s_waitcnt vmcnt(0)" ::: "memory");
        } else {
            XB_SPIN(xb_ld(&bar[XB_XGEN(b.x)]) == gen, bar);
            __builtin_amdgcn_fence(__ATOMIC_ACQUIRE, "agent");
            asm volatile("s_waitcnt vmcnt(0)" ::: "memory");
        }
    }
    __syncthreads();
}

#define GEMM_PHASE(MTILES, NTILES, SM, SN, CALL) do { \
    const int nsn_ = (NTILES) / (SN), nsuper_ = ((MTILES) / (SM)) * nsn_; \
    const int xcd_ = blockIdx.x & 7, loc_ = blockIdx.x >> 3, nloc_ = gridDim.x >> 3; \
    for (int s_ = xcd_; s_ < nsuper_; s_ += 8) { const int sm_ = s_ / nsn_, sn_ = s_ - sm_ * nsn_; \
      for (int l_ = loc_; l_ < (SM) * (SN); l_ += nloc_) { const int mt = sm_ * (SM) + l_ / (SN), nt = sn_ * (SN) + l_ % (SN); CALL; } } } while (0)

__global__ void __launch_bounds__(NTHR, LB2) mega(const Params p_unused, int ph_lo, int ph_hi) {
  __shared__ __attribute__((aligned(16))) char lds[SMEM_BYTES];
  volatile LAS unsigned* xb_words = (volatile LAS unsigned*)(lds + SMEM_BYTES - 16);
  constexpr int MT = T_TOK / 128;
  XcdBarrier xb;
  { const __attribute__((address_space(4))) Params* pp0 = (const __attribute__((address_space(4))) Params*)__builtin_amdgcn_kernarg_segment_ptr();
    if (threadIdx.x < 4) xb_words[threadIdx.x] = 0u;
    __syncthreads();
    xb = xcd_barrier_post(pp0->bar, xb_words); }
  for (int ph = ph_lo; ph < ph_hi; ++ph) {
    const __attribute__((address_space(4))) Params* pp = (const __attribute__((address_space(4))) Params*)__builtin_amdgcn_kernarg_segment_ptr();
    asm volatile("" : "+s"(pp));
    KP p = *pp;
    const int type = p.prog_type[ph], layer = p.prog_layer[ph];
    const int j = layer >> 1;
    switch (type) {
      case PH_PREP: if (!PHON(PH_PREP)) break; phase_prep(p, lds); break;
      case PH_MLA_A: if (!PHON(PH_MLA_A)) break;
        GEMM_PHASE(MT / 2, 6, 8, 6, (gemm_big<EPI_A>(p, j, p.xb, DM, p.wa_t[j], 1024, mt * 256, nt * 128, lds)));
        break;
      case PH_MLA_B: if (!PHON(PH_MLA_B)) break;
        GEMM_PHASE(MT / 2, 12, 16, 4, (gemm_big<EPI_UQ>(p, j, p.cqkv, 768, p.wuq_t[j], 384, mt * 256, nt * 128, lds)));
        GEMM_PHASE(MT / 2, 8, 8, 8, (gemm_big<EPI_UK>(p, j, p.cqkv + 384, 768, p.wukv_t[j], 256, mt * 256, nt * 256, lds)));
        GEMM_PHASE(MT, 8, 8, 8, (gemm_tile<EPI_UV, true>(p, j, p.cqkv + 384, 768, p.wukv_t[j], 256, mt * 128, nt * 256 + 128, lds)));
        break;
      case PH_MLA_ATT: if (!PHON(PH_MLA_ATT)) break;
#ifndef SKEW_BIT
#define SKEW_BIT 256
#endif
        if (blockIdx.x & SKEW_BIT) { __builtin_amdgcn_s_sleep(24); __builtin_amdgcn_s_setprio(1); }
        {
          unsigned* ctr = p.bar + XCD_BAR_WORDS + ph;
          for (;;) {
            if (threadIdx.x == 0) xb_words[2] = atomicAdd(ctr, 1u);
            __syncthreads();
            const int t = (int)xb_words[2];
            __syncthreads();
            if (t >= 3072) break;
            attn_mla(p, t, lds);
          } }
        __builtin_amdgcn_s_setprio(0);
        break;
      case PH_MLA_O: if (!PHON(PH_MLA_O)) break;
        GEMM_PHASE(MT, 8, 8, 8, (gemm_tile<EPI_O, false>(p, j, p.o, 1024, p.mla_wo_t[j], 1024, mt * 128, nt * 128, lds)));
        break;
      case PH_NA_QKV: if (!PHON(PH_NA_QKV)) break;
        GEMM_PHASE(MT / 2, 24, 8, 8, (gemm_big<EPI_QKV>(p, j, p.xb, DM, p.na_wqkv_t[j], 1024, mt * 256, nt * 128, lds)));
        break;
      case PH_NA_ATT: if (!PHON(PH_NA_ATT)) break;
        if (blockIdx.x & SKEW_BIT) { __builtin_amdgcn_s_sleep(12); }
        { unsigned* ctr = p.bar + XCD_BAR_WORDS + ph;
          for (;;) {
            if (threadIdx.x == 0) xb_words[2] = atomicAdd(ctr, 1u);
            __syncthreads();
            const int t = (int)xb_words[2];
            __syncthreads();
            if (t >= 6144) break;
            attn_item<1>(p, j, t, lds);
          } }
        break;
      case PH_NA_O: if (!PHON(PH_NA_O)) break;
        GEMM_PHASE(MT, 8, 8, 8, (gemm_tile<EPI_O, false>(p, j, p.o, 1024, p.na_wo_t[j], 1024, mt * 128, nt * 128, lds)));
        break;
      case PH_PEER_Q: if (!PHON(PH_PEER_Q)) break;
        GEMM_PHASE(MT, 16, 8, 8, (gemm_tile<EPI_PEER, true>(p, layer, p.xb, DM, p.peer_wq_t[layer], 1024, mt * 128, nt * 128, lds)));
        break;
      case PH_PEER_C: if (!PHON(PH_PEER_C)) break; phase_peer_combine(p, layer, lds, p.bar + XCD_BAR_WORDS + ph); break;
      case PH_FINAL: if (!PHON(PH_FINAL)) break; phase_final(p); break;
      default: break;
    }
    if (ph + 1 < ph_hi) { if (ph_hi > 1000) cg::this_grid().sync(); else xcd_barrier(xb); }
  }
}

extern "C" void kernel_launch(void* const* d_in, const int* in_sizes, int n_in, void* d_out, int out_size, void* d_ws, size_t ws_size, hipStream_t stream) {
  static int grid_blocks = 0, n_cus = 0;
  if (!grid_blocks) {
    int dev = 0, cus = 0;
    (void)hipGetDevice(&dev);
    (void)hipDeviceGetAttribute(&cus, hipDeviceAttributeMultiprocessorCount, dev);
    if (cus < 8) cus = 256;
    n_cus = cus;
    grid_blocks = cus * 2;
  }
  Params p; memset(&p, 0, sizeof(p));
  const float* const* in = (const float* const*)d_in;
  char* ws = (char*)d_ws; size_t off = 0;
  auto alloc = [&](size_t bytes) -> void* { void* r = ws + off; off += (bytes + 255) & ~(size_t)255; return r; };
  p.xin0 = in[0]; p.xin1 = in[1]; p.x = (float*)d_out; p.norm_final = in[4];
  for (int l = 0; l < 2; ++l) {
    p.wa_t[l] = (u16*)alloc(768UL * 1024 * 2); p.wuq_t[l] = (u16*)alloc(1536UL * 384 * 2); p.wukv_t[l] = (u16*)alloc(2048UL * 256 * 2); p.mla_wo_t[l] = (u16*)alloc(1024UL * 1024 * 2);
    p.na_wqkv_t[l] = (u16*)alloc(3072UL * 1024 * 2); p.na_wo_t[l] = (u16*)alloc(1024UL * 1024 * 2);
  }
  for (int l = 0; l < 4; ++l) p.peer_wq_t[l] = (u16*)alloc(2048UL * 1024 * 2);
  p.na_bias_s = (float*)alloc(2 * 3072 * 4); p.na_rpb_s = (float*)alloc(2 * 16 * 465 * 4);
  p.peer_sk = (u16*)alloc(4UL * 8 * 2 * 128 * 128 * 2);
  p.peer_u8 = (unsigned char*)alloc(4UL * 16384 * 1024); p.peer_v8 = (unsigned char*)alloc(4UL * 16384 * 1024);
  p.ropeC = (float*)alloc(16384UL * 32 * 4); p.ropeS = (float*)alloc(16384UL * 32 * 4);
  p.bar = (unsigned*)alloc((XCD_BAR_WORDS + 64) * 4);
  p.o = (u16*)alloc((size_t)T_TOK * 1024 * 2); p.xb = (u16*)alloc((size_t)T_TOK * 1024 * 2);
  char* un = (char*)alloc((size_t)T_TOK * (768 + 1536 + 2048) * 2);
  p.cqkv = (u16*)un; p.q = (u16*)(un + (size_t)T_TOK * 768 * 2); p.kv = (u16*)(un + (size_t)T_TOK * (768 + 1536) * 2);
  { unsigned char* b8 = (unsigned char*)un + (size_t)T_TOK * 768 * 2; p.q8 = b8; p.k8 = b8 + (size_t)T_TOK * 1536; p.kpe8 = p.k8; p.vT8 = p.k8 + (size_t)T_TOK * 1088; }
  p.qkv = (u16*)un; p.pkeys = (u32*)un;
  if (off > ws_size) { fprintf(stderr, "kernel_launch: workspace too small: need %zu have %zu\n", off, ws_size); return; }
  p.in_sub_keys = in[17]; p.in_peer_u = in[18]; p.in_peer_v = in[19]; p.in_norm_ffn = in[3]; p.in_na_bias = in[13]; p.in_na_rpb = in[14];
  for (int jf = 0; jf < 32; ++jf) p.inv_freq[jf] = pow(10000.0, -(double)(2 * jf) / 64.0);
  int nj = 0, tile = 0;
  auto job = [&](const float* src, u16* dst, const float* gain, int K, int N, float scale, int scale_cols) {
    PrepJob& J = p.jobs[nj++]; J.src = src; J.dst = dst; J.gain = gain; J.K = K; J.N = N; J.tile0 = tile; J.scale = scale; J.scale_cols = scale_cols; J.pad = 0; tile += (K / 64) * (N / 64); };
  const float sc_mla = (float)(pow(192.0, -0.5) * 1.4426950408889634);
  for (int l = 0; l < 2; ++l) {
    job(in[5] + (size_t)l * 1024 * 384, p.wa_t[l], in[2] + (2 * l) * 1024, 1024, 384, 1.f, 0);
    job(in[8] + (size_t)l * 1024 * 320, p.wa_t[l] + 384UL * 1024, in[2] + (2 * l) * 1024, 1024, 320, 1.f, 0);
    job(in[7] + (size_t)l * 384 * 1536, p.wuq_t[l], in[6] + l * 384, 384, 1536, sc_mla, 1536);
    job(in[10] + (size_t)l * 256 * 2048, p.wukv_t[l], in[9] + l * 256, 256, 2048, 1.f, 0);
    job(in[11] + (size_t)l * 1024 * 1024, p.mla_wo_t[l], nullptr, 1024, 1024, 1.f, 0);
    job(in[12] + (size_t)l * 1024 * 3072, p.na_wqkv_t[l], in[2] + (2 * l + 1) * 1024, 1024, 3072, 0.125f * 1.4426950408889634f, 1024);
    job(in[15] + (size_t)l * 1024 * 1024, p.na_wo_t[l], nullptr, 1024, 1024, 1.f, 0);
  }
  for (int l = 0; l < 4; ++l) job(in[16] + (size_t)l * 1024 * 2048, p.peer_wq_t[l], in[3] + l * 1024, 1024, 2048, 1.f, 0);
  p.njobs = nj; p.ntiles_prep = tile;
  int np = 0;
#ifndef DUPMASK
#define DUPMASK 0
#endif
  auto ph = [&](int type, int layer) { p.prog_type[np] = type; p.prog_layer[np] = layer; ++np;
    if ((DUPMASK >> type) & 1) { p.prog_type[np] = type; p.prog_layer[np] = layer; ++np; } };
  ph(PH_PREP, 0);
  for (int i = 0; i < 4; ++i) {
    if ((i & 1) == 0) { ph(PH_MLA_A, i); ph(PH_MLA_B, i); ph(PH_MLA_ATT, i); ph(PH_MLA_O, i); }
    else { ph(PH_NA_QKV, i); ph(PH_NA_ATT, i); ph(PH_NA_O, i); }
    ph(PH_PEER_Q, i); ph(PH_PEER_C, i);
  }
  p.nprog = np;
#if COOP
  (void)hipMemsetAsync(p.bar, 0, (XCD_BAR_WORDS + 64) * 4, stream);
  int lo = 0, hi = np;
  void* args[] = {(void*)&p, (void*)&lo, (void*)&hi};
  hipError_t e = hipLaunchCooperativeKernel((const void*)mega, dim3(grid_blocks), dim3(NTHR), args, 0, stream);
  if (e != hipSuccess && grid_blocks != n_cus) {
    (void)hipGetLastError(); grid_blocks = n_cus;
    e = hipLaunchCooperativeKernel((const void*)mega, dim3(grid_blocks), dim3(NTHR), args, 0, stream);
  }
  if (e != hipSuccess) fprintf(stderr, "cooperative launch failed: %s (grid %d)\n", hipGetErrorString(e), grid_blocks);
#else
  for (int i = 0; i < np; ++i) hipLaunchKernelGGL(mega, dim3(grid_blocks), dim3(NTHR), 0, stream, p, i, i + 1);
#endif
}
```

```cpp
#include <hip/hip_runtime.h>
#include <hip/hip_cooperative_groups.h>
#include <stdint.h>
#include <string.h>
#include <math.h>
#include <cstdio>
namespace cg = cooperative_groups;

#ifndef COOP
#define COOP 1
#endif
#ifndef PHMASK
#define PHMASK 0xFFFF
#endif
#ifndef LB2
#define LB2 2
#endif
#define PHON(t) ((PHMASK >> (t)) & 1)

typedef unsigned short u16;
typedef unsigned int u32;
using bf16x8 = __attribute__((ext_vector_type(8))) short;
using s16x4  = __attribute__((ext_vector_type(4))) short;
using f32x16 = __attribute__((ext_vector_type(16))) float;
using f32x4  = __attribute__((ext_vector_type(4))) float;
using u32x4  = __attribute__((ext_vector_type(4))) unsigned;
using u32x2  = __attribute__((ext_vector_type(2))) unsigned;
typedef __attribute__((ext_vector_type(2))) __bf16 v2bf;

constexpr int T_TOK = 49152, T_PROMPT = 16384, DM = 1024;
constexpr int NTHR = 256;
constexpr float LOG2E = 1.4426950408889634f;
constexpr float RMS_EPS = 1e-6f;

enum { PH_PREP = 0, PH_MLA_A, PH_MLA_B, PH_MLA_ATT, PH_MLA_O, PH_NA_QKV, PH_NA_ATT, PH_NA_O, PH_PEER_Q, PH_PEER_C, PH_FINAL };

struct PrepJob { const float* src; u16* dst; const float* gain; int K, N, tile0, scale_cols; float scale; int pad; };

struct Params {
  const float* xin0; const float* xin1;
  float* x; u16* xb;
  const float* norm_final;
  u16* wa_t[2]; u16* wuq_t[2]; u16* wukv_t[2]; u16* mla_wo_t[2];
  u16* na_wqkv_t[2]; u16* na_wo_t[2]; float* na_bias_s; float* na_rpb_s;
  u16* peer_wq_t[4]; u16* peer_sk; unsigned char* peer_u8; unsigned char* peer_v8;
  u16* cqkv; u16* q; u16* kv; u16* o; u16* qkv; u32* pkeys;
  unsigned char* q8; unsigned char* k8; unsigned char* kpe8; unsigned char* vT8;
  float* ropeC; float* ropeS; unsigned* bar;
  const float* in_sub_keys; const float* in_peer_u; const float* in_peer_v; const float* in_norm_ffn; const float* in_na_bias; const float* in_na_rpb;
  PrepJob jobs[24];
  double inv_freq[32];
  int njobs, ntiles_prep;
  int prog_type[48]; int prog_layer[48];
  int nprog, pad0;
};

typedef const __attribute__((address_space(4))) Params& KP;

__device__ __forceinline__ int crow(int r, int hi) { return (r & 3) + 8 * (r >> 2) + 4 * hi; }
__device__ __forceinline__ u32 cvtpk(float lo, float hi) { u32 r; asm("v_cvt_pk_bf16_f32 %0, %1, %2" : "=v"(r) : "v"(lo), "v"(hi)); return r; }
__device__ __forceinline__ float bf_lo(u32 v) { return __uint_as_float(v << 16); }
__device__ __forceinline__ float bf_hi(u32 v) { return __uint_as_float(v & 0xffff0000u); }
__device__ __forceinline__ int tok_pos(int t) { return t < T_PROMPT ? (t & 2047) : (t & 16383); }
__device__ __forceinline__ f32x16 mfma32(bf16x8 a, bf16x8 b, f32x16 c) { return __builtin_amdgcn_mfma_f32_32x32x16_bf16(a, b, c, 0, 0, 0); }
__device__ __forceinline__ float shx(float v, int m) { return __shfl_xor(v, m, 64); }

constexpr int BK = 64;
constexpr int OPB = 16384;
constexpr int GEMM_LDS = 4 * OPB;
constexpr int SMEM_BYTES = 81920;
constexpr int RSTD_OFF = 73728;

enum { EPI_A = 0, EPI_UQ, EPI_UK, EPI_UV, EPI_O, EPI_QKV, EPI_PEER };
constexpr float KEY_BIAS = 16.f;
constexpr float Q8_SCALE = 16.f, K8_SCALE = 4.f, V8_SCALE = 4.f, P8_SCALE = 128.f;
__device__ __forceinline__ u32 pack4_fp8(float a, float b, float c, float d) { int v = 0; v = __builtin_amdgcn_cvt_pk_fp8_f32(a, b, v, false); v = __builtin_amdgcn_cvt_pk_fp8_f32(c, d, v, true); return (u32)v; }

__device__ __forceinline__ float dot2bf(u32 a, u32 b, float c) { return __builtin_amdgcn_fdot2_f32_bf16(__builtin_bit_cast(v2bf, a), __builtin_bit_cast(v2bf, b), c, false); }

template <int EPI, bool NORM>
__device__ __forceinline__ void gemm_tile(KP p, int layer, const u16* Ap, int lda, const u16* Bt, int K, int m0, int n0, char* lds) {
  int tid_ = threadIdx.x; asm volatile("" : "+v"(tid_));
  const int tid = tid_, lane = tid & 63, w = tid >> 6;
  const int wm = w >> 1, wn = w & 1, r32 = lane & 31, hi = lane >> 5;
  float* rstd_l = (float*)(lds + RSTD_OFF);
  const int srow = w * 32 + (lane >> 2);
  const int scol = ((lane & 3) ^ ((lane >> 4) & 3)) * 8;
  const u16* Ag = Ap + (long)(m0 + srow) * lda + scol;
  const u16* Bg = Bt + (long)(n0 + srow) * K + scol;
#define GSTAGE(st, kt) do { _Pragma("unroll") for (int j = 0; j < 2; ++j) { \
    __builtin_amdgcn_global_load_lds((const unsigned*)(Ag + (long)j * 16 * lda + (kt) * 32), (unsigned*)(lds + (st) * 16384 + (w * 2 + j) * 1024), 16, 0, 0); \
    __builtin_amdgcn_global_load_lds((const unsigned*)(Bg + (long)j * 16 * K + (kt) * 32), (unsigned*)(lds + (st) * 16384 + 8192 + (w * 2 + j) * 1024), 16, 0, 0); } } while (0)
  f32x16 acc[2][2];
#pragma unroll
  for (int i = 0; i < 2; ++i)
#pragma unroll
    for (int j = 0; j < 2; ++j)
#pragma unroll
      for (int r = 0; r < 16; ++r) acc[i][j][r] = 0.f;
  float ssq0 = 0.f, ssq1 = 0.f;
  bf16x8 skr[8];
  const int sw = (r32 >> 2) & 3;
  const int arow = (wm * 64 + r32) * 64, brow = 8192 + (wn * 64 + r32) * 64;
  const int co0 = ((0 + hi) ^ sw) << 4, co1 = ((2 + hi) ^ sw) << 4;
  const int nk = K / 32;

#ifndef KREP
#define KREP 1
#endif
  for (int rep_ = 0; rep_ < KREP; ++rep_) {
  if (KREP > 1) {
#pragma unroll
    for (int i = 0; i < 2; ++i)
#pragma unroll
      for (int j = 0; j < 2; ++j)
#pragma unroll
        for (int r = 0; r < 16; ++r) acc[i][j][r] = 0.f;
    ssq0 = 0.f; ssq1 = 0.f; }
  __syncthreads();
  GSTAGE(0, 0); GSTAGE(1, 1); GSTAGE(2, 2);
  if constexpr (EPI == EPI_PEER) {
    const u16* sk = p.peer_sk + ((long)layer * 16 + (n0 >> 7)) * 16384;
#pragma unroll
    for (int i = 0; i < 8; ++i) { const int c = tid + 256 * i; skr[i] = *(const bf16x8*)(sk + (c >> 4) * 128 + (c & 15) * 8); }
  }
  for (int kt = 0; kt < nk; ++kt) {
    if (kt + 2 < nk) asm volatile("s_waitcnt vmcnt(8)" ::: "memory");
    else if (kt + 1 < nk) asm volatile("s_waitcnt vmcnt(4)" ::: "memory");
    else asm volatile("s_waitcnt vmcnt(0)" ::: "memory");
    asm volatile("s_waitcnt lgkmcnt(0)" ::: "memory");
    __builtin_amdgcn_s_barrier();
    if (kt + 3 < nk) GSTAGE((kt + 3) & 3, kt + 3);
    const char* base = lds + (kt & 3) * 16384;
    {
      const bf16x8 a0 = *(const bf16x8*)(base + arow + co0), a1 = *(const bf16x8*)(base + arow + 32 * 64 + co0);
      const bf16x8 b0 = *(const bf16x8*)(base + brow + co0), b1 = *(const bf16x8*)(base + brow + 32 * 64 + co0);
      const bf16x8 c0 = *(const bf16x8*)(base + arow + co1), c1 = *(const bf16x8*)(base + arow + 32 * 64 + co1);
      const bf16x8 d0 = *(const bf16x8*)(base + brow + co1), d1 = *(const bf16x8*)(base + brow + 32 * 64 + co1);
      if constexpr (EPI != EPI_UV) {
        acc[0][0] = mfma32(b0, a0, acc[0][0]); acc[0][1] = mfma32(b1, a0, acc[0][1]);
        acc[1][0] = mfma32(b0, a1, acc[1][0]); acc[1][1] = mfma32(b1, a1, acc[1][1]);
        acc[0][0] = mfma32(d0, c0, acc[0][0]); acc[0][1] = mfma32(d1, c0, acc[0][1]);
        acc[1][0] = mfma32(d0, c1, acc[1][0]); acc[1][1] = mfma32(d1, c1, acc[1][1]);
      } else {
        acc[0][0] = mfma32(a0, b0, acc[0][0]); acc[0][1] = mfma32(a0, b1, acc[0][1]);
        acc[1][0] = mfma32(a1, b0, acc[1][0]); acc[1][1] = mfma32(a1, b1, acc[1][1]);
        acc[0][0] = mfma32(c0, d0, acc[0][0]); acc[0][1] = mfma32(c0, d1, acc[0][1]);
        acc[1][0] = mfma32(c1, d0, acc[1][0]); acc[1][1] = mfma32(c1, d1, acc[1][1]);
      }
      if constexpr (NORM) {
        const u32x4 x0 = __builtin_bit_cast(u32x4, a0), x1 = __builtin_bit_cast(u32x4, a1), y0 = __builtin_bit_cast(u32x4, c0), y1 = __builtin_bit_cast(u32x4, c1);
#pragma unroll
        for (int q = 0; q < 4; ++q) { ssq0 = dot2bf(x0[q], x0[q], ssq0); ssq1 = dot2bf(x1[q], x1[q], ssq1); ssq0 = dot2bf(y0[q], y0[q], ssq0); ssq1 = dot2bf(y1[q], y1[q], ssq1); }
      }
    }
  }
  }
#undef GSTAGE
  __syncthreads();
  float rs[2] = {1.f, 1.f};
  if constexpr (NORM) {
    ssq0 += shx(ssq0, 32); ssq1 += shx(ssq1, 32);
    rs[0] = rsqrtf(ssq0 / (float)K + RMS_EPS); rs[1] = rsqrtf(ssq1 / (float)K + RMS_EPS);
  }
  const int rowb = wm * 64, colb = wn * 64;
  if constexpr (EPI == EPI_A || EPI == EPI_QKV) {
    constexpr int OROW = 272;
    u16* outp; int ldo; bool rope = false;
    if constexpr (EPI == EPI_A) { outp = p.cqkv; ldo = 768; rope = (n0 + colb == 640); }
    else { outp = p.qkv; ldo = 3072; }
#pragma unroll
    for (int mi = 0; mi < 2; ++mi) {
      const int rl = rowb + mi * 32 + r32; const int pos = tok_pos(m0 + rl);
#pragma unroll
      for (int g = 0; g < 4; ++g) {
        f32x4 v0, v1;
#pragma unroll
        for (int e = 0; e < 4; ++e) { v0[e] = acc[mi][0][4 * g + e] * rs[mi]; v1[e] = acc[mi][1][4 * g + e] * rs[mi]; }
        if constexpr (EPI == EPI_QKV) {
          const f32x4 b0 = *(const f32x4*)(p.na_bias_s + layer * 3072 + n0 + colb + 8 * g + 4 * hi), b1 = *(const f32x4*)(p.na_bias_s + layer * 3072 + n0 + colb + 32 + 8 * g + 4 * hi);
          v0 += b0; v1 += b1;
        }
        if (rope) {
          const f32x4 c = *(const f32x4*)(p.ropeC + pos * 32 + 8 * g + 4 * hi), sn = *(const f32x4*)(p.ropeS + pos * 32 + 8 * g + 4 * hi);
          const f32x4 t0 = (v0 * c - v1 * sn) * K8_SCALE, t1 = (v0 * sn + v1 * c) * K8_SCALE;
          unsigned char* kp_ = p.k8 + (long)(m0 + rl) * 1088 + 1024 + 8 * g + 4 * hi;
          *(u32*)kp_ = pack4_fp8(t0[0], t0[1], t0[2], t0[3]); *(u32*)(kp_ + 32) = pack4_fp8(t1[0], t1[1], t1[2], t1[3]);
        }
        char* e_ = lds + rl * OROW + (colb + 8 * g + 4 * hi) * 2;
        *(u32x2*)e_ = (u32x2){cvtpk(v0[0], v0[1]), cvtpk(v0[2], v0[3])};
        *(u32x2*)(e_ + 64) = (u32x2){cvtpk(v1[0], v1[1]), cvtpk(v1[2], v1[3])};
      }
    }
    __syncthreads();
#pragma unroll
    for (int i = 0; i < 8; ++i) { const int c = tid + 256 * i, row = c >> 4, ch = c & 15;
      *(u32x4*)(outp + (long)(m0 + row) * ldo + n0 + ch * 8) = *(const u32x4*)(lds + row * OROW + ch * 16); }
  } else if constexpr (EPI == EPI_UQ || EPI == EPI_UK) {
    constexpr int BROW = 144;
    const bool rope = (EPI == EPI_UQ) && ((n0 + colb) % 192 == 128);
    const float sc = (EPI == EPI_UQ) ? Q8_SCALE : K8_SCALE;
#pragma unroll
    for (int mi = 0; mi < 2; ++mi) {
      const int rl = rowb + mi * 32 + r32; const int pos = tok_pos(m0 + rl);
#pragma unroll
      for (int g = 0; g < 4; ++g) {
        f32x4 v0, v1;
#pragma unroll
        for (int e = 0; e < 4; ++e) { v0[e] = acc[mi][0][4 * g + e] * rs[mi] * sc; v1[e] = acc[mi][1][4 * g + e] * rs[mi] * sc; }
        if (rope) {
          const f32x4 c = *(const f32x4*)(p.ropeC + pos * 32 + 8 * g + 4 * hi), sn = *(const f32x4*)(p.ropeS + pos * 32 + 8 * g + 4 * hi);
          const f32x4 t0 = v0 * c - v1 * sn, t1 = v0 * sn + v1 * c; v0 = t0; v1 = t1;
        }
        char* e_ = lds + rl * BROW + (colb + 8 * g + 4 * hi);
        *(u32*)e_ = pack4_fp8(v0[0], v0[1], v0[2], v0[3]); *(u32*)(e_ + 32) = pack4_fp8(v1[0], v1[1], v1[2], v1[3]);
      }
    }
    __syncthreads();
    unsigned char* outb; long ldo;
    if constexpr (EPI == EPI_UQ) { outb = p.q8 + n0; ldo = 1536; } else { outb = p.k8 + (n0 >> 8) * 128; ldo = 1088; }
#pragma unroll
    for (int i = 0; i < 4; ++i) { const int c = tid + 256 * i, row = c >> 3, ch = c & 7;
      *(u32x4*)(outb + (long)(m0 + row) * ldo + ch * 16) = *(const u32x4*)(lds + row * BROW + ch * 16); }
  } else if constexpr (EPI == EPI_UV) {
    constexpr int BROW = 144;
#pragma unroll
    for (int mi = 0; mi < 2; ++mi) {
#pragma unroll
      for (int g = 0; g < 4; ++g) {
        float rr[4];
#pragma unroll
        for (int e = 0; e < 4; ++e) rr[e] = __int_as_float(__builtin_amdgcn_ds_bpermute((8 * g + 4 * hi + e) << 2, __float_as_int(rs[mi]))) * V8_SCALE;
#pragma unroll
        for (int ni = 0; ni < 2; ++ni) {
          char* e_ = lds + (colb + ni * 32 + r32) * BROW + rowb + mi * 32 + 8 * g + 4 * hi;
          *(u32*)e_ = pack4_fp8(acc[mi][ni][4 * g] * rr[0], acc[mi][ni][4 * g + 1] * rr[1], acc[mi][ni][4 * g + 2] * rr[2], acc[mi][ni][4 * g + 3] * rr[3]);
        }
      }
    }
    __syncthreads();
    unsigned char* outb = p.vT8 + (long)((n0 >> 8) * 128) * T_TOK + m0;
#pragma unroll
    for (int i = 0; i < 4; ++i) { const int c = tid + 256 * i, d = c >> 3, ch = c & 7;
      *(u32x4*)(outb + (long)d * T_TOK + ch * 16) = *(const u32x4*)(lds + d * BROW + ch * 16); }
  } else if constexpr (EPI == EPI_O) {
    constexpr int FROW = 528;
#pragma unroll
    for (int mi = 0; mi < 2; ++mi) {
      const int rl = rowb + mi * 32 + r32;
#pragma unroll
      for (int ni = 0; ni < 2; ++ni)
#pragma unroll
        for (int g = 0; g < 4; ++g)
          *(f32x4*)(lds + rl * FROW + (colb + ni * 32 + 8 * g + 4 * hi) * 4) = (f32x4){acc[mi][ni][4 * g], acc[mi][ni][4 * g + 1], acc[mi][ni][4 * g + 2], acc[mi][ni][4 * g + 3]};
    }
    __syncthreads();
#pragma unroll 4
    for (int i = 0; i < 16; ++i) { const int c = tid + 256 * i, row = c >> 5, ch = c & 31;
      const f32x4 a = *(const f32x4*)(lds + row * FROW + ch * 16);
      float* xp = p.x + (long)(m0 + row) * DM + n0 + ch * 4;
      f32x4 xv = *(const f32x4*)xp; xv += a; *(f32x4*)xp = xv;
      *(u32x2*)(p.xb + (long)(m0 + row) * DM + n0 + ch * 4) = (u32x2){cvtpk(xv[0], xv[1]), cvtpk(xv[2], xv[3])}; }
  } else {
    constexpr int QROW = 272;
    char* Qs = lds; char* Ss = lds + 128 * QROW;
    const int hp = n0 >> 7;
#pragma unroll
    for (int mi = 0; mi < 2; ++mi) {
      const int rl = rowb + mi * 32 + r32;
#pragma unroll
      for (int g = 0; g < 4; ++g) {
        char* e_ = Qs + rl * QROW + (colb + 8 * g + 4 * hi) * 2;
        *(u32x2*)e_ = (u32x2){cvtpk(acc[mi][0][4 * g] * rs[mi], acc[mi][0][4 * g + 1] * rs[mi]), cvtpk(acc[mi][0][4 * g + 2] * rs[mi], acc[mi][0][4 * g + 3] * rs[mi])};
        *(u32x2*)(e_ + 64) = (u32x2){cvtpk(acc[mi][1][4 * g] * rs[mi], acc[mi][1][4 * g + 1] * rs[mi]), cvtpk(acc[mi][1][4 * g + 2] * rs[mi], acc[mi][1][4 * g + 3] * rs[mi])};
      }
    }
#pragma unroll
    for (int i = 0; i < 8; ++i) { const int c = tid + 256 * i, kr = c >> 4, ch = c & 15; *(bf16x8*)(Ss + kr * QROW + ch * 16) = skr[i]; }
    __syncthreads();
    f32x16 a2[2][2];
#pragma unroll
    for (int i = 0; i < 2; ++i)
#pragma unroll
      for (int j = 0; j < 2; ++j)
#pragma unroll
        for (int r = 0; r < 16; ++r) a2[i][j][r] = 0.f;
    { const char* Ar = Qs + (rowb + r32) * QROW + hi * 16; const char* Br = Ss + (colb + r32) * QROW + hi * 16;
#pragma unroll
      for (int ks = 0; ks < 8; ++ks) {
        bf16x8 a0 = *(const bf16x8*)(Ar + ks * 32), a1 = *(const bf16x8*)(Ar + 32 * QROW + ks * 32);
        bf16x8 b0 = *(const bf16x8*)(Br + ks * 32), b1 = *(const bf16x8*)(Br + 32 * QROW + ks * 32);
        a2[0][0] = mfma32(b0, a0, a2[0][0]); a2[0][1] = mfma32(b1, a0, a2[0][1]);
        a2[1][0] = mfma32(b0, a1, a2[1][0]); a2[1][1] = mfma32(b1, a1, a2[1][1]);
      } }
    __syncthreads();
    constexpr int SROW = 544;
    char* Sc = lds;
#pragma unroll
    for (int mi = 0; mi < 2; ++mi) {
      const int rl = rowb + mi * 32 + r32;
#pragma unroll
      for (int ni = 0; ni < 2; ++ni)
#pragma unroll
        for (int g = 0; g < 4; ++g)
          *(f32x4*)(Sc + rl * SROW + (colb + ni * 32 + 8 * g + 4 * hi) * 4) = (f32x4){a2[mi][ni][4 * g], a2[mi][ni][4 * g + 1], a2[mi][ni][4 * g + 2], a2[mi][ni][4 * g + 3]};
    }
    __syncthreads();
    { const int row = tid >> 1, hf = tid & 1;
      u32 kv[64];
#pragma unroll
      for (int i = 0; i < 16; ++i) {
        const f32x4 v = *(const f32x4*)(Sc + row * SROW + (2 * i + hf) * 16);
#pragma unroll
        for (int e = 0; e < 4; ++e) { const u32 b = __float_as_uint(v[e] + KEY_BIAS);
          kv[i * 4 + e] = (b & ~127u) | (u32)((2 * i + hf) * 4 + e); }
      }
      u32 mprev = 0xffffffffu;
      u32* outk = p.pkeys + (long)(m0 + row) * 256 + hp * 16;
#pragma unroll 1
      for (int ps = 0; ps < 16; ++ps) {
        u32 best = 0;
#pragma unroll
        for (int i = 0; i < 64; ++i) { const u32 d = kv[i] - mprev; best = d > best ? d : best; }
        u32 cand = mprev + best;
        if (best < (0u - mprev)) cand = 0u;
        const u32 oth = (u32)__shfl_xor((int)cand, 1, 64);
        mprev = cand > oth ? cand : oth;
        if (hf == 0) outk[ps] = mprev;
      }
    }
  }
}

template <int OFF> __device__ __forceinline__ s16x4 tr_read(int vb) {
  s16x4 r; asm volatile("ds_read_b64_tr_b16 %0, %1 offset:%2" : "=&v"(r) : "v"(vb), "i"(OFF) : "memory"); return r;
}
__device__ __forceinline__ int v_st(int k, int c) { const int kk = (k & ~0xC) | ((k & 4) << 1) | ((k & 8) >> 1); return ((kk >> 3) * 4 + (c >> 5)) * 512 + ((kk & 7) * 32 + (c & 31)) * 2; }
__device__ __forceinline__ int v_rd_base(int lane) { return ((lane & 3) << 3) | (((lane >> 2) & 3) << 6) | (((lane >> 4) & 1) << 5) | (((lane >> 5) & 1) << 8); }
constexpr int v_rd_off(int d0, int ks, int half) { return d0 * 512 + ks * 4096 + half * 2048; }
template <int D0> __device__ __forceinline__ void pv_one(f32x16& od, int vb, bf16x8 pa0, bf16x8 pa1, bf16x8 pa2, bf16x8 pa3) {
  const s16x4 l0 = tr_read<v_rd_off(D0, 0, 0)>(vb), h0 = tr_read<v_rd_off(D0, 0, 1)>(vb), l1 = tr_read<v_rd_off(D0, 1, 0)>(vb), h1 = tr_read<v_rd_off(D0, 1, 1)>(vb);
  const s16x4 l2 = tr_read<v_rd_off(D0, 2, 0)>(vb), h2 = tr_read<v_rd_off(D0, 2, 1)>(vb), l3 = tr_read<v_rd_off(D0, 3, 0)>(vb), h3 = tr_read<v_rd_off(D0, 3, 1)>(vb);
  asm volatile("s_waitcnt lgkmcnt(0)" ::: "memory"); __builtin_amdgcn_sched_barrier(0);
#define PKV(L, H) (bf16x8){L[0], L[1], L[2], L[3], H[0], H[1], H[2], H[3]}
  od = mfma32(pa0, PKV(l0, h0), od); od = mfma32(pa1, PKV(l1, h1), od); od = mfma32(pa2, PKV(l2, h2), od); od = mfma32(pa3, PKV(l3, h3), od);
#undef PKV
}

constexpr float THR_L2 = 11.5f;

__device__ __forceinline__ void partialSM(f32x16& p0, f32x16& p1, float& m_reg, float& alpha) {
  float pmax = p0[0];
#pragma unroll
  for (int r = 1; r < 16; ++r) pmax = fmaxf(pmax, p0[r]);
#pragma unroll
  for (int r = 0; r < 16; ++r) pmax = fmaxf(pmax, p1[r]);
  { auto rr = __builtin_amdgcn_permlane32_swap(__float_as_uint(pmax), __float_as_uint(pmax), false, false);
    pmax = fmaxf(__uint_as_float(rr[0]), __uint_as_float(rr[1])); }
  float mn;
  if (__all(pmax - m_reg <= THR_L2)) { mn = m_reg; alpha = 1.f; }
  else { mn = fmaxf(m_reg, pmax); alpha = __builtin_amdgcn_exp2f(m_reg - mn); m_reg = mn; }
#pragma unroll
  for (int r = 0; r < 16; ++r) { p0[r] = __builtin_amdgcn_exp2f(p0[r] - mn); p1[r] = __builtin_amdgcn_exp2f(p1[r] - mn); }
}
__device__ __forceinline__ void finishSM(f32x16& p0, f32x16& p1, float alpha, float& l_reg, bf16x8& pa0, bf16x8& pa1, bf16x8& pa2, bf16x8& pa3) {
  float ps = 0.f;
#pragma unroll
  for (int r = 0; r < 16; ++r) ps += p0[r];
#pragma unroll
  for (int r = 0; r < 16; ++r) ps += p1[r];
  { auto rr = __builtin_amdgcn_permlane32_swap(__float_as_uint(ps), __float_as_uint(ps), false, false);
    ps = __uint_as_float(rr[0]) + __uint_as_float(rr[1]); }
  l_reg = l_reg * alpha + ps;
#define PK4(P, BASE, OUT) do { unsigned a0 = cvtpk(P[BASE + 0], P[BASE + 1]), a1 = cvtpk(P[BASE + 2], P[BASE + 3]);   \
    unsigned b0 = cvtpk(P[BASE + 4], P[BASE + 5]), b1 = cvtpk(P[BASE + 6], P[BASE + 7]);                              \
    auto r0 = __builtin_amdgcn_permlane32_swap(a0, b0, false, false); auto r1 = __builtin_amdgcn_permlane32_swap(a1, b1, false, false); \
    u32x4 w_ = {r0[0], r1[0], r0[1], r1[1]}; OUT = __builtin_bit_cast(bf16x8, w_); } while (0)
  PK4(p0, 0, pa0); PK4(p0, 8, pa1); PK4(p1, 0, pa2); PK4(p1, 8, pa3);
#undef PK4
}

constexpr int ATT_K_OFF = 0, ATT_V_OFF = 25600, ATT_WS_OFF = 41984, ATT_RPB_OFF = 43008;

template <int MODE>
__device__ __forceinline__ void attn_item(KP p, int layer, int item, char* lds) {
  constexpr int KST = MODE == 0 ? 12 : 4;
  constexpr int KROW = MODE == 0 ? 400 : 272;
  constexpr int ND0 = MODE == 0 ? 4 : 2;
  int tid_ = threadIdx.x; asm volatile("" : "+v"(tid_));
  const int tid = tid_, lane = tid & 63, w = tid >> 6, r32 = lane & 31, hi = lane >> 5;
  char* Kl = lds + ATT_K_OFF; char* Vl = lds + ATT_V_OFF;
  float* wsl = (float*)(lds + ATT_WS_OFF) + w * 64; float* al_l = wsl; float* li_l = wsl + 32;
  float* rpbl = (float*)(lds + ATT_RPB_OFF);

  int NT, qtok, ktok0, head, kcolB = 0; long obase;
  int na_c = 0, na_c0 = 0, na_relrow0 = 0, na_hl = 0;
  const u16* Qp;
  if constexpr (MODE == 0) {
    int seq, qb;
    if (item < 2048) { const int sh = item >> 7; seq = 8 + (sh >> 3); head = sh & 7; qb = item & 127; ktok0 = T_PROMPT + (seq - 8) * 16384; NT = 256; }
    else { const int it = item - 2048; const int sh = it >> 4; seq = sh >> 3; head = sh & 7; qb = it & 15; ktok0 = seq * 2048; NT = 32; }
    qtok = ktok0 + qb * 128 + w * 32 + r32;
    Qp = p.q + (long)qtok * 1536 + head * 192 + hi * 8;
    obase = (long)(ktok0 + qb * 128 + w * 32) * 1024 + head * 128;
  } else {
    const int Rg = item >> 3, hpair = item & 7;
    int grow0, r, rows;
    if (Rg < 256) { grow0 = (Rg >> 5) << 5; r = Rg & 31; rows = 32; } else { grow0 = 256 + (((Rg - 256) >> 8) << 8); r = (Rg - 256) & 255; rows = 256; }
    int r0 = r - 4; r0 = r0 < 0 ? 0 : r0; r0 = r0 > rows - 8 ? rows - 8 : r0;
    ktok0 = (grow0 + r0) * 64; NT = 8;
    na_hl = w >> 1; head = hpair * 2 + na_hl;
    na_c = (w & 1) * 32 + r32; na_c0 = na_c - 8; na_c0 = na_c0 < 0 ? 0 : na_c0; na_c0 = na_c0 > 48 ? 48 : na_c0;
    na_relrow0 = r0 - r + 7;
    qtok = Rg * 64 + na_c;
    Qp = p.qkv + (long)qtok * 3072 + head * 64 + hi * 8;
    obase = (long)(Rg * 64 + (w & 1) * 32) * 1024 + head * 64;
    kcolB = na_hl * 128;
    __syncthreads();
    { const float* src = p.na_rpb_s + ((long)layer * 16 + hpair * 2) * 465;
      for (int e = tid; e < 930; e += 256) rpbl[e] = src[e]; }
  }
  bf16x8 qr[KST];
#pragma unroll
  for (int d = 0; d < KST; ++d) qr[d] = *(const bf16x8*)(Qp + d * 16);

  bf16x8 sk[MODE == 0 ? 6 : 4], sv[4];
  const int s_key = tid >> 4, s_ch = tid & 15;
  const int s_key8 = tid >> 3, s_ch8 = tid & 7;
#define ALOAD(j) do { const long kt_ = (long)ktok0 + (j) * 64; \
    if constexpr (MODE == 0) { \
      _Pragma("unroll") for (int i = 0; i < 4; ++i) { const u16* b_ = p.kv + (kt_ + s_key + 16 * i) * 2048 + head * 256 + s_ch * 8; sk[i] = *(const bf16x8*)b_; sv[i] = *(const bf16x8*)(b_ + 128); } \
      _Pragma("unroll") for (int i = 0; i < 2; ++i) sk[4 + i] = *(const bf16x8*)(p.cqkv + (kt_ + s_key8 + 32 * i) * 768 + 640 + s_ch8 * 8); \
    } else { \
      _Pragma("unroll") for (int i = 0; i < 4; ++i) { const u16* b_ = p.qkv + (kt_ + s_key + 16 * i) * 3072 + 1024 + (head & ~1) * 64 + s_ch * 8; sk[i] = *(const bf16x8*)b_; sv[i] = *(const bf16x8*)(b_ + 1024); } \
    } } while (0)
#define AWRITE() do { \
    _Pragma("unroll") for (int i = 0; i < 4; ++i) { *(bf16x8*)(Kl + (s_key + 16 * i) * KROW + s_ch * 16) = sk[i]; *(bf16x8*)(Vl + v_st(s_key + 16 * i, s_ch * 8)) = sv[i]; } \
    if constexpr (MODE == 0) { _Pragma("unroll") for (int i = 0; i < 2; ++i) *(bf16x8*)(Kl + (s_key8 + 32 * i) * KROW + 256 + s_ch8 * 16) = sk[4 + i]; } } while (0)

  float m_reg = -1e30f, l_reg = 0.f;
  f32x16 o[ND0];
#pragma unroll
  for (int d = 0; d < ND0; ++d)
#pragma unroll
    for (int r = 0; r < 16; ++r) o[d][r] = 0.f;
  const int vb0 = (int)(uintptr_t)Vl + v_rd_base(lane) + (MODE == 1 ? na_hl * 1024 : 0);

  ALOAD(0);
  for (int j = 0; j < NT; ++j) {
    __syncthreads();
    AWRITE();
    __syncthreads();
    if (j + 1 < NT) ALOAD(j + 1);
    f32x16 p0, p1;
#pragma unroll
    for (int r = 0; r < 16; ++r) { p0[r] = 0.f; p1[r] = 0.f; }
#pragma unroll
    for (int d = 0; d < KST; ++d) {
      const int cb = kcolB + (d * 16 + hi * 8) * 2;
      bf16x8 b0 = *(const bf16x8*)(Kl + r32 * KROW + cb), b1 = *(const bf16x8*)(Kl + (32 + r32) * KROW + cb);
      p0 = mfma32(b0, qr[d], p0); p1 = mfma32(b1, qr[d], p1);
    }
    if constexpr (MODE == 1) {
      const float* rb = rpbl + (na_hl * 15 + na_relrow0 + j) * 31;
#pragma unroll
      for (int r = 0; r < 16; ++r) {
        const int kc0 = crow(r, hi), kc1 = 32 + kc0;
        int i0 = kc0 - na_c + 15, i1 = kc1 - na_c + 15;
        i0 = i0 < 0 ? 0 : (i0 > 30 ? 30 : i0); i1 = i1 < 0 ? 0 : (i1 > 30 ? 30 : i1);
        const float b0 = rb[i0], b1 = rb[i1];
        p0[r] = ((unsigned)(kc0 - na_c0) < 16u) ? p0[r] + b0 : -1e30f;
        p1[r] = ((unsigned)(kc1 - na_c0) < 16u) ? p1[r] + b1 : -1e30f;
      }
    }
    float alpha;
    partialSM(p0, p1, m_reg, alpha);
    if (__any(alpha < 1.f)) {
      if (hi == 0) al_l[r32] = alpha;
      __builtin_amdgcn_wave_barrier();
#pragma unroll
      for (int r = 0; r < 16; ++r) { const float a = al_l[crow(r, hi)];
#pragma unroll
        for (int d = 0; d < ND0; ++d) o[d][r] *= a; }
      __builtin_amdgcn_wave_barrier();
    }
    bf16x8 pa0, pa1, pa2, pa3;
    finishSM(p0, p1, alpha, l_reg, pa0, pa1, pa2, pa3);
    pv_one<0>(o[0], vb0, pa0, pa1, pa2, pa3); pv_one<1>(o[1], vb0, pa0, pa1, pa2, pa3);
    if constexpr (MODE == 0) { pv_one<2>(o[2], vb0, pa0, pa1, pa2, pa3); pv_one<3>(o[3], vb0, pa0, pa1, pa2, pa3); }
  }
#undef ALOAD
#undef AWRITE
  if (hi == 0) li_l[r32] = l_reg;
  __builtin_amdgcn_wave_barrier();
#pragma unroll
  for (int r = 0; r < 16; ++r) {
    const int qrow = crow(r, hi); const float rl = 1.f / li_l[qrow];
    u16* o_ = p.o + obase + (long)qrow * 1024 + r32;
#pragma unroll
    for (int d = 0; d < ND0; ++d) o_[d * 32] = (u16)(cvtpk(o[d][r] * rl, 0.f) & 0xffffu);
  }
  __builtin_amdgcn_wave_barrier();
}

__device__ __forceinline__ float lane_bcast(float v, int src_lane) { return __int_as_float(__builtin_amdgcn_ds_bpermute(src_lane << 2, __float_as_int(v))); }
__device__ __forceinline__ float rowmax32(const f32x16& p0, const f32x16& p1) {
  float pmax = p0[0];
#pragma unroll
  for (int r = 1; r < 16; ++r) pmax = fmaxf(pmax, p0[r]);
#pragma unroll
  for (int r = 0; r < 16; ++r) pmax = fmaxf(pmax, p1[r]);
  auto rr = __builtin_amdgcn_permlane32_swap(__float_as_uint(pmax), __float_as_uint(pmax), false, false);
  return fmaxf(__uint_as_float(rr[0]), __uint_as_float(rr[1]));
}

typedef __attribute__((ext_vector_type(8))) int i32x8;
#define MFMA8(A, B, C, SA, SB_) __builtin_amdgcn_mfma_scale_f32_32x32x64_f8f6f4(A, B, C, 0, 0, 0, SA, 0, SB_)
constexpr int SC_K = 0x7D7D7D7D, SC_Q = 0x7B7B7B7B, SC_P = 0x7F7F7F7F, SC_V = 0x7D7D7D7D;
constexpr float THR8_L2 = 1.5f;

__device__ __forceinline__ void attn_mla(KP p, int item, char* lds) {
  constexpr int KSTAGE = 64 * 192, VSTAGE = 128 * 64, VOFF = 2 * KSTAGE;
  int tid_ = threadIdx.x; asm volatile("" : "+v"(tid_));
  const int tid = tid_, lane = tid & 63, w = tid >> 6, r32 = lane & 31, hi = lane >> 5;
  int NT, ktok0, head, seq, qb;
  if (item < 2048) { const int sh = item >> 7; seq = 8 + (sh >> 3); head = sh & 7; qb = item & 127; ktok0 = T_PROMPT + (seq - 8) * 16384; NT = 256; }
  else { const int it = item - 2048; const int sh = it >> 4; seq = sh >> 3; head = sh & 7; qb = it & 15; ktok0 = seq * 2048; NT = 32; }
  const int qtok = ktok0 + qb * 128 + w * 32 + r32;
  const long obase = (long)(ktok0 + qb * 128 + w * 32) * 1024 + head * 128;
  i32x8 qf[3];
  { const unsigned char* Qp = p.q8 + (long)qtok * 1536 + head * 192 + hi * 32;
#pragma unroll
    for (int s3 = 0; s3 < 3; ++s3) { const u32x4 a = *(const u32x4*)(Qp + s3 * 64), b = *(const u32x4*)(Qp + s3 * 64 + 16);
      qf[s3] = (i32x8){(int)a[0], (int)a[1], (int)a[2], (int)a[3], (int)b[0], (int)b[1], (int)b[2], (int)b[3]}; } }
  unsigned ko[3], vo[2];
#pragma unroll
  for (int i = 0; i < 3; ++i) {
    const int g = (w * 3 + i) * 64 + lane, key = g / 12, pc = g - key * 12, c = pc ^ ((key >> 2) & 3);
    ko[i] = (c < 8) ? (unsigned)(key * 1088 + head * 128 + c * 16) : (unsigned)(key * 1088 + 1024 + (c - 8) * 16);
  }
#pragma unroll
  for (int i = 0; i < 2; ++i) {
    const int g = (w * 2 + i) * 64 + lane, d = g >> 2, pc = g & 3, c = pc ^ ((d >> 2) & 3);
    vo[i] = (unsigned)(d * T_TOK + c * 16);
  }
  const unsigned char* k8b = p.k8 + (long)ktok0 * 1088;
  const unsigned char* vtb = p.vT8 + (long)head * 128 * T_TOK + ktok0;
#define GLK(st, jt) do { const unsigned char* kt_ = k8b + (long)(jt) * (64 * 1088); int w_ = w; asm volatile("" : "+v"(w_)); \
    _Pragma("unroll") for (int i = 0; i < 3; ++i) { unsigned k_ = ko[i]; asm volatile("" : "+v"(k_)); \
    __builtin_amdgcn_global_load_lds((const unsigned*)(kt_ + k_), (unsigned*)(lds + (st) * KSTAGE + (w_ * 3 + i) * 1024), 16, 0, 0); } } while (0)
#define GLV(st, jt) do { const unsigned char* vt_ = vtb + (long)(jt) * 64; int w_ = w; asm volatile("" : "+v"(w_)); \
    _Pragma("unroll") for (int i = 0; i < 2; ++i) { unsigned v_ = vo[i]; asm volatile("" : "+v"(v_)); \
    __builtin_amdgcn_global_load_lds((const unsigned*)(vt_ + v_), (unsigned*)(lds + VOFF + (st) * VSTAGE + (w_ * 2 + i) * 1024), 16, 0, 0); } } while (0)
#define QK8(P0, P1, st) do { const int r_ = r32, h_ = hi, sw_ = (r_ >> 2) & 3; const char* Kr_ = lds + (st) * KSTAGE + r_ * 192; \
    const f32x16 z_ = {0.f, 0.f, 0.f, 0.f, 0.f, 0.f, 0.f, 0.f, 0.f, 0.f, 0.f, 0.f, 0.f, 0.f, 0.f, 0.f}; \
    _Pragma("unroll") for (int s3 = 0; s3 < 3; ++s3) { const int c0_ = ((s3 * 4 + h_ * 2) ^ sw_) << 4, c1_ = ((s3 * 4 + h_ * 2 + 1) ^ sw_) << 4; \
      const u32x4 a0_ = *(const u32x4*)(Kr_ + c0_), a1_ = *(const u32x4*)(Kr_ + c1_), b0_ = *(const u32x4*)(Kr_ + 32 * 192 + c0_), b1_ = *(const u32x4*)(Kr_ + 32 * 192 + c1_); \
      const i32x8 ka_ = {(int)a0_[0], (int)a0_[1], (int)a0_[2], (int)a0_[3], (int)a1_[0], (int)a1_[1], (int)a1_[2], (int)a1_[3]}; \
      const i32x8 kb_ = {(int)b0_[0], (int)b0_[1], (int)b0_[2], (int)b0_[3], (int)b1_[0], (int)b1_[1], (int)b1_[2], (int)b1_[3]}; \
      P0 = MFMA8(ka_, qf[s3], (s3 == 0 ? z_ : P0), SC_K, SC_Q); P1 = MFMA8(kb_, qf[s3], (s3 == 0 ? z_ : P1), SC_K, SC_Q); } } while (0)
#define PZERO(P0, P1) do { _Pragma("unroll") for (int r = 0; r < 16; ++r) { P0[r] = 0.f; P1[r] = 0.f; } } while (0)
#define EXPC(P, mn, R0, R1) do { _Pragma("unroll") for (int r = (R0); r < (R1); ++r) P[r] = __builtin_amdgcn_exp2f(P[r] - (mn)); } while (0)
#define SB() do {} while (0)

  float m_reg = -1e30f, l_reg = 0.f;
  f32x16 o[4];
#pragma unroll
  for (int d = 0; d < 4; ++d)
#pragma unroll
    for (int r = 0; r < 16; ++r) o[d][r] = 0.f;
  f32x16 pA0, pA1, pB0, pB1; float pmaxA, pmaxB;

  __syncthreads();
  GLK(0, 0); GLV(0, 0); GLK(1, 1);
  asm volatile("s_waitcnt vmcnt(0)" ::: "memory");
  __syncthreads();
  QK8(pA0, pA1, 0); pmaxA = rowmax32(pA0, pA1);

#define STEP(j, PX0, PX1, PMX, PY0, PY1, PMY, LAST) do { \
    asm volatile("s_waitcnt lgkmcnt(0)" ::: "memory"); __builtin_amdgcn_s_barrier(); \
    if ((j) + 2 < NT) GLK((j) & 1, (j) + 2); \
    if (!(LAST)) GLV(((j) + 1) & 1, (j) + 1); \
    const bool keep_ = __all(PMX - m_reg <= THR8_L2); \
    const float mn_ = keep_ ? m_reg : fmaxf(m_reg, PMX); \
    const float alpha_ = keep_ ? 1.f : __builtin_amdgcn_exp2f(m_reg - mn_); m_reg = mn_; \
    if (!keep_) { _Pragma("unroll") for (int r = 0; r < 16; ++r) { const float a_ = lane_bcast(alpha_, crow(r, hi)); \
      _Pragma("unroll") for (int d = 0; d < 4; ++d) o[d][r] *= a_; } } \
    SB(); \
    if (!(LAST)) { QK8(PY0, PY1, ((j) + 1) & 1); } \
    { const float mnp_ = mn_ - 7.f; EXPC(PX0, mnp_, 0, 16); EXPC(PX1, mnp_, 0, 16); }     \
    SB(); \
    { float ps_ = 0.f; \
      _Pragma("unroll") for (int r = 0; r < 16; ++r) ps_ += PX0[r] + PX1[r]; \
      auto rr_ = __builtin_amdgcn_permlane32_swap(__float_as_uint(ps_), __float_as_uint(ps_), false, false); \
      l_reg = l_reg * alpha_ + __uint_as_float(rr_[0]) + __uint_as_float(rr_[1]); } \
    i32x8 pf_; \
    _Pragma("unroll") for (int g = 0; g < 4; ++g) { \
      const u32 x_ = pack4_fp8(PX0[4 * g], PX0[4 * g + 1], PX0[4 * g + 2], PX0[4 * g + 3]); \
      const u32 y_ = pack4_fp8(PX1[4 * g], PX1[4 * g + 1], PX1[4 * g + 2], PX1[4 * g + 3]); \
      auto sw_ = __builtin_amdgcn_permlane32_swap(x_, y_, false, false); pf_[2 * g] = (int)sw_[0]; pf_[2 * g + 1] = (int)sw_[1]; } \
    SB(); \
    { const int r_ = r32, h_ = hi, sw2_ = (r_ >> 2) & 3; \
      const char* Vr_ = lds + VOFF + ((j) & 1) * VSTAGE + r_ * 64; const int c0_ = ((h_ * 2) ^ sw2_) << 4, c1_ = ((h_ * 2 + 1) ^ sw2_) << 4; \
      _Pragma("unroll") for (int d0 = 0; d0 < 4; ++d0) { \
        const u32x4 a0_ = *(const u32x4*)(Vr_ + d0 * 2048 + c0_), a1_ = *(const u32x4*)(Vr_ + d0 * 2048 + c1_); \
        const i32x8 vf_ = {(int)a0_[0], (int)a0_[1], (int)a0_[2], (int)a0_[3], (int)a1_[0], (int)a1_[1], (int)a1_[2], (int)a1_[3]}; \
        o[d0] = MFMA8(pf_, vf_, o[d0], SC_P, SC_V); } } \
    if (!(LAST)) PMY = rowmax32(PY0, PY1); \
    asm volatile("s_waitcnt vmcnt(0)" ::: "memory"); } while (0)

  for (int j = 0; j < NT - 2; j += 2) {
    STEP(j, pA0, pA1, pmaxA, pB0, pB1, pmaxB, false);
    STEP(j + 1, pB0, pB1, pmaxB, pA0, pA1, pmaxA, false);
  }
  STEP(NT - 2, pA0, pA1, pmaxA, pB0, pB1, pmaxB, false);
  STEP(NT - 1, pB0, pB1, pmaxB, pA0, pA1, pmaxA, true);
#undef STEP
#undef QK8
#undef PZERO
#undef EXPC
#undef SB
#undef GLK
#undef GLV
#pragma unroll
  for (int r = 0; r < 16; ++r) {
    const int qrow = crow(r, hi); const float rl = 1.f / lane_bcast(l_reg, qrow);
    u16* o_ = p.o + obase + (long)qrow * 1024 + r32;
#pragma unroll
    for (int d = 0; d < 4; ++d) o_[d * 32] = (u16)(cvtpk(o[d][r] * rl, 0.f) & 0xffffu);
  }
}

typedef __attribute__((ext_vector_type(2))) float f32x2;
constexpr float U_SCALE = 256.f, V_SCALE = 64.f;
__device__ __forceinline__ float keyval(u32 k) { return __uint_as_float(k & ~127u) - KEY_BIAS; }
template <int CTRL> __device__ __forceinline__ float dppf(float v) { return __int_as_float(__builtin_amdgcn_update_dpp(0, __float_as_int(v), CTRL, 0xF, 0xF, true)); }
__device__ __forceinline__ float red16(float v) { v += dppf<0xB1>(v); v += dppf<0x4E>(v); v += dppf<0x141>(v); v += dppf<0x140>(v); return v; }
__device__ __forceinline__ void fp8dot(u32 dw, const f32x4& x, f32x2& acc) {
  const f32x2 lo = __builtin_amdgcn_cvt_pk_f32_fp8((int)dw, false), hi = __builtin_amdgcn_cvt_pk_f32_fp8((int)dw, true);
  acc = __builtin_elementwise_fma(lo, (f32x2){x[0], x[1]}, acc); acc = __builtin_elementwise_fma(hi, (f32x2){x[2], x[3]}, acc);
}

#ifndef PEER_FP4
#define PEER_FP4 1
#endif
#if PEER_FP4
constexpr float U4_SCALE = 96.f, V4_SCALE = 22.f;
__device__ __forceinline__ void fp4dot(u32 dw, const f32x4& x0, const f32x4& x1, f32x2& acc) {
  acc = __builtin_elementwise_fma(__builtin_amdgcn_cvt_scalef32_pk_f32_fp4(dw, 1.0f, 0), (f32x2){x0[0], x0[1]}, acc);
  acc = __builtin_elementwise_fma(__builtin_amdgcn_cvt_scalef32_pk_f32_fp4(dw, 1.0f, 1), (f32x2){x0[2], x0[3]}, acc);
  acc = __builtin_elementwise_fma(__builtin_amdgcn_cvt_scalef32_pk_f32_fp4(dw, 1.0f, 2), (f32x2){x1[0], x1[1]}, acc);
  acc = __builtin_elementwise_fma(__builtin_amdgcn_cvt_scalef32_pk_f32_fp4(dw, 1.0f, 3), (f32x2){x1[2], x1[3]}, acc);
}
__device__ __forceinline__ void phase_peer_combine(KP p, int layer, char* lds, unsigned* ctr) {
  const bool last = (layer == 3);
  int tid_ = threadIdx.x; asm volatile("" : "+v"(tid_));
  const int tid = tid_, lane = tid & 63, w = tid >> 6;
  int* eL = (int*)(lds + w * 1536); float* gL = (float*)(lds + w * 1536 + 512); float* wL = (float*)(lds + w * 1536 + 1024);
  int ci = 0, cj = 0; bool cvalid = false;
  { int cnt = 0;
#pragma unroll
    for (int i = 0; i < 16; ++i) { const int n = 16 / (i + 1); if (!cvalid && lane < cnt + n) { ci = i; cj = lane - cnt; cvalid = true; } cnt += n; } }
  const unsigned char* U = p.peer_u8 + (long)layer * 16384 * 512; const unsigned char* V = p.peer_v8 + (long)layer * 16384 * 512;
  const int sub = lane & 15, grp = lane >> 4, l32 = lane & 31, hf = lane >> 5;
  __syncthreads();
  for (;;) {
   int base_ = 0; if (lane == 0) base_ = (int)atomicAdd(ctr, 4u);
   base_ = __builtin_amdgcn_readfirstlane(base_);
   if (base_ >= T_TOK) break;
#pragma unroll 1
   for (int t = base_; t < base_ + 4; ++t) {
    float* xr = p.x + (long)t * DM;
    const u32* pk = p.pkeys + (long)t * 256;
    u32 ka[8], kb[8];
#pragma unroll
    for (int hd = 0; hd < 8; ++hd) { ka[hd] = pk[hd * 32 + ci]; kb[hd] = pk[hd * 32 + 16 + cj]; }
    u32 xe[2][4], xo[2][4]; int sumx = 0; float rstd, sx;
    f32x4 xs[2][8];
#pragma unroll
    for (int j = 0; j < 2; ++j)
#pragma unroll
      for (int q = 0; q < 8; ++q) xs[j][q] = *(const f32x4*)(xr + (sub + 16 * j) * 32 + q * 4);
#pragma unroll
    for (int hd = 0; hd < 8; ++hd) {
      const float cand = cvalid ? keyval(ka[hd]) + keyval(kb[hd]) : -3.0e38f;
      u32 ck = __float_as_uint(cand); ck = (ck & 0x80000000u) ? ~ck : (ck | 0x80000000u); ck = (ck & ~63u) | (u32)(63 - lane);
      int rank = 0;
#pragma unroll
      for (int m = 0; m < 50; ++m) { const u32 c = __builtin_amdgcn_readlane(ck, m); rank += (c > ck) ? 1 : 0; }
      const float cmax = __uint_as_float(__builtin_amdgcn_readlane(__float_as_uint(cand), 0));
      if (cvalid && rank < 16) { eL[hd * 16 + rank] = (int)((ka[hd] & 127u) * 128u + (kb[hd] & 127u)); gL[hd * 16 + rank] = __expf(cand - cmax); }
    }
    __builtin_amdgcn_wave_barrier();
    { const float g0 = gL[lane], g1 = gL[lane + 64]; const float s0 = red16(g0), s1 = red16(g1);
      __builtin_amdgcn_wave_barrier();
      gL[lane] = g0 / s0; gL[lane + 64] = g1 / s1; }
    __builtin_amdgcn_wave_barrier();
    u32x4 cA[8], cB[8];
#define LOADU(C, it) do { const int k0_ = (it) * 16 + grp * 4; \
      _Pragma("unroll") for (int rr = 0; rr < 4; ++rr) { const int e_ = eL[k0_ + rr]; const unsigned char* u_ = U + (long)e_ * 512 + sub * 16; \
        C[rr * 2] = *(const u32x4*)u_; C[rr * 2 + 1] = *(const u32x4*)(u_ + 256); } } while (0)
#define COMPU(C, it) do { const int k0_ = (it) * 16 + grp * 4; \
      _Pragma("unroll") for (int rr = 0; rr < 4; ++rr) { int a_ = 0; \
        _Pragma("unroll") for (int j = 0; j < 2; ++j) { _Pragma("unroll") for (int d = 0; d < 4; ++d) { const u32 dw_ = C[rr * 2 + j][d]; \
          a_ = __builtin_amdgcn_sdot4((int)(dw_ & 0x0F0F0F0Fu), (int)xe[j][d], a_, false); a_ = __builtin_amdgcn_sdot4((int)((dw_ >> 4) & 0x0F0F0F0Fu), (int)xo[j][d], a_, false); } } \
        const float r_ = red16((float)(a_ - 8 * sumx)); \
        if (sub == 0) wL[k0_ + rr] = r_; } } while (0)
#define LOADV(C, g) do { _Pragma("unroll") for (int i = 0; i < 8; ++i) { const int e_ = eL[(g) * 16 + 2 * i + hf]; \
      C[i] = *(const u32x4*)(V + (long)e_ * 512 + l32 * 16); } } while (0)
#define COMPV(C, g) do { _Pragma("unroll") for (int i = 0; i < 8; ++i) { const float wk_ = wL[(g) * 16 + 2 * i + hf]; const f32x2 w2_ = {wk_, wk_}; \
      _Pragma("unroll") for (int d = 0; d < 4; ++d) { const u32 dw_ = C[i][d]; \
        out[d * 4 + 0] = __builtin_elementwise_fma(__builtin_amdgcn_cvt_scalef32_pk_f32_fp4(dw_, 1.0f, 0), w2_, out[d * 4 + 0]); \
        out[d * 4 + 1] = __builtin_elementwise_fma(__builtin_amdgcn_cvt_scalef32_pk_f32_fp4(dw_, 1.0f, 1), w2_, out[d * 4 + 1]); \
        out[d * 4 + 2] = __builtin_elementwise_fma(__builtin_amdgcn_cvt_scalef32_pk_f32_fp4(dw_, 1.0f, 2), w2_, out[d * 4 + 2]); \
        out[d * 4 + 3] = __builtin_elementwise_fma(__builtin_amdgcn_cvt_scalef32_pk_f32_fp4(dw_, 1.0f, 3), w2_, out[d * 4 + 3]); } } } while (0)
    LOADU(cA, 0);
    { float ss = 0.f, am = 0.f;
#pragma unroll
      for (int j = 0; j < 2; ++j)
#pragma unroll
        for (int q = 0; q < 8; ++q) { const f32x4 a = xs[j][q]; ss += a[0] * a[0] + a[1] * a[1] + a[2] * a[2] + a[3] * a[3];
          am = fmaxf(fmaxf(am, fmaxf(fabsf(a[0]), fabsf(a[1]))), fmaxf(fabsf(a[2]), fabsf(a[3]))); }
      ss = red16(ss);
      am = fmaxf(am, dppf<0xB1>(am)); am = fmaxf(am, dppf<0x4E>(am)); am = fmaxf(am, dppf<0x141>(am)); am = fmaxf(am, dppf<0x140>(am));
      rstd = rsqrtf(ss * (1.f / DM) + RMS_EPS);
      am = fmaxf(am, 1e-20f); sx = am * (1.f / 127.f); const float inv = 127.f / am;
#pragma unroll
      for (int j = 0; j < 2; ++j)
#pragma unroll
        for (int d = 0; d < 4; ++d) {
          const f32x4 lo4 = xs[j][2 * d], hi4 = xs[j][2 * d + 1];
          const int i0 = (int)__builtin_rintf(lo4[0] * inv), i1 = (int)__builtin_rintf(lo4[1] * inv), i2 = (int)__builtin_rintf(lo4[2] * inv), i3 = (int)__builtin_rintf(lo4[3] * inv);
          const int i4 = (int)__builtin_rintf(hi4[0] * inv), i5 = (int)__builtin_rintf(hi4[1] * inv), i6 = (int)__builtin_rintf(hi4[2] * inv), i7 = (int)__builtin_rintf(hi4[3] * inv);
          sumx += i0 + i1 + i2 + i3 + i4 + i5 + i6 + i7;
          xe[j][d] = (u32)(i0 & 0xFF) | ((u32)(i2 & 0xFF) << 8) | ((u32)(i4 & 0xFF) << 16) | ((u32)i6 << 24);
          xo[j][d] = (u32)(i1 & 0xFF) | ((u32)(i3 & 0xFF) << 8) | ((u32)(i5 & 0xFF) << 16) | ((u32)i7 << 24);
        } }
#pragma unroll 1
    for (int it = 0; it < 6; it += 2) { LOADU(cB, it + 1); COMPU(cA, it); LOADU(cA, it + 2); COMPU(cB, it + 1); }
    LOADU(cB, 7); COMPU(cA, 6);
    LOADV(cA, 0);
    COMPU(cB, 7);
    __builtin_amdgcn_wave_barrier();
    { const float sc_ = rstd * sx * (1.f / U4_SCALE); const float a0 = wL[lane] * sc_, a1 = wL[lane + 64] * sc_;
      const float w0 = gL[lane] * 0.5f * a0 * (1.f + erff(a0 * 0.70710678118654752f)), w1 = gL[lane + 64] * 0.5f * a1 * (1.f + erff(a1 * 0.70710678118654752f));
      __builtin_amdgcn_wave_barrier();
      wL[lane] = w0; wL[lane + 64] = w1; }
    __builtin_amdgcn_wave_barrier();
    f32x2 out[16];
#pragma unroll
    for (int i = 0; i < 16; ++i) out[i] = (f32x2){0.f, 0.f};
#pragma unroll 1
    for (int g = 0; g < 6; g += 2) { LOADV(cB, g + 1); COMPV(cA, g); LOADV(cA, g + 2); COMPV(cB, g + 1); }
    LOADV(cB, 7); COMPV(cA, 6); COMPV(cB, 7);
#undef LOADU
#undef COMPU
#undef LOADV
#undef COMPV
    {
      f32x4 v[4];
#pragma unroll
      for (int q = 0; q < 4; ++q) {
        const f32x2 m0 = hf ? out[8 + 2 * q] : out[2 * q], o0 = hf ? out[2 * q] : out[8 + 2 * q];
        const f32x2 m1 = hf ? out[8 + 2 * q + 1] : out[2 * q + 1], o1 = hf ? out[2 * q + 1] : out[8 + 2 * q + 1];
        v[q] = (f32x4){m0[0] + shx(o0[0], 32), m0[1] + shx(o0[1], 32), m1[0] + shx(o1[0], 32), m1[1] + shx(o1[1], 32)};
      }
      f32x4* xo = (f32x4*)(xr + l32 * 32 + hf * 16);
#pragma unroll
      for (int q = 0; q < 4; ++q) { const f32x4 xv = xo[q]; v[q] = xv + v[q] * (1.f / V4_SCALE); }
      __builtin_amdgcn_wave_barrier();
      if (last) {
        float s2 = 0.f;
#pragma unroll
        for (int q = 0; q < 4; ++q) s2 += v[q][0] * v[q][0] + v[q][1] * v[q][1] + v[q][2] * v[q][2] + v[q][3] * v[q][3];
        s2 = red16(s2); s2 += shx(s2, 16); s2 += shx(s2, 32);
        const float rf = rsqrtf(s2 * (1.f / DM) + RMS_EPS);
#pragma unroll
        for (int q = 0; q < 4; ++q) { const f32x4 gf = *(const f32x4*)(p.norm_final + l32 * 32 + hf * 16 + q * 4); v[q] = v[q] * rf * gf; }
      }
#pragma unroll
      for (int q = 0; q < 4; ++q) xo[q] = v[q];
      u32x4* xbo = (u32x4*)(p.xb + (long)t * DM + l32 * 32 + hf * 16);
      xbo[0] = (u32x4){cvtpk(v[0][0], v[0][1]), cvtpk(v[0][2], v[0][3]), cvtpk(v[1][0], v[1][1]), cvtpk(v[1][2], v[1][3])};
      xbo[1] = (u32x4){cvtpk(v[2][0], v[2][1]), cvtpk(v[2][2], v[2][3]), cvtpk(v[3][0], v[3][1]), cvtpk(v[3][2], v[3][3])}; }
    __builtin_amdgcn_wave_barrier();
   }
  }
}
#else
__device__ __forceinline__ void phase_peer_combine(KP p, int layer, char* lds, unsigned*) {
  const bool last = (layer == 3);
  int tid_ = threadIdx.x; asm volatile("" : "+v"(tid_));
  const int tid = tid_, lane = tid & 63, w = tid >> 6;
  int* eL = (int*)(lds + w * 1536); float* gL = (float*)(lds + w * 1536 + 512); float* wL = (float*)(lds + w * 1536 + 1024);
  int ci = 0, cj = 0; bool cvalid = false;
  { int cnt = 0;
#pragma unroll
    for (int i = 0; i < 16; ++i) { const int n = 16 / (i + 1); if (!cvalid && lane < cnt + n) { ci = i; cj = lane - cnt; cvalid = true; } cnt += n; } }
  const unsigned char* U = p.peer_u8 + (long)layer * 16384 * 1024; const unsigned char* V = p.peer_v8 + (long)layer * 16384 * 1024;
  const int sub = lane & 15, grp = lane >> 4;
  __syncthreads();
  for (int t = blockIdx.x * 4 + w; t < T_TOK; t += gridDim.x * 4) {
    float* xr = p.x + (long)t * DM;
    const u32* pk = p.pkeys + (long)t * 256;
    u32 ka[8], kb[8];
#pragma unroll
    for (int hd = 0; hd < 8; ++hd) { ka[hd] = pk[hd * 32 + ci]; kb[hd] = pk[hd * 32 + 16 + cj]; }
    f32x4 xs[4][4]; float ss = 0.f;
#pragma unroll
    for (int i = 0; i < 4; ++i)
#pragma unroll
      for (int q = 0; q < 4; ++q) { const f32x4 a = *(const f32x4*)(xr + (sub + 16 * i) * 16 + q * 4); xs[i][q] = a; ss += a[0] * a[0] + a[1] * a[1] + a[2] * a[2] + a[3] * a[3]; }
    ss = red16(ss);
    const float rstd = rsqrtf(ss * (1.f / DM) + RMS_EPS);
#pragma unroll
    for (int hd = 0; hd < 8; ++hd) {
      const float cand = cvalid ? keyval(ka[hd]) + keyval(kb[hd]) : -3.0e38f;
      u32 ck = __float_as_uint(cand); ck = (ck & 0x80000000u) ? ~ck : (ck | 0x80000000u); ck = (ck & ~63u) | (u32)(63 - lane);
      int rank = 0;
#pragma unroll
      for (int m = 0; m < 50; ++m) { const u32 c = __builtin_amdgcn_readlane(ck, m); rank += (c > ck) ? 1 : 0; }
      const float cmax = __uint_as_float(__builtin_amdgcn_readlane(__float_as_uint(cand), 0));
      if (cvalid && rank < 16) { eL[hd * 16 + rank] = (int)((ka[hd] & 127u) * 128u + (kb[hd] & 127u)); gL[hd * 16 + rank] = __expf(cand - cmax); }
    }
    __builtin_amdgcn_wave_barrier();
    { const float g0 = gL[lane], g1 = gL[lane + 64]; const float s0 = red16(g0), s1 = red16(g1);
      __builtin_amdgcn_wave_barrier();
      gL[lane] = g0 / s0; gL[lane + 64] = g1 / s1; }
    __builtin_amdgcn_wave_barrier();
    u32x4 cA[8], cB[8];
#define LOADU(C, it) do { const int k0_ = (it) * 8 + grp * 2; const int e0_ = eL[k0_], e1_ = eL[k0_ + 1]; \
      const unsigned char* u0_ = U + (long)e0_ * 1024 + sub * 16; const unsigned char* u1_ = U + (long)e1_ * 1024 + sub * 16; \
      _Pragma("unroll") for (int i = 0; i < 4; ++i) { C[i] = *(const u32x4*)(u0_ + i * 256); C[4 + i] = *(const u32x4*)(u1_ + i * 256); } } while (0)
#define COMPU(C, it) do { const int k0_ = (it) * 8 + grp * 2; f32x2 a0_ = {0.f, 0.f}, a1_ = {0.f, 0.f}; \
      _Pragma("unroll") for (int i = 0; i < 4; ++i) { _Pragma("unroll") for (int q = 0; q < 4; ++q) { fp8dot(C[i][q], xs[i][q], a0_); fp8dot(C[4 + i][q], xs[i][q], a1_); } } \
      const float r0_ = red16(a0_[0] + a0_[1]), r1_ = red16(a1_[0] + a1_[1]); \
      if (sub == 0) { const float aa_ = r0_ * rstd * (1.f / U_SCALE), ab_ = r1_ * rstd * (1.f / U_SCALE); \
        wL[k0_] = gL[k0_] * 0.5f * aa_ * (1.f + erff(aa_ * 0.70710678118654752f)); \
        wL[k0_ + 1] = gL[k0_ + 1] * 0.5f * ab_ * (1.f + erff(ab_ * 0.70710678118654752f)); } } while (0)
#define LOADV(C, g) do { _Pragma("unroll") for (int i = 0; i < 8; ++i) { const int e_ = eL[(g) * 8 + i]; C[i] = *(const u32x4*)(V + (long)e_ * 1024 + lane * 16); } } while (0)
#define COMPV(C, g) do { _Pragma("unroll") for (int i = 0; i < 8; ++i) { const float wk_ = wL[(g) * 8 + i]; const f32x2 w2_ = {wk_, wk_}; \
      _Pragma("unroll") for (int q = 0; q < 4; ++q) { \
        const f32x2 lo_ = __builtin_amdgcn_cvt_pk_f32_fp8((int)C[i][q], false), hi_ = __builtin_amdgcn_cvt_pk_f32_fp8((int)C[i][q], true); \
        out[2 * q] = __builtin_elementwise_fma(lo_, w2_, out[2 * q]); out[2 * q + 1] = __builtin_elementwise_fma(hi_, w2_, out[2 * q + 1]); } } } while (0)
    LOADU(cA, 0);
#pragma unroll 1
    for (int it = 0; it < 14; it += 2) { LOADU(cB, it + 1); COMPU(cA, it); LOADU(cA, it + 2); COMPU(cB, it + 1); }
    LOADU(cB, 15); COMPU(cA, 14);
    LOADV(cA, 0);
    COMPU(cB, 15);
    __builtin_amdgcn_wave_barrier();
    f32x2 out[8];
#pragma unroll
    for (int i = 0; i < 8; ++i) out[i] = (f32x2){0.f, 0.f};
#pragma unroll 1
    for (int g = 0; g < 14; g += 2) { LOADV(cB, g + 1); COMPV(cA, g); LOADV(cA, g + 2); COMPV(cB, g + 1); }
    LOADV(cB, 15); COMPV(cA, 14); COMPV(cB, 15);
#undef LOADU
#undef COMPU
#undef LOADV
#undef COMPV
    { f32x4* xo = (f32x4*)(xr + lane * 16);
      f32x4 v[4];
#pragma unroll
      for (int q = 0; q < 4; ++q) { v[q] = xo[q]; v[q][0] += out[2 * q][0] * (1.f / V_SCALE); v[q][1] += out[2 * q][1] * (1.f / V_SCALE); v[q][2] += out[2 * q + 1][0] * (1.f / V_SCALE); v[q][3] += out[2 * q + 1][1] * (1.f / V_SCALE); }
      __builtin_amdgcn_wave_barrier();
      if (last) {
        float s2 = 0.f;
#pragma unroll
        for (int q = 0; q < 4; ++q) s2 += v[q][0] * v[q][0] + v[q][1] * v[q][1] + v[q][2] * v[q][2] + v[q][3] * v[q][3];
        s2 = red16(s2); s2 += shx(s2, 16); s2 += shx(s2, 32);
        const float rf = rsqrtf(s2 * (1.f / DM) + RMS_EPS);
#pragma unroll
        for (int q = 0; q < 4; ++q) { const f32x4 gf = *(const f32x4*)(p.norm_final + lane * 16 + q * 4); v[q] = v[q] * rf * gf; }
      }
#pragma unroll
      for (int q = 0; q < 4; ++q) xo[q] = v[q];
      u32x4* xbo = (u32x4*)(p.xb + (long)t * DM + lane * 16);
      xbo[0] = (u32x4){cvtpk(v[0][0], v[0][1]), cvtpk(v[0][2], v[0][3]), cvtpk(v[1][0], v[1][1]), cvtpk(v[1][2], v[1][3])};
      xbo[1] = (u32x4){cvtpk(v[2][0], v[2][1]), cvtpk(v[2][2], v[2][3]), cvtpk(v[3][0], v[3][1]), cvtpk(v[3][2], v[3][3])}; }
    __builtin_amdgcn_wave_barrier();
  }
}

#endif

__device__ __forceinline__ void phase_prep(KP p, char* lds) {
  int tid_ = threadIdx.x; asm volatile("" : "+v"(tid_));
  const int tid = tid_;
  const long gtid = (long)blockIdx.x * NTHR + tid, gsz = (long)gridDim.x * NTHR;
  float* tl = (float*)lds;
  for (int t = blockIdx.x; t < p.ntiles_prep; t += gridDim.x) {
    int j = 0;
    while (j + 1 < p.njobs && t >= p.jobs[j + 1].tile0) ++j;
    const float* src = p.jobs[j].src; u16* dst = p.jobs[j].dst; const float* gain = p.jobs[j].gain;
    const int K = p.jobs[j].K, N = p.jobs[j].N, scale_cols = p.jobs[j].scale_cols; const float scale = p.jobs[j].scale;
    const int lt = t - p.jobs[j].tile0, ntn = N >> 6, kt = lt / ntn, nt = lt - kt * ntn;
    __syncthreads();
    for (int e = tid; e < 4096; e += 256) { const int kk = e >> 6, nn = e & 63, k = kt * 64 + kk; const float g = gain ? gain[k] : 1.f; tl[kk * 65 + nn] = src[(long)k * N + nt * 64 + nn] * g; }
    __syncthreads();
    for (int e = tid; e < 2048; e += 256) { const int nn = e >> 5, kp = (e & 31) * 2, n = nt * 64 + nn; const float s = (n < scale_cols) ? scale : 1.f;
      *(u32*)(dst + (long)n * K + kt * 64 + kp) = cvtpk(tl[kp * 65 + nn] * s, tl[(kp + 1) * 65 + nn] * s); }
  }
  for (long i = gtid; i < (long)T_TOK * DM / 4; i += gsz) {
    const long e = i * 4; const f32x4 v = e < (long)T_PROMPT * DM ? *(const f32x4*)(p.xin0 + e) : *(const f32x4*)(p.xin1 + (e - (long)T_PROMPT * DM));
    *(f32x4*)(p.x + e) = v; *(u32*)(p.xb + e) = cvtpk(v[0], v[1]); *(u32*)(p.xb + e + 2) = cvtpk(v[2], v[3]); }
  for (long i = gtid; i < 4L * 8 * 2 * 128 * 128 / 2; i += gsz) { const float a = p.in_sub_keys[2 * i], b = p.in_sub_keys[2 * i + 1]; *(u32*)(p.peer_sk + 2 * i) = cvtpk(a, b); }
#if PEER_FP4
#define Q4(val) ((u32)(int)(fminf(fmaxf(__builtin_rintf((val) * U4_SCALE), -8.f), 7.f) + 8.f))
  for (long i = gtid; i < 4L * 16384 * 1024 / 16; i += gsz) {
    const long e = i * 16; const int layer = (int)(e >> 24); const int d = (int)(e & 1023);
    u32 uo[2], vo[2];
#pragma unroll
    for (int h = 0; h < 2; ++h) {
      u32 a = 0, b = 0;
#pragma unroll
      for (int q = 0; q < 2; ++q) {
        const f32x4 g = *(const f32x4*)(p.in_norm_ffn + layer * 1024 + d + h * 8 + q * 4);
        const f32x4 u = *(const f32x4*)(p.in_peer_u + e + h * 8 + q * 4), v = *(const f32x4*)(p.in_peer_v + e + h * 8 + q * 4);
        if (q == 0) {
          a |= Q4(u[0] * g[0]) | (Q4(u[1] * g[1]) << 4) | (Q4(u[2] * g[2]) << 8) | (Q4(u[3] * g[3]) << 12);
          b = __builtin_amdgcn_cvt_scalef32_pk_fp4_f32(b, v[0] * V4_SCALE, v[1] * V4_SCALE, 1.0f, 0); b = __builtin_amdgcn_cvt_scalef32_pk_fp4_f32(b, v[2] * V4_SCALE, v[3] * V4_SCALE, 1.0f, 1);
        } else {
          a |= (Q4(u[0] * g[0]) << 16) | (Q4(u[1] * g[1]) << 20) | (Q4(u[2] * g[2]) << 24) | (Q4(u[3] * g[3]) << 28);
          b = __builtin_amdgcn_cvt_scalef32_pk_fp4_f32(b, v[0] * V4_SCALE, v[1] * V4_SCALE, 1.0f, 2); b = __builtin_amdgcn_cvt_scalef32_pk_fp4_f32(b, v[2] * V4_SCALE, v[3] * V4_SCALE, 1.0f, 3);
        }
      }
      uo[h] = a; vo[h] = b;
    }
    *(u32x2*)(p.peer_u8 + (e >> 1)) = (u32x2){uo[0], uo[1]}; *(u32x2*)(p.peer_v8 + (e >> 1)) = (u32x2){vo[0], vo[1]};
  }
#else
  for (long i = gtid; i < 4L * 16384 * 1024 / 16; i += gsz) {
    const long e = i * 16; const int layer = (int)(e >> 24); const int d = (int)(e & 1023);
    u32x4 uo, vo;
#pragma unroll
    for (int q = 0; q < 4; ++q) {
      const f32x4 g = *(const f32x4*)(p.in_norm_ffn + layer * 1024 + d + q * 4);
      const f32x4 u = *(const f32x4*)(p.in_peer_u + e + q * 4), v = *(const f32x4*)(p.in_peer_v + e + q * 4);
      int a = 0, b = 0;
      a = __builtin_amdgcn_cvt_pk_fp8_f32(u[0] * g[0] * U_SCALE, u[1] * g[1] * U_SCALE, a, false); a = __builtin_amdgcn_cvt_pk_fp8_f32(u[2] * g[2] * U_SCALE, u[3] * g[3] * U_SCALE, a, true);
      b = __builtin_amdgcn_cvt_pk_fp8_f32(v[0] * V_SCALE, v[1] * V_SCALE, b, false); b = __builtin_amdgcn_cvt_pk_fp8_f32(v[2] * V_SCALE, v[3] * V_SCALE, b, true);
      uo[q] = (u32)a; vo[q] = (u32)b;
    }
    *(u32x4*)(p.peer_u8 + e) = uo; *(u32x4*)(p.peer_v8 + e) = vo;
  }
#endif
  for (long i = gtid; i < 2 * 3072; i += gsz) { const int c = (int)(i % 3072); p.na_bias_s[i] = p.in_na_bias[i] * (c < 1024 ? 0.125f * LOG2E : 1.f); }
  for (long i = gtid; i < 2 * 16 * 465; i += gsz) p.na_rpb_s[i] = p.in_na_rpb[i] * LOG2E;
  for (long i = gtid; i < 16384L * 32; i += gsz) {
    const int pos = (int)(i >> 5), jf = (int)(i & 31);
    const double a = (double)pos * p.inv_freq[jf] * 0.15915494309189535;
    const double fr = a - rint(a);
    const float f = (float)fr;
    p.ropeC[i] = __builtin_amdgcn_cosf(f); p.ropeS[i] = __builtin_amdgcn_sinf(f);
  }
  for (long i = gtid; i < 2L * 64 * 1024 / 2; i += gsz) { const int l = (int)(i >> 15); const long e = (i & 32767) * 2; *(u32*)(p.wa_t[l] + 704L * 1024 + e) = 0u; }
}

__device__ __forceinline__ void phase_final(KP p) {
  int tid_ = threadIdx.x; asm volatile("" : "+v"(tid_));
  const int lane = tid_ & 63, w = tid_ >> 6;
  for (int t = blockIdx.x * 4 + w; t < T_TOK; t += gridDim.x * 4) {
    float* xr = p.x + (long)t * DM;
    f32x4 v[4]; float ss = 0.f;
#pragma unroll
    for (int i = 0; i < 4; ++i) { v[i] = *(const f32x4*)(xr + i * 256 + lane * 4); ss += v[i][0] * v[i][0] + v[i][1] * v[i][1] + v[i][2] * v[i][2] + v[i][3] * v[i][3]; }
    ss += shx(ss, 1); ss += shx(ss, 2); ss += shx(ss, 4); ss += shx(ss, 8); ss += shx(ss, 16); ss += shx(ss, 32);
    const float rs = rsqrtf(ss * (1.f / DM) + RMS_EPS);
#pragma unroll
    for (int i = 0; i < 4; ++i) { const f32x4 g = *(const f32x4*)(p.norm_final + i * 256 + lane * 4); f32x4 o_ = {v[i][0] * rs * g[0], v[i][1] * rs * g[1], v[i][2] * rs * g[2], v[i][3] * rs * g[3]}; *(f32x4*)(xr + i * 256 + lane * 4) = o_; }
  }
}

template <int EPI>
__device__ __forceinline__ void gemm_big(KP p, int layer, const u16* Ap, int lda, const u16* Bt, int K, int m0, int n0, char* lds) {
  int tid_ = threadIdx.x; asm volatile("" : "+v"(tid_));
  const int tid = tid_, lane = tid & 63, w = tid >> 6;
  const int wm = w >> 1, wn = w & 1, r32 = lane & 31, hi = lane >> 5;
  constexpr int STG = 24576;
  const int scol = ((lane & 3) ^ ((lane >> 4) & 3)) * 8;
  const u16* Ag = Ap + (long)(m0 + w * 64 + (lane >> 2)) * lda + scol;
  const u16* Bg = Bt + (long)(n0 + w * 32 + (lane >> 2)) * K + scol;
#define GST(st, kt) do { int w_ = w; asm volatile("" : "+v"(w_)); \
    _Pragma("unroll") for (int i = 0; i < 4; ++i) __builtin_amdgcn_global_load_lds((const unsigned*)(Ag + (long)i * 16 * lda + (kt) * 32), (unsigned*)(lds + (st) * STG + (w_ * 4 + i) * 1024), 16, 0, 0); \
    _Pragma("unroll") for (int i = 0; i < 2; ++i) __builtin_amdgcn_global_load_lds((const unsigned*)(Bg + (long)i * 16 * K + (kt) * 32), (unsigned*)(lds + (st) * STG + 16384 + (w_ * 2 + i) * 1024), 16, 0, 0); } while (0)
  f32x16 acc[4][2];
#pragma unroll
  for (int i = 0; i < 4; ++i)
#pragma unroll
    for (int j = 0; j < 2; ++j)
#pragma unroll
      for (int r = 0; r < 16; ++r) acc[i][j][r] = 0.f;
  float ssq[4] = {0.f, 0.f, 0.f, 0.f};
  const int sw = (r32 >> 2) & 3;
  const int arow = (wm * 128 + r32) * 64, brow = 16384 + (wn * 64 + r32) * 64;
  const int nk = K / 32;
  __syncthreads();
  GST(0, 0); GST(1, 1);
  int st = 0;
  for (int kt = 0; kt < nk; ++kt) {
    if (kt + 1 < nk) asm volatile("s_waitcnt vmcnt(6)" ::: "memory"); else asm volatile("s_waitcnt vmcnt(0)" ::: "memory");
    asm volatile("s_waitcnt lgkmcnt(0)" ::: "memory");
    __builtin_amdgcn_s_barrier();
    if (kt + 2 < nk) { const int s2 = st + 2 >= 3 ? st - 1 : st + 2; GST(s2, kt + 2); }
    const char* base = lds + st * STG;
#pragma unroll
    for (int ks = 0; ks < 2; ++ks) {
      const int co = ((ks * 2 + hi) ^ sw) << 4;
      bf16x8 a[4], b[2];
#pragma unroll
      for (int mi = 0; mi < 4; ++mi) a[mi] = *(const bf16x8*)(base + arow + mi * 2048 + co);
#pragma unroll
      for (int ni = 0; ni < 2; ++ni) b[ni] = *(const bf16x8*)(base + brow + ni * 2048 + co);
#pragma unroll
      for (int mi = 0; mi < 4; ++mi) { acc[mi][0] = mfma32(b[0], a[mi], acc[mi][0]); acc[mi][1] = mfma32(b[1], a[mi], acc[mi][1]); }
#pragma unroll
      for (int mi = 0; mi < 4; ++mi) { const u32x4 x = __builtin_bit_cast(u32x4, a[mi]);
#pragma unroll
        for (int q = 0; q < 4; ++q) ssq[mi] = dot2bf(x[q], x[q], ssq[mi]); }
    }
    st = st == 2 ? 0 : st + 1;
  }
#undef GST
  __syncthreads();
  float rs[4];
#pragma unroll
  for (int mi = 0; mi < 4; ++mi) { const float t = ssq[mi] + shx(ssq[mi], 32); rs[mi] = rsqrtf(t / (float)K + RMS_EPS); }
  const int rowb = wm * 128, colb = wn * 64;
  if constexpr (EPI == EPI_A || EPI == EPI_QKV) {
    constexpr int OROW = 272;
    u16* outp; int ldo; bool rope = false;
    if constexpr (EPI == EPI_A) { outp = p.cqkv; ldo = 768; rope = (n0 + colb == 640); }
    else { outp = p.qkv; ldo = 3072; }
#pragma unroll
    for (int mi = 0; mi < 4; ++mi) {
      const int rl = rowb + mi * 32 + r32; const int pos = tok_pos(m0 + rl);
#pragma unroll
      for (int g = 0; g < 4; ++g) {
        f32x4 v0, v1;
#pragma unroll
        for (int e = 0; e < 4; ++e) { v0[e] = acc[mi][0][4 * g + e] * rs[mi]; v1[e] = acc[mi][1][4 * g + e] * rs[mi]; }
        if constexpr (EPI == EPI_QKV) {
          const f32x4 b0 = *(const f32x4*)(p.na_bias_s + layer * 3072 + n0 + colb + 8 * g + 4 * hi), b1 = *(const f32x4*)(p.na_bias_s + layer * 3072 + n0 + colb + 32 + 8 * g + 4 * hi);
          v0 += b0; v1 += b1;
        }
        if (rope) {
          const f32x4 c = *(const f32x4*)(p.ropeC + pos * 32 + 8 * g + 4 * hi), sn = *(const f32x4*)(p.ropeS + pos * 32 + 8 * g + 4 * hi);
          const f32x4 t0 = (v0 * c - v1 * sn) * K8_SCALE, t1 = (v0 * sn + v1 * c) * K8_SCALE;
          unsigned char* kp_ = p.k8 + (long)(m0 + rl) * 1088 + 1024 + 8 * g + 4 * hi;
          *(u32*)kp_ = pack4_fp8(t0[0], t0[1], t0[2], t0[3]); *(u32*)(kp_ + 32) = pack4_fp8(t1[0], t1[1], t1[2], t1[3]);
        }
        char* e_ = lds + rl * OROW + (colb + 8 * g + 4 * hi) * 2;
        *(u32x2*)e_ = (u32x2){cvtpk(v0[0], v0[1]), cvtpk(v0[2], v0[3])};
        *(u32x2*)(e_ + 64) = (u32x2){cvtpk(v1[0], v1[1]), cvtpk(v1[2], v1[3])};
      }
    }
    __syncthreads();
#pragma unroll 4
    for (int i = 0; i < 16; ++i) { const int c = tid + 256 * i, row = c >> 4, ch = c & 15;
      *(u32x4*)(outp + (long)(m0 + row) * ldo + n0 + ch * 8) = *(const u32x4*)(lds + row * OROW + ch * 16); }
  } else {
    constexpr int BROW = 144;
    const bool rope = (EPI == EPI_UQ) && ((n0 + colb) % 192 == 128);
    const float sc = (EPI == EPI_UQ) ? Q8_SCALE : K8_SCALE;
#pragma unroll
    for (int mi = 0; mi < 4; ++mi) {
      const int rl = rowb + mi * 32 + r32; const int pos = tok_pos(m0 + rl);
#pragma unroll
      for (int g = 0; g < 4; ++g) {
        f32x4 v0, v1;
#pragma unroll
        for (int e = 0; e < 4; ++e) { v0[e] = acc[mi][0][4 * g + e] * rs[mi] * sc; v1[e] = acc[mi][1][4 * g + e] * rs[mi] * sc; }
        if (rope) {
          const f32x4 c = *(const f32x4*)(p.ropeC + pos * 32 + 8 * g + 4 * hi), sn = *(const f32x4*)(p.ropeS + pos * 32 + 8 * g + 4 * hi);
          const f32x4 t0 = v0 * c - v1 * sn, t1 = v0 * sn + v1 * c; v0 = t0; v1 = t1;
        }
        char* e_ = lds + rl * BROW + (colb + 8 * g + 4 * hi);
        *(u32*)e_ = pack4_fp8(v0[0], v0[1], v0[2], v0[3]); *(u32*)(e_ + 32) = pack4_fp8(v1[0], v1[1], v1[2], v1[3]);
      }
    }
    __syncthreads();
    unsigned char* outb; long ldo;
    if constexpr (EPI == EPI_UQ) { outb = p.q8 + n0; ldo = 1536; } else { outb = p.k8 + (n0 >> 8) * 128; ldo = 1088; }
#pragma unroll 2
    for (int i = 0; i < 8; ++i) { const int c = tid + 256 * i, row = c >> 3, ch = c & 7;
      *(u32x4*)(outb + (long)(m0 + row) * ldo + ch * 16) = *(const u32x4*)(lds + row * BROW + ch * 16); }
  }
}

__device__ __forceinline__ void ukv_tile(KP p, int j, int mt, int nt, char* lds) {
  if (nt & 1) gemm_tile<EPI_UV, true>(p, j, p.cqkv + 384, 768, p.wukv_t[j], 256, mt * 128, nt * 128, lds);
  else gemm_tile<EPI_UK, true>(p, j, p.cqkv + 384, 768, p.wukv_t[j], 256, mt * 128, nt * 128, lds);
}
#define XB_TMO      128
#define XB_XCNT(j)  (256  + 64 * (j))
#define XB_XSUB(j)  (1280 + 64 * (j))
#define XB_XGEN(j)  (2304 + 64 * (j))
#define XB_TOP      3328
#define XB_TOPGEN   3392
#define XCD_BAR_WORDS 3456
#define XB_SPIN_CAP (1u << 18)
#define LAS __attribute__((address_space(3)))
__device__ __forceinline__ unsigned xb_ld(unsigned* p)              { return __hip_atomic_load(p, __ATOMIC_RELAXED, __HIP_MEMORY_SCOPE_AGENT); }
__device__ __forceinline__ unsigned xb_add(unsigned* p, unsigned v) { return __hip_atomic_fetch_add(p, v, __ATOMIC_RELAXED, __HIP_MEMORY_SCOPE_AGENT); }
__device__ __forceinline__ unsigned xb_xcc_id() { return (unsigned)__builtin_amdgcn_s_getreg((3 << 11) | 20) & 0xFu; }
#define XB_SPIN(cond, bar) do { unsigned _sp = 0; while (cond) { __builtin_amdgcn_s_sleep(1); \
    if ((++_sp & 255u) == 0u) { if (xb_ld(&(bar)[XB_TMO])) break; if (_sp > XB_SPIN_CAP) { atomicAdd(&(bar)[XB_TMO], 1u); break; } } } } while (0)
struct XcdBarrier { unsigned* bar; unsigned x; volatile LAS unsigned* st; };
__device__ __forceinline__ XcdBarrier xcd_barrier_post(unsigned* bar, volatile LAS unsigned* st) {
    XcdBarrier b; b.bar = bar; b.x = xb_xcc_id(); b.st = st;
    if (threadIdx.x == 0) (void)xb_add(&bar[XB_XCNT(b.x)], 1u);
    return b;
}
__device__ __forceinline__ void xcd_barrier_complete(unsigned* bar, unsigned x, unsigned& nloc, unsigned& nx) {
    const unsigned G = gridDim.x * gridDim.y * gridDim.z;
    unsigned sum, cnt, mine, sp = 0u;
    for (;;) {
        sum = 0u; cnt = 0u; mine = 0u;
#pragma unroll
        for (unsigned j = 0; j < 16; ++j) { const unsigned c = xb_ld(&bar[XB_XCNT(j)]); sum += c; cnt += (c > 0u) ? 1u : 0u; mine = (j == x) ? c : mine; }
        if (sum == G) break;
        __builtin_amdgcn_s_sleep(1);
        if ((++sp & 255u) == 0u) { if (xb_ld(&bar[XB_TMO])) break; if (sp > XB_SPIN_CAP) { atomicAdd(&bar[XB_TMO], 1u); break; } }
    }
    nloc = mine > 0u ? mine : 1u; nx = cnt > 0u ? cnt : 1u;
}
__device__ __forceinline__ void xcd_barrier(const XcdBarrier& b) {
    asm volatile("s_waitcnt vmcnt(0)" ::: "memory");
    __syncthreads();
    if (threadIdx.x == 0) {
        unsigned* bar = b.bar;
        __builtin_amdgcn_s_waitcnt(0);
        unsigned nloc = b.st[0], nx = b.st[1];
        if (nloc == 0u) { xcd_barrier_complete(bar, b.x, nloc, nx); b.st[0] = nloc; b.st[1] = nx; }
        const unsigned old = xb_add(&bar[XB_XSUB(b.x)], 1u);
        const unsigned gen = old / nloc;
        if (old + 1u == (gen + 1u) * nloc) {
            __builtin_amdgcn_fence(__ATOMIC_RELEASE, "agent");
            asm volatile("s_waitcnt vmcnt(0)" ::: "memory");
            const unsigned og = xb_add(&bar[XB_TOP], 1u);
            const unsigned tg = og / nx;
            if (og + 1u == (tg + 1u) * nx) xb_add(&bar[XB_TOPGEN], 1u);
            else XB_SPIN(xb_ld(&bar[XB_TOPGEN]) == tg, bar);
            __builtin_amdgcn_fence(__ATOMIC_ACQUIRE, "agent");
            xb_add(&bar[XB_XGEN(b.x)], 1u);
            asm volatile("s_waitcnt vmcnt(0)" ::: "memory");
        } else {
            XB_SPIN(xb_ld(&bar[XB_XGEN(b.x)]) == gen, bar);
            __builtin_amdgcn_fence(__ATOMIC_ACQUIRE, "agent");
            asm volatile("s_waitcnt vmcnt(0)" ::: "memory");
        }
    }
    __syncthreads();
}

#define GEMM_PHASE(SUB, MTILES, NTILES, SM, SN, CALL) do { \
    const int nsn_ = (NTILES) / (SN), nsuper_ = ((MTILES) / (SM)) * nsn_, per_ = (SM) * (SN); \
    const int xcd_ = blockIdx.x & 7; \
    const int total_ = ((nsuper_ - xcd_ + 7) >> 3) * per_;            \
    unsigned* q_ = p.bar + XCD_BAR_WORDS + 64 + (ph * 3 + (SUB)) * 8 + xcd_; \
    for (;;) { \
      if (threadIdx.x == 0) xb_words[2] = atomicAdd(q_, 1u); \
      __syncthreads(); const int idx_ = (int)xb_words[2]; __syncthreads(); \
      if (idx_ >= total_) break; \
      const int r_ = idx_ / per_, l_ = idx_ - r_ * per_, s_ = xcd_ + 8 * r_, sm_ = s_ / nsn_, sn_ = s_ - sm_ * nsn_; \
      const int mt = sm_ * (SM) + l_ / (SN), nt = sn_ * (SN) + l_ % (SN); CALL; } } while (0)

__global__ void __launch_bounds__(NTHR, LB2) mega(const Params p_unused, int ph_lo, int ph_hi) {
  __shared__ __attribute__((aligned(16))) char lds[SMEM_BYTES];
  volatile LAS unsigned* xb_words = (volatile LAS unsigned*)(lds + SMEM_BYTES - 16);
  constexpr int MT = T_TOK / 128;
  XcdBarrier xb;
  { const __attribute__((address_space(4))) Params* pp0 = (const __attribute__((address_space(4))) Params*)__builtin_amdgcn_kernarg_segment_ptr();
    if (threadIdx.x < 4) xb_words[threadIdx.x] = 0u;
    __syncthreads();
    xb = xcd_barrier_post(pp0->bar, xb_words); }
  for (int ph = ph_lo; ph < ph_hi; ++ph) {
    const __attribute__((address_space(4))) Params* pp = (const __attribute__((address_space(4))) Params*)__builtin_amdgcn_kernarg_segment_ptr();
    asm volatile("" : "+s"(pp));
    KP p = *pp;
    const int type = p.prog_type[ph], layer = p.prog_layer[ph];
    const int j = layer >> 1;
    switch (type) {
      case PH_PREP: if (!PHON(PH_PREP)) break; phase_prep(p, lds); break;
      case PH_MLA_A: if (!PHON(PH_MLA_A)) break;
        GEMM_PHASE(0, MT / 2, 6, 8, 6, (gemm_big<EPI_A>(p, j, p.xb, DM, p.wa_t[j], 1024, mt * 256, nt * 128, lds)));
        break;
      case PH_MLA_B: if (!PHON(PH_MLA_B)) break;
        GEMM_PHASE(0, MT / 2, 12, 16, 4, (gemm_big<EPI_UQ>(p, j, p.cqkv, 768, p.wuq_t[j], 384, mt * 256, nt * 128, lds)));
        GEMM_PHASE(1, MT / 2, 8, 8, 8, (gemm_big<EPI_UK>(p, j, p.cqkv + 384, 768, p.wukv_t[j], 256, mt * 256, nt * 256, lds)));
        GEMM_PHASE(2, MT, 8, 8, 8, (gemm_tile<EPI_UV, true>(p, j, p.cqkv + 384, 768, p.wukv_t[j], 256, mt * 128, nt * 256 + 128, lds)));
        break;
      case PH_MLA_ATT: if (!PHON(PH_MLA_ATT)) break;
#ifndef SKEW_BIT
#define SKEW_BIT 256
#endif
        if (blockIdx.x & SKEW_BIT) { __builtin_amdgcn_s_sleep(24); __builtin_amdgcn_s_setprio(1); }
        {
          unsigned* ctr = p.bar + XCD_BAR_WORDS + ph;
          for (;;) {
            if (threadIdx.x == 0) xb_words[2] = atomicAdd(ctr, 1u);
            __syncthreads();
            const int t = (int)xb_words[2];
            __syncthreads();
            if (t >= 3072) break;
            attn_mla(p, t, lds);
          } }
        __builtin_amdgcn_s_setprio(0);
        break;
      case PH_MLA_O: if (!PHON(PH_MLA_O)) break;
        GEMM_PHASE(0, MT, 8, 8, 8, (gemm_tile<EPI_O, false>(p, j, p.o, 1024, p.mla_wo_t[j], 1024, mt * 128, nt * 128, lds)));
        break;
      case PH_NA_QKV: if (!PHON(PH_NA_QKV)) break;
        GEMM_PHASE(0, MT / 2, 24, 8, 8, (gemm_big<EPI_QKV>(p, j, p.xb, DM, p.na_wqkv_t[j], 1024, mt * 256, nt * 128, lds)));
        break;
      case PH_NA_ATT: if (!PHON(PH_NA_ATT)) break;
        if (blockIdx.x & SKEW_BIT) { __builtin_amdgcn_s_sleep(12); }
        { unsigned* ctr = p.bar + XCD_BAR_WORDS + ph;
          for (;;) {
            if (threadIdx.x == 0) xb_words[2] = atomicAdd(ctr, 1u);
            __syncthreads();
            const int t = (int)xb_words[2];
            __syncthreads();
            if (t >= 6144) break;
            attn_item<1>(p, j, t, lds);
          } }
        break;
      case PH_NA_O: if (!PHON(PH_NA_O)) break;
        GEMM_PHASE(0, MT, 8, 8, 8, (gemm_tile<EPI_O, false>(p, j, p.o, 1024, p.na_wo_t[j], 1024, mt * 128, nt * 128, lds)));
        break;
      case PH_PEER_Q: if (!PHON(PH_PEER_Q)) break;
        GEMM_PHASE(0, MT, 16, 8, 8, (gemm_tile<EPI_PEER, true>(p, layer, p.xb, DM, p.peer_wq_t[layer], 1024, mt * 128, nt * 128, lds)));
        break;
      case PH_PEER_C: if (!PHON(PH_PEER_C)) break; phase_peer_combine(p, layer, lds, p.bar + XCD_BAR_WORDS + ph); break;
      case PH_FINAL: if (!PHON(PH_FINAL)) break; phase_final(p); break;
      default: break;
    }
    if (ph + 1 < ph_hi) { if (ph_hi > 1000) cg::this_grid().sync(); else xcd_barrier(xb); }
  }
}

extern "C" void kernel_launch(void* const* d_in, const int* in_sizes, int n_in, void* d_out, int out_size, void* d_ws, size_t ws_size, hipStream_t stream) {
  static int grid_blocks = 0, n_cus = 0;
  if (!grid_blocks) {
    int dev = 0, cus = 0;
    (void)hipGetDevice(&dev);
    (void)hipDeviceGetAttribute(&cus, hipDeviceAttributeMultiprocessorCount, dev);
    if (cus < 8) cus = 256;
    n_cus = cus;
    grid_blocks = cus * 2;
  }
  Params p; memset(&p, 0, sizeof(p));
  const float* const* in = (const float* const*)d_in;
  char* ws = (char*)d_ws; size_t off = 0;
  auto alloc = [&](size_t bytes) -> void* { void* r = ws + off; off += (bytes + 255) & ~(size_t)255; return r; };
  p.xin0 = in[0]; p.xin1 = in[1]; p.x = (float*)d_out; p.norm_final = in[4];
  for (int l = 0; l < 2; ++l) {
    p.wa_t[l] = (u16*)alloc(768UL * 1024 * 2); p.wuq_t[l] = (u16*)alloc(1536UL * 384 * 2); p.wukv_t[l] = (u16*)alloc(2048UL * 256 * 2); p.mla_wo_t[l] = (u16*)alloc(1024UL * 1024 * 2);
    p.na_wqkv_t[l] = (u16*)alloc(3072UL * 1024 * 2); p.na_wo_t[l] = (u16*)alloc(1024UL * 1024 * 2);
  }
  for (int l = 0; l < 4; ++l) p.peer_wq_t[l] = (u16*)alloc(2048UL * 1024 * 2);
  p.na_bias_s = (float*)alloc(2 * 3072 * 4); p.na_rpb_s = (float*)alloc(2 * 16 * 465 * 4);
  p.peer_sk = (u16*)alloc(4UL * 8 * 2 * 128 * 128 * 2);
  p.peer_u8 = (unsigned char*)alloc(4UL * 16384 * 1024); p.peer_v8 = (unsigned char*)alloc(4UL * 16384 * 1024);
  p.ropeC = (float*)alloc(16384UL * 32 * 4); p.ropeS = (float*)alloc(16384UL * 32 * 4);
  p.bar = (unsigned*)alloc((XCD_BAR_WORDS + 1024) * 4);
  p.o = (u16*)alloc((size_t)T_TOK * 1024 * 2); p.xb = (u16*)alloc((size_t)T_TOK * 1024 * 2);
  char* un = (char*)alloc((size_t)T_TOK * (768 + 1536 + 2048) * 2);
  p.cqkv = (u16*)un; p.q = (u16*)(un + (size_t)T_TOK * 768 * 2); p.kv = (u16*)(un + (size_t)T_TOK * (768 + 1536) * 2);
  { unsigned char* b8 = (unsigned char*)un + (size_t)T_TOK * 768 * 2; p.q8 = b8; p.k8 = b8 + (size_t)T_TOK * 1536; p.kpe8 = p.k8; p.vT8 = p.k8 + (size_t)T_TOK * 1088; }
  p.qkv = (u16*)un; p.pkeys = (u32*)un;
  if (off > ws_size) { fprintf(stderr, "kernel_launch: workspace too small: need %zu have %zu\n", off, ws_size); return; }
  p.in_sub_keys = in[17]; p.in_peer_u = in[18]; p.in_peer_v = in[19]; p.in_norm_ffn = in[3]; p.in_na_bias = in[13]; p.in_na_rpb = in[14];
  for (int jf = 0; jf < 32; ++jf) p.inv_freq[jf] = pow(10000.0, -(double)(2 * jf) / 64.0);
  int nj = 0, tile = 0;
  auto job = [&](const float* src, u16* dst, const float* gain, int K, int N, float scale, int scale_cols) {
    PrepJob& J = p.jobs[nj++]; J.src = src; J.dst = dst; J.gain = gain; J.K = K; J.N = N; J.tile0 = tile; J.scale = scale; J.scale_cols = scale_cols; J.pad = 0; tile += (K / 64) * (N / 64); };
  const float sc_mla = (float)(pow(192.0, -0.5) * 1.4426950408889634);
  for (int l = 0; l < 2; ++l) {
    job(in[5] + (size_t)l * 1024 * 384, p.wa_t[l], in[2] + (2 * l) * 1024, 1024, 384, 1.f, 0);
    job(in[8] + (size_t)l * 1024 * 320, p.wa_t[l] + 384UL * 1024, in[2] + (2 * l) * 1024, 1024, 320, 1.f, 0);
    job(in[7] + (size_t)l * 384 * 1536, p.wuq_t[l], in[6] + l * 384, 384, 1536, sc_mla, 1536);
    job(in[10] + (size_t)l * 256 * 2048, p.wukv_t[l], in[9] + l * 256, 256, 2048, 1.f, 0);
    job(in[11] + (size_t)l * 1024 * 1024, p.mla_wo_t[l], nullptr, 1024, 1024, 1.f, 0);
    job(in[12] + (size_t)l * 1024 * 3072, p.na_wqkv_t[l], in[2] + (2 * l + 1) * 1024, 1024, 3072, 0.125f * 1.4426950408889634f, 1024);
    job(in[15] + (size_t)l * 1024 * 1024, p.na_wo_t[l], nullptr, 1024, 1024, 1.f, 0);
  }
  for (int l = 0; l < 4; ++l) job(in[16] + (size_t)l * 1024 * 2048, p.peer_wq_t[l], in[3] + l * 1024, 1024, 2048, 1.f, 0);
  p.njobs = nj; p.ntiles_prep = tile;
  int np = 0;
#ifndef DUPMASK
#define DUPMASK 0
#endif
  auto ph = [&](int type, int layer) { p.prog_type[np] = type; p.prog_layer[np] = layer; ++np;
    if ((DUPMASK >> type) & 1) { p.prog_type[np] = type; p.prog_layer[np] = layer; ++np; } };
  ph(PH_PREP, 0);
  for (int i = 0; i < 4; ++i) {
    if ((i & 1) == 0) { ph(PH_MLA_A, i); ph(PH_MLA_B, i); ph(PH_MLA_ATT, i); ph(PH_MLA_O, i); }
    else { ph(PH_NA_QKV, i); ph(PH_NA_ATT, i); ph(PH_NA_O, i); }
    ph(PH_PEER_Q, i); ph(PH_PEER_C, i);
  }
  p.nprog = np;
#if COOP
  (void)hipMemsetAsync(p.bar, 0, (XCD_BAR_WORDS + 1024) * 4, stream);
  int lo = 0, hi = np;
  void* args[] = {(void*)&p, (void*)&lo, (void*)&hi};
  hipError_t e = hipLaunchCooperativeKernel((const void*)mega, dim3(grid_blocks), dim3(NTHR), args, 0, stream);
  if (e != hipSuccess && grid_blocks != n_cus) {
    (void)hipGetLastError(); grid_blocks = n_cus;
    e = hipLaunchCooperativeKernel((const void*)mega, dim3(grid_blocks), dim3(NTHR), args, 0, stream);
  }
  if (e != hipSuccess) fprintf(stderr, "cooperative launch failed: %s (grid %d)\n", hipGetErrorString(e), grid_blocks);
#else
  for (int i = 0; i < np; ++i) hipLaunchKernelGGL(mega, dim3(grid_blocks), dim3(NTHR), 0, stream, p, i, i + 1);
#endif
}
```

```cpp
#include <hip/hip_runtime.h>
#include <hip/hip_cooperative_groups.h>
#include <stdint.h>
#include <string.h>
#include <math.h>
#include <cstdio>
namespace cg = cooperative_groups;

#ifndef COOP
#define COOP 1
#endif
#ifndef PHMASK
#define PHMASK 0xFFFF
#endif
#ifndef LB2
#define LB2 2
#endif
#define PHON(t) ((PHMASK >> (t)) & 1)

typedef unsigned short u16;
typedef unsigned int u32;
using bf16x8 = __attribute__((ext_vector_type(8))) short;
using s16x4  = __attribute__((ext_vector_type(4))) short;
using f32x16 = __attribute__((ext_vector_type(16))) float;
using f32x4  = __attribute__((ext_vector_type(4))) float;
using u32x4  = __attribute__((ext_vector_type(4))) unsigned;
using u32x2  = __attribute__((ext_vector_type(2))) unsigned;
typedef __attribute__((ext_vector_type(2))) __bf16 v2bf;

constexpr int T_TOK = 49152, T_PROMPT = 16384, DM = 1024;
constexpr int NTHR = 256;
constexpr float LOG2E = 1.4426950408889634f;
constexpr float RMS_EPS = 1e-6f;

enum { PH_PREP = 0, PH_MLA_A, PH_MLA_B, PH_MLA_ATT, PH_MLA_O, PH_NA_QKV, PH_NA_ATT, PH_NA_O, PH_PEER_Q, PH_PEER_C, PH_FINAL };

struct PrepJob { const float* src; u16* dst; const float* gain; int K, N, tile0, scale_cols; float scale; int pad; };

struct Params {
  const float* xin0; const float* xin1;
  float* x; u16* xb;
  const float* norm_final;
  u16* wa_t[2]; u16* wuq_t[2]; u16* wukv_t[2]; u16* mla_wo_t[2];
  u16* na_wqkv_t[2]; u16* na_wo_t[2]; float* na_bias_s; float* na_rpb_s;
  u16* peer_wq_t[4]; u16* peer_sk; unsigned char* peer_u8; unsigned char* peer_v8;
  u16* cqkv; u16* q; u16* kv; u16* o; u16* qkv; u32* pkeys;
  unsigned char* q8; unsigned char* k8; unsigned char* kpe8; unsigned char* vT8;
  float* ropeC; float* ropeS; unsigned* bar;
  const float* in_sub_keys; const float* in_peer_u; const float* in_peer_v; const float* in_norm_ffn; const float* in_na_bias; const float* in_na_rpb;
  PrepJob jobs[24];
  double inv_freq[32];
  int njobs, ntiles_prep;
  int prog_type[48]; int prog_layer[48];
  int nprog, pad0;
};

typedef const __attribute__((address_space(4))) Params& KP;

__device__ __forceinline__ int crow(int r, int hi) { return (r & 3) + 8 * (r >> 2) + 4 * hi; }
__device__ __forceinline__ u32 cvtpk(float lo, float hi) { u32 r; asm("v_cvt_pk_bf16_f32 %0, %1, %2" : "=v"(r) : "v"(lo), "v"(hi)); return r; }
__device__ __forceinline__ float bf_lo(u32 v) { return __uint_as_float(v << 16); }
__device__ __forceinline__ float bf_hi(u32 v) { return __uint_as_float(v & 0xffff0000u); }
__device__ __forceinline__ int tok_pos(int t) { return t < T_PROMPT ? (t & 2047) : (t & 16383); }
__device__ __forceinline__ f32x16 mfma32(bf16x8 a, bf16x8 b, f32x16 c) { return __builtin_amdgcn_mfma_f32_32x32x16_bf16(a, b, c, 0, 0, 0); }
__device__ __forceinline__ float shx(float v, int m) { return __shfl_xor(v, m, 64); }

constexpr int BK = 64;
constexpr int OPB = 16384;
constexpr int GEMM_LDS = 4 * OPB;
constexpr int SMEM_BYTES = 81920;
constexpr int RSTD_OFF = 73728;

enum { EPI_A = 0, EPI_UQ, EPI_UK, EPI_UV, EPI_O, EPI_QKV, EPI_PEER };
constexpr float KEY_BIAS = 16.f;
constexpr float Q8_SCALE = 16.f, K8_SCALE = 4.f, V8_SCALE = 4.f, P8_SCALE = 128.f;
__device__ __forceinline__ u32 pack4_fp8(float a, float b, float c, float d) { int v = 0; v = __builtin_amdgcn_cvt_pk_fp8_f32(a, b, v, false); v = __builtin_amdgcn_cvt_pk_fp8_f32(c, d, v, true); return (u32)v; }

__device__ __forceinline__ float dot2bf(u32 a, u32 b, float c) { return __builtin_amdgcn_fdot2_f32_bf16(__builtin_bit_cast(v2bf, a), __builtin_bit_cast(v2bf, b), c, false); }

template <int EPI, bool NORM>
__device__ __forceinline__ void gemm_tile(KP p, int layer, const u16* Ap, int lda, const u16* Bt, int K, int m0, int n0, char* lds) {
  int tid_ = threadIdx.x; asm volatile("" : "+v"(tid_));
  const int tid = tid_, lane = tid & 63, w = tid >> 6;
  const int wm = w >> 1, wn = w & 1, r32 = lane & 31, hi = lane >> 5;
  float* rstd_l = (float*)(lds + RSTD_OFF);
  const int srow = w * 32 + (lane >> 2);
  const int scol = ((lane & 3) ^ ((lane >> 4) & 3)) * 8;
  const u16* Ag = Ap + (long)(m0 + srow) * lda + scol;
  const u16* Bg = Bt + (long)(n0 + srow) * K + scol;
#define GSTAGE(st, kt) do { _Pragma("unroll") for (int j = 0; j < 2; ++j) { \
    __builtin_amdgcn_global_load_lds((const unsigned*)(Ag + (long)j * 16 * lda + (kt) * 32), (unsigned*)(lds + (st) * 16384 + (w * 2 + j) * 1024), 16, 0, 0); \
    __builtin_amdgcn_global_load_lds((const unsigned*)(Bg + (long)j * 16 * K + (kt) * 32), (unsigned*)(lds + (st) * 16384 + 8192 + (w * 2 + j) * 1024), 16, 0, 0); } } while (0)
  f32x16 acc[2][2];
#pragma unroll
  for (int i = 0; i < 2; ++i)
#pragma unroll
    for (int j = 0; j < 2; ++j)
#pragma unroll
      for (int r = 0; r < 16; ++r) acc[i][j][r] = 0.f;
  float ssq0 = 0.f, ssq1 = 0.f;
  bf16x8 skr[8];
  const int sw = (r32 >> 2) & 3;
  const int arow = (wm * 64 + r32) * 64, brow = 8192 + (wn * 64 + r32) * 64;
  const int co0 = ((0 + hi) ^ sw) << 4, co1 = ((2 + hi) ^ sw) << 4;
  const int nk = K / 32;

#ifndef KREP
#define KREP 1
#endif
  for (int rep_ = 0; rep_ < KREP; ++rep_) {
  if (KREP > 1) {
#pragma unroll
    for (int i = 0; i < 2; ++i)
#pragma unroll
      for (int j = 0; j < 2; ++j)
#pragma unroll
        for (int r = 0; r < 16; ++r) acc[i][j][r] = 0.f;
    ssq0 = 0.f; ssq1 = 0.f; }
  __syncthreads();
  GSTAGE(0, 0); GSTAGE(1, 1); GSTAGE(2, 2);
  if constexpr (EPI == EPI_PEER) {
    const u16* sk = p.peer_sk + ((long)layer * 16 + (n0 >> 7)) * 16384;
#pragma unroll
    for (int i = 0; i < 8; ++i) { const int c = tid + 256 * i; skr[i] = *(const bf16x8*)(sk + (c >> 4) * 128 + (c & 15) * 8); }
  }
  for (int kt = 0; kt < nk; ++kt) {
    if (kt + 2 < nk) asm volatile("s_waitcnt vmcnt(8)" ::: "memory");
    else if (kt + 1 < nk) asm volatile("s_waitcnt vmcnt(4)" ::: "memory");
    else asm volatile("s_waitcnt vmcnt(0)" ::: "memory");
    asm volatile("s_waitcnt lgkmcnt(0)" ::: "memory");
    __builtin_amdgcn_s_barrier();
    if (kt + 3 < nk) GSTAGE((kt + 3) & 3, kt + 3);
    const char* base = lds + (kt & 3) * 16384;
    {
      const bf16x8 a0 = *(const bf16x8*)(base + arow + co0), a1 = *(const bf16x8*)(base + arow + 32 * 64 + co0);
      const bf16x8 b0 = *(const bf16x8*)(base + brow + co0), b1 = *(const bf16x8*)(base + brow + 32 * 64 + co0);
      const bf16x8 c0 = *(const bf16x8*)(base + arow + co1), c1 = *(const bf16x8*)(base + arow + 32 * 64 + co1);
      const bf16x8 d0 = *(const bf16x8*)(base + brow + co1), d1 = *(const bf16x8*)(base + brow + 32 * 64 + co1);
      if constexpr (EPI != EPI_UV) {
        acc[0][0] = mfma32(b0, a0, acc[0][0]); acc[0][1] = mfma32(b1, a0, acc[0][1]);
        acc[1][0] = mfma32(b0, a1, acc[1][0]); acc[1][1] = mfma32(b1, a1, acc[1][1]);
        acc[0][0] = mfma32(d0, c0, acc[0][0]); acc[0][1] = mfma32(d1, c0, acc[0][1]);
        acc[1][0] = mfma32(d0, c1, acc[1][0]); acc[1][1] = mfma32(d1, c1, acc[1][1]);
      } else {
        acc[0][0] = mfma32(a0, b0, acc[0][0]); acc[0][1] = mfma32(a0, b1, acc[0][1]);
        acc[1][0] = mfma32(a1, b0, acc[1][0]); acc[1][1] = mfma32(a1, b1, acc[1][1]);
        acc[0][0] = mfma32(c0, d0, acc[0][0]); acc[0][1] = mfma32(c0, d1, acc[0][1]);
        acc[1][0] = mfma32(c1, d0, acc[1][0]); acc[1][1] = mfma32(c1, d1, acc[1][1]);
      }
      if constexpr (NORM) {
        const u32x4 x0 = __builtin_bit_cast(u32x4, a0), x1 = __builtin_bit_cast(u32x4, a1), y0 = __builtin_bit_cast(u32x4, c0), y1 = __builtin_bit_cast(u32x4, c1);
#pragma unroll
        for (int q = 0; q < 4; ++q) { ssq0 = dot2bf(x0[q], x0[q], ssq0); ssq1 = dot2bf(x1[q], x1[q], ssq1); ssq0 = dot2bf(y0[q], y0[q], ssq0); ssq1 = dot2bf(y1[q], y1[q], ssq1); }
      }
    }
  }
  }
#undef GSTAGE
  __syncthreads();
  float rs[2] = {1.f, 1.f};
  if constexpr (NORM) {
    ssq0 += shx(ssq0, 32); ssq1 += shx(ssq1, 32);
    rs[0] = rsqrtf(ssq0 / (float)K + RMS_EPS); rs[1] = rsqrtf(ssq1 / (float)K + RMS_EPS);
  }
  const int rowb = wm * 64, colb = wn * 64;
  if constexpr (EPI == EPI_A || EPI == EPI_QKV) {
    constexpr int OROW = 272;
    u16* outp; int ldo; bool rope = false;
    if constexpr (EPI == EPI_A) { outp = p.cqkv; ldo = 768; rope = (n0 + colb == 640); }
    else { outp = p.qkv; ldo = 3072; }
#pragma unroll
    for (int mi = 0; mi < 2; ++mi) {
      const int rl = rowb + mi * 32 + r32; const int pos = tok_pos(m0 + rl);
#pragma unroll
      for (int g = 0; g < 4; ++g) {
        f32x4 v0, v1;
#pragma unroll
        for (int e = 0; e < 4; ++e) { v0[e] = acc[mi][0][4 * g + e] * rs[mi]; v1[e] = acc[mi][1][4 * g + e] * rs[mi]; }
        if constexpr (EPI == EPI_QKV) {
          const f32x4 b0 = *(const f32x4*)(p.na_bias_s + layer * 3072 + n0 + colb + 8 * g + 4 * hi), b1 = *(const f32x4*)(p.na_bias_s + layer * 3072 + n0 + colb + 32 + 8 * g + 4 * hi);
          v0 += b0; v1 += b1;
        }
        if (rope) {
          const f32x4 c = *(const f32x4*)(p.ropeC + pos * 32 + 8 * g + 4 * hi), sn = *(const f32x4*)(p.ropeS + pos * 32 + 8 * g + 4 * hi);
          const f32x4 t0 = (v0 * c - v1 * sn) * K8_SCALE, t1 = (v0 * sn + v1 * c) * K8_SCALE;
          unsigned char* kp_ = p.k8 + (long)(m0 + rl) * 1088 + 1024 + 8 * g + 4 * hi;
          *(u32*)kp_ = pack4_fp8(t0[0], t0[1], t0[2], t0[3]); *(u32*)(kp_ + 32) = pack4_fp8(t1[0], t1[1], t1[2], t1[3]);
        }
        char* e_ = lds + rl * OROW + (colb + 8 * g + 4 * hi) * 2;
        *(u32x2*)e_ = (u32x2){cvtpk(v0[0], v0[1]), cvtpk(v0[2], v0[3])};
        *(u32x2*)(e_ + 64) = (u32x2){cvtpk(v1[0], v1[1]), cvtpk(v1[2], v1[3])};
      }
    }
    __syncthreads();
#pragma unroll
    for (int i = 0; i < 8; ++i) { const int c = tid + 256 * i, row = c >> 4, ch = c & 15;
      *(u32x4*)(outp + (long)(m0 + row) * ldo + n0 + ch * 8) = *(const u32x4*)(lds + row * OROW + ch * 16); }
  } else if constexpr (EPI == EPI_UQ || EPI == EPI_UK) {
    constexpr int BROW = 144;
    const bool rope = (EPI == EPI_UQ) && ((n0 + colb) % 192 == 128);
    const float sc = (EPI == EPI_UQ) ? Q8_SCALE : K8_SCALE;
#pragma unroll
    for (int mi = 0; mi < 2; ++mi) {
      const int rl = rowb + mi * 32 + r32; const int pos = tok_pos(m0 + rl);
#pragma unroll
      for (int g = 0; g < 4; ++g) {
        f32x4 v0, v1;
#pragma unroll
        for (int e = 0; e < 4; ++e) { v0[e] = acc[mi][0][4 * g + e] * rs[mi] * sc; v1[e] = acc[mi][1][4 * g + e] * rs[mi] * sc; }
        if (rope) {
          const f32x4 c = *(const f32x4*)(p.ropeC + pos * 32 + 8 * g + 4 * hi), sn = *(const f32x4*)(p.ropeS + pos * 32 + 8 * g + 4 * hi);
          const f32x4 t0 = v0 * c - v1 * sn, t1 = v0 * sn + v1 * c; v0 = t0; v1 = t1;
        }
        char* e_ = lds + rl * BROW + (colb + 8 * g + 4 * hi);
        *(u32*)e_ = pack4_fp8(v0[0], v0[1], v0[2], v0[3]); *(u32*)(e_ + 32) = pack4_fp8(v1[0], v1[1], v1[2], v1[3]);
      }
    }
    __syncthreads();
    unsigned char* outb; long ldo;
    if constexpr (EPI == EPI_UQ) { outb = p.q8 + n0; ldo = 1536; } else { outb = p.k8 + (n0 >> 8) * 128; ldo = 1088; }
#pragma unroll
    for (int i = 0; i < 4; ++i) { const int c = tid + 256 * i, row = c >> 3, ch = c & 7;
      *(u32x4*)(outb + (long)(m0 + row) * ldo + ch * 16) = *(const u32x4*)(lds + row * BROW + ch * 16); }
  } else if constexpr (EPI == EPI_UV) {
    constexpr int BROW = 144;
#pragma unroll
    for (int mi = 0; mi < 2; ++mi) {
#pragma unroll
      for (int g = 0; g < 4; ++g) {
        float rr[4];
#pragma unroll
        for (int e = 0; e < 4; ++e) rr[e] = __int_as_float(__builtin_amdgcn_ds_bpermute((8 * g + 4 * hi + e) << 2, __float_as_int(rs[mi]))) * V8_SCALE;
#pragma unroll
        for (int ni = 0; ni < 2; ++ni) {
          char* e_ = lds + (colb + ni * 32 + r32) * BROW + rowb + mi * 32 + 8 * g + 4 * hi;
          *(u32*)e_ = pack4_fp8(acc[mi][ni][4 * g] * rr[0], acc[mi][ni][4 * g + 1] * rr[1], acc[mi][ni][4 * g + 2] * rr[2], acc[mi][ni][4 * g + 3] * rr[3]);
        }
      }
    }
    __syncthreads();
    unsigned char* outb = p.vT8 + (long)((n0 >> 8) * 128) * T_TOK + m0;
#pragma unroll
    for (int i = 0; i < 4; ++i) { const int c = tid + 256 * i, d = c >> 3, ch = c & 7;
      *(u32x4*)(outb + (long)d * T_TOK + ch * 16) = *(const u32x4*)(lds + d * BROW + ch * 16); }
  } else if constexpr (EPI == EPI_O) {
    constexpr int FROW = 528;
#pragma unroll
    for (int mi = 0; mi < 2; ++mi) {
      const int rl = rowb + mi * 32 + r32;
#pragma unroll
      for (int ni = 0; ni < 2; ++ni)
#pragma unroll
        for (int g = 0; g < 4; ++g)
          *(f32x4*)(lds + rl * FROW + (colb + ni * 32 + 8 * g + 4 * hi) * 4) = (f32x4){acc[mi][ni][4 * g], acc[mi][ni][4 * g + 1], acc[mi][ni][4 * g + 2], acc[mi][ni][4 * g + 3]};
    }
    __syncthreads();
#pragma unroll 4
    for (int i = 0; i < 16; ++i) { const int c = tid + 256 * i, row = c >> 5, ch = c & 31;
      const f32x4 a = *(const f32x4*)(lds + row * FROW + ch * 16);
      float* xp = p.x + (long)(m0 + row) * DM + n0 + ch * 4;
      f32x4 xv = *(const f32x4*)xp; xv += a; *(f32x4*)xp = xv;
      *(u32x2*)(p.xb + (long)(m0 + row) * DM + n0 + ch * 4) = (u32x2){cvtpk(xv[0], xv[1]), cvtpk(xv[2], xv[3])}; }
  } else {
    constexpr int QROW = 272;
    char* Qs = lds; char* Ss = lds + 128 * QROW;
    const int hp = n0 >> 7;
#pragma unroll
    for (int mi = 0; mi < 2; ++mi) {
      const int rl = rowb + mi * 32 + r32;
#pragma unroll
      for (int g = 0; g < 4; ++g) {
        char* e_ = Qs + rl * QROW + (colb + 8 * g + 4 * hi) * 2;
        *(u32x2*)e_ = (u32x2){cvtpk(acc[mi][0][4 * g] * rs[mi], acc[mi][0][4 * g + 1] * rs[mi]), cvtpk(acc[mi][0][4 * g + 2] * rs[mi], acc[mi][0][4 * g + 3] * rs[mi])};
        *(u32x2*)(e_ + 64) = (u32x2){cvtpk(acc[mi][1][4 * g] * rs[mi], acc[mi][1][4 * g + 1] * rs[mi]), cvtpk(acc[mi][1][4 * g + 2] * rs[mi], acc[mi][1][4 * g + 3] * rs[mi])};
      }
    }
#pragma unroll
    for (int i = 0; i < 8; ++i) { const int c = tid + 256 * i, kr = c >> 4, ch = c & 15; *(bf16x8*)(Ss + kr * QROW + ch * 16) = skr[i]; }
    __syncthreads();
    f32x16 a2[2][2];
#pragma unroll
    for (int i = 0; i < 2; ++i)
#pragma unroll
      for (int j = 0; j < 2; ++j)
#pragma unroll
        for (int r = 0; r < 16; ++r) a2[i][j][r] = 0.f;
    { const char* Ar = Qs + (rowb + r32) * QROW + hi * 16; const char* Br = Ss + (colb + r32) * QROW + hi * 16;
#pragma unroll
      for (int ks = 0; ks < 8; ++ks) {
        bf16x8 a0 = *(const bf16x8*)(Ar + ks * 32), a1 = *(const bf16x8*)(Ar + 32 * QROW + ks * 32);
        bf16x8 b0 = *(const bf16x8*)(Br + ks * 32), b1 = *(const bf16x8*)(Br + 32 * QROW + ks * 32);
        a2[0][0] = mfma32(b0, a0, a2[0][0]); a2[0][1] = mfma32(b1, a0, a2[0][1]);
        a2[1][0] = mfma32(b0, a1, a2[1][0]); a2[1][1] = mfma32(b1, a1, a2[1][1]);
      } }
    __syncthreads();
    constexpr int SROW = 544;
    char* Sc = lds;
#pragma unroll
    for (int mi = 0; mi < 2; ++mi) {
      const int rl = rowb + mi * 32 + r32;
#pragma unroll
      for (int ni = 0; ni < 2; ++ni)
#pragma unroll
        for (int g = 0; g < 4; ++g)
          *(f32x4*)(Sc + rl * SROW + (colb + ni * 32 + 8 * g + 4 * hi) * 4) = (f32x4){a2[mi][ni][4 * g], a2[mi][ni][4 * g + 1], a2[mi][ni][4 * g + 2], a2[mi][ni][4 * g + 3]};
    }
    __syncthreads();
    { const int row = tid >> 1, hf = tid & 1;
      u32 kv[64];
#pragma unroll
      for (int i = 0; i < 16; ++i) {
        const f32x4 v = *(const f32x4*)(Sc + row * SROW + (2 * i + hf) * 16);
#pragma unroll
        for (int e = 0; e < 4; ++e) { const u32 b = __float_as_uint(v[e] + KEY_BIAS);
          kv[i * 4 + e] = (b & ~127u) | (u32)((2 * i + hf) * 4 + e); }
      }
      u32 mprev = 0xffffffffu;
      u32* outk = p.pkeys + (long)(m0 + row) * 256 + hp * 16;
#pragma unroll 1
      for (int ps = 0; ps < 16; ++ps) {
        u32 best = 0;
#pragma unroll
        for (int i = 0; i < 64; ++i) { const u32 d = kv[i] - mprev; best = d > best ? d : best; }
        u32 cand = mprev + best;
        if (best < (0u - mprev)) cand = 0u;
        const u32 oth = (u32)__shfl_xor((int)cand, 1, 64);
        mprev = cand > oth ? cand : oth;
        if (hf == 0) outk[ps] = mprev;
      }
    }
  }
}

template <int OFF> __device__ __forceinline__ s16x4 tr_read(int vb) {
  s16x4 r; asm volatile("ds_read_b64_tr_b16 %0, %1 offset:%2" : "=&v"(r) : "v"(vb), "i"(OFF) : "memory"); return r;
}
__device__ __forceinline__ int v_st(int k, int c) { const int kk = (k & ~0xC) | ((k & 4) << 1) | ((k & 8) >> 1); return ((kk >> 3) * 4 + (c >> 5)) * 512 + ((kk & 7) * 32 + (c & 31)) * 2; }
__device__ __forceinline__ int v_rd_base(int lane) { return ((lane & 3) << 3) | (((lane >> 2) & 3) << 6) | (((lane >> 4) & 1) << 5) | (((lane >> 5) & 1) << 8); }
constexpr int v_rd_off(int d0, int ks, int half) { return d0 * 512 + ks * 4096 + half * 2048; }
template <int D0> __device__ __forceinline__ void pv_one(f32x16& od, int vb, bf16x8 pa0, bf16x8 pa1, bf16x8 pa2, bf16x8 pa3) {
  const s16x4 l0 = tr_read<v_rd_off(D0, 0, 0)>(vb), h0 = tr_read<v_rd_off(D0, 0, 1)>(vb), l1 = tr_read<v_rd_off(D0, 1, 0)>(vb), h1 = tr_read<v_rd_off(D0, 1, 1)>(vb);
  const s16x4 l2 = tr_read<v_rd_off(D0, 2, 0)>(vb), h2 = tr_read<v_rd_off(D0, 2, 1)>(vb), l3 = tr_read<v_rd_off(D0, 3, 0)>(vb), h3 = tr_read<v_rd_off(D0, 3, 1)>(vb);
  asm volatile("s_waitcnt lgkmcnt(0)" ::: "memory"); __builtin_amdgcn_sched_barrier(0);
#define PKV(L, H) (bf16x8){L[0], L[1], L[2], L[3], H[0], H[1], H[2], H[3]}
  od = mfma32(pa0, PKV(l0, h0), od); od = mfma32(pa1, PKV(l1, h1), od); od = mfma32(pa2, PKV(l2, h2), od); od = mfma32(pa3, PKV(l3, h3), od);
#undef PKV
}

constexpr float THR_L2 = 11.5f;

__device__ __forceinline__ void partialSM(f32x16& p0, f32x16& p1, float& m_reg, float& alpha) {
  float pmax = p0[0];
#pragma unroll
  for (int r = 1; r < 16; ++r) pmax = fmaxf(pmax, p0[r]);
#pragma unroll
  for (int r = 0; r < 16; ++r) pmax = fmaxf(pmax, p1[r]);
  { auto rr = __builtin_amdgcn_permlane32_swap(__float_as_uint(pmax), __float_as_uint(pmax), false, false);
    pmax = fmaxf(__uint_as_float(rr[0]), __uint_as_float(rr[1])); }
  float mn;
  if (__all(pmax - m_reg <= THR_L2)) { mn = m_reg; alpha = 1.f; }
  else { mn = fmaxf(m_reg, pmax); alpha = __builtin_amdgcn_exp2f(m_reg - mn); m_reg = mn; }
#pragma unroll
  for (int r = 0; r < 16; ++r) { p0[r] = __builtin_amdgcn_exp2f(p0[r] - mn); p1[r] = __builtin_amdgcn_exp2f(p1[r] - mn); }
}
__device__ __forceinline__ void finishSM(f32x16& p0, f32x16& p1, float alpha, float& l_reg, bf16x8& pa0, bf16x8& pa1, bf16x8& pa2, bf16x8& pa3) {
  float ps = 0.f;
#pragma unroll
  for (int r = 0; r < 16; ++r) ps += p0[r];
#pragma unroll
  for (int r = 0; r < 16; ++r) ps += p1[r];
  { auto rr = __builtin_amdgcn_permlane32_swap(__float_as_uint(ps), __float_as_uint(ps), false, false);
    ps = __uint_as_float(rr[0]) + __uint_as_float(rr[1]); }
  l_reg = l_reg * alpha + ps;
#define PK4(P, BASE, OUT) do { unsigned a0 = cvtpk(P[BASE + 0], P[BASE + 1]), a1 = cvtpk(P[BASE + 2], P[BASE + 3]);   \
    unsigned b0 = cvtpk(P[BASE + 4], P[BASE + 5]), b1 = cvtpk(P[BASE + 6], P[BASE + 7]);                              \
    auto r0 = __builtin_amdgcn_permlane32_swap(a0, b0, false, false); auto r1 = __builtin_amdgcn_permlane32_swap(a1, b1, false, false); \
    u32x4 w_ = {r0[0], r1[0], r0[1], r1[1]}; OUT = __builtin_bit_cast(bf16x8, w_); } while (0)
  PK4(p0, 0, pa0); PK4(p0, 8, pa1); PK4(p1, 0, pa2); PK4(p1, 8, pa3);
#undef PK4
}

constexpr int ATT_K_OFF = 0, ATT_V_OFF = 25600, ATT_WS_OFF = 41984, ATT_RPB_OFF = 43008;

template <int MODE>
__device__ __forceinline__ void attn_item(KP p, int layer, int item, char* lds) {
  constexpr int KST = MODE == 0 ? 12 : 4;
  constexpr int KROW = MODE == 0 ? 400 : 272;
  constexpr int ND0 = MODE == 0 ? 4 : 2;
  int tid_ = threadIdx.x; asm volatile("" : "+v"(tid_));
  const int tid = tid_, lane = tid & 63, w = tid >> 6, r32 = lane & 31, hi = lane >> 5;
  char* Kl = lds + ATT_K_OFF; char* Vl = lds + ATT_V_OFF;
  float* wsl = (float*)(lds + ATT_WS_OFF) + w * 64; float* al_l = wsl; float* li_l = wsl + 32;
  float* rpbl = (float*)(lds + ATT_RPB_OFF);

  int NT, qtok, ktok0, head, kcolB = 0; long obase;
  int na_c = 0, na_c0 = 0, na_relrow0 = 0, na_hl = 0;
  const u16* Qp;
  if constexpr (MODE == 0) {
    int seq, qb;
    if (item < 2048) { const int sh = item >> 7; seq = 8 + (sh >> 3); head = sh & 7; qb = item & 127; ktok0 = T_PROMPT + (seq - 8) * 16384; NT = 256; }
    else { const int it = item - 2048; const int sh = it >> 4; seq = sh >> 3; head = sh & 7; qb = it & 15; ktok0 = seq * 2048; NT = 32; }
    qtok = ktok0 + qb * 128 + w * 32 + r32;
    Qp = p.q + (long)qtok * 1536 + head * 192 + hi * 8;
    obase = (long)(ktok0 + qb * 128 + w * 32) * 1024 + head * 128;
  } else {
    const int Rg = item >> 3, hpair = item & 7;
    int grow0, r, rows;
    if (Rg < 256) { grow0 = (Rg >> 5) << 5; r = Rg & 31; rows = 32; } else { grow0 = 256 + (((Rg - 256) >> 8) << 8); r = (Rg - 256) & 255; rows = 256; }
    int r0 = r - 4; r0 = r0 < 0 ? 0 : r0; r0 = r0 > rows - 8 ? rows - 8 : r0;
    ktok0 = (grow0 + r0) * 64; NT = 8;
    na_hl = w >> 1; head = hpair * 2 + na_hl;
    na_c = (w & 1) * 32 + r32; na_c0 = na_c - 8; na_c0 = na_c0 < 0 ? 0 : na_c0; na_c0 = na_c0 > 48 ? 48 : na_c0;
    na_relrow0 = r0 - r + 7;
    qtok = Rg * 64 + na_c;
    Qp = p.qkv + (long)qtok * 3072 + head * 64 + hi * 8;
    obase = (long)(Rg * 64 + (w & 1) * 32) * 1024 + head * 64;
    kcolB = na_hl * 128;
    __syncthreads();
    { const float* src = p.na_rpb_s + ((long)layer * 16 + hpair * 2) * 465;
      for (int e = tid; e < 930; e += 256) rpbl[e] = src[e]; }
  }
  bf16x8 qr[KST];
#pragma unroll
  for (int d = 0; d < KST; ++d) qr[d] = *(const bf16x8*)(Qp + d * 16);

  bf16x8 sk[MODE == 0 ? 6 : 4], sv[4];
  const int s_key = tid >> 4, s_ch = tid & 15;
  const int s_key8 = tid >> 3, s_ch8 = tid & 7;
#define ALOAD(j) do { const long kt_ = (long)ktok0 + (j) * 64; \
    if constexpr (MODE == 0) { \
      _Pragma("unroll") for (int i = 0; i < 4; ++i) { const u16* b_ = p.kv + (kt_ + s_key + 16 * i) * 2048 + head * 256 + s_ch * 8; sk[i] = *(const bf16x8*)b_; sv[i] = *(const bf16x8*)(b_ + 128); } \
      _Pragma("unroll") for (int i = 0; i < 2; ++i) sk[4 + i] = *(const bf16x8*)(p.cqkv + (kt_ + s_key8 + 32 * i) * 768 + 640 + s_ch8 * 8); \
    } else { \
      _Pragma("unroll") for (int i = 0; i < 4; ++i) { const u16* b_ = p.qkv + (kt_ + s_key + 16 * i) * 3072 + 1024 + (head & ~1) * 64 + s_ch * 8; sk[i] = *(const bf16x8*)b_; sv[i] = *(const bf16x8*)(b_ + 1024); } \
    } } while (0)
#define AWRITE() do { \
    _Pragma("unroll") for (int i = 0; i < 4; ++i) { *(bf16x8*)(Kl + (s_key + 16 * i) * KROW + s_ch * 16) = sk[i]; *(bf16x8*)(Vl + v_st(s_key + 16 * i, s_ch * 8)) = sv[i]; } \
    if constexpr (MODE == 0) { _Pragma("unroll") for (int i = 0; i < 2; ++i) *(bf16x8*)(Kl + (s_key8 + 32 * i) * KROW + 256 + s_ch8 * 16) = sk[4 + i]; } } while (0)

  float m_reg = -1e30f, l_reg = 0.f;
  f32x16 o[ND0];
#pragma unroll
  for (int d = 0; d < ND0; ++d)
#pragma unroll
    for (int r = 0; r < 16; ++r) o[d][r] = 0.f;
  const int vb0 = (int)(uintptr_t)Vl + v_rd_base(lane) + (MODE == 1 ? na_hl * 1024 : 0);

  ALOAD(0);
  for (int j = 0; j < NT; ++j) {
    __syncthreads();
    AWRITE();
    __syncthreads();
    if (j + 1 < NT) ALOAD(j + 1);
    f32x16 p0, p1;
#pragma unroll
    for (int r = 0; r < 16; ++r) { p0[r] = 0.f; p1[r] = 0.f; }
#pragma unroll
    for (int d = 0; d < KST; ++d) {
      const int cb = kcolB + (d * 16 + hi * 8) * 2;
      bf16x8 b0 = *(const bf16x8*)(Kl + r32 * KROW + cb), b1 = *(const bf16x8*)(Kl + (32 + r32) * KROW + cb);
      p0 = mfma32(b0, qr[d], p0); p1 = mfma32(b1, qr[d], p1);
    }
    if constexpr (MODE == 1) {
      const float* rb = rpbl + (na_hl * 15 + na_relrow0 + j) * 31;
#pragma unroll
      for (int r = 0; r < 16; ++r) {
        const int kc0 = crow(r, hi), kc1 = 32 + kc0;
        int i0 = kc0 - na_c + 15, i1 = kc1 - na_c + 15;
        i0 = i0 < 0 ? 0 : (i0 > 30 ? 30 : i0); i1 = i1 < 0 ? 0 : (i1 > 30 ? 30 : i1);
        const float b0 = rb[i0], b1 = rb[i1];
        p0[r] = ((unsigned)(kc0 - na_c0) < 16u) ? p0[r] + b0 : -1e30f;
        p1[r] = ((unsigned)(kc1 - na_c0) < 16u) ? p1[r] + b1 : -1e30f;
      }
    }
    float alpha;
    partialSM(p0, p1, m_reg, alpha);
    if (__any(alpha < 1.f)) {
      if (hi == 0) al_l[r32] = alpha;
      __builtin_amdgcn_wave_barrier();
#pragma unroll
      for (int r = 0; r < 16; ++r) { const float a = al_l[crow(r, hi)];
#pragma unroll
        for (int d = 0; d < ND0; ++d) o[d][r] *= a; }
      __builtin_amdgcn_wave_barrier();
    }
    bf16x8 pa0, pa1, pa2, pa3;
    finishSM(p0, p1, alpha, l_reg, pa0, pa1, pa2, pa3);
    pv_one<0>(o[0], vb0, pa0, pa1, pa2, pa3); pv_one<1>(o[1], vb0, pa0, pa1, pa2, pa3);
    if constexpr (MODE == 0) { pv_one<2>(o[2], vb0, pa0, pa1, pa2, pa3); pv_one<3>(o[3], vb0, pa0, pa1, pa2, pa3); }
  }
#undef ALOAD
#undef AWRITE
  if (hi == 0) li_l[r32] = l_reg;
  __builtin_amdgcn_wave_barrier();
#pragma unroll
  for (int r = 0; r < 16; ++r) {
    const int qrow = crow(r, hi); const float rl = 1.f / li_l[qrow];
    u16* o_ = p.o + obase + (long)qrow * 1024 + r32;
#pragma unroll
    for (int d = 0; d < ND0; ++d) o_[d * 32] = (u16)(cvtpk(o[d][r] * rl, 0.f) & 0xffffu);
  }
  __builtin_amdgcn_wave_barrier();
}

__device__ __forceinline__ float lane_bcast(float v, int src_lane) { return __int_as_float(__builtin_amdgcn_ds_bpermute(src_lane << 2, __float_as_int(v))); }
__device__ __forceinline__ float rowmax32(const f32x16& p0, const f32x16& p1) {
  float pmax = p0[0];
#pragma unroll
  for (int r = 1; r < 16; ++r) pmax = fmaxf(pmax, p0[r]);
#pragma unroll
  for (int r = 0; r < 16; ++r) pmax = fmaxf(pmax, p1[r]);
  auto rr = __builtin_amdgcn_permlane32_swap(__float_as_uint(pmax), __float_as_uint(pmax), false, false);
  return fmaxf(__uint_as_float(rr[0]), __uint_as_float(rr[1]));
}

typedef __attribute__((ext_vector_type(8))) int i32x8;
#define MFMA8(A, B, C, SA, SB_) __builtin_amdgcn_mfma_scale_f32_32x32x64_f8f6f4(A, B, C, 0, 0, 0, SA, 0, SB_)
constexpr int SC_K = 0x7D7D7D7D, SC_Q = 0x7B7B7B7B, SC_P = 0x7F7F7F7F, SC_V = 0x7D7D7D7D;
constexpr float THR8_L2 = 1.5f;

__device__ __forceinline__ void attn_mla(KP p, int item, char* lds) {
  constexpr int KSTAGE = 64 * 192, VSTAGE = 128 * 64, VOFF = 2 * KSTAGE;
  int tid_ = threadIdx.x; asm volatile("" : "+v"(tid_));
  const int tid = tid_, lane = tid & 63, w = tid >> 6, r32 = lane & 31, hi = lane >> 5;
  int NT, ktok0, head, seq, qb;
  if (item < 2048) { const int sh = item >> 7; seq = 8 + (sh >> 3); head = sh & 7; qb = item & 127; ktok0 = T_PROMPT + (seq - 8) * 16384; NT = 256; }
  else { const int it = item - 2048; const int sh = it >> 4; seq = sh >> 3; head = sh & 7; qb = it & 15; ktok0 = seq * 2048; NT = 32; }
  const int qtok = ktok0 + qb * 128 + w * 32 + r32;
  const long obase = (long)(ktok0 + qb * 128 + w * 32) * 1024 + head * 128;
  i32x8 qf[3];
  { const unsigned char* Qp = p.q8 + (long)qtok * 1536 + head * 192 + hi * 32;
#pragma unroll
    for (int s3 = 0; s3 < 3; ++s3) { const u32x4 a = *(const u32x4*)(Qp + s3 * 64), b = *(const u32x4*)(Qp + s3 * 64 + 16);
      qf[s3] = (i32x8){(int)a[0], (int)a[1], (int)a[2], (int)a[3], (int)b[0], (int)b[1], (int)b[2], (int)b[3]}; } }
  unsigned ko[3], vo[2];
#pragma unroll
  for (int i = 0; i < 3; ++i) {
    const int g = (w * 3 + i) * 64 + lane, key = g / 12, pc = g - key * 12, c = pc ^ ((key >> 2) & 3);
    ko[i] = (c < 8) ? (unsigned)(key * 1088 + head * 128 + c * 16) : (unsigned)(key * 1088 + 1024 + (c - 8) * 16);
  }
#pragma unroll
  for (int i = 0; i < 2; ++i) {
    const int g = (w * 2 + i) * 64 + lane, d = g >> 2, pc = g & 3, c = pc ^ ((d >> 2) & 3);
    vo[i] = (unsigned)(d * T_TOK + c * 16);
  }
  const unsigned char* k8b = p.k8 + (long)ktok0 * 1088;
  const unsigned char* vtb = p.vT8 + (long)head * 128 * T_TOK + ktok0;
#define GLK(st, jt) do { const unsigned char* kt_ = k8b + (long)(jt) * (64 * 1088); int w_ = w; asm volatile("" : "+v"(w_)); \
    _Pragma("unroll") for (int i = 0; i < 3; ++i) { unsigned k_ = ko[i]; asm volatile("" : "+v"(k_)); \
    __builtin_amdgcn_global_load_lds((const unsigned*)(kt_ + k_), (unsigned*)(lds + (st) * KSTAGE + (w_ * 3 + i) * 1024), 16, 0, 0); } } while (0)
#define GLV(st, jt) do { const unsigned char* vt_ = vtb + (long)(jt) * 64; int w_ = w; asm volatile("" : "+v"(w_)); \
    _Pragma("unroll") for (int i = 0; i < 2; ++i) { unsigned v_ = vo[i]; asm volatile("" : "+v"(v_)); \
    __builtin_amdgcn_global_load_lds((const unsigned*)(vt_ + v_), (unsigned*)(lds + VOFF + (st) * VSTAGE + (w_ * 2 + i) * 1024), 16, 0, 0); } } while (0)
#define QK8(P0, P1, st) do { const int r_ = r32, h_ = hi, sw_ = (r_ >> 2) & 3; const char* Kr_ = lds + (st) * KSTAGE + r_ * 192; \
    const f32x16 z_ = {0.f, 0.f, 0.f, 0.f, 0.f, 0.f, 0.f, 0.f, 0.f, 0.f, 0.f, 0.f, 0.f, 0.f, 0.f, 0.f}; \
    _Pragma("unroll") for (int s3 = 0; s3 < 3; ++s3) { const int c0_ = ((s3 * 4 + h_ * 2) ^ sw_) << 4, c1_ = ((s3 * 4 + h_ * 2 + 1) ^ sw_) << 4; \
      const u32x4 a0_ = *(const u32x4*)(Kr_ + c0_), a1_ = *(const u32x4*)(Kr_ + c1_), b0_ = *(const u32x4*)(Kr_ + 32 * 192 + c0_), b1_ = *(const u32x4*)(Kr_ + 32 * 192 + c1_); \
      const i32x8 ka_ = {(int)a0_[0], (int)a0_[1], (int)a0_[2], (int)a0_[3], (int)a1_[0], (int)a1_[1], (int)a1_[2], (int)a1_[3]}; \
      const i32x8 kb_ = {(int)b0_[0], (int)b0_[1], (int)b0_[2], (int)b0_[3], (int)b1_[0], (int)b1_[1], (int)b1_[2], (int)b1_[3]}; \
      P0 = MFMA8(ka_, qf[s3], (s3 == 0 ? z_ : P0), SC_K, SC_Q); P1 = MFMA8(kb_, qf[s3], (s3 == 0 ? z_ : P1), SC_K, SC_Q); } } while (0)
#define PZERO(P0, P1) do { _Pragma("unroll") for (int r = 0; r < 16; ++r) { P0[r] = 0.f; P1[r] = 0.f; } } while (0)
#define EXPC(P, mn, R0, R1) do { _Pragma("unroll") for (int r = (R0); r < (R1); ++r) P[r] = __builtin_amdgcn_exp2f(P[r] - (mn)); } while (0)
#define SB() do {} while (0)

  float m_reg = -1e30f, l_reg = 0.f;
  f32x16 o[4];
#pragma unroll
  for (int d = 0; d < 4; ++d)
#pragma unroll
    for (int r = 0; r < 16; ++r) o[d][r] = 0.f;
  f32x16 pA0, pA1, pB0, pB1; float pmaxA, pmaxB;

  __syncthreads();
  GLK(0, 0); GLV(0, 0); GLK(1, 1);
  asm volatile("s_waitcnt vmcnt(0)" ::: "memory");
  __syncthreads();
  QK8(pA0, pA1, 0); pmaxA = rowmax32(pA0, pA1);

#define STEP(j, PX0, PX1, PMX, PY0, PY1, PMY, LAST) do { \
    asm volatile("s_waitcnt lgkmcnt(0)" ::: "memory"); __builtin_amdgcn_s_barrier(); \
    if ((j) + 2 < NT) GLK((j) & 1, (j) + 2); \
    if (!(LAST)) GLV(((j) + 1) & 1, (j) + 1); \
    const bool keep_ = __all(PMX - m_reg <= THR8_L2); \
    const float mn_ = keep_ ? m_reg : fmaxf(m_reg, PMX); \
    const float alpha_ = keep_ ? 1.f : __builtin_amdgcn_exp2f(m_reg - mn_); m_reg = mn_; \
    if (!keep_) { _Pragma("unroll") for (int r = 0; r < 16; ++r) { const float a_ = lane_bcast(alpha_, crow(r, hi)); \
      _Pragma("unroll") for (int d = 0; d < 4; ++d) o[d][r] *= a_; } } \
    SB(); \
    if (!(LAST)) { QK8(PY0, PY1, ((j) + 1) & 1); } \
    { const float mnp_ = mn_ - 7.f; EXPC(PX0, mnp_, 0, 16); EXPC(PX1, mnp_, 0, 16); }     \
    SB(); \
    { float ps_ = 0.f; \
      _Pragma("unroll") for (int r = 0; r < 16; ++r) ps_ += PX0[r] + PX1[r]; \
      auto rr_ = __builtin_amdgcn_permlane32_swap(__float_as_uint(ps_), __float_as_uint(ps_), false, false); \
      l_reg = l_reg * alpha_ + __uint_as_float(rr_[0]) + __uint_as_float(rr_[1]); } \
    i32x8 pf_; \
    _Pragma("unroll") for (int g = 0; g < 4; ++g) { \
      const u32 x_ = pack4_fp8(PX0[4 * g], PX0[4 * g + 1], PX0[4 * g + 2], PX0[4 * g + 3]); \
      const u32 y_ = pack4_fp8(PX1[4 * g], PX1[4 * g + 1], PX1[4 * g + 2], PX1[4 * g + 3]); \
      auto sw_ = __builtin_amdgcn_permlane32_swap(x_, y_, false, false); pf_[2 * g] = (int)sw_[0]; pf_[2 * g + 1] = (int)sw_[1]; } \
    SB(); \
    { const int r_ = r32, h_ = hi, sw2_ = (r_ >> 2) & 3; \
      const char* Vr_ = lds + VOFF + ((j) & 1) * VSTAGE + r_ * 64; const int c0_ = ((h_ * 2) ^ sw2_) << 4, c1_ = ((h_ * 2 + 1) ^ sw2_) << 4; \
      _Pragma("unroll") for (int d0 = 0; d0 < 4; ++d0) { \
        const u32x4 a0_ = *(const u32x4*)(Vr_ + d0 * 2048 + c0_), a1_ = *(const u32x4*)(Vr_ + d0 * 2048 + c1_); \
        const i32x8 vf_ = {(int)a0_[0], (int)a0_[1], (int)a0_[2], (int)a0_[3], (int)a1_[0], (int)a1_[1], (int)a1_[2], (int)a1_[3]}; \
        o[d0] = MFMA8(pf_, vf_, o[d0], SC_P, SC_V); } } \
    if (!(LAST)) PMY = rowmax32(PY0, PY1); \
    asm volatile("s_waitcnt vmcnt(0)" ::: "memory"); } while (0)

  for (int j = 0; j < NT - 2; j += 2) {
    STEP(j, pA0, pA1, pmaxA, pB0, pB1, pmaxB, false);
    STEP(j + 1, pB0, pB1, pmaxB, pA0, pA1, pmaxA, false);
  }
  STEP(NT - 2, pA0, pA1, pmaxA, pB0, pB1, pmaxB, false);
  STEP(NT - 1, pB0, pB1, pmaxB, pA0, pA1, pmaxA, true);
#undef STEP
#undef QK8
#undef PZERO
#undef EXPC
#undef SB
#undef GLK
#undef GLV
#pragma unroll
  for (int r = 0; r < 16; ++r) {
    const int qrow = crow(r, hi); const float rl = 1.f / lane_bcast(l_reg, qrow);
    u16* o_ = p.o + obase + (long)qrow * 1024 + r32;
#pragma unroll
    for (int d = 0; d < 4; ++d) o_[d * 32] = (u16)(cvtpk(o[d][r] * rl, 0.f) & 0xffffu);
  }
}

typedef __attribute__((ext_vector_type(2))) float f32x2;
constexpr float U_SCALE = 256.f, V_SCALE = 64.f;
__device__ __forceinline__ float keyval(u32 k) { return __uint_as_float(k & ~127u) - KEY_BIAS; }
template <int CTRL> __device__ __forceinline__ float dppf(float v) { return __int_as_float(__builtin_amdgcn_update_dpp(0, __float_as_int(v), CTRL, 0xF, 0xF, true)); }
__device__ __forceinline__ float red16(float v) { v += dppf<0xB1>(v); v += dppf<0x4E>(v); v += dppf<0x141>(v); v += dppf<0x140>(v); return v; }
__device__ __forceinline__ void fp8dot(u32 dw, const f32x4& x, f32x2& acc) {
  const f32x2 lo = __builtin_amdgcn_cvt_pk_f32_fp8((int)dw, false), hi = __builtin_amdgcn_cvt_pk_f32_fp8((int)dw, true);
  acc = __builtin_elementwise_fma(lo, (f32x2){x[0], x[1]}, acc); acc = __builtin_elementwise_fma(hi, (f32x2){x[2], x[3]}, acc);
}

#ifndef PEER_FP4
#define PEER_FP4 1
#endif
#if PEER_FP4
constexpr float U4_SCALE = 96.f, V4_SCALE = 22.f;
__device__ __forceinline__ void fp4dot(u32 dw, const f32x4& x0, const f32x4& x1, f32x2& acc) {
  acc = __builtin_elementwise_fma(__builtin_amdgcn_cvt_scalef32_pk_f32_fp4(dw, 1.0f, 0), (f32x2){x0[0], x0[1]}, acc);
  acc = __builtin_elementwise_fma(__builtin_amdgcn_cvt_scalef32_pk_f32_fp4(dw, 1.0f, 1), (f32x2){x0[2], x0[3]}, acc);
  acc = __builtin_elementwise_fma(__builtin_amdgcn_cvt_scalef32_pk_f32_fp4(dw, 1.0f, 2), (f32x2){x1[0], x1[1]}, acc);
  acc = __builtin_elementwise_fma(__builtin_amdgcn_cvt_scalef32_pk_f32_fp4(dw, 1.0f, 3), (f32x2){x1[2], x1[3]}, acc);
}
__device__ __forceinline__ void phase_peer_combine(KP p, int layer, char* lds, unsigned* ctr) {
  const bool last = (layer == 3);
  int tid_ = threadIdx.x; asm volatile("" : "+v"(tid_));
  const int tid = tid_, lane = tid & 63, w = tid >> 6;
  int* eL = (int*)(lds + w * 1536); float* gL = (float*)(lds + w * 1536 + 512); float* wL = (float*)(lds + w * 1536 + 1024);
  int ci = 0, cj = 0; bool cvalid = false;
  { int cnt = 0;
#pragma unroll
    for (int i = 0; i < 16; ++i) { const int n = 16 / (i + 1); if (!cvalid && lane < cnt + n) { ci = i; cj = lane - cnt; cvalid = true; } cnt += n; } }
  const unsigned char* U = p.peer_u8 + (long)layer * 16384 * 512; const unsigned char* V = p.peer_v8 + (long)layer * 16384 * 512;
  const int sub = lane & 15, grp = lane >> 4, l32 = lane & 31, hf = lane >> 5;
  __syncthreads();
  for (;;) {
   int base_ = 0; if (lane == 0) base_ = (int)atomicAdd(ctr, 4u);
   base_ = __builtin_amdgcn_readfirstlane(base_);
   if (base_ >= T_TOK) break;
#pragma unroll 1
   for (int t = base_; t < base_ + 4; ++t) {
    float* xr = p.x + (long)t * DM;
    const u32* pk = p.pkeys + (long)t * 256;
    u32 ka[8], kb[8];
#pragma unroll
    for (int hd = 0; hd < 8; ++hd) { ka[hd] = pk[hd * 32 + ci]; kb[hd] = pk[hd * 32 + 16 + cj]; }
    u32 xe[2][4], xo[2][4]; int sumx = 0; float rstd, sx;
    f32x4 xs[2][8];
#pragma unroll
    for (int j = 0; j < 2; ++j)
#pragma unroll
      for (int q = 0; q < 8; ++q) xs[j][q] = *(const f32x4*)(xr + (sub + 16 * j) * 32 + q * 4);
#pragma unroll
    for (int hd = 0; hd < 8; ++hd) {
      const float cand = cvalid ? keyval(ka[hd]) + keyval(kb[hd]) : -3.0e38f;
      u32 ck = __float_as_uint(cand); ck = (ck & 0x80000000u) ? ~ck : (ck | 0x80000000u); ck = (ck & ~63u) | (u32)(63 - lane);
      int rank = 0;
#pragma unroll
      for (int m = 0; m < 50; ++m) { const u32 c = __builtin_amdgcn_readlane(ck, m); rank += (c > ck) ? 1 : 0; }
      const float cmax = __uint_as_float(__builtin_amdgcn_readlane(__float_as_uint(cand), 0));
      if (cvalid && rank < 16) { eL[hd * 16 + rank] = (int)((ka[hd] & 127u) * 128u + (kb[hd] & 127u)); gL[hd * 16 + rank] = __expf(cand - cmax); }
    }
    __builtin_amdgcn_wave_barrier();
    { const float g0 = gL[lane], g1 = gL[lane + 64]; const float s0 = red16(g0), s1 = red16(g1);
      __builtin_amdgcn_wave_barrier();
      gL[lane] = g0 / s0; gL[lane + 64] = g1 / s1; }
    __builtin_amdgcn_wave_barrier();
    u32x4 cA[8], cB[8];
#define LOADU(C, it) do { const int k0_ = (it) * 16 + grp * 4; \
      _Pragma("unroll") for (int rr = 0; rr < 4; ++rr) { const int e_ = eL[k0_ + rr]; const unsigned char* u_ = U + (long)e_ * 512 + sub * 16; \
        C[rr * 2] = *(const u32x4*)u_; C[rr * 2 + 1] = *(const u32x4*)(u_ + 256); } } while (0)
#define COMPU(C, it) do { const int k0_ = (it) * 16 + grp * 4; \
      _Pragma("unroll") for (int rr = 0; rr < 4; ++rr) { int a_ = 0; \
        _Pragma("unroll") for (int j = 0; j < 2; ++j) { _Pragma("unroll") for (int d = 0; d < 4; ++d) { const u32 dw_ = C[rr * 2 + j][d]; \
          a_ = __builtin_amdgcn_sdot4((int)(dw_ & 0x0F0F0F0Fu), (int)xe[j][d], a_, false); a_ = __builtin_amdgcn_sdot4((int)((dw_ >> 4) & 0x0F0F0F0Fu), (int)xo[j][d], a_, false); } } \
        const float r_ = red16((float)(a_ - 8 * sumx)); \
        if (sub == 0) wL[k0_ + rr] = r_; } } while (0)
#define LOADV(C, g) do { _Pragma("unroll") for (int i = 0; i < 8; ++i) { const int e_ = eL[(g) * 16 + 2 * i + hf]; \
      C[i] = *(const u32x4*)(V + (long)e_ * 512 + l32 * 16); } } while (0)
#define COMPV(C, g) do { _Pragma("unroll") for (int i = 0; i < 8; ++i) { const float wk_ = wL[(g) * 16 + 2 * i + hf]; const f32x2 w2_ = {wk_, wk_}; \
      _Pragma("unroll") for (int d = 0; d < 4; ++d) { const u32 dw_ = C[i][d]; \
        out[d * 4 + 0] = __builtin_elementwise_fma(__builtin_amdgcn_cvt_scalef32_pk_f32_fp4(dw_, 1.0f, 0), w2_, out[d * 4 + 0]); \
        out[d * 4 + 1] = __builtin_elementwise_fma(__builtin_amdgcn_cvt_scalef32_pk_f32_fp4(dw_, 1.0f, 1), w2_, out[d * 4 + 1]); \
        out[d * 4 + 2] = __builtin_elementwise_fma(__builtin_amdgcn_cvt_scalef32_pk_f32_fp4(dw_, 1.0f, 2), w2_, out[d * 4 + 2]); \
        out[d * 4 + 3] = __builtin_elementwise_fma(__builtin_amdgcn_cvt_scalef32_pk_f32_fp4(dw_, 1.0f, 3), w2_, out[d * 4 + 3]); } } } while (0)
    LOADU(cA, 0);
    { float ss = 0.f, am = 0.f;
#pragma unroll
      for (int j = 0; j < 2; ++j)
#pragma unroll
        for (int q = 0; q < 8; ++q) { const f32x4 a = xs[j][q]; ss += a[0] * a[0] + a[1] * a[1] + a[2] * a[2] + a[3] * a[3];
          am = fmaxf(fmaxf(am, fmaxf(fabsf(a[0]), fabsf(a[1]))), fmaxf(fabsf(a[2]), fabsf(a[3]))); }
      ss = red16(ss);
      am = fmaxf(am, dppf<0xB1>(am)); am = fmaxf(am, dppf<0x4E>(am)); am = fmaxf(am, dppf<0x141>(am)); am = fmaxf(am, dppf<0x140>(am));
      rstd = rsqrtf(ss * (1.f / DM) + RMS_EPS);
      am = fmaxf(am, 1e-20f); sx = am * (1.f / 127.f); const float inv = 127.f / am;
#pragma unroll
      for (int j = 0; j < 2; ++j)
#pragma unroll
        for (int d = 0; d < 4; ++d) {
          const f32x4 lo4 = xs[j][2 * d], hi4 = xs[j][2 * d + 1];
          const int i0 = (int)__builtin_rintf(lo4[0] * inv), i1 = (int)__builtin_rintf(lo4[1] * inv), i2 = (int)__builtin_rintf(lo4[2] * inv), i3 = (int)__builtin_rintf(lo4[3] * inv);
          const int i4 = (int)__builtin_rintf(hi4[0] * inv), i5 = (int)__builtin_rintf(hi4[1] * inv), i6 = (int)__builtin_rintf(hi4[2] * inv), i7 = (int)__builtin_rintf(hi4[3] * inv);
          sumx += i0 + i1 + i2 + i3 + i4 + i5 + i6 + i7;
          xe[j][d] = (u32)(i0 & 0xFF) | ((u32)(i2 & 0xFF) << 8) | ((u32)(i4 & 0xFF) << 16) | ((u32)i6 << 24);
          xo[j][d] = (u32)(i1 & 0xFF) | ((u32)(i3 & 0xFF) << 8) | ((u32)(i5 & 0xFF) << 16) | ((u32)i7 << 24);
        } }
#pragma unroll 1
    for (int it = 0; it < 6; it += 2) { LOADU(cB, it + 1); COMPU(cA, it); LOADU(cA, it + 2); COMPU(cB, it + 1); }
    LOADU(cB, 7); COMPU(cA, 6);
    LOADV(cA, 0);
    COMPU(cB, 7);
    __builtin_amdgcn_wave_barrier();
    { const float sc_ = rstd * sx * (1.f / U4_SCALE); const float a0 = wL[lane] * sc_, a1 = wL[lane + 64] * sc_;
      const float w0 = gL[lane] * 0.5f * a0 * (1.f + erff(a0 * 0.70710678118654752f)), w1 = gL[lane + 64] * 0.5f * a1 * (1.f + erff(a1 * 0.70710678118654752f));
      __builtin_amdgcn_wave_barrier();
      wL[lane] = w0; wL[lane + 64] = w1; }
    __builtin_amdgcn_wave_barrier();
    f32x2 out[16];
#pragma unroll
    for (int i = 0; i < 16; ++i) out[i] = (f32x2){0.f, 0.f};
#pragma unroll 1
    for (int g = 0; g < 6; g += 2) { LOADV(cB, g + 1); COMPV(cA, g); LOADV(cA, g + 2); COMPV(cB, g + 1); }
    LOADV(cB, 7); COMPV(cA, 6); COMPV(cB, 7);
#undef LOADU
#undef COMPU
#undef LOADV
#undef COMPV
    {
      f32x4 v[4];
#pragma unroll
      for (int q = 0; q < 4; ++q) {
        const f32x2 m0 = hf ? out[8 + 2 * q] : out[2 * q], o0 = hf ? out[2 * q] : out[8 + 2 * q];
        const f32x2 m1 = hf ? out[8 + 2 * q + 1] : out[2 * q + 1], o1 = hf ? out[2 * q + 1] : out[8 + 2 * q + 1];
        v[q] = (f32x4){m0[0] + shx(o0[0], 32), m0[1] + shx(o0[1], 32), m1[0] + shx(o1[0], 32), m1[1] + shx(o1[1], 32)};
      }
      f32x4* xo = (f32x4*)(xr + l32 * 32 + hf * 16);
#pragma unroll
      for (int q = 0; q < 4; ++q) { const f32x4 xv = xo[q]; v[q] = xv + v[q] * (1.f / V4_SCALE); }
      __builtin_amdgcn_wave_barrier();
      if (last) {
        float s2 = 0.f;
#pragma unroll
        for (int q = 0; q < 4; ++q) s2 += v[q][0] * v[q][0] + v[q][1] * v[q][1] + v[q][2] * v[q][2] + v[q][3] * v[q][3];
        s2 = red16(s2); s2 += shx(s2, 16); s2 += shx(s2, 32);
        const float rf = rsqrtf(s2 * (1.f / DM) + RMS_EPS);
#pragma unroll
        for (int q = 0; q < 4; ++q) { const f32x4 gf = *(const f32x4*)(p.norm_final + l32 * 32 + hf * 16 + q * 4); v[q] = v[q] * rf * gf; }
      }
#pragma unroll
      for (int q = 0; q < 4; ++q) xo[q] = v[q];
      u32x4* xbo = (u32x4*)(p.xb + (long)t * DM + l32 * 32 + hf * 16);
      xbo[0] = (u32x4){cvtpk(v[0][0], v[0][1]), cvtpk(v[0][2], v[0][3]), cvtpk(v[1][0], v[1][1]), cvtpk(v[1][2], v[1][3])};
      xbo[1] = (u32x4){cvtpk(v[2][0], v[2][1]), cvtpk(v[2][2], v[2][3]), cvtpk(v[3][0], v[3][1]), cvtpk(v[3][2], v[3][3])}; }
    __builtin_amdgcn_wave_barrier();
   }
  }
}
#else
__device__ __forceinline__ void phase_peer_combine(KP p, int layer, char* lds, unsigned*) {
  const bool last = (layer == 3);
  int tid_ = threadIdx.x; asm volatile("" : "+v"(tid_));
  const int tid = tid_, lane = tid & 63, w = tid >> 6;
  int* eL = (int*)(lds + w * 1536); float* gL = (float*)(lds + w * 1536 + 512); float* wL = (float*)(lds + w * 1536 + 1024);
  int ci = 0, cj = 0; bool cvalid = false;
  { int cnt = 0;
#pragma unroll
    for (int i = 0; i < 16; ++i) { const int n = 16 / (i + 1); if (!cvalid && lane < cnt + n) { ci = i; cj = lane - cnt; cvalid = true; } cnt += n; } }
  const unsigned char* U = p.peer_u8 + (long)layer * 16384 * 1024; const unsigned char* V = p.peer_v8 + (long)layer * 16384 * 1024;
  const int sub = lane & 15, grp = lane >> 4;
  __syncthreads();
  for (int t = blockIdx.x * 4 + w; t < T_TOK; t += gridDim.x * 4) {
    float* xr = p.x + (long)t * DM;
    const u32* pk = p.pkeys + (long)t * 256;
    u32 ka[8], kb[8];
#pragma unroll
    for (int hd = 0; hd < 8; ++hd) { ka[hd] = pk[hd * 32 + ci]; kb[hd] = pk[hd * 32 + 16 + cj]; }
    f32x4 xs[4][4]; float ss = 0.f;
#pragma unroll
    for (int i = 0; i < 4; ++i)
#pragma unroll
      for (int q = 0; q < 4; ++q) { const f32x4 a = *(const f32x4*)(xr + (sub + 16 * i) * 16 + q * 4); xs[i][q] = a; ss += a[0] * a[0] + a[1] * a[1] + a[2] * a[2] + a[3] * a[3]; }
    ss = red16(ss);
    const float rstd = rsqrtf(ss * (1.f / DM) + RMS_EPS);
#pragma unroll
    for (int hd = 0; hd < 8; ++hd) {
      const float cand = cvalid ? keyval(ka[hd]) + keyval(kb[hd]) : -3.0e38f;
      u32 ck = __float_as_uint(cand); ck = (ck & 0x80000000u) ? ~ck : (ck | 0x80000000u); ck = (ck & ~63u) | (u32)(63 - lane);
      int rank = 0;
#pragma unroll
      for (int m = 0; m < 50; ++m) { const u32 c = __builtin_amdgcn_readlane(ck, m); rank += (c > ck) ? 1 : 0; }
      const float cmax = __uint_as_float(__builtin_amdgcn_readlane(__float_as_uint(cand), 0));
      if (cvalid && rank < 16) { eL[hd * 16 + rank] = (int)((ka[hd] & 127u) * 128u + (kb[hd] & 127u)); gL[hd * 16 + rank] = __expf(cand - cmax); }
    }
    __builtin_amdgcn_wave_barrier();
    { const float g0 = gL[lane], g1 = gL[lane + 64]; const float s0 = red16(g0), s1 = red16(g1);
      __builtin_amdgcn_wave_barrier();
      gL[lane] = g0 / s0; gL[lane + 64] = g1 / s1; }
    __builtin_amdgcn_wave_barrier();
    u32x4 cA[8], cB[8];
#define LOADU(C, it) do { const int k0_ = (it) * 8 + grp * 2; const int e0_ = eL[k0_], e1_ = eL[k0_ + 1]; \
      const unsigned char* u0_ = U + (long)e0_ * 1024 + sub * 16; const unsigned char* u1_ = U + (long)e1_ * 1024 + sub * 16; \
      _Pragma("unroll") for (int i = 0; i < 4; ++i) { C[i] = *(const u32x4*)(u0_ + i * 256); C[4 + i] = *(const u32x4*)(u1_ + i * 256); } } while (0)
#define COMPU(C, it) do { const int k0_ = (it) * 8 + grp * 2; f32x2 a0_ = {0.f, 0.f}, a1_ = {0.f, 0.f}; \
      _Pragma("unroll") for (int i = 0; i < 4; ++i) { _Pragma("unroll") for (int q = 0; q < 4; ++q) { fp8dot(C[i][q], xs[i][q], a0_); fp8dot(C[4 + i][q], xs[i][q], a1_); } } \
      const float r0_ = red16(a0_[0] + a0_[1]), r1_ = red16(a1_[0] + a1_[1]); \
      if (sub == 0) { const float aa_ = r0_ * rstd * (1.f / U_SCALE), ab_ = r1_ * rstd * (1.f / U_SCALE); \
        wL[k0_] = gL[k0_] * 0.5f * aa_ * (1.f + erff(aa_ * 0.70710678118654752f)); \
        wL[k0_ + 1] = gL[k0_ + 1] * 0.5f * ab_ * (1.f + erff(ab_ * 0.70710678118654752f)); } } while (0)
#define LOADV(C, g) do { _Pragma("unroll") for (int i = 0; i < 8; ++i) { const int e_ = eL[(g) * 8 + i]; C[i] = *(const u32x4*)(V + (long)e_ * 1024 + lane * 16); } } while (0)
#define COMPV(C, g) do { _Pragma("unroll") for (int i = 0; i < 8; ++i) { const float wk_ = wL[(g) * 8 + i]; const f32x2 w2_ = {wk_, wk_}; \
      _Pragma("unroll") for (int q = 0; q < 4; ++q) { \
        const f32x2 lo_ = __builtin_amdgcn_cvt_pk_f32_fp8((int)C[i][q], false), hi_ = __builtin_amdgcn_cvt_pk_f32_fp8((int)C[i][q], true); \
        out[2 * q] = __builtin_elementwise_fma(lo_, w2_, out[2 * q]); out[2 * q + 1] = __builtin_elementwise_fma(hi_, w2_, out[2 * q + 1]); } } } while (0)
    LOADU(cA, 0);
#pragma unroll 1
    for (int it = 0; it < 14; it += 2) { LOADU(cB, it + 1); COMPU(cA, it); LOADU(cA, it + 2); COMPU(cB, it + 1); }
    LOADU(cB, 15); COMPU(cA, 14);
    LOADV(cA, 0);
    COMPU(cB, 15);
    __builtin_amdgcn_wave_barrier();
    f32x2 out[8];
#pragma unroll
    for (int i = 0; i < 8; ++i) out[i] = (f32x2){0.f, 0.f};
#pragma unroll 1
    for (int g = 0; g < 14; g += 2) { LOADV(cB, g + 1); COMPV(cA, g); LOADV(cA, g + 2); COMPV(cB, g + 1); }
    LOADV(cB, 15); COMPV(cA, 14); COMPV(cB, 15);
#undef LOADU
#undef COMPU
#undef LOADV
#undef COMPV
    { f32x4* xo = (f32x4*)(xr + lane * 16);
      f32x4 v[4];
#pragma unroll
      for (int q = 0; q < 4; ++q) { v[q] = xo[q]; v[q][0] += out[2 * q][0] * (1.f / V_SCALE); v[q][1] += out[2 * q][1] * (1.f / V_SCALE); v[q][2] += out[2 * q + 1][0] * (1.f / V_SCALE); v[q][3] += out[2 * q + 1][1] * (1.f / V_SCALE); }
      __builtin_amdgcn_wave_barrier();
      if (last) {
        float s2 = 0.f;
#pragma unroll
        for (int q = 0; q < 4; ++q) s2 += v[q][0] * v[q][0] + v[q][1] * v[q][1] + v[q][2] * v[q][2] + v[q][3] * v[q][3];
        s2 = red16(s2); s2 += shx(s2, 16); s2 += shx(s2, 32);
        const float rf = rsqrtf(s2 * (1.f / DM) + RMS_EPS);
#pragma unroll
        for (int q = 0; q < 4; ++q) { const f32x4 gf = *(const f32x4*)(p.norm_final + lane * 16 + q * 4); v[q] = v[q] * rf * gf; }
      }
#pragma unroll
      for (int q = 0; q < 4; ++q) xo[q] = v[q];
      u32x4* xbo = (u32x4*)(p.xb + (long)t * DM + lane * 16);
      xbo[0] = (u32x4){cvtpk(v[0][0], v[0][1]), cvtpk(v[0][2], v[0][3]), cvtpk(v[1][0], v[1][1]), cvtpk(v[1][2], v[1][3])};
      xbo[1] = (u32x4){cvtpk(v[2][0], v[2][1]), cvtpk(v[2][2], v[2][3]), cvtpk(v[3][0], v[3][1]), cvtpk(v[3][2], v[3][3])}; }
    __builtin_amdgcn_wave_barrier();
  }
}

#endif

#if PEER_FP4
constexpr long TBL_ITERS = 4L * 16384 * 1024 / 16; constexpr int TBL_NCHUNK = 512; constexpr long TBL_CHUNK = TBL_ITERS / TBL_NCHUNK;
__device__ __forceinline__ void convert_tables_chunk(KP p, int chunk) {
  int tid_ = threadIdx.x; asm volatile("" : "+v"(tid_));
#define Q4(val) ((u32)(int)(fminf(fmaxf(__builtin_rintf((val) * U4_SCALE), -8.f), 7.f) + 8.f))
  for (long i = (long)chunk * TBL_CHUNK + tid_; i < (long)(chunk + 1) * TBL_CHUNK; i += NTHR) {
    const long e = i * 16; const int layer = (int)(e >> 24); const int d = (int)(e & 1023);
    u32 uo[2], vo[2];
#pragma unroll
    for (int h = 0; h < 2; ++h) {
      u32 a = 0, b = 0;
#pragma unroll
      for (int q = 0; q < 2; ++q) {
        const f32x4 g = *(const f32x4*)(p.in_norm_ffn + layer * 1024 + d + h * 8 + q * 4);
        const f32x4 u = *(const f32x4*)(p.in_peer_u + e + h * 8 + q * 4), v = *(const f32x4*)(p.in_peer_v + e + h * 8 + q * 4);
        if (q == 0) {
          a |= Q4(u[0] * g[0]) | (Q4(u[1] * g[1]) << 4) | (Q4(u[2] * g[2]) << 8) | (Q4(u[3] * g[3]) << 12);
          b = __builtin_amdgcn_cvt_scalef32_pk_fp4_f32(b, v[0] * V4_SCALE, v[1] * V4_SCALE, 1.0f, 0); b = __builtin_amdgcn_cvt_scalef32_pk_fp4_f32(b, v[2] * V4_SCALE, v[3] * V4_SCALE, 1.0f, 1);
        } else {
          a |= (Q4(u[0] * g[0]) << 16) | (Q4(u[1] * g[1]) << 20) | (Q4(u[2] * g[2]) << 24) | (Q4(u[3] * g[3]) << 28);
          b = __builtin_amdgcn_cvt_scalef32_pk_fp4_f32(b, v[0] * V4_SCALE, v[1] * V4_SCALE, 1.0f, 2); b = __builtin_amdgcn_cvt_scalef32_pk_fp4_f32(b, v[2] * V4_SCALE, v[3] * V4_SCALE, 1.0f, 3);
        }
      }
      uo[h] = a; vo[h] = b;
    }
    *(u32x2*)(p.peer_u8 + (e >> 1)) = (u32x2){uo[0], uo[1]}; *(u32x2*)(p.peer_v8 + (e >> 1)) = (u32x2){vo[0], vo[1]};
  }
}

#endif
__device__ __forceinline__ void phase_prep(KP p, char* lds) {
  int tid_ = threadIdx.x; asm volatile("" : "+v"(tid_));
  const int tid = tid_;
  const long gtid = (long)blockIdx.x * NTHR + tid, gsz = (long)gridDim.x * NTHR;
  float* tl = (float*)lds;
  for (int t = blockIdx.x; t < p.ntiles_prep; t += gridDim.x) {
    int j = 0;
    while (j + 1 < p.njobs && t >= p.jobs[j + 1].tile0) ++j;
    const float* src = p.jobs[j].src; u16* dst = p.jobs[j].dst; const float* gain = p.jobs[j].gain;
    const int K = p.jobs[j].K, N = p.jobs[j].N, scale_cols = p.jobs[j].scale_cols; const float scale = p.jobs[j].scale;
    const int lt = t - p.jobs[j].tile0, ntn = N >> 6, kt = lt / ntn, nt = lt - kt * ntn;
    __syncthreads();
    for (int e = tid; e < 4096; e += 256) { const int kk = e >> 6, nn = e & 63, k = kt * 64 + kk; const float g = gain ? gain[k] : 1.f; tl[kk * 65 + nn] = src[(long)k * N + nt * 64 + nn] * g; }
    __syncthreads();
    for (int e = tid; e < 2048; e += 256) { const int nn = e >> 5, kp = (e & 31) * 2, n = nt * 64 + nn; const float s = (n < scale_cols) ? scale : 1.f;
      *(u32*)(dst + (long)n * K + kt * 64 + kp) = cvtpk(tl[kp * 65 + nn] * s, tl[(kp + 1) * 65 + nn] * s); }
  }
  for (long i = gtid; i < (long)T_TOK * DM / 4; i += gsz) {
    const long e = i * 4; const f32x4 v = e < (long)T_PROMPT * DM ? *(const f32x4*)(p.xin0 + e) : *(const f32x4*)(p.xin1 + (e - (long)T_PROMPT * DM));
    *(f32x4*)(p.x + e) = v; *(u32*)(p.xb + e) = cvtpk(v[0], v[1]); *(u32*)(p.xb + e + 2) = cvtpk(v[2], v[3]); }
  for (long i = gtid; i < 4L * 8 * 2 * 128 * 128 / 2; i += gsz) { const float a = p.in_sub_keys[2 * i], b = p.in_sub_keys[2 * i + 1]; *(u32*)(p.peer_sk + 2 * i) = cvtpk(a, b); }
#if PEER_FP4
#else
  for (long i = gtid; i < 4L * 16384 * 1024 / 16; i += gsz) {
    const long e = i * 16; const int layer = (int)(e >> 24); const int d = (int)(e & 1023);
    u32x4 uo, vo;
#pragma unroll
    for (int q = 0; q < 4; ++q) {
      const f32x4 g = *(const f32x4*)(p.in_norm_ffn + layer * 1024 + d + q * 4);
      const f32x4 u = *(const f32x4*)(p.in_peer_u + e + q * 4), v = *(const f32x4*)(p.in_peer_v + e + q * 4);
      int a = 0, b = 0;
      a = __builtin_amdgcn_cvt_pk_fp8_f32(u[0] * g[0] * U_SCALE, u[1] * g[1] * U_SCALE, a, false); a = __builtin_amdgcn_cvt_pk_fp8_f32(u[2] * g[2] * U_SCALE, u[3] * g[3] * U_SCALE, a, true);
      b = __builtin_amdgcn_cvt_pk_fp8_f32(v[0] * V_SCALE, v[1] * V_SCALE, b, false); b = __builtin_amdgcn_cvt_pk_fp8_f32(v[2] * V_SCALE, v[3] * V_SCALE, b, true);
      uo[q] = (u32)a; vo[q] = (u32)b;
    }
    *(u32x4*)(p.peer_u8 + e) = uo; *(u32x4*)(p.peer_v8 + e) = vo;
  }
#endif
  for (long i = gtid; i < 2 * 3072; i += gsz) { const int c = (int)(i % 3072); p.na_bias_s[i] = p.in_na_bias[i] * (c < 1024 ? 0.125f * LOG2E : 1.f); }
  for (long i = gtid; i < 2 * 16 * 465; i += gsz) p.na_rpb_s[i] = p.in_na_rpb[i] * LOG2E;
  for (long i = gtid; i < 16384L * 32; i += gsz) {
    const int pos = (int)(i >> 5), jf = (int)(i & 31);
    const double a = (double)pos * p.inv_freq[jf] * 0.15915494309189535;
    const double fr = a - rint(a);
    const float f = (float)fr;
    p.ropeC[i] = __builtin_amdgcn_cosf(f); p.ropeS[i] = __builtin_amdgcn_sinf(f);
  }
  for (long i = gtid; i < 2L * 64 * 1024 / 2; i += gsz) { const int l = (int)(i >> 15); const long e = (i & 32767) * 2; *(u32*)(p.wa_t[l] + 704L * 1024 + e) = 0u; }
}

__device__ __forceinline__ void phase_final(KP p) {
  int tid_ = threadIdx.x; asm volatile("" : "+v"(tid_));
  const int lane = tid_ & 63, w = tid_ >> 6;
  for (int t = blockIdx.x * 4 + w; t < T_TOK; t += gridDim.x * 4) {
    float* xr = p.x + (long)t * DM;
    f32x4 v[4]; float ss = 0.f;
#pragma unroll
    for (int i = 0; i < 4; ++i) { v[i] = *(const f32x4*)(xr + i * 256 + lane * 4); ss += v[i][0] * v[i][0] + v[i][1] * v[i][1] + v[i][2] * v[i][2] + v[i][3] * v[i][3]; }
    ss += shx(ss, 1); ss += shx(ss, 2); ss += shx(ss, 4); ss += shx(ss, 8); ss += shx(ss, 16); ss += shx(ss, 32);
    const float rs = rsqrtf(ss * (1.f / DM) + RMS_EPS);
#pragma unroll
    for (int i = 0; i < 4; ++i) { const f32x4 g = *(const f32x4*)(p.norm_final + i * 256 + lane * 4); f32x4 o_ = {v[i][0] * rs * g[0], v[i][1] * rs * g[1], v[i][2] * rs * g[2], v[i][3] * rs * g[3]}; *(f32x4*)(xr + i * 256 + lane * 4) = o_; }
  }
}

template <int EPI>
__device__ __forceinline__ void gemm_big(KP p, int layer, const u16* Ap, int lda, const u16* Bt, int K, int m0, int n0, char* lds) {
  int tid_ = threadIdx.x; asm volatile("" : "+v"(tid_));
  const int tid = tid_, lane = tid & 63, w = tid >> 6;
  const int wm = w >> 1, wn = w & 1, r32 = lane & 31, hi = lane >> 5;
  constexpr int STG = 24576;
  const int scol = ((lane & 3) ^ ((lane >> 4) & 3)) * 8;
  const u16* Ag = Ap + (long)(m0 + w * 64 + (lane >> 2)) * lda + scol;
  const u16* Bg = Bt + (long)(n0 + w * 32 + (lane >> 2)) * K + scol;
#define GST(st, kt) do { int w_ = w; asm volatile("" : "+v"(w_)); \
    _Pragma("unroll") for (int i = 0; i < 4; ++i) __builtin_amdgcn_global_load_lds((const unsigned*)(Ag + (long)i * 16 * lda + (kt) * 32), (unsigned*)(lds + (st) * STG + (w_ * 4 + i) * 1024), 16, 0, 0); \
    _Pragma("unroll") for (int i = 0; i < 2; ++i) __builtin_amdgcn_global_load_lds((const unsigned*)(Bg + (long)i * 16 * K + (kt) * 32), (unsigned*)(lds + (st) * STG + 16384 + (w_ * 2 + i) * 1024), 16, 0, 0); } while (0)
  f32x16 acc[4][2];
#pragma unroll
  for (int i = 0; i < 4; ++i)
#pragma unroll
    for (int j = 0; j < 2; ++j)
#pragma unroll
      for (int r = 0; r < 16; ++r) acc[i][j][r] = 0.f;
  float ssq[4] = {0.f, 0.f, 0.f, 0.f};
  const int sw = (r32 >> 2) & 3;
  const int arow = (wm * 128 + r32) * 64, brow = 16384 + (wn * 64 + r32) * 64;
  const int nk = K / 32;
  __syncthreads();
  GST(0, 0); GST(1, 1);
  int st = 0;
  for (int kt = 0; kt < nk; ++kt) {
    if (kt + 1 < nk) asm volatile("s_waitcnt vmcnt(6)" ::: "memory"); else asm volatile("s_waitcnt vmcnt(0)" ::: "memory");
    asm volatile("s_waitcnt lgkmcnt(0)" ::: "memory");
    __builtin_amdgcn_s_barrier();
    if (kt + 2 < nk) { const int s2 = st + 2 >= 3 ? st - 1 : st + 2; GST(s2, kt + 2); }
    const char* base = lds + st * STG;
#pragma unroll
    for (int ks = 0; ks < 2; ++ks) {
      const int co = ((ks * 2 + hi) ^ sw) << 4;
      bf16x8 a[4], b[2];
#pragma unroll
      for (int mi = 0; mi < 4; ++mi) a[mi] = *(const bf16x8*)(base + arow + mi * 2048 + co);
#pragma unroll
      for (int ni = 0; ni < 2; ++ni) b[ni] = *(const bf16x8*)(base + brow + ni * 2048 + co);
#pragma unroll
      for (int mi = 0; mi < 4; ++mi) { acc[mi][0] = mfma32(b[0], a[mi], acc[mi][0]); acc[mi][1] = mfma32(b[1], a[mi], acc[mi][1]); }
#pragma unroll
      for (int mi = 0; mi < 4; ++mi) { const u32x4 x = __builtin_bit_cast(u32x4, a[mi]);
#pragma unroll
        for (int q = 0; q < 4; ++q) ssq[mi] = dot2bf(x[q], x[q], ssq[mi]); }
    }
    st = st == 2 ? 0 : st + 1;
  }
#undef GST
  __syncthreads();
  float rs[4];
#pragma unroll
  for (int mi = 0; mi < 4; ++mi) { const float t = ssq[mi] + shx(ssq[mi], 32); rs[mi] = rsqrtf(t / (float)K + RMS_EPS); }
  const int rowb = wm * 128, colb = wn * 64;
  if constexpr (EPI == EPI_A || EPI == EPI_QKV) {
    constexpr int OROW = 272;
    u16* outp; int ldo; bool rope = false;
    if constexpr (EPI == EPI_A) { outp = p.cqkv; ldo = 768; rope = (n0 + colb == 640); }
    else { outp = p.qkv; ldo = 3072; }
#pragma unroll
    for (int mi = 0; mi < 4; ++mi) {
      const int rl = rowb + mi * 32 + r32; const int pos = tok_pos(m0 + rl);
#pragma unroll
      for (int g = 0; g < 4; ++g) {
        f32x4 v0, v1;
#pragma unroll
        for (int e = 0; e < 4; ++e) { v0[e] = acc[mi][0][4 * g + e] * rs[mi]; v1[e] = acc[mi][1][4 * g + e] * rs[mi]; }
        if constexpr (EPI == EPI_QKV) {
          const f32x4 b0 = *(const f32x4*)(p.na_bias_s + layer * 3072 + n0 + colb + 8 * g + 4 * hi), b1 = *(const f32x4*)(p.na_bias_s + layer * 3072 + n0 + colb + 32 + 8 * g + 4 * hi);
          v0 += b0; v1 += b1;
        }
        if (rope) {
          const f32x4 c = *(const f32x4*)(p.ropeC + pos * 32 + 8 * g + 4 * hi), sn = *(const f32x4*)(p.ropeS + pos * 32 + 8 * g + 4 * hi);
          const f32x4 t0 = (v0 * c - v1 * sn) * K8_SCALE, t1 = (v0 * sn + v1 * c) * K8_SCALE;
          unsigned char* kp_ = p.k8 + (long)(m0 + rl) * 1088 + 1024 + 8 * g + 4 * hi;
          *(u32*)kp_ = pack4_fp8(t0[0], t0[1], t0[2], t0[3]); *(u32*)(kp_ + 32) = pack4_fp8(t1[0], t1[1], t1[2], t1[3]);
        }
        char* e_ = lds + rl * OROW + (colb + 8 * g + 4 * hi) * 2;
        *(u32x2*)e_ = (u32x2){cvtpk(v0[0], v0[1]), cvtpk(v0[2], v0[3])};
        *(u32x2*)(e_ + 64) = (u32x2){cvtpk(v1[0], v1[1]), cvtpk(v1[2], v1[3])};
      }
    }
    __syncthreads();
#pragma unroll 4
    for (int i = 0; i < 16; ++i) { const int c = tid + 256 * i, row = c >> 4, ch = c & 15;
      *(u32x4*)(outp + (long)(m0 + row) * ldo + n0 + ch * 8) = *(const u32x4*)(lds + row * OROW + ch * 16); }
  } else {
    constexpr int BROW = 144;
    const bool rope = (EPI == EPI_UQ) && ((n0 + colb) % 192 == 128);
    const float sc = (EPI == EPI_UQ) ? Q8_SCALE : K8_SCALE;
#pragma unroll
    for (int mi = 0; mi < 4; ++mi) {
      const int rl = rowb + mi * 32 + r32; const int pos = tok_pos(m0 + rl);
#pragma unroll
      for (int g = 0; g < 4; ++g) {
        f32x4 v0, v1;
#pragma unroll
        for (int e = 0; e < 4; ++e) { v0[e] = acc[mi][0][4 * g + e] * rs[mi] * sc; v1[e] = acc[mi][1][4 * g + e] * rs[mi] * sc; }
        if (rope) {
          const f32x4 c = *(const f32x4*)(p.ropeC + pos * 32 + 8 * g + 4 * hi), sn = *(const f32x4*)(p.ropeS + pos * 32 + 8 * g + 4 * hi);
          const f32x4 t0 = v0 * c - v1 * sn, t1 = v0 * sn + v1 * c; v0 = t0; v1 = t1;
        }
        char* e_ = lds + rl * BROW + (colb + 8 * g + 4 * hi);
        *(u32*)e_ = pack4_fp8(v0[0], v0[1], v0[2], v0[3]); *(u32*)(e_ + 32) = pack4_fp8(v1[0], v1[1], v1[2], v1[3]);
      }
    }
    __syncthreads();
    unsigned char* outb; long ldo;
    if constexpr (EPI == EPI_UQ) { outb = p.q8 + n0; ldo = 1536; } else { outb = p.k8 + (n0 >> 8) * 128; ldo = 1088; }
#pragma unroll 2
    for (int i = 0; i < 8; ++i) { const int c = tid + 256 * i, row = c >> 3, ch = c & 7;
      *(u32x4*)(outb + (long)(m0 + row) * ldo + ch * 16) = *(const u32x4*)(lds + row * BROW + ch * 16); }
  }
}

__device__ __forceinline__ void ukv_tile(KP p, int j, int mt, int nt, char* lds) {
  if (nt & 1) gemm_tile<EPI_UV, true>(p, j, p.cqkv + 384, 768, p.wukv_t[j], 256, mt * 128, nt * 128, lds);
  else gemm_tile<EPI_UK, true>(p, j, p.cqkv + 384, 768, p.wukv_t[j], 256, mt * 128, nt * 128, lds);
}
#define XB_TMO      128
#define XB_XCNT(j)  (256  + 64 * (j))
#define XB_XSUB(j)  (1280 + 64 * (j))
#define XB_XGEN(j)  (2304 + 64 * (j))
#define XB_TOP      3328
#define XB_TOPGEN   3392
#define XCD_BAR_WORDS 3456
#define XB_SPIN_CAP (1u << 18)
#define LAS __attribute__((address_space(3)))
__device__ __forceinline__ unsigned xb_ld(unsigned* p)              { return __hip_atomic_load(p, __ATOMIC_RELAXED, __HIP_MEMORY_SCOPE_AGENT); }
__device__ __forceinline__ unsigned xb_add(unsigned* p, unsigned v) { return __hip_atomic_fetch_add(p, v, __ATOMIC_RELAXED, __HIP_MEMORY_SCOPE_AGENT); }
__device__ __forceinline__ unsigned xb_xcc_id() { return (unsigned)__builtin_amdgcn_s_getreg((3 << 11) | 20) & 0xFu; }
#define XB_SPIN(cond, bar) do { unsigned _sp = 0; while (cond) { __builtin_amdgcn_s_sleep(1); \
    if ((++_sp & 255u) == 0u) { if (xb_ld(&(bar)[XB_TMO])) break; if (_sp > XB_SPIN_CAP) { atomicAdd(&(bar)[XB_TMO], 1u); break; } } } } while (0)
struct XcdBarrier { unsigned* bar; unsigned x; volatile LAS unsigned* st; };
__device__ __forceinline__ XcdBarrier xcd_barrier_post(unsigned* bar, volatile LAS unsigned* st) {
    XcdBarrier b; b.bar = bar; b.x = xb_xcc_id(); b.st = st;
    if (threadIdx.x == 0) (void)xb_add(&bar[XB_XCNT(b.x)], 1u);
    return b;
}
__device__ __forceinline__ void xcd_barrier_complete(unsigned* bar, unsigned x, unsigned& nloc, unsigned& nx) {
    const unsigned G = gridDim.x * gridDim.y * gridDim.z;
    unsigned sum, cnt, mine, sp = 0u;
    for (;;) {
        sum = 0u; cnt = 0u; mine = 0u;
#pragma unroll
        for (unsigned j = 0; j < 16; ++j) { const unsigned c = xb_ld(&bar[XB_XCNT(j)]); sum += c; cnt += (c > 0u) ? 1u : 0u; mine = (j == x) ? c : mine; }
        if (sum == G) break;
        __builtin_amdgcn_s_sleep(1);
        if ((++sp & 255u) == 0u) { if (xb_ld(&bar[XB_TMO])) break; if (sp > XB_SPIN_CAP) { atomicAdd(&bar[XB_TMO], 1u); break; } }
    }
    nloc = mine > 0u ? mine : 1u; nx = cnt > 0u ? cnt : 1u;
}
__device__ __forceinline__ void xcd_barrier(const XcdBarrier& b) {
    asm volatile("s_waitcnt vmcnt(0)" ::: "memory");
    __syncthreads();
    if (threadIdx.x == 0) {
        unsigned* bar = b.bar;
        __builtin_amdgcn_s_waitcnt(0);
        unsigned nloc = b.st[0], nx = b.st[1];
        if (nloc == 0u) { xcd_barrier_complete(bar, b.x, nloc, nx); b.st[0] = nloc; b.st[1] = nx; }
        const unsigned old = xb_add(&bar[XB_XSUB(b.x)], 1u);
        const unsigned gen = old / nloc;
        if (old + 1u == (gen + 1u) * nloc) {
            __builtin_amdgcn_fence(__ATOMIC_RELEASE, "agent");
            asm volatile("s_waitcnt vmcnt(0)" ::: "memory");
            const unsigned og = xb_add(&bar[XB_TOP], 1u);
            const unsigned tg = og / nx;
            if (og + 1u == (tg + 1u) * nx) xb_add(&bar[XB_TOPGEN], 1u);
            else XB_SPIN(xb_ld(&bar[XB_TOPGEN]) == tg, bar);
            __builtin_amdgcn_fence(__ATOMIC_ACQUIRE, "agent");
            xb_add(&bar[XB_XGEN(b.x)], 1u);
            asm volatile("s_waitcnt vmcnt(0)" ::: "memory");
        } else {
            XB_SPIN(xb_ld(&bar[XB_XGEN(b.x)]) == gen, bar);
            __builtin_amdgcn_fence(__ATOMIC_ACQUIRE, "agent");
            asm volatile("s_waitcnt vmcnt(0)" ::: "memory");
        }
    }
    __syncthreads();
}

#define GEMM_PHASE(SUB, MTILES, NTILES, SM, SN, CALL) do { \
    const int nsn_ = (NTILES) / (SN), nsuper_ = ((MTILES) / (SM)) * nsn_, per_ = (SM) * (SN); \
    const int xcd_ = blockIdx.x & 7; \
    const int total_ = ((nsuper_ - xcd_ + 7) >> 3) * per_;            \
    unsigned* q_ = p.bar + XCD_BAR_WORDS + 64 + (ph * 3 + (SUB)) * 8 + xcd_; \
    for (;;) { \
      if (threadIdx.x == 0) xb_words[2] = atomicAdd(q_, 1u); \
      __syncthreads(); const int idx_ = (int)xb_words[2]; __syncthreads(); \
      if (idx_ >= total_) break; \
      const int r_ = idx_ / per_, l_ = idx_ - r_ * per_, s_ = xcd_ + 8 * r_, sm_ = s_ / nsn_, sn_ = s_ - sm_ * nsn_; \
      const int mt = sm_ * (SM) + l_ / (SN), nt = sn_ * (SN) + l_ % (SN); CALL; } } while (0)

__global__ void __launch_bounds__(NTHR, LB2) mega(const Params p_unused, int ph_lo, int ph_hi) {
  __shared__ __attribute__((aligned(16))) char lds[SMEM_BYTES];
  volatile LAS unsigned* xb_words = (volatile LAS unsigned*)(lds + SMEM_BYTES - 16);
  constexpr int MT = T_TOK / 128;
  XcdBarrier xb;
  { const __attribute__((address_space(4))) Params* pp0 = (const __attribute__((address_space(4))) Params*)__builtin_amdgcn_kernarg_segment_ptr();
    if (threadIdx.x < 4) xb_words[threadIdx.x] = 0u;
    __syncthreads();
    xb = xcd_barrier_post(pp0->bar, xb_words); }
  for (int ph = ph_lo; ph < ph_hi; ++ph) {
    const __attribute__((address_space(4))) Params* pp = (const __attribute__((address_space(4))) Params*)__builtin_amdgcn_kernarg_segment_ptr();
    asm volatile("" : "+s"(pp));
    KP p = *pp;
    const int type = p.prog_type[ph], layer = p.prog_layer[ph];
    const int j = layer >> 1;
    switch (type) {
      case PH_PREP: if (!PHON(PH_PREP)) break; phase_prep(p, lds); break;
      case PH_MLA_A: if (!PHON(PH_MLA_A)) break;
        GEMM_PHASE(0, MT / 2, 6, 8, 6, (gemm_big<EPI_A>(p, j, p.xb, DM, p.wa_t[j], 1024, mt * 256, nt * 128, lds)));
        break;
      case PH_MLA_B: if (!PHON(PH_MLA_B)) break;
        GEMM_PHASE(0, MT / 2, 12, 16, 4, (gemm_big<EPI_UQ>(p, j, p.cqkv, 768, p.wuq_t[j], 384, mt * 256, nt * 128, lds)));
        GEMM_PHASE(1, MT / 2, 8, 8, 8, (gemm_big<EPI_UK>(p, j, p.cqkv + 384, 768, p.wukv_t[j], 256, mt * 256, nt * 256, lds)));
        GEMM_PHASE(2, MT, 8, 8, 8, (gemm_tile<EPI_UV, true>(p, j, p.cqkv + 384, 768, p.wukv_t[j], 256, mt * 128, nt * 256 + 128, lds)));
        break;
      case PH_MLA_ATT: if (!PHON(PH_MLA_ATT)) break;
#ifndef SKEW_BIT
#define SKEW_BIT 256
#endif
        if (blockIdx.x & SKEW_BIT) { __builtin_amdgcn_s_sleep(24); __builtin_amdgcn_s_setprio(1); }
        {
          unsigned* ctr = p.bar + XCD_BAR_WORDS + ph;
          for (;;) {
            if (threadIdx.x == 0) xb_words[2] = atomicAdd(ctr, 1u);
            __syncthreads();
            const int t = (int)xb_words[2];
            __syncthreads();
            if (t < 3072) attn_mla(p, t, lds);
            else if (PEER_FP4 && layer == 0 && t < 3072 + TBL_NCHUNK) convert_tables_chunk(p, t - 3072);
            else break;
          } }
        __builtin_amdgcn_s_setprio(0);
        break;
      case PH_MLA_O: if (!PHON(PH_MLA_O)) break;
        GEMM_PHASE(0, MT, 8, 8, 8, (gemm_tile<EPI_O, false>(p, j, p.o, 1024, p.mla_wo_t[j], 1024, mt * 128, nt * 128, lds)));
        break;
      case PH_NA_QKV: if (!PHON(PH_NA_QKV)) break;
        GEMM_PHASE(0, MT / 2, 24, 8, 8, (gemm_big<EPI_QKV>(p, j, p.xb, DM, p.na_wqkv_t[j], 1024, mt * 256, nt * 128, lds)));
        break;
      case PH_NA_ATT: if (!PHON(PH_NA_ATT)) break;
        if (blockIdx.x & SKEW_BIT) { __builtin_amdgcn_s_sleep(12); }
        { unsigned* ctr = p.bar + XCD_BAR_WORDS + ph;
          for (;;) {
            if (threadIdx.x == 0) xb_words[2] = atomicAdd(ctr, 1u);
            __syncthreads();
            const int t = (int)xb_words[2];
            __syncthreads();
            if (t >= 6144) break;
            attn_item<1>(p, j, t, lds);
          } }
        break;
      case PH_NA_O: if (!PHON(PH_NA_O)) break;
        GEMM_PHASE(0, MT, 8, 8, 8, (gemm_tile<EPI_O, false>(p, j, p.o, 1024, p.na_wo_t[j], 1024, mt * 128, nt * 128, lds)));
        break;
      case PH_PEER_Q: if (!PHON(PH_PEER_Q)) break;
        GEMM_PHASE(0, MT, 16, 8, 8, (gemm_tile<EPI_PEER, true>(p, layer, p.xb, DM, p.peer_wq_t[layer], 1024, mt * 128, nt * 128, lds)));
        break;
      case PH_PEER_C: if (!PHON(PH_PEER_C)) break; phase_peer_combine(p, layer, lds, p.bar + XCD_BAR_WORDS + ph); break;
      case PH_FINAL: if (!PHON(PH_FINAL)) break; phase_final(p); break;
      default: break;
    }
    if (ph + 1 < ph_hi) { if (ph_hi > 1000) cg::this_grid().sync(); else xcd_barrier(xb); }
  }
}

extern "C" void kernel_launch(void* const* d_in, const int* in_sizes, int n_in, void* d_out, int out_size, void* d_ws, size_t ws_size, hipStream_t stream) {
  static int grid_blocks = 0, n_cus = 0;
  if (!grid_blocks) {
    int dev = 0, cus = 0;
    (void)hipGetDevice(&dev);
    (void)hipDeviceGetAttribute(&cus, hipDeviceAttributeMultiprocessorCount, dev);
    if (cus < 8) cus = 256;
    n_cus = cus;
    grid_blocks = cus * 2;
  }
  Params p; memset(&p, 0, sizeof(p));
  const float* const* in = (const float* const*)d_in;
  char* ws = (char*)d_ws; size_t off = 0;
  auto alloc = [&](size_t bytes) -> void* { void* r = ws + off; off += (bytes + 255) & ~(size_t)255; return r; };
  p.xin0 = in[0]; p.xin1 = in[1]; p.x = (float*)d_out; p.norm_final = in[4];
  for (int l = 0; l < 2; ++l) {
    p.wa_t[l] = (u16*)alloc(768UL * 1024 * 2); p.wuq_t[l] = (u16*)alloc(1536UL * 384 * 2); p.wukv_t[l] = (u16*)alloc(2048UL * 256 * 2); p.mla_wo_t[l] = (u16*)alloc(1024UL * 1024 * 2);
    p.na_wqkv_t[l] = (u16*)alloc(3072UL * 1024 * 2); p.na_wo_t[l] = (u16*)alloc(1024UL * 1024 * 2);
  }
  for (int l = 0; l < 4; ++l) p.peer_wq_t[l] = (u16*)alloc(2048UL * 1024 * 2);
  p.na_bias_s = (float*)alloc(2 * 3072 * 4); p.na_rpb_s = (float*)alloc(2 * 16 * 465 * 4);
  p.peer_sk = (u16*)alloc(4UL * 8 * 2 * 128 * 128 * 2);
  p.peer_u8 = (unsigned char*)alloc(4UL * 16384 * 1024); p.peer_v8 = (unsigned char*)alloc(4UL * 16384 * 1024);
  p.ropeC = (float*)alloc(16384UL * 32 * 4); p.ropeS = (float*)alloc(16384UL * 32 * 4);
  p.bar = (unsigned*)alloc((XCD_BAR_WORDS + 1024) * 4);
  p.o = (u16*)alloc((size_t)T_TOK * 1024 * 2); p.xb = (u16*)alloc((size_t)T_TOK * 1024 * 2);
  char* un = (char*)alloc((size_t)T_TOK * (768 + 1536 + 2048) * 2);
  p.cqkv = (u16*)un; p.q = (u16*)(un + (size_t)T_TOK * 768 * 2); p.kv = (u16*)(un + (size_t)T_TOK * (768 + 1536) * 2);
  { unsigned char* b8 = (unsigned char*)un + (size_t)T_TOK * 768 * 2; p.q8 = b8; p.k8 = b8 + (size_t)T_TOK * 1536; p.kpe8 = p.k8; p.vT8 = p.k8 + (size_t)T_TOK * 1088; }
  p.qkv = (u16*)un; p.pkeys = (u32*)un;
  if (off > ws_size) { fprintf(stderr, "kernel_launch: workspace too small: need %zu have %zu\n", off, ws_size); return; }
  p.in_sub_keys = in[17]; p.in_peer_u = in[18]; p.in_peer_v = in[19]; p.in_norm_ffn = in[3]; p.in_na_bias = in[13]; p.in_na_rpb = in[14];
  for (int jf = 0; jf < 32; ++jf) p.inv_freq[jf] = pow(10000.0, -(double)(2 * jf) / 64.0);
  int nj = 0, tile = 0;
  auto job = [&](const float* src, u16* dst, const float* gain, int K, int N, float scale, int scale_cols) {
    PrepJob& J = p.jobs[nj++]; J.src = src; J.dst = dst; J.gain = gain; J.K = K; J.N = N; J.tile0 = tile; J.scale = scale; J.scale_cols = scale_cols; J.pad = 0; tile += (K / 64) * (N / 64); };
  const float sc_mla = (float)(pow(192.0, -0.5) * 1.4426950408889634);
  for (int l = 0; l < 2; ++l) {
    job(in[5] + (size_t)l * 1024 * 384, p.wa_t[l], in[2] + (2 * l) * 1024, 1024, 384, 1.f, 0);
    job(in[8] + (size_t)l * 1024 * 320, p.wa_t[l] + 384UL * 1024, in[2] + (2 * l) * 1024, 1024, 320, 1.f, 0);
    job(in[7] + (size_t)l * 384 * 1536, p.wuq_t[l], in[6] + l * 384, 384, 1536, sc_mla, 1536);
    job(in[10] + (size_t)l * 256 * 2048, p.wukv_t[l], in[9] + l * 256, 256, 2048, 1.f, 0);
    job(in[11] + (size_t)l * 1024 * 1024, p.mla_wo_t[l], nullptr, 1024, 1024, 1.f, 0);
    job(in[12] + (size_t)l * 1024 * 3072, p.na_wqkv_t[l], in[2] + (2 * l + 1) * 1024, 1024, 3072, 0.125f * 1.4426950408889634f, 1024);
    job(in[15] + (size_t)l * 1024 * 1024, p.na_wo_t[l], nullptr, 1024, 1024, 1.f, 0);
  }
  for (int l = 0; l < 4; ++l) job(in[16] + (size_t)l * 1024 * 2048, p.peer_wq_t[l], in[3] + l * 1024, 1024, 2048, 1.f, 0);
  p.njobs = nj; p.ntiles_prep = tile;
  int np = 0;
#ifndef DUPMASK
#define DUPMASK 0
#endif
  auto ph = [&](int type, int layer) { p.prog_type[np] = type; p.prog_layer[np] = layer; ++np;
    if ((DUPMASK >> type) & 1) { p.prog_type[np] = type; p.prog_layer[np] = layer; ++np; } };
  ph(PH_PREP, 0);
  for (int i = 0; i < 4; ++i) {
    if ((i & 1) == 0) { ph(PH_MLA_A, i); ph(PH_MLA_B, i); ph(PH_MLA_ATT, i); ph(PH_MLA_O, i); }
    else { ph(PH_NA_QKV, i); ph(PH_NA_ATT, i); ph(PH_NA_O, i); }
    ph(PH_PEER_Q, i); ph(PH_PEER_C, i);
  }
  p.nprog = np;
#if COOP
  (void)hipMemsetAsync(p.bar, 0, (XCD_BAR_WORDS + 1024) * 4, stream);
  int lo = 0, hi = np;
  void* args[] = {(void*)&p, (void*)&lo, (void*)&hi};
  hipError_t e = hipLaunchCooperativeKernel((const void*)mega, dim3(grid_blocks), dim3(NTHR), args, 0, stream);
  if (e != hipSuccess && grid_blocks != n_cus) {
    (void)hipGetLastError(); grid_blocks = n_cus;
    e = hipLaunchCooperativeKernel((const void*)mega, dim3(grid_blocks), dim3(NTHR), args, 0, stream);
  }
  if (e != hipSuccess) fprintf(stderr, "cooperative launch failed: %s (grid %d)\n", hipGetErrorString(e), grid_blocks);
#else
  for (int i = 0; i < np; ++i) hipLaunchKernelGGL(mega, dim3(grid_blocks), dim3(NTHR), 0, stream, p, i, i + 1);
#endif
}
```

```cpp
#include <hip/hip_runtime.h>
#include <hip/hip_cooperative_groups.h>
#include <stdint.h>
#include <string.h>
#include <math.h>
#include <cstdio>
namespace cg = cooperative_groups;

#ifndef COOP
#define COOP 1
#endif
#ifndef PHMASK
#define PHMASK 0xFFFF
#endif
#ifndef LB2
#define LB2 2
#endif
#define PHON(t) ((PHMASK >> (t)) & 1)

typedef unsigned short u16;
typedef unsigned int u32;
using bf16x8 = __attribute__((ext_vector_type(8))) short;
using s16x4  = __attribute__((ext_vector_type(4))) short;
using f32x16 = __attribute__((ext_vector_type(16))) float;
using f32x4  = __attribute__((ext_vector_type(4))) float;
using u32x4  = __attribute__((ext_vector_type(4))) unsigned;
using u32x2  = __attribute__((ext_vector_type(2))) unsigned;
typedef __attribute__((ext_vector_type(2))) __bf16 v2bf;

constexpr int T_TOK = 49152, T_PROMPT = 16384, DM = 1024;
constexpr int NTHR = 256;
constexpr float LOG2E = 1.4426950408889634f;
constexpr float RMS_EPS = 1e-6f;

enum { PH_PREP = 0, PH_MLA_A, PH_MLA_B, PH_MLA_ATT, PH_MLA_O, PH_NA_QKV, PH_NA_ATT, PH_NA_O, PH_PEER_Q, PH_PEER_C, PH_FINAL };

struct PrepJob { const float* src; u16* dst; const float* gain; int K, N, tile0, scale_cols; float scale; int pad; };

struct Params {
  const float* xin0; const float* xin1;
  float* x; u16* xb;
  const float* norm_final;
  u16* wa_t[2]; u16* wuq_t[2]; u16* wukv_t[2]; u16* mla_wo_t[2];
  u16* na_wqkv_t[2]; u16* na_wo_t[2]; float* na_bias_s; float* na_rpb_s;
  u16* peer_wq_t[4]; u16* peer_sk; unsigned char* peer_u8; unsigned char* peer_v8;
  u16* cqkv; u16* q; u16* kv; u16* o; u16* qkv; u32* pkeys;
  unsigned char* q8; unsigned char* k8; unsigned char* kpe8; unsigned char* vT8;
  float* ropeC; float* ropeS; unsigned* bar;
  const float* in_sub_keys; const float* in_peer_u; const float* in_peer_v; const float* in_norm_ffn; const float* in_na_bias; const float* in_na_rpb;
  PrepJob jobs[24];
  double inv_freq[32];
  int njobs, ntiles_prep;
  int prog_type[48]; int prog_layer[48];
  int nprog, pad0;
};

typedef const __attribute__((address_space(4))) Params& KP;

__device__ __forceinline__ int crow(int r, int hi) { return (r & 3) + 8 * (r >> 2) + 4 * hi; }
__device__ __forceinline__ u32 cvtpk(float lo, float hi) { u32 r; asm("v_cvt_pk_bf16_f32 %0, %1, %2" : "=v"(r) : "v"(lo), "v"(hi)); return r; }
__device__ __forceinline__ float bf_lo(u32 v) { return __uint_as_float(v << 16); }
__device__ __forceinline__ float bf_hi(u32 v) { return __uint_as_float(v & 0xffff0000u); }
__device__ __forceinline__ int tok_pos(int t) { return t < T_PROMPT ? (t & 2047) : (t & 16383); }
__device__ __forceinline__ f32x16 mfma32(bf16x8 a, bf16x8 b, f32x16 c) { return __builtin_amdgcn_mfma_f32_32x32x16_bf16(a, b, c, 0, 0, 0); }
__device__ __forceinline__ float shx(float v, int m) { return __shfl_xor(v, m, 64); }

constexpr int BK = 64;
constexpr int OPB = 16384;
constexpr int GEMM_LDS = 4 * OPB;
constexpr int SMEM_BYTES = 81920;
constexpr int RSTD_OFF = 73728;

enum { EPI_A = 0, EPI_UQ, EPI_UK, EPI_UV, EPI_O, EPI_QKV, EPI_PEER };
constexpr float KEY_BIAS = 16.f;
constexpr float Q8_SCALE = 16.f, K8_SCALE = 4.f, V8_SCALE = 4.f, P8_SCALE = 128.f;
__device__ __forceinline__ u32 pack4_fp8(float a, float b, float c, float d) { int v = 0; v = __builtin_amdgcn_cvt_pk_fp8_f32(a, b, v, false); v = __builtin_amdgcn_cvt_pk_fp8_f32(c, d, v, true); return (u32)v; }

__device__ __forceinline__ float dot2bf(u32 a, u32 b, float c) { return __builtin_amdgcn_fdot2_f32_bf16(__builtin_bit_cast(v2bf, a), __builtin_bit_cast(v2bf, b), c, false); }

template <int EPI, bool NORM>
__device__ __forceinline__ void gemm_tile(KP p, int layer, const u16* Ap, int lda, const u16* Bt, int K, int m0, int n0, char* lds) {
  int tid_ = threadIdx.x; asm volatile("" : "+v"(tid_));
  const int tid = tid_, lane = tid & 63, w = tid >> 6;
  const int wm = w >> 1, wn = w & 1, r32 = lane & 31, hi = lane >> 5;
  float* rstd_l = (float*)(lds + RSTD_OFF);
  const int srow = w * 32 + (lane >> 2);
  const int scol = ((lane & 3) ^ ((lane >> 4) & 3)) * 8;
  const u16* Ag = Ap + (long)(m0 + srow) * lda + scol;
  const u16* Bg = Bt + (long)(n0 + srow) * K + scol;
#define GSTAGE(st, kt) do { _Pragma("unroll") for (int j = 0; j < 2; ++j) { \
    __builtin_amdgcn_global_load_lds((const unsigned*)(Ag + (long)j * 16 * lda + (kt) * 32), (unsigned*)(lds + (st) * 16384 + (w * 2 + j) * 1024), 16, 0, 0); \
    __builtin_amdgcn_global_load_lds((const unsigned*)(Bg + (long)j * 16 * K + (kt) * 32), (unsigned*)(lds + (st) * 16384 + 8192 + (w * 2 + j) * 1024), 16, 0, 0); } } while (0)
  f32x16 acc[2][2];
#pragma unroll
  for (int i = 0; i < 2; ++i)
#pragma unroll
    for (int j = 0; j < 2; ++j)
#pragma unroll
      for (int r = 0; r < 16; ++r) acc[i][j][r] = 0.f;
  float ssq0 = 0.f, ssq1 = 0.f;
  bf16x8 skr[8];
  const int sw = (r32 >> 2) & 3;
  const int arow = (wm * 64 + r32) * 64, brow = 8192 + (wn * 64 + r32) * 64;
  const int co0 = ((0 + hi) ^ sw) << 4, co1 = ((2 + hi) ^ sw) << 4;
  const int nk = K / 32;

#ifndef KREP
#define KREP 1
#endif
  for (int rep_ = 0; rep_ < KREP; ++rep_) {
  if (KREP > 1) {
#pragma unroll
    for (int i = 0; i < 2; ++i)
#pragma unroll
      for (int j = 0; j < 2; ++j)
#pragma unroll
        for (int r = 0; r < 16; ++r) acc[i][j][r] = 0.f;
    ssq0 = 0.f; ssq1 = 0.f; }
  __syncthreads();
  GSTAGE(0, 0); GSTAGE(1, 1); GSTAGE(2, 2);
  if constexpr (EPI == EPI_PEER) {
    const u16* sk = p.peer_sk + ((long)layer * 16 + (n0 >> 7)) * 16384;
#pragma unroll
    for (int i = 0; i < 8; ++i) { const int c = tid + 256 * i; skr[i] = *(const bf16x8*)(sk + (c >> 4) * 128 + (c & 15) * 8); }
  }
  for (int kt = 0; kt < nk; ++kt) {
    if (kt + 2 < nk) asm volatile("s_waitcnt vmcnt(8)" ::: "memory");
    else if (kt + 1 < nk) asm volatile("s_waitcnt vmcnt(4)" ::: "memory");
    else asm volatile("s_waitcnt vmcnt(0)" ::: "memory");
    asm volatile("s_waitcnt lgkmcnt(0)" ::: "memory");
    __builtin_amdgcn_s_barrier();
    if (kt + 3 < nk) GSTAGE((kt + 3) & 3, kt + 3);
    const char* base = lds + (kt & 3) * 16384;
    {
      const bf16x8 a0 = *(const bf16x8*)(base + arow + co0), a1 = *(const bf16x8*)(base + arow + 32 * 64 + co0);
      const bf16x8 b0 = *(const bf16x8*)(base + brow + co0), b1 = *(const bf16x8*)(base + brow + 32 * 64 + co0);
      const bf16x8 c0 = *(const bf16x8*)(base + arow + co1), c1 = *(const bf16x8*)(base + arow + 32 * 64 + co1);
      const bf16x8 d0 = *(const bf16x8*)(base + brow + co1), d1 = *(const bf16x8*)(base + brow + 32 * 64 + co1);
      if constexpr (EPI != EPI_UV) {
        acc[0][0] = mfma32(b0, a0, acc[0][0]); acc[0][1] = mfma32(b1, a0, acc[0][1]);
        acc[1][0] = mfma32(b0, a1, acc[1][0]); acc[1][1] = mfma32(b1, a1, acc[1][1]);
        acc[0][0] = mfma32(d0, c0, acc[0][0]); acc[0][1] = mfma32(d1, c0, acc[0][1]);
        acc[1][0] = mfma32(d0, c1, acc[1][0]); acc[1][1] = mfma32(d1, c1, acc[1][1]);
      } else {
        acc[0][0] = mfma32(a0, b0, acc[0][0]); acc[0][1] = mfma32(a0, b1, acc[0][1]);
        acc[1][0] = mfma32(a1, b0, acc[1][0]); acc[1][1] = mfma32(a1, b1, acc[1][1]);
        acc[0][0] = mfma32(c0, d0, acc[0][0]); acc[0][1] = mfma32(c0, d1, acc[0][1]);
        acc[1][0] = mfma32(c1, d0, acc[1][0]); acc[1][1] = mfma32(c1, d1, acc[1][1]);
      }
      if constexpr (NORM) {
        const u32x4 x0 = __builtin_bit_cast(u32x4, a0), x1 = __builtin_bit_cast(u32x4, a1), y0 = __builtin_bit_cast(u32x4, c0), y1 = __builtin_bit_cast(u32x4, c1);
#pragma unroll
        for (int q = 0; q < 4; ++q) { ssq0 = dot2bf(x0[q], x0[q], ssq0); ssq1 = dot2bf(x1[q], x1[q], ssq1); ssq0 = dot2bf(y0[q], y0[q], ssq0); ssq1 = dot2bf(y1[q], y1[q], ssq1); }
      }
    }
  }
  }
#undef GSTAGE
  __syncthreads();
  float rs[2] = {1.f, 1.f};
  if constexpr (NORM) {
    ssq0 += shx(ssq0, 32); ssq1 += shx(ssq1, 32);
    rs[0] = rsqrtf(ssq0 / (float)K + RMS_EPS); rs[1] = rsqrtf(ssq1 / (float)K + RMS_EPS);
  }
  const int rowb = wm * 64, colb = wn * 64;
  if constexpr (EPI == EPI_A || EPI == EPI_QKV) {
    constexpr int OROW = 272;
    u16* outp; int ldo; bool rope = false;
    if constexpr (EPI == EPI_A) { outp = p.cqkv; ldo = 768; rope = (n0 + colb == 640); }
    else { outp = p.qkv; ldo = 3072; }
#pragma unroll
    for (int mi = 0; mi < 2; ++mi) {
      const int rl = rowb + mi * 32 + r32; const int pos = tok_pos(m0 + rl);
#pragma unroll
      for (int g = 0; g < 4; ++g) {
        f32x4 v0, v1;
#pragma unroll
        for (int e = 0; e < 4; ++e) { v0[e] = acc[mi][0][4 * g + e] * rs[mi]; v1[e] = acc[mi][1][4 * g + e] * rs[mi]; }
        if constexpr (EPI == EPI_QKV) {
          const f32x4 b0 = *(const f32x4*)(p.na_bias_s + layer * 3072 + n0 + colb + 8 * g + 4 * hi), b1 = *(const f32x4*)(p.na_bias_s + layer * 3072 + n0 + colb + 32 + 8 * g + 4 * hi);
          v0 += b0; v1 += b1;
        }
        if (rope) {
          const f32x4 c = *(const f32x4*)(p.ropeC + pos * 32 + 8 * g + 4 * hi), sn = *(const f32x4*)(p.ropeS + pos * 32 + 8 * g + 4 * hi);
          const f32x4 t0 = (v0 * c - v1 * sn) * K8_SCALE, t1 = (v0 * sn + v1 * c) * K8_SCALE;
          unsigned char* kp_ = p.k8 + (long)(m0 + rl) * 1088 + 1024 + 8 * g + 4 * hi;
          *(u32*)kp_ = pack4_fp8(t0[0], t0[1], t0[2], t0[3]); *(u32*)(kp_ + 32) = pack4_fp8(t1[0], t1[1], t1[2], t1[3]);
        }
        char* e_ = lds + rl * OROW + (colb + 8 * g + 4 * hi) * 2;
        *(u32x2*)e_ = (u32x2){cvtpk(v0[0], v0[1]), cvtpk(v0[2], v0[3])};
        *(u32x2*)(e_ + 64) = (u32x2){cvtpk(v1[0], v1[1]), cvtpk(v1[2], v1[3])};
      }
    }
    __syncthreads();
#pragma unroll
    for (int i = 0; i < 8; ++i) { const int c = tid + 256 * i, row = c >> 4, ch = c & 15;
      *(u32x4*)(outp + (long)(m0 + row) * ldo + n0 + ch * 8) = *(const u32x4*)(lds + row * OROW + ch * 16); }
  } else if constexpr (EPI == EPI_UQ || EPI == EPI_UK) {
    constexpr int BROW = 144;
    const bool rope = (EPI == EPI_UQ) && ((n0 + colb) % 192 == 128);
    const float sc = (EPI == EPI_UQ) ? Q8_SCALE : K8_SCALE;
#pragma unroll
    for (int mi = 0; mi < 2; ++mi) {
      const int rl = rowb + mi * 32 + r32; const int pos = tok_pos(m0 + rl);
#pragma unroll
      for (int g = 0; g < 4; ++g) {
        f32x4 v0, v1;
#pragma unroll
        for (int e = 0; e < 4; ++e) { v0[e] = acc[mi][0][4 * g + e] * rs[mi] * sc; v1[e] = acc[mi][1][4 * g + e] * rs[mi] * sc; }
        if (rope) {
          const f32x4 c = *(const f32x4*)(p.ropeC + pos * 32 + 8 * g + 4 * hi), sn = *(const f32x4*)(p.ropeS + pos * 32 + 8 * g + 4 * hi);
          const f32x4 t0 = v0 * c - v1 * sn, t1 = v0 * sn + v1 * c; v0 = t0; v1 = t1;
        }
        char* e_ = lds + rl * BROW + (colb + 8 * g + 4 * hi);
        *(u32*)e_ = pack4_fp8(v0[0], v0[1], v0[2], v0[3]); *(u32*)(e_ + 32) = pack4_fp8(v1[0], v1[1], v1[2], v1[3]);
      }
    }
    __syncthreads();
    unsigned char* outb; long ldo;
    if constexpr (EPI == EPI_UQ) { outb = p.q8 + n0; ldo = 1536; } else { outb = p.k8 + (n0 >> 8) * 128; ldo = 1088; }
#pragma unroll
    for (int i = 0; i < 4; ++i) { const int c = tid + 256 * i, row = c >> 3, ch = c & 7;
      *(u32x4*)(outb + (long)(m0 + row) * ldo + ch * 16) = *(const u32x4*)(lds + row * BROW + ch * 16); }
  } else if constexpr (EPI == EPI_UV) {
    constexpr int BROW = 144;
#pragma unroll
    for (int mi = 0; mi < 2; ++mi) {
#pragma unroll
      for (int g = 0; g < 4; ++g) {
        float rr[4];
#pragma unroll
        for (int e = 0; e < 4; ++e) rr[e] = __int_as_float(__builtin_amdgcn_ds_bpermute((8 * g + 4 * hi + e) << 2, __float_as_int(rs[mi]))) * V8_SCALE;
#pragma unroll
        for (int ni = 0; ni < 2; ++ni) {
          char* e_ = lds + (colb + ni * 32 + r32) * BROW + rowb + mi * 32 + 8 * g + 4 * hi;
          *(u32*)e_ = pack4_fp8(acc[mi][ni][4 * g] * rr[0], acc[mi][ni][4 * g + 1] * rr[1], acc[mi][ni][4 * g + 2] * rr[2], acc[mi][ni][4 * g + 3] * rr[3]);
        }
      }
    }
    __syncthreads();
    unsigned char* outb = p.vT8 + (long)((n0 >> 8) * 128) * T_TOK + m0;
#pragma unroll
    for (int i = 0; i < 4; ++i) { const int c = tid + 256 * i, d = c >> 3, ch = c & 7;
      *(u32x4*)(outb + (long)d * T_TOK + ch * 16) = *(const u32x4*)(lds + d * BROW + ch * 16); }
  } else if constexpr (EPI == EPI_O) {
    constexpr int FROW = 528;
#pragma unroll
    for (int mi = 0; mi < 2; ++mi) {
      const int rl = rowb + mi * 32 + r32;
#pragma unroll
      for (int ni = 0; ni < 2; ++ni)
#pragma unroll
        for (int g = 0; g < 4; ++g)
          *(f32x4*)(lds + rl * FROW + (colb + ni * 32 + 8 * g + 4 * hi) * 4) = (f32x4){acc[mi][ni][4 * g], acc[mi][ni][4 * g + 1], acc[mi][ni][4 * g + 2], acc[mi][ni][4 * g + 3]};
    }
    __syncthreads();
#pragma unroll 4
    for (int i = 0; i < 16; ++i) { const int c = tid + 256 * i, row = c >> 5, ch = c & 31;
      const f32x4 a = *(const f32x4*)(lds + row * FROW + ch * 16);
      float* xp = p.x + (long)(m0 + row) * DM + n0 + ch * 4;
      f32x4 xv = *(const f32x4*)xp; xv += a; *(f32x4*)xp = xv;
      *(u32x2*)(p.xb + (long)(m0 + row) * DM + n0 + ch * 4) = (u32x2){cvtpk(xv[0], xv[1]), cvtpk(xv[2], xv[3])}; }
  } else {
    constexpr int QROW = 272;
    char* Qs = lds; char* Ss = lds + 128 * QROW;
    const int hp = n0 >> 7;
#pragma unroll
    for (int mi = 0; mi < 2; ++mi) {
      const int rl = rowb + mi * 32 + r32;
#pragma unroll
      for (int g = 0; g < 4; ++g) {
        char* e_ = Qs + rl * QROW + (colb + 8 * g + 4 * hi) * 2;
        *(u32x2*)e_ = (u32x2){cvtpk(acc[mi][0][4 * g] * rs[mi], acc[mi][0][4 * g + 1] * rs[mi]), cvtpk(acc[mi][0][4 * g + 2] * rs[mi], acc[mi][0][4 * g + 3] * rs[mi])};
        *(u32x2*)(e_ + 64) = (u32x2){cvtpk(acc[mi][1][4 * g] * rs[mi], acc[mi][1][4 * g + 1] * rs[mi]), cvtpk(acc[mi][1][4 * g + 2] * rs[mi], acc[mi][1][4 * g + 3] * rs[mi])};
      }
    }
#pragma unroll
    for (int i = 0; i < 8; ++i) { const int c = tid + 256 * i, kr = c >> 4, ch = c & 15; *(bf16x8*)(Ss + kr * QROW + ch * 16) = skr[i]; }
    __syncthreads();
    f32x16 a2[2][2];
#pragma unroll
    for (int i = 0; i < 2; ++i)
#pragma unroll
      for (int j = 0; j < 2; ++j)
#pragma unroll
        for (int r = 0; r < 16; ++r) a2[i][j][r] = 0.f;
    { const char* Ar = Qs + (rowb + r32) * QROW + hi * 16; const char* Br = Ss + (colb + r32) * QROW + hi * 16;
#pragma unroll
      for (int ks = 0; ks < 8; ++ks) {
        bf16x8 a0 = *(const bf16x8*)(Ar + ks * 32), a1 = *(const bf16x8*)(Ar + 32 * QROW + ks * 32);
        bf16x8 b0 = *(const bf16x8*)(Br + ks * 32), b1 = *(const bf16x8*)(Br + 32 * QROW + ks * 32);
        a2[0][0] = mfma32(b0, a0, a2[0][0]); a2[0][1] = mfma32(b1, a0, a2[0][1]);
        a2[1][0] = mfma32(b0, a1, a2[1][0]); a2[1][1] = mfma32(b1, a1, a2[1][1]);
      } }
    __syncthreads();
    constexpr int SROW = 544;
    char* Sc = lds;
#pragma unroll
    for (int mi = 0; mi < 2; ++mi) {
      const int rl = rowb + mi * 32 + r32;
#pragma unroll
      for (int ni = 0; ni < 2; ++ni)
#pragma unroll
        for (int g = 0; g < 4; ++g)
          *(f32x4*)(Sc + rl * SROW + (colb + ni * 32 + 8 * g + 4 * hi) * 4) = (f32x4){a2[mi][ni][4 * g], a2[mi][ni][4 * g + 1], a2[mi][ni][4 * g + 2], a2[mi][ni][4 * g + 3]};
    }
    __syncthreads();
    { const int row = tid >> 1, hf = tid & 1;
      u32 kv[64];
#pragma unroll
      for (int i = 0; i < 16; ++i) {
        const f32x4 v = *(const f32x4*)(Sc + row * SROW + (2 * i + hf) * 16);
#pragma unroll
        for (int e = 0; e < 4; ++e) { const u32 b = __float_as_uint(v[e] + KEY_BIAS);
          kv[i * 4 + e] = (b & ~127u) | (u32)((2 * i + hf) * 4 + e); }
      }
      u32 mprev = 0xffffffffu;
      u32* outk = p.pkeys + (long)(m0 + row) * 256 + hp * 16;
#pragma unroll 1
      for (int ps = 0; ps < 16; ++ps) {
        u32 best = 0;
#pragma unroll
        for (int i = 0; i < 64; ++i) { const u32 d = kv[i] - mprev; best = d > best ? d : best; }
        u32 cand = mprev + best;
        if (best < (0u - mprev)) cand = 0u;
        const u32 oth = (u32)__shfl_xor((int)cand, 1, 64);
        mprev = cand > oth ? cand : oth;
        if (hf == 0) outk[ps] = mprev;
      }
    }
  }
}

template <int OFF> __device__ __forceinline__ s16x4 tr_read(int vb) {
  s16x4 r; asm volatile("ds_read_b64_tr_b16 %0, %1 offset:%2" : "=&v"(r) : "v"(vb), "i"(OFF) : "memory"); return r;
}
__device__ __forceinline__ int v_st(int k, int c) { const int kk = (k & ~0xC) | ((k & 4) << 1) | ((k & 8) >> 1); return ((kk >> 3) * 4 + (c >> 5)) * 512 + ((kk & 7) * 32 + (c & 31)) * 2; }
__device__ __forceinline__ int v_rd_base(int lane) { return ((lane & 3) << 3) | (((lane >> 2) & 3) << 6) | (((lane >> 4) & 1) << 5) | (((lane >> 5) & 1) << 8); }
constexpr int v_rd_off(int d0, int ks, int half) { return d0 * 512 + ks * 4096 + half * 2048; }
template <int D0> __device__ __forceinline__ void pv_one(f32x16& od, int vb, bf16x8 pa0, bf16x8 pa1, bf16x8 pa2, bf16x8 pa3) {
  const s16x4 l0 = tr_read<v_rd_off(D0, 0, 0)>(vb), h0 = tr_read<v_rd_off(D0, 0, 1)>(vb), l1 = tr_read<v_rd_off(D0, 1, 0)>(vb), h1 = tr_read<v_rd_off(D0, 1, 1)>(vb);
  const s16x4 l2 = tr_read<v_rd_off(D0, 2, 0)>(vb), h2 = tr_read<v_rd_off(D0, 2, 1)>(vb), l3 = tr_read<v_rd_off(D0, 3, 0)>(vb), h3 = tr_read<v_rd_off(D0, 3, 1)>(vb);
  asm volatile("s_waitcnt lgkmcnt(0)" ::: "memory"); __builtin_amdgcn_sched_barrier(0);
#define PKV(L, H) (bf16x8){L[0], L[1], L[2], L[3], H[0], H[1], H[2], H[3]}
  od = mfma32(pa0, PKV(l0, h0), od); od = mfma32(pa1, PKV(l1, h1), od); od = mfma32(pa2, PKV(l2, h2), od); od = mfma32(pa3, PKV(l3, h3), od);
#undef PKV
}

constexpr float THR_L2 = 11.5f;

__device__ __forceinline__ void partialSM(f32x16& p0, f32x16& p1, float& m_reg, float& alpha) {
  float pmax = p0[0];
#pragma unroll
  for (int r = 1; r < 16; ++r) pmax = fmaxf(pmax, p0[r]);
#pragma unroll
  for (int r = 0; r < 16; ++r) pmax = fmaxf(pmax, p1[r]);
  { auto rr = __builtin_amdgcn_permlane32_swap(__float_as_uint(pmax), __float_as_uint(pmax), false, false);
    pmax = fmaxf(__uint_as_float(rr[0]), __uint_as_float(rr[1])); }
  float mn;
  if (__all(pmax - m_reg <= THR_L2)) { mn = m_reg; alpha = 1.f; }
  else { mn = fmaxf(m_reg, pmax); alpha = __builtin_amdgcn_exp2f(m_reg - mn); m_reg = mn; }
#pragma unroll
  for (int r = 0; r < 16; ++r) { p0[r] = __builtin_amdgcn_exp2f(p0[r] - mn); p1[r] = __builtin_amdgcn_exp2f(p1[r] - mn); }
}
__device__ __forceinline__ void finishSM(f32x16& p0, f32x16& p1, float alpha, float& l_reg, bf16x8& pa0, bf16x8& pa1, bf16x8& pa2, bf16x8& pa3) {
  float ps = 0.f;
#pragma unroll
  for (int r = 0; r < 16; ++r) ps += p0[r];
#pragma unroll
  for (int r = 0; r < 16; ++r) ps += p1[r];
  { auto rr = __builtin_amdgcn_permlane32_swap(__float_as_uint(ps), __float_as_uint(ps), false, false);
    ps = __uint_as_float(rr[0]) + __uint_as_float(rr[1]); }
  l_reg = l_reg * alpha + ps;
#define PK4(P, BASE, OUT) do { unsigned a0 = cvtpk(P[BASE + 0], P[BASE + 1]), a1 = cvtpk(P[BASE + 2], P[BASE + 3]);   \
    unsigned b0 = cvtpk(P[BASE + 4], P[BASE + 5]), b1 = cvtpk(P[BASE + 6], P[BASE + 7]);                              \
    auto r0 = __builtin_amdgcn_permlane32_swap(a0, b0, false, false); auto r1 = __builtin_amdgcn_permlane32_swap(a1, b1, false, false); \
    u32x4 w_ = {r0[0], r1[0], r0[1], r1[1]}; OUT = __builtin_bit_cast(bf16x8, w_); } while (0)
  PK4(p0, 0, pa0); PK4(p0, 8, pa1); PK4(p1, 0, pa2); PK4(p1, 8, pa3);
#undef PK4
}

constexpr int ATT_K_OFF = 0, ATT_V_OFF = 25600, ATT_WS_OFF = 41984, ATT_RPB_OFF = 43008;

template <int MODE>
__device__ __forceinline__ void attn_item(KP p, int layer, int item, char* lds) {
  constexpr int KST = MODE == 0 ? 12 : 4;
  constexpr int KROW = MODE == 0 ? 400 : 272;
  constexpr int ND0 = MODE == 0 ? 4 : 2;
  int tid_ = threadIdx.x; asm volatile("" : "+v"(tid_));
  const int tid = tid_, lane = tid & 63, w = tid >> 6, r32 = lane & 31, hi = lane >> 5;
  char* Kl = lds + ATT_K_OFF; char* Vl = lds + ATT_V_OFF;
  float* wsl = (float*)(lds + ATT_WS_OFF) + w * 64; float* al_l = wsl; float* li_l = wsl + 32;
  float* rpbl = (float*)(lds + ATT_RPB_OFF);

  int NT, qtok, ktok0, head, kcolB = 0; long obase;
  int na_c = 0, na_c0 = 0, na_relrow0 = 0, na_hl = 0;
  const u16* Qp;
  if constexpr (MODE == 0) {
    int seq, qb;
    if (item < 2048) { const int sh = item >> 7; seq = 8 + (sh >> 3); head = sh & 7; qb = item & 127; ktok0 = T_PROMPT + (seq - 8) * 16384; NT = 256; }
    else { const int it = item - 2048; const int sh = it >> 4; seq = sh >> 3; head = sh & 7; qb = it & 15; ktok0 = seq * 2048; NT = 32; }
    qtok = ktok0 + qb * 128 + w * 32 + r32;
    Qp = p.q + (long)qtok * 1536 + head * 192 + hi * 8;
    obase = (long)(ktok0 + qb * 128 + w * 32) * 1024 + head * 128;
  } else {
    const int Rg = item >> 3, hpair = item & 7;
    int grow0, r, rows;
    if (Rg < 256) { grow0 = (Rg >> 5) << 5; r = Rg & 31; rows = 32; } else { grow0 = 256 + (((Rg - 256) >> 8) << 8); r = (Rg - 256) & 255; rows = 256; }
    int r0 = r - 4; r0 = r0 < 0 ? 0 : r0; r0 = r0 > rows - 8 ? rows - 8 : r0;
    ktok0 = (grow0 + r0) * 64; NT = 8;
    na_hl = w >> 1; head = hpair * 2 + na_hl;
    na_c = (w & 1) * 32 + r32; na_c0 = na_c - 8; na_c0 = na_c0 < 0 ? 0 : na_c0; na_c0 = na_c0 > 48 ? 48 : na_c0;
    na_relrow0 = r0 - r + 7;
    qtok = Rg * 64 + na_c;
    Qp = p.qkv + (long)qtok * 3072 + head * 64 + hi * 8;
    obase = (long)(Rg * 64 + (w & 1) * 32) * 1024 + head * 64;
    kcolB = na_hl * 128;
    __syncthreads();
    { const float* src = p.na_rpb_s + ((long)layer * 16 + hpair * 2) * 465;
      for (int e = tid; e < 930; e += 256) rpbl[e] = src[e]; }
  }
  bf16x8 qr[KST];
#pragma unroll
  for (int d = 0; d < KST; ++d) qr[d] = *(const bf16x8*)(Qp + d * 16);

  bf16x8 sk[MODE == 0 ? 6 : 4], sv[4];
  const int s_key = tid >> 4, s_ch = tid & 15;
  const int s_key8 = tid >> 3, s_ch8 = tid & 7;
#define ALOAD(j) do { const long kt_ = (long)ktok0 + (j) * 64; \
    if constexpr (MODE == 0) { \
      _Pragma("unroll") for (int i = 0; i < 4; ++i) { const u16* b_ = p.kv + (kt_ + s_key + 16 * i) * 2048 + head * 256 + s_ch * 8; sk[i] = *(const bf16x8*)b_; sv[i] = *(const bf16x8*)(b_ + 128); } \
      _Pragma("unroll") for (int i = 0; i < 2; ++i) sk[4 + i] = *(const bf16x8*)(p.cqkv + (kt_ + s_key8 + 32 * i) * 768 + 640 + s_ch8 * 8); \
    } else { \
      _Pragma("unroll") for (int i = 0; i < 4; ++i) { const u16* b_ = p.qkv + (kt_ + s_key + 16 * i) * 3072 + 1024 + (head & ~1) * 64 + s_ch * 8; sk[i] = *(const bf16x8*)b_; sv[i] = *(const bf16x8*)(b_ + 1024); } \
    } } while (0)
#define AWRITE() do { \
    _Pragma("unroll") for (int i = 0; i < 4; ++i) { *(bf16x8*)(Kl + (s_key + 16 * i) * KROW + s_ch * 16) = sk[i]; *(bf16x8*)(Vl + v_st(s_key + 16 * i, s_ch * 8)) = sv[i]; } \
    if constexpr (MODE == 0) { _Pragma("unroll") for (int i = 0; i < 2; ++i) *(bf16x8*)(Kl + (s_key8 + 32 * i) * KROW + 256 + s_ch8 * 16) = sk[4 + i]; } } while (0)

  float m_reg = -1e30f, l_reg = 0.f;
  f32x16 o[ND0];
#pragma unroll
  for (int d = 0; d < ND0; ++d)
#pragma unroll
    for (int r = 0; r < 16; ++r) o[d][r] = 0.f;
  const int vb0 = (int)(uintptr_t)Vl + v_rd_base(lane) + (MODE == 1 ? na_hl * 1024 : 0);

  ALOAD(0);
  for (int j = 0; j < NT; ++j) {
    __syncthreads();
    AWRITE();
    __syncthreads();
    if (j + 1 < NT) ALOAD(j + 1);
    f32x16 p0, p1;
#pragma unroll
    for (int r = 0; r < 16; ++r) { p0[r] = 0.f; p1[r] = 0.f; }
#pragma unroll
    for (int d = 0; d < KST; ++d) {
      const int cb = kcolB + (d * 16 + hi * 8) * 2;
      bf16x8 b0 = *(const bf16x8*)(Kl + r32 * KROW + cb), b1 = *(const bf16x8*)(Kl + (32 + r32) * KROW + cb);
      p0 = mfma32(b0, qr[d], p0); p1 = mfma32(b1, qr[d], p1);
    }
    if constexpr (MODE == 1) {
      const float* rb = rpbl + (na_hl * 15 + na_relrow0 + j) * 31;
#pragma unroll
      for (int r = 0; r < 16; ++r) {
        const int kc0 = crow(r, hi), kc1 = 32 + kc0;
        int i0 = kc0 - na_c + 15, i1 = kc1 - na_c + 15;
        i0 = i0 < 0 ? 0 : (i0 > 30 ? 30 : i0); i1 = i1 < 0 ? 0 : (i1 > 30 ? 30 : i1);
        const float b0 = rb[i0], b1 = rb[i1];
        p0[r] = ((unsigned)(kc0 - na_c0) < 16u) ? p0[r] + b0 : -1e30f;
        p1[r] = ((unsigned)(kc1 - na_c0) < 16u) ? p1[r] + b1 : -1e30f;
      }
    }
    float alpha;
    partialSM(p0, p1, m_reg, alpha);
    if (__any(alpha < 1.f)) {
      if (hi == 0) al_l[r32] = alpha;
      __builtin_amdgcn_wave_barrier();
#pragma unroll
      for (int r = 0; r < 16; ++r) { const float a = al_l[crow(r, hi)];
#pragma unroll
        for (int d = 0; d < ND0; ++d) o[d][r] *= a; }
      __builtin_amdgcn_wave_barrier();
    }
    bf16x8 pa0, pa1, pa2, pa3;
    finishSM(p0, p1, alpha, l_reg, pa0, pa1, pa2, pa3);
    pv_one<0>(o[0], vb0, pa0, pa1, pa2, pa3); pv_one<1>(o[1], vb0, pa0, pa1, pa2, pa3);
    if constexpr (MODE == 0) { pv_one<2>(o[2], vb0, pa0, pa1, pa2, pa3); pv_one<3>(o[3], vb0, pa0, pa1, pa2, pa3); }
  }
#undef ALOAD
#undef AWRITE
  if (hi == 0) li_l[r32] = l_reg;
  __builtin_amdgcn_wave_barrier();
#pragma unroll
  for (int r = 0; r < 16; ++r) {
    const int qrow = crow(r, hi); const float rl = 1.f / li_l[qrow];
    u16* o_ = p.o + obase + (long)qrow * 1024 + r32;
#pragma unroll
    for (int d = 0; d < ND0; ++d) o_[d * 32] = (u16)(cvtpk(o[d][r] * rl, 0.f) & 0xffffu);
  }
  __builtin_amdgcn_wave_barrier();
}

__device__ __forceinline__ float lane_bcast(float v, int src_lane) { return __int_as_float(__builtin_amdgcn_ds_bpermute(src_lane << 2, __float_as_int(v))); }
__device__ __forceinline__ float rowmax32(const f32x16& p0, const f32x16& p1) {
  float pmax = p0[0];
#pragma unroll
  for (int r = 1; r < 16; ++r) pmax = fmaxf(pmax, p0[r]);
#pragma unroll
  for (int r = 0; r < 16; ++r) pmax = fmaxf(pmax, p1[r]);
  auto rr = __builtin_amdgcn_permlane32_swap(__float_as_uint(pmax), __float_as_uint(pmax), false, false);
  return fmaxf(__uint_as_float(rr[0]), __uint_as_float(rr[1]));
}

typedef __attribute__((ext_vector_type(8))) int i32x8;
#define MFMA8(A, B, C, SA, SB_) __builtin_amdgcn_mfma_scale_f32_32x32x64_f8f6f4(A, B, C, 0, 0, 0, SA, 0, SB_)
constexpr int SC_K = 0x7D7D7D7D, SC_Q = 0x7B7B7B7B, SC_P = 0x7F7F7F7F, SC_V = 0x7D7D7D7D;
constexpr float THR8_L2 = 1.5f;

__device__ __forceinline__ void attn_mla(KP p, int item, char* lds) {
  constexpr int KSTAGE = 64 * 192, VSTAGE = 128 * 64, VOFF = 2 * KSTAGE;
  int tid_ = threadIdx.x; asm volatile("" : "+v"(tid_));
  const int tid = tid_, lane = tid & 63, w = tid >> 6, r32 = lane & 31, hi = lane >> 5;
  int NT, ktok0, head, seq, qb;
  if (item < 2048) { const int sh = item >> 7; seq = 8 + (sh >> 3); head = sh & 7; qb = item & 127; ktok0 = T_PROMPT + (seq - 8) * 16384; NT = 256; }
  else { const int it = item - 2048; const int sh = it >> 4; seq = sh >> 3; head = sh & 7; qb = it & 15; ktok0 = seq * 2048; NT = 32; }
  const int qtok = ktok0 + qb * 128 + w * 32 + r32;
  const long obase = (long)(ktok0 + qb * 128 + w * 32) * 1024 + head * 128;
  i32x8 qf[3];
  { const unsigned char* Qp = p.q8 + (long)qtok * 1536 + head * 192 + hi * 32;
#pragma unroll
    for (int s3 = 0; s3 < 3; ++s3) { const u32x4 a = *(const u32x4*)(Qp + s3 * 64), b = *(const u32x4*)(Qp + s3 * 64 + 16);
      qf[s3] = (i32x8){(int)a[0], (int)a[1], (int)a[2], (int)a[3], (int)b[0], (int)b[1], (int)b[2], (int)b[3]}; } }
  unsigned ko[3], vo[2];
#pragma unroll
  for (int i = 0; i < 3; ++i) {
    const int g = (w * 3 + i) * 64 + lane, key = g / 12, pc = g - key * 12, c = pc ^ ((key >> 2) & 3);
    ko[i] = (c < 8) ? (unsigned)(key * 1088 + head * 128 + c * 16) : (unsigned)(key * 1088 + 1024 + (c - 8) * 16);
  }
#pragma unroll
  for (int i = 0; i < 2; ++i) {
    const int g = (w * 2 + i) * 64 + lane, d = g >> 2, pc = g & 3, c = pc ^ ((d >> 2) & 3);
    vo[i] = (unsigned)(d * T_TOK + c * 16);
  }
  const unsigned char* k8b = p.k8 + (long)ktok0 * 1088;
  const unsigned char* vtb = p.vT8 + (long)head * 128 * T_TOK + ktok0;
#define GLK(st, jt) do { const unsigned char* kt_ = k8b + (long)(jt) * (64 * 1088); int w_ = w; asm volatile("" : "+v"(w_)); \
    _Pragma("unroll") for (int i = 0; i < 3; ++i) { unsigned k_ = ko[i]; asm volatile("" : "+v"(k_)); \
    __builtin_amdgcn_global_load_lds((const unsigned*)(kt_ + k_), (unsigned*)(lds + (st) * KSTAGE + (w_ * 3 + i) * 1024), 16, 0, 0); } } while (0)
#define GLV(st, jt) do { const unsigned char* vt_ = vtb + (long)(jt) * 64; int w_ = w; asm volatile("" : "+v"(w_)); \
    _Pragma("unroll") for (int i = 0; i < 2; ++i) { unsigned v_ = vo[i]; asm volatile("" : "+v"(v_)); \
    __builtin_amdgcn_global_load_lds((const unsigned*)(vt_ + v_), (unsigned*)(lds + VOFF + (st) * VSTAGE + (w_ * 2 + i) * 1024), 16, 0, 0); } } while (0)
#define QK8(P0, P1, st) do { const int r_ = r32, h_ = hi, sw_ = (r_ >> 2) & 3; const char* Kr_ = lds + (st) * KSTAGE + r_ * 192; \
    const f32x16 z_ = {0.f, 0.f, 0.f, 0.f, 0.f, 0.f, 0.f, 0.f, 0.f, 0.f, 0.f, 0.f, 0.f, 0.f, 0.f, 0.f}; \
    _Pragma("unroll") for (int s3 = 0; s3 < 3; ++s3) { const int c0_ = ((s3 * 4 + h_ * 2) ^ sw_) << 4, c1_ = ((s3 * 4 + h_ * 2 + 1) ^ sw_) << 4; \
      const u32x4 a0_ = *(const u32x4*)(Kr_ + c0_), a1_ = *(const u32x4*)(Kr_ + c1_), b0_ = *(const u32x4*)(Kr_ + 32 * 192 + c0_), b1_ = *(const u32x4*)(Kr_ + 32 * 192 + c1_); \
      const i32x8 ka_ = {(int)a0_[0], (int)a0_[1], (int)a0_[2], (int)a0_[3], (int)a1_[0], (int)a1_[1], (int)a1_[2], (int)a1_[3]}; \
      const i32x8 kb_ = {(int)b0_[0], (int)b0_[1], (int)b0_[2], (int)b0_[3], (int)b1_[0], (int)b1_[1], (int)b1_[2], (int)b1_[3]}; \
      P0 = MFMA8(ka_, qf[s3], (s3 == 0 ? z_ : P0), SC_K, SC_Q); P1 = MFMA8(kb_, qf[s3], (s3 == 0 ? z_ : P1), SC_K, SC_Q); } } while (0)
#define PZERO(P0, P1) do { _Pragma("unroll") for (int r = 0; r < 16; ++r) { P0[r] = 0.f; P1[r] = 0.f; } } while (0)
#define EXPC(P, mn, R0, R1) do { _Pragma("unroll") for (int r = (R0); r < (R1); ++r) P[r] = __builtin_amdgcn_exp2f(P[r] - (mn)); } while (0)
#define SB() do {} while (0)

  float m_reg = -1e30f, l_reg = 0.f;
  f32x16 o[4];
#pragma unroll
  for (int d = 0; d < 4; ++d)
#pragma unroll
    for (int r = 0; r < 16; ++r) o[d][r] = 0.f;
  f32x16 pA0, pA1, pB0, pB1; float pmaxA, pmaxB;

  __syncthreads();
  GLK(0, 0); GLV(0, 0); GLK(1, 1);
  asm volatile("s_waitcnt vmcnt(0)" ::: "memory");
  __syncthreads();
  QK8(pA0, pA1, 0); pmaxA = rowmax32(pA0, pA1);

#define STEP(j, PX0, PX1, PMX, PY0, PY1, PMY, LAST) do { \
    asm volatile("s_waitcnt lgkmcnt(0)" ::: "memory"); __builtin_amdgcn_s_barrier(); \
    if ((j) + 2 < NT) GLK((j) & 1, (j) + 2); \
    if (!(LAST)) GLV(((j) + 1) & 1, (j) + 1); \
    const bool keep_ = __all(PMX - m_reg <= THR8_L2); \
    const float mn_ = keep_ ? m_reg : fmaxf(m_reg, PMX); \
    const float alpha_ = keep_ ? 1.f : __builtin_amdgcn_exp2f(m_reg - mn_); m_reg = mn_; \
    if (!keep_) { _Pragma("unroll") for (int r = 0; r < 16; ++r) { const float a_ = lane_bcast(alpha_, crow(r, hi)); \
      _Pragma("unroll") for (int d = 0; d < 4; ++d) o[d][r] *= a_; } } \
    SB(); \
    if (!(LAST)) { QK8(PY0, PY1, ((j) + 1) & 1); } \
    { const float mnp_ = mn_ - 7.f; EXPC(PX0, mnp_, 0, 16); EXPC(PX1, mnp_, 0, 16); }     \
    SB(); \
    { float ps_ = 0.f; \
      _Pragma("unroll") for (int r = 0; r < 16; ++r) ps_ += PX0[r] + PX1[r]; \
      auto rr_ = __builtin_amdgcn_permlane32_swap(__float_as_uint(ps_), __float_as_uint(ps_), false, false); \
      l_reg = l_reg * alpha_ + __uint_as_float(rr_[0]) + __uint_as_float(rr_[1]); } \
    i32x8 pf_; \
    _Pragma("unroll") for (int g = 0; g < 4; ++g) { \
      const u32 x_ = pack4_fp8(PX0[4 * g], PX0[4 * g + 1], PX0[4 * g + 2], PX0[4 * g + 3]); \
      const u32 y_ = pack4_fp8(PX1[4 * g], PX1[4 * g + 1], PX1[4 * g + 2], PX1[4 * g + 3]); \
      auto sw_ = __builtin_amdgcn_permlane32_swap(x_, y_, false, false); pf_[2 * g] = (int)sw_[0]; pf_[2 * g + 1] = (int)sw_[1]; } \
    SB(); \
    { const int r_ = r32, h_ = hi, sw2_ = (r_ >> 2) & 3; \
      const char* Vr_ = lds + VOFF + ((j) & 1) * VSTAGE + r_ * 64; const int c0_ = ((h_ * 2) ^ sw2_) << 4, c1_ = ((h_ * 2 + 1) ^ sw2_) << 4; \
      _Pragma("unroll") for (int d0 = 0; d0 < 4; ++d0) { \
        const u32x4 a0_ = *(const u32x4*)(Vr_ + d0 * 2048 + c0_), a1_ = *(const u32x4*)(Vr_ + d0 * 2048 + c1_); \
        const i32x8 vf_ = {(int)a0_[0], (int)a0_[1], (int)a0_[2], (int)a0_[3], (int)a1_[0], (int)a1_[1], (int)a1_[2], (int)a1_[3]}; \
        o[d0] = MFMA8(pf_, vf_, o[d0], SC_P, SC_V); } } \
    if (!(LAST)) PMY = rowmax32(PY0, PY1); \
    asm volatile("s_waitcnt vmcnt(0)" ::: "memory"); } while (0)

  for (int j = 0; j < NT - 2; j += 2) {
    STEP(j, pA0, pA1, pmaxA, pB0, pB1, pmaxB, false);
    STEP(j + 1, pB0, pB1, pmaxB, pA0, pA1, pmaxA, false);
  }
  STEP(NT - 2, pA0, pA1, pmaxA, pB0, pB1, pmaxB, false);
  STEP(NT - 1, pB0, pB1, pmaxB, pA0, pA1, pmaxA, true);
#undef STEP
#undef QK8
#undef PZERO
#undef EXPC
#undef SB
#undef GLK
#undef GLV
#pragma unroll
  for (int r = 0; r < 16; ++r) {
    const int qrow = crow(r, hi); const float rl = 1.f / lane_bcast(l_reg, qrow);
    u16* o_ = p.o + obase + (long)qrow * 1024 + r32;
#pragma unroll
    for (int d = 0; d < 4; ++d) o_[d * 32] = (u16)(cvtpk(o[d][r] * rl, 0.f) & 0xffffu);
  }
}

typedef __attribute__((ext_vector_type(2))) float f32x2;
constexpr float U_SCALE = 256.f, V_SCALE = 64.f;
__device__ __forceinline__ float keyval(u32 k) { return __uint_as_float(k & ~127u) - KEY_BIAS; }
template <int CTRL> __device__ __forceinline__ float dppf(float v) { return __int_as_float(__builtin_amdgcn_update_dpp(0, __float_as_int(v), CTRL, 0xF, 0xF, true)); }
__device__ __forceinline__ float red16(float v) { v += dppf<0xB1>(v); v += dppf<0x4E>(v); v += dppf<0x141>(v); v += dppf<0x140>(v); return v; }
__device__ __forceinline__ void fp8dot(u32 dw, const f32x4& x, f32x2& acc) {
  const f32x2 lo = __builtin_amdgcn_cvt_pk_f32_fp8((int)dw, false), hi = __builtin_amdgcn_cvt_pk_f32_fp8((int)dw, true);
  acc = __builtin_elementwise_fma(lo, (f32x2){x[0], x[1]}, acc); acc = __builtin_elementwise_fma(hi, (f32x2){x[2], x[3]}, acc);
}

#ifndef PEER_FP4
#define PEER_FP4 1
#endif
#if PEER_FP4
constexpr float U4_SCALE = 96.f, V4_SCALE = 22.f;
__device__ __forceinline__ void fp4dot(u32 dw, const f32x4& x0, const f32x4& x1, f32x2& acc) {
  acc = __builtin_elementwise_fma(__builtin_amdgcn_cvt_scalef32_pk_f32_fp4(dw, 1.0f, 0), (f32x2){x0[0], x0[1]}, acc);
  acc = __builtin_elementwise_fma(__builtin_amdgcn_cvt_scalef32_pk_f32_fp4(dw, 1.0f, 1), (f32x2){x0[2], x0[3]}, acc);
  acc = __builtin_elementwise_fma(__builtin_amdgcn_cvt_scalef32_pk_f32_fp4(dw, 1.0f, 2), (f32x2){x1[0], x1[1]}, acc);
  acc = __builtin_elementwise_fma(__builtin_amdgcn_cvt_scalef32_pk_f32_fp4(dw, 1.0f, 3), (f32x2){x1[2], x1[3]}, acc);
}
__device__ __forceinline__ void phase_peer_combine(KP p, int layer, char* lds, unsigned* ctr) {
  const bool last = (layer == 3);
  int tid_ = threadIdx.x; asm volatile("" : "+v"(tid_));
  const int tid = tid_, lane = tid & 63, w = tid >> 6;
  int* eL = (int*)(lds + w * 1536); float* gL = (float*)(lds + w * 1536 + 512); float* wL = (float*)(lds + w * 1536 + 1024);
  int ci = 0, cj = 0; bool cvalid = false;
  { int cnt = 0;
#pragma unroll
    for (int i = 0; i < 16; ++i) { const int n = 16 / (i + 1); if (!cvalid && lane < cnt + n) { ci = i; cj = lane - cnt; cvalid = true; } cnt += n; } }
  const unsigned char* U = p.peer_u8 + (long)layer * 16384 * 512; const unsigned char* V = p.peer_v8 + (long)layer * 16384 * 512;
  const int sub = lane & 15, grp = lane >> 4, l32 = lane & 31, hf = lane >> 5;
  __syncthreads();
  for (;;) {
   int base_ = 0; if (lane == 0) base_ = (int)atomicAdd(ctr, 4u);
   base_ = __builtin_amdgcn_readfirstlane(base_);
   if (base_ >= T_TOK) break;
#pragma unroll 1
   for (int t = base_; t < base_ + 4; ++t) {
    float* xr = p.x + (long)t * DM;
    const u32* pk = p.pkeys + (long)t * 256;
    u32 ka[8], kb[8];
#pragma unroll
    for (int hd = 0; hd < 8; ++hd) { ka[hd] = pk[hd * 32 + ci]; kb[hd] = pk[hd * 32 + 16 + cj]; }
    u32 xe[2][4], xo[2][4]; int sumx = 0; float rstd, sx;
    f32x4 xs[2][8];
#pragma unroll
    for (int j = 0; j < 2; ++j)
#pragma unroll
      for (int q = 0; q < 8; ++q) xs[j][q] = *(const f32x4*)(xr + (sub + 16 * j) * 32 + q * 4);
#pragma unroll
    for (int hd = 0; hd < 8; ++hd) {
      const float cand = cvalid ? keyval(ka[hd]) + keyval(kb[hd]) : -3.0e38f;
      u32 ck = __float_as_uint(cand); ck = (ck & 0x80000000u) ? ~ck : (ck | 0x80000000u); ck = (ck & ~63u) | (u32)(63 - lane);
      int rank = 0;
#pragma unroll
      for (int m = 0; m < 50; ++m) { const u32 c = __builtin_amdgcn_readlane(ck, m); rank += (c > ck) ? 1 : 0; }
      const float cmax = __uint_as_float(__builtin_amdgcn_readlane(__float_as_uint(cand), 0));
      if (cvalid && rank < 16) { eL[hd * 16 + rank] = (int)((ka[hd] & 127u) * 128u + (kb[hd] & 127u)); gL[hd * 16 + rank] = __expf(cand - cmax); }
    }
    __builtin_amdgcn_wave_barrier();
    { const float g0 = gL[lane], g1 = gL[lane + 64]; const float s0 = red16(g0), s1 = red16(g1);
      __builtin_amdgcn_wave_barrier();
      gL[lane] = g0 / s0; gL[lane + 64] = g1 / s1; }
    __builtin_amdgcn_wave_barrier();
    u32x4 cA[8], cB[8];
#define LOADU(C, it) do { const int k0_ = (it) * 16 + grp * 4; \
      _Pragma("unroll") for (int rr = 0; rr < 4; ++rr) { const int e_ = eL[k0_ + rr]; const unsigned char* u_ = U + (long)e_ * 512 + sub * 16; \
        C[rr * 2] = *(const u32x4*)u_; C[rr * 2 + 1] = *(const u32x4*)(u_ + 256); } } while (0)
#define COMPU(C, it) do { const int k0_ = (it) * 16 + grp * 4; \
      _Pragma("unroll") for (int rr = 0; rr < 4; ++rr) { int a_ = 0; \
        _Pragma("unroll") for (int j = 0; j < 2; ++j) { _Pragma("unroll") for (int d = 0; d < 4; ++d) { const u32 dw_ = C[rr * 2 + j][d]; \
          a_ = __builtin_amdgcn_sdot4((int)(dw_ & 0x0F0F0F0Fu), (int)xe[j][d], a_, false); a_ = __builtin_amdgcn_sdot4((int)((dw_ >> 4) & 0x0F0F0F0Fu), (int)xo[j][d], a_, false); } } \
        const float r_ = red16((float)(a_ - 8 * sumx)); \
        if (sub == 0) wL[k0_ + rr] = r_; } } while (0)
#define LOADV(C, g) do { _Pragma("unroll") for (int i = 0; i < 8; ++i) { const int e_ = eL[(g) * 16 + 2 * i + hf]; \
      C[i] = *(const u32x4*)(V + (long)e_ * 512 + l32 * 16); } } while (0)
#define COMPV(C, g) do { _Pragma("unroll") for (int i = 0; i < 8; ++i) { const float wk_ = wL[(g) * 16 + 2 * i + hf]; const f32x2 w2_ = {wk_, wk_}; \
      _Pragma("unroll") for (int d = 0; d < 4; ++d) { const u32 dw_ = C[i][d]; \
        out[d * 4 + 0] = __builtin_elementwise_fma(__builtin_amdgcn_cvt_scalef32_pk_f32_fp4(dw_, 1.0f, 0), w2_, out[d * 4 + 0]); \
        out[d * 4 + 1] = __builtin_elementwise_fma(__builtin_amdgcn_cvt_scalef32_pk_f32_fp4(dw_, 1.0f, 1), w2_, out[d * 4 + 1]); \
        out[d * 4 + 2] = __builtin_elementwise_fma(__builtin_amdgcn_cvt_scalef32_pk_f32_fp4(dw_, 1.0f, 2), w2_, out[d * 4 + 2]); \
        out[d * 4 + 3] = __builtin_elementwise_fma(__builtin_amdgcn_cvt_scalef32_pk_f32_fp4(dw_, 1.0f, 3), w2_, out[d * 4 + 3]); } } } while (0)
    LOADU(cA, 0);
    { float ss = 0.f, am = 0.f;
#pragma unroll
      for (int j = 0; j < 2; ++j)
#pragma unroll
        for (int q = 0; q < 8; ++q) { const f32x4 a = xs[j][q]; ss += a[0] * a[0] + a[1] * a[1] + a[2] * a[2] + a[3] * a[3];
          am = fmaxf(fmaxf(am, fmaxf(fabsf(a[0]), fabsf(a[1]))), fmaxf(fabsf(a[2]), fabsf(a[3]))); }
      ss = red16(ss);
      am = fmaxf(am, dppf<0xB1>(am)); am = fmaxf(am, dppf<0x4E>(am)); am = fmaxf(am, dppf<0x141>(am)); am = fmaxf(am, dppf<0x140>(am));
      rstd = rsqrtf(ss * (1.f / DM) + RMS_EPS);
      am = fmaxf(am, 1e-20f); sx = am * (1.f / 127.f); const float inv = 127.f / am;
#pragma unroll
      for (int j = 0; j < 2; ++j)
#pragma unroll
        for (int d = 0; d < 4; ++d) {
          const f32x4 lo4 = xs[j][2 * d], hi4 = xs[j][2 * d + 1];
          const int i0 = (int)__builtin_rintf(lo4[0] * inv), i1 = (int)__builtin_rintf(lo4[1] * inv), i2 = (int)__builtin_rintf(lo4[2] * inv), i3 = (int)__builtin_rintf(lo4[3] * inv);
          const int i4 = (int)__builtin_rintf(hi4[0] * inv), i5 = (int)__builtin_rintf(hi4[1] * inv), i6 = (int)__builtin_rintf(hi4[2] * inv), i7 = (int)__builtin_rintf(hi4[3] * inv);
          sumx += i0 + i1 + i2 + i3 + i4 + i5 + i6 + i7;
          xe[j][d] = (u32)(i0 & 0xFF) | ((u32)(i2 & 0xFF) << 8) | ((u32)(i4 & 0xFF) << 16) | ((u32)i6 << 24);
          xo[j][d] = (u32)(i1 & 0xFF) | ((u32)(i3 & 0xFF) << 8) | ((u32)(i5 & 0xFF) << 16) | ((u32)i7 << 24);
        } }
#pragma unroll 1
    for (int it = 0; it < 6; it += 2) { LOADU(cB, it + 1); COMPU(cA, it); LOADU(cA, it + 2); COMPU(cB, it + 1); }
    LOADU(cB, 7); COMPU(cA, 6);
    LOADV(cA, 0);
    COMPU(cB, 7);
    __builtin_amdgcn_wave_barrier();
    { const float sc_ = rstd * sx * (1.f / U4_SCALE); const float a0 = wL[lane] * sc_, a1 = wL[lane + 64] * sc_;
      const float w0 = gL[lane] * 0.5f * a0 * (1.f + erff(a0 * 0.70710678118654752f)), w1 = gL[lane + 64] * 0.5f * a1 * (1.f + erff(a1 * 0.70710678118654752f));
      __builtin_amdgcn_wave_barrier();
      wL[lane] = w0; wL[lane + 64] = w1; }
    __builtin_amdgcn_wave_barrier();
    f32x2 out[16];
#pragma unroll
    for (int i = 0; i < 16; ++i) out[i] = (f32x2){0.f, 0.f};
#pragma unroll 1
    for (int g = 0; g < 6; g += 2) { LOADV(cB, g + 1); COMPV(cA, g); LOADV(cA, g + 2); COMPV(cB, g + 1); }
    LOADV(cB, 7); COMPV(cA, 6); COMPV(cB, 7);
#undef LOADU
#undef COMPU
#undef LOADV
#undef COMPV
    {
      f32x4 v[4];
#pragma unroll
      for (int q = 0; q < 4; ++q) {
        const f32x2 m0 = hf ? out[8 + 2 * q] : out[2 * q], o0 = hf ? out[2 * q] : out[8 + 2 * q];
        const f32x2 m1 = hf ? out[8 + 2 * q + 1] : out[2 * q + 1], o1 = hf ? out[2 * q + 1] : out[8 + 2 * q + 1];
        v[q] = (f32x4){m0[0] + shx(o0[0], 32), m0[1] + shx(o0[1], 32), m1[0] + shx(o1[0], 32), m1[1] + shx(o1[1], 32)};
      }
      f32x4* xo = (f32x4*)(xr + l32 * 32 + hf * 16);
#pragma unroll
      for (int q = 0; q < 4; ++q) { const f32x4 xv = xo[q]; v[q] = xv + v[q] * (1.f / V4_SCALE); }
      __builtin_amdgcn_wave_barrier();
      if (last) {
        float s2 = 0.f;
#pragma unroll
        for (int q = 0; q < 4; ++q) s2 += v[q][0] * v[q][0] + v[q][1] * v[q][1] + v[q][2] * v[q][2] + v[q][3] * v[q][3];
        s2 = red16(s2); s2 += shx(s2, 16); s2 += shx(s2, 32);
        const float rf = rsqrtf(s2 * (1.f / DM) + RMS_EPS);
#pragma unroll
        for (int q = 0; q < 4; ++q) { const f32x4 gf = *(const f32x4*)(p.norm_final + l32 * 32 + hf * 16 + q * 4); v[q] = v[q] * rf * gf; }
      }
#pragma unroll
      for (int q = 0; q < 4; ++q) xo[q] = v[q];
      u32x4* xbo = (u32x4*)(p.xb + (long)t * DM + l32 * 32 + hf * 16);
      xbo[0] = (u32x4){cvtpk(v[0][0], v[0][1]), cvtpk(v[0][2], v[0][3]), cvtpk(v[1][0], v[1][1]), cvtpk(v[1][2], v[1][3])};
      xbo[1] = (u32x4){cvtpk(v[2][0], v[2][1]), cvtpk(v[2][2], v[2][3]), cvtpk(v[3][0], v[3][1]), cvtpk(v[3][2], v[3][3])}; }
    __builtin_amdgcn_wave_barrier();
   }
  }
}
#else
__device__ __forceinline__ void phase_peer_combine(KP p, int layer, char* lds, unsigned*) {
  const bool last = (layer == 3);
  int tid_ = threadIdx.x; asm volatile("" : "+v"(tid_));
  const int tid = tid_, lane = tid & 63, w = tid >> 6;
  int* eL = (int*)(lds + w * 1536); float* gL = (float*)(lds + w * 1536 + 512); float* wL = (float*)(lds + w * 1536 + 1024);
  int ci = 0, cj = 0; bool cvalid = false;
  { int cnt = 0;
#pragma unroll
    for (int i = 0; i < 16; ++i) { const int n = 16 / (i + 1); if (!cvalid && lane < cnt + n) { ci = i; cj = lane - cnt; cvalid = true; } cnt += n; } }
  const unsigned char* U = p.peer_u8 + (long)layer * 16384 * 1024; const unsigned char* V = p.peer_v8 + (long)layer * 16384 * 1024;
  const int sub = lane & 15, grp = lane >> 4;
  __syncthreads();
  for (int t = blockIdx.x * 4 + w; t < T_TOK; t += gridDim.x * 4) {
    float* xr = p.x + (long)t * DM;
    const u32* pk = p.pkeys + (long)t * 256;
    u32 ka[8], kb[8];
#pragma unroll
    for (int hd = 0; hd < 8; ++hd) { ka[hd] = pk[hd * 32 + ci]; kb[hd] = pk[hd * 32 + 16 + cj]; }
    f32x4 xs[4][4]; float ss = 0.f;
#pragma unroll
    for (int i = 0; i < 4; ++i)
#pragma unroll
      for (int q = 0; q < 4; ++q) { const f32x4 a = *(const f32x4*)(xr + (sub + 16 * i) * 16 + q * 4); xs[i][q] = a; ss += a[0] * a[0] + a[1] * a[1] + a[2] * a[2] + a[3] * a[3]; }
    ss = red16(ss);
    const float rstd = rsqrtf(ss * (1.f / DM) + RMS_EPS);
#pragma unroll
    for (int hd = 0; hd < 8; ++hd) {
      const float cand = cvalid ? keyval(ka[hd]) + keyval(kb[hd]) : -3.0e38f;
      u32 ck = __float_as_uint(cand); ck = (ck & 0x80000000u) ? ~ck : (ck | 0x80000000u); ck = (ck & ~63u) | (u32)(63 - lane);
      int rank = 0;
#pragma unroll
      for (int m = 0; m < 50; ++m) { const u32 c = __builtin_amdgcn_readlane(ck, m); rank += (c > ck) ? 1 : 0; }
      const float cmax = __uint_as_float(__builtin_amdgcn_readlane(__float_as_uint(cand), 0));
      if (cvalid && rank < 16) { eL[hd * 16 + rank] = (int)((ka[hd] & 127u) * 128u + (kb[hd] & 127u)); gL[hd * 16 + rank] = __expf(cand - cmax); }
    }
    __builtin_amdgcn_wave_barrier();
    { const float g0 = gL[lane], g1 = gL[lane + 64]; const float s0 = red16(g0), s1 = red16(g1);
      __builtin_amdgcn_wave_barrier();
      gL[lane] = g0 / s0; gL[lane + 64] = g1 / s1; }
    __builtin_amdgcn_wave_barrier();
    u32x4 cA[8], cB[8];
#define LOADU(C, it) do { const int k0_ = (it) * 8 + grp * 2; const int e0_ = eL[k0_], e1_ = eL[k0_ + 1]; \
      const unsigned char* u0_ = U + (long)e0_ * 1024 + sub * 16; const unsigned char* u1_ = U + (long)e1_ * 1024 + sub * 16; \
      _Pragma("unroll") for (int i = 0; i < 4; ++i) { C[i] = *(const u32x4*)(u0_ + i * 256); C[4 + i] = *(const u32x4*)(u1_ + i * 256); } } while (0)
#define COMPU(C, it) do { const int k0_ = (it) * 8 + grp * 2; f32x2 a0_ = {0.f, 0.f}, a1_ = {0.f, 0.f}; \
      _Pragma("unroll") for (int i = 0; i < 4; ++i) { _Pragma("unroll") for (int q = 0; q < 4; ++q) { fp8dot(C[i][q], xs[i][q], a0_); fp8dot(C[4 + i][q], xs[i][q], a1_); } } \
      const float r0_ = red16(a0_[0] + a0_[1]), r1_ = red16(a1_[0] + a1_[1]); \
      if (sub == 0) { const float aa_ = r0_ * rstd * (1.f / U_SCALE), ab_ = r1_ * rstd * (1.f / U_SCALE); \
        wL[k0_] = gL[k0_] * 0.5f * aa_ * (1.f + erff(aa_ * 0.70710678118654752f)); \
        wL[k0_ + 1] = gL[k0_ + 1] * 0.5f * ab_ * (1.f + erff(ab_ * 0.70710678118654752f)); } } while (0)
#define LOADV(C, g) do { _Pragma("unroll") for (int i = 0; i < 8; ++i) { const int e_ = eL[(g) * 8 + i]; C[i] = *(const u32x4*)(V + (long)e_ * 1024 + lane * 16); } } while (0)
#define COMPV(C, g) do { _Pragma("unroll") for (int i = 0; i < 8; ++i) { const float wk_ = wL[(g) * 8 + i]; const f32x2 w2_ = {wk_, wk_}; \
      _Pragma("unroll") for (int q = 0; q < 4; ++q) { \
        const f32x2 lo_ = __builtin_amdgcn_cvt_pk_f32_fp8((int)C[i][q], false), hi_ = __builtin_amdgcn_cvt_pk_f32_fp8((int)C[i][q], true); \
        out[2 * q] = __builtin_elementwise_fma(lo_, w2_, out[2 * q]); out[2 * q + 1] = __builtin_elementwise_fma(hi_, w2_, out[2 * q + 1]); } } } while (0)
    LOADU(cA, 0);
#pragma unroll 1
    for (int it = 0; it < 14; it += 2) { LOADU(cB, it + 1); COMPU(cA, it); LOADU(cA, it + 2); COMPU(cB, it + 1); }
    LOADU(cB, 15); COMPU(cA, 14);
    LOADV(cA, 0);
    COMPU(cB, 15);
    __builtin_amdgcn_wave_barrier();
    f32x2 out[8];
#pragma unroll
    for (int i = 0; i < 8; ++i) out[i] = (f32x2){0.f, 0.f};
#pragma unroll 1
    for (int g = 0; g < 14; g += 2) { LOADV(cB, g + 1); COMPV(cA, g); LOADV(cA, g + 2); COMPV(cB, g + 1); }
    LOADV(cB, 15); COMPV(cA, 14); COMPV(cB, 15);
#undef LOADU
#undef COMPU
#undef LOADV
#undef COMPV
    { f32x4* xo = (f32x4*)(xr + lane * 16);
      f32x4 v[4];
#pragma unroll
      for (int q = 0; q < 4; ++q) { v[q] = xo[q]; v[q][0] += out[2 * q][0] * (1.f / V_SCALE); v[q][1] += out[2 * q][1] * (1.f / V_SCALE); v[q][2] += out[2 * q + 1][0] * (1.f / V_SCALE); v[q][3] += out[2 * q + 1][1] * (1.f / V_SCALE); }
      __builtin_amdgcn_wave_barrier();
      if (last) {
        float s2 = 0.f;
#pragma unroll
        for (int q = 0; q < 4; ++q) s2 += v[q][0] * v[q][0] + v[q][1] * v[q][1] + v[q][2] * v[q][2] + v[q][3] * v[q][3];
        s2 = red16(s2); s2 += shx(s2, 16); s2 += shx(s2, 32);
        const float rf = rsqrtf(s2 * (1.f / DM) + RMS_EPS);
#pragma unroll
        for (int q = 0; q < 4; ++q) { const f32x4 gf = *(const f32x4*)(p.norm_final + lane * 16 + q * 4); v[q] = v[q] * rf * gf; }
      }
#pragma unroll
      for (int q = 0; q < 4; ++q) xo[q] = v[q];
      u32x4* xbo = (u32x4*)(p.xb + (long)t * DM + lane * 16);
      xbo[0] = (u32x4){cvtpk(v[0][0], v[0][1]), cvtpk(v[0][2], v[0][3]), cvtpk(v[1][0], v[1][1]), cvtpk(v[1][2], v[1][3])};
      xbo[1] = (u32x4){cvtpk(v[2][0], v[2][1]), cvtpk(v[2][2], v[2][3]), cvtpk(v[3][0], v[3][1]), cvtpk(v[3][2], v[3][3])}; }
    __builtin_amdgcn_wave_barrier();
  }
}

#endif

#if PEER_FP4
constexpr long TBL_ITERS = 4L * 16384 * 1024 / 16; constexpr int TBL_NCHUNK = 512; constexpr long TBL_CHUNK = TBL_ITERS / TBL_NCHUNK;
__device__ __forceinline__ void convert_tables_chunk(KP p, int chunk) {
  int tid_ = threadIdx.x; asm volatile("" : "+v"(tid_));
#define Q4(val) ((u32)(int)(fminf(fmaxf(__builtin_rintf((val) * U4_SCALE), -8.f), 7.f) + 8.f))
  for (long i = (long)chunk * TBL_CHUNK + tid_; i < (long)(chunk + 1) * TBL_CHUNK; i += NTHR) {
    const long e = i * 16; const int layer = (int)(e >> 24); const int d = (int)(e & 1023);
    u32 uo[2], vo[2];
#pragma unroll
    for (int h = 0; h < 2; ++h) {
      u32 a = 0, b = 0;
#pragma unroll
      for (int q = 0; q < 2; ++q) {
        const f32x4 g = *(const f32x4*)(p.in_norm_ffn + layer * 1024 + d + h * 8 + q * 4);
        const f32x4 u = *(const f32x4*)(p.in_peer_u + e + h * 8 + q * 4), v = *(const f32x4*)(p.in_peer_v + e + h * 8 + q * 4);
        if (q == 0) {
          a |= Q4(u[0] * g[0]) | (Q4(u[1] * g[1]) << 4) | (Q4(u[2] * g[2]) << 8) | (Q4(u[3] * g[3]) << 12);
          b = __builtin_amdgcn_cvt_scalef32_pk_fp4_f32(b, v[0] * V4_SCALE, v[1] * V4_SCALE, 1.0f, 0); b = __builtin_amdgcn_cvt_scalef32_pk_fp4_f32(b, v[2] * V4_SCALE, v[3] * V4_SCALE, 1.0f, 1);
        } else {
          a |= (Q4(u[0] * g[0]) << 16) | (Q4(u[1] * g[1]) << 20) | (Q4(u[2] * g[2]) << 24) | (Q4(u[3] * g[3]) << 28);
          b = __builtin_amdgcn_cvt_scalef32_pk_fp4_f32(b, v[0] * V4_SCALE, v[1] * V4_SCALE, 1.0f, 2); b = __builtin_amdgcn_cvt_scalef32_pk_fp4_f32(b, v[2] * V4_SCALE, v[3] * V4_SCALE, 1.0f, 3);
        }
      }
      uo[h] = a; vo[h] = b;
    }
    *(u32x2*)(p.peer_u8 + (e >> 1)) = (u32x2){uo[0], uo[1]}; *(u32x2*)(p.peer_v8 + (e >> 1)) = (u32x2){vo[0], vo[1]};
  }
}

#endif
__device__ __forceinline__ void prep_transpose_tile(KP p, int t, char* lds) {
  int tid_ = threadIdx.x; asm volatile("" : "+v"(tid_));
  const int tid = tid_;
  float* tl = (float*)lds;
  int j = 0;
  while (j + 1 < p.njobs && t >= p.jobs[j + 1].tile0) ++j;
  const float* src = p.jobs[j].src; u16* dst = p.jobs[j].dst; const float* gain = p.jobs[j].gain;
  const int K = p.jobs[j].K, N = p.jobs[j].N, scale_cols = p.jobs[j].scale_cols; const float scale = p.jobs[j].scale;
  const int lt = t - p.jobs[j].tile0, ntn = N >> 6, kt = lt / ntn, nt = lt - kt * ntn;
  __syncthreads();
  for (int e = tid; e < 4096; e += 256) { const int kk = e >> 6, nn = e & 63, k = kt * 64 + kk; const float g = gain ? gain[k] : 1.f; tl[kk * 65 + nn] = src[(long)k * N + nt * 64 + nn] * g; }
  __syncthreads();
  for (int e = tid; e < 2048; e += 256) { const int nn = e >> 5, kp = (e & 31) * 2, n = nt * 64 + nn; const float s = (n < scale_cols) ? scale : 1.f;
    *(u32*)(dst + (long)n * K + kt * 64 + kp) = cvtpk(tl[kp * 65 + nn] * s, tl[(kp + 1) * 65 + nn] * s); }
  __syncthreads();
}

__device__ __forceinline__ void phase_prep(KP p, char* lds) {
  int tid_ = threadIdx.x; asm volatile("" : "+v"(tid_));
  const int tid = tid_;
  const long gtid = (long)blockIdx.x * NTHR + tid, gsz = (long)gridDim.x * NTHR;
  float* tl = (float*)lds;
  for (int t = blockIdx.x; t < p.jobs[4].tile0; t += gridDim.x) prep_transpose_tile(p, t, lds);
  for (long i = gtid; i < (long)T_TOK * DM / 4; i += gsz) {
    const long e = i * 4; const f32x4 v = e < (long)T_PROMPT * DM ? *(const f32x4*)(p.xin0 + e) : *(const f32x4*)(p.xin1 + (e - (long)T_PROMPT * DM));
    *(f32x4*)(p.x + e) = v; *(u32*)(p.xb + e) = cvtpk(v[0], v[1]); *(u32*)(p.xb + e + 2) = cvtpk(v[2], v[3]); }
  for (long i = gtid; i < 4L * 8 * 2 * 128 * 128 / 2; i += gsz) { const float a = p.in_sub_keys[2 * i], b = p.in_sub_keys[2 * i + 1]; *(u32*)(p.peer_sk + 2 * i) = cvtpk(a, b); }
#if PEER_FP4
#else
  for (long i = gtid; i < 4L * 16384 * 1024 / 16; i += gsz) {
    const long e = i * 16; const int layer = (int)(e >> 24); const int d = (int)(e & 1023);
    u32x4 uo, vo;
#pragma unroll
    for (int q = 0; q < 4; ++q) {
      const f32x4 g = *(const f32x4*)(p.in_norm_ffn + layer * 1024 + d + q * 4);
      const f32x4 u = *(const f32x4*)(p.in_peer_u + e + q * 4), v = *(const f32x4*)(p.in_peer_v + e + q * 4);
      int a = 0, b = 0;
      a = __builtin_amdgcn_cvt_pk_fp8_f32(u[0] * g[0] * U_SCALE, u[1] * g[1] * U_SCALE, a, false); a = __builtin_amdgcn_cvt_pk_fp8_f32(u[2] * g[2] * U_SCALE, u[3] * g[3] * U_SCALE, a, true);
      b = __builtin_amdgcn_cvt_pk_fp8_f32(v[0] * V_SCALE, v[1] * V_SCALE, b, false); b = __builtin_amdgcn_cvt_pk_fp8_f32(v[2] * V_SCALE, v[3] * V_SCALE, b, true);
      uo[q] = (u32)a; vo[q] = (u32)b;
    }
    *(u32x4*)(p.peer_u8 + e) = uo; *(u32x4*)(p.peer_v8 + e) = vo;
  }
#endif
  for (long i = gtid; i < 2 * 3072; i += gsz) { const int c = (int)(i % 3072); p.na_bias_s[i] = p.in_na_bias[i] * (c < 1024 ? 0.125f * LOG2E : 1.f); }
  for (long i = gtid; i < 2 * 16 * 465; i += gsz) p.na_rpb_s[i] = p.in_na_rpb[i] * LOG2E;
  for (long i = gtid; i < 16384L * 32; i += gsz) {
    const int pos = (int)(i >> 5), jf = (int)(i & 31);
    const double a = (double)pos * p.inv_freq[jf] * 0.15915494309189535;
    const double fr = a - rint(a);
    const float f = (float)fr;
    p.ropeC[i] = __builtin_amdgcn_cosf(f); p.ropeS[i] = __builtin_amdgcn_sinf(f);
  }
  for (long i = gtid; i < 2L * 64 * 1024 / 2; i += gsz) { const int l = (int)(i >> 15); const long e = (i & 32767) * 2; *(u32*)(p.wa_t[l] + 704L * 1024 + e) = 0u; }
}

__device__ __forceinline__ void phase_final(KP p) {
  int tid_ = threadIdx.x; asm volatile("" : "+v"(tid_));
  const int lane = tid_ & 63, w = tid_ >> 6;
  for (int t = blockIdx.x * 4 + w; t < T_TOK; t += gridDim.x * 4) {
    float* xr = p.x + (long)t * DM;
    f32x4 v[4]; float ss = 0.f;
#pragma unroll
    for (int i = 0; i < 4; ++i) { v[i] = *(const f32x4*)(xr + i * 256 + lane * 4); ss += v[i][0] * v[i][0] + v[i][1] * v[i][1] + v[i][2] * v[i][2] + v[i][3] * v[i][3]; }
    ss += shx(ss, 1); ss += shx(ss, 2); ss += shx(ss, 4); ss += shx(ss, 8); ss += shx(ss, 16); ss += shx(ss, 32);
    const float rs = rsqrtf(ss * (1.f / DM) + RMS_EPS);
#pragma unroll
    for (int i = 0; i < 4; ++i) { const f32x4 g = *(const f32x4*)(p.norm_final + i * 256 + lane * 4); f32x4 o_ = {v[i][0] * rs * g[0], v[i][1] * rs * g[1], v[i][2] * rs * g[2], v[i][3] * rs * g[3]}; *(f32x4*)(xr + i * 256 + lane * 4) = o_; }
  }
}

template <int EPI>
__device__ __forceinline__ void gemm_big(KP p, int layer, const u16* Ap, int lda, const u16* Bt, int K, int m0, int n0, char* lds) {
  int tid_ = threadIdx.x; asm volatile("" : "+v"(tid_));
  const int tid = tid_, lane = tid & 63, w = tid >> 6;
  const int wm = w >> 1, wn = w & 1, r32 = lane & 31, hi = lane >> 5;
  constexpr int STG = 24576;
  const int scol = ((lane & 3) ^ ((lane >> 4) & 3)) * 8;
  const u16* Ag = Ap + (long)(m0 + w * 64 + (lane >> 2)) * lda + scol;
  const u16* Bg = Bt + (long)(n0 + w * 32 + (lane >> 2)) * K + scol;
#define GST(st, kt) do { int w_ = w; asm volatile("" : "+v"(w_)); \
    _Pragma("unroll") for (int i = 0; i < 4; ++i) __builtin_amdgcn_global_load_lds((const unsigned*)(Ag + (long)i * 16 * lda + (kt) * 32), (unsigned*)(lds + (st) * STG + (w_ * 4 + i) * 1024), 16, 0, 0); \
    _Pragma("unroll") for (int i = 0; i < 2; ++i) __builtin_amdgcn_global_load_lds((const unsigned*)(Bg + (long)i * 16 * K + (kt) * 32), (unsigned*)(lds + (st) * STG + 16384 + (w_ * 2 + i) * 1024), 16, 0, 0); } while (0)
  f32x16 acc[4][2];
#pragma unroll
  for (int i = 0; i < 4; ++i)
#pragma unroll
    for (int j = 0; j < 2; ++j)
#pragma unroll
      for (int r = 0; r < 16; ++r) acc[i][j][r] = 0.f;
  float ssq[4] = {0.f, 0.f, 0.f, 0.f};
  const int sw = (r32 >> 2) & 3;
  const int arow = (wm * 128 + r32) * 64, brow = 16384 + (wn * 64 + r32) * 64;
  const int nk = K / 32;
  __syncthreads();
  GST(0, 0); GST(1, 1);
  int st = 0;
  for (int kt = 0; kt < nk; ++kt) {
    if (kt + 1 < nk) asm volatile("s_waitcnt vmcnt(6)" ::: "memory"); else asm volatile("s_waitcnt vmcnt(0)" ::: "memory");
    asm volatile("s_waitcnt lgkmcnt(0)" ::: "memory");
    __builtin_amdgcn_s_barrier();
    if (kt + 2 < nk) { const int s2 = st + 2 >= 3 ? st - 1 : st + 2; GST(s2, kt + 2); }
    const char* base = lds + st * STG;
#pragma unroll
    for (int ks = 0; ks < 2; ++ks) {
      const int co = ((ks * 2 + hi) ^ sw) << 4;
      bf16x8 a[4], b[2];
#pragma unroll
      for (int mi = 0; mi < 4; ++mi) a[mi] = *(const bf16x8*)(base + arow + mi * 2048 + co);
#pragma unroll
      for (int ni = 0; ni < 2; ++ni) b[ni] = *(const bf16x8*)(base + brow + ni * 2048 + co);
#pragma unroll
      for (int mi = 0; mi < 4; ++mi) { acc[mi][0] = mfma32(b[0], a[mi], acc[mi][0]); acc[mi][1] = mfma32(b[1], a[mi], acc[mi][1]); }
#pragma unroll
      for (int mi = 0; mi < 4; ++mi) { const u32x4 x = __builtin_bit_cast(u32x4, a[mi]);
#pragma unroll
        for (int q = 0; q < 4; ++q) ssq[mi] = dot2bf(x[q], x[q], ssq[mi]); }
    }
    st = st == 2 ? 0 : st + 1;
  }
#undef GST
  __syncthreads();
  float rs[4];
#pragma unroll
  for (int mi = 0; mi < 4; ++mi) { const float t = ssq[mi] + shx(ssq[mi], 32); rs[mi] = rsqrtf(t / (float)K + RMS_EPS); }
  const int rowb = wm * 128, colb = wn * 64;
  if constexpr (EPI == EPI_A || EPI == EPI_QKV) {
    constexpr int OROW = 272;
    u16* outp; int ldo; bool rope = false;
    if constexpr (EPI == EPI_A) { outp = p.cqkv; ldo = 768; rope = (n0 + colb == 640); }
    else { outp = p.qkv; ldo = 3072; }
#pragma unroll
    for (int mi = 0; mi < 4; ++mi) {
      const int rl = rowb + mi * 32 + r32; const int pos = tok_pos(m0 + rl);
#pragma unroll
      for (int g = 0; g < 4; ++g) {
        f32x4 v0, v1;
#pragma unroll
        for (int e = 0; e < 4; ++e) { v0[e] = acc[mi][0][4 * g + e] * rs[mi]; v1[e] = acc[mi][1][4 * g + e] * rs[mi]; }
        if constexpr (EPI == EPI_QKV) {
          const f32x4 b0 = *(const f32x4*)(p.na_bias_s + layer * 3072 + n0 + colb + 8 * g + 4 * hi), b1 = *(const f32x4*)(p.na_bias_s + layer * 3072 + n0 + colb + 32 + 8 * g + 4 * hi);
          v0 += b0; v1 += b1;
        }
        if (rope) {
          const f32x4 c = *(const f32x4*)(p.ropeC + pos * 32 + 8 * g + 4 * hi), sn = *(const f32x4*)(p.ropeS + pos * 32 + 8 * g + 4 * hi);
          const f32x4 t0 = (v0 * c - v1 * sn) * K8_SCALE, t1 = (v0 * sn + v1 * c) * K8_SCALE;
          unsigned char* kp_ = p.k8 + (long)(m0 + rl) * 1088 + 1024 + 8 * g + 4 * hi;
          *(u32*)kp_ = pack4_fp8(t0[0], t0[1], t0[2], t0[3]); *(u32*)(kp_ + 32) = pack4_fp8(t1[0], t1[1], t1[2], t1[3]);
        }
        char* e_ = lds + rl * OROW + (colb + 8 * g + 4 * hi) * 2;
        *(u32x2*)e_ = (u32x2){cvtpk(v0[0], v0[1]), cvtpk(v0[2], v0[3])};
        *(u32x2*)(e_ + 64) = (u32x2){cvtpk(v1[0], v1[1]), cvtpk(v1[2], v1[3])};
      }
    }
    __syncthreads();
#pragma unroll 4
    for (int i = 0; i < 16; ++i) { const int c = tid + 256 * i, row = c >> 4, ch = c & 15;
      *(u32x4*)(outp + (long)(m0 + row) * ldo + n0 + ch * 8) = *(const u32x4*)(lds + row * OROW + ch * 16); }
  } else {
    constexpr int BROW = 144;
    const bool rope = (EPI == EPI_UQ) && ((n0 + colb) % 192 == 128);
    const float sc = (EPI == EPI_UQ) ? Q8_SCALE : K8_SCALE;
#pragma unroll
    for (int mi = 0; mi < 4; ++mi) {
      const int rl = rowb + mi * 32 + r32; const int pos = tok_pos(m0 + rl);
#pragma unroll
      for (int g = 0; g < 4; ++g) {
        f32x4 v0, v1;
#pragma unroll
        for (int e = 0; e < 4; ++e) { v0[e] = acc[mi][0][4 * g + e] * rs[mi] * sc; v1[e] = acc[mi][1][4 * g + e] * rs[mi] * sc; }
        if (rope) {
          const f32x4 c = *(const f32x4*)(p.ropeC + pos * 32 + 8 * g + 4 * hi), sn = *(const f32x4*)(p.ropeS + pos * 32 + 8 * g + 4 * hi);
          const f32x4 t0 = v0 * c - v1 * sn, t1 = v0 * sn + v1 * c; v0 = t0; v1 = t1;
        }
        char* e_ = lds + rl * BROW + (colb + 8 * g + 4 * hi);
        *(u32*)e_ = pack4_fp8(v0[0], v0[1], v0[2], v0[3]); *(u32*)(e_ + 32) = pack4_fp8(v1[0], v1[1], v1[2], v1[3]);
      }
    }
    __syncthreads();
    unsigned char* outb; long ldo;
    if constexpr (EPI == EPI_UQ) { outb = p.q8 + n0; ldo = 1536; } else { outb = p.k8 + (n0 >> 8) * 128; ldo = 1088; }
#pragma unroll 2
    for (int i = 0; i < 8; ++i) { const int c = tid + 256 * i, row = c >> 3, ch = c & 7;
      *(u32x4*)(outb + (long)(m0 + row) * ldo + ch * 16) = *(const u32x4*)(lds + row * BROW + ch * 16); }
  }
}

__device__ __forceinline__ void ukv_tile(KP p, int j, int mt, int nt, char* lds) {
  if (nt & 1) gemm_tile<EPI_UV, true>(p, j, p.cqkv + 384, 768, p.wukv_t[j], 256, mt * 128, nt * 128, lds);
  else gemm_tile<EPI_UK, true>(p, j, p.cqkv + 384, 768, p.wukv_t[j], 256, mt * 128, nt * 128, lds);
}
#define XB_TMO      128
#define XB_XCNT(j)  (256  + 64 * (j))
#define XB_XSUB(j)  (1280 + 64 * (j))
#define XB_XGEN(j)  (2304 + 64 * (j))
#define XB_TOP      3328
#define XB_TOPGEN   3392
#define XCD_BAR_WORDS 3456
#define XB_SPIN_CAP (1u << 18)
#define LAS __attribute__((address_space(3)))
__device__ __forceinline__ unsigned xb_ld(unsigned* p)              { return __hip_atomic_load(p, __ATOMIC_RELAXED, __HIP_MEMORY_SCOPE_AGENT); }
__device__ __forceinline__ unsigned xb_add(unsigned* p, unsigned v) { return __hip_atomic_fetch_add(p, v, __ATOMIC_RELAXED, __HIP_MEMORY_SCOPE_AGENT); }
__device__ __forceinline__ unsigned xb_xcc_id() { return (unsigned)__builtin_amdgcn_s_getreg((3 << 11) | 20) & 0xFu; }
#define XB_SPIN(cond, bar) do { unsigned _sp = 0; while (cond) { __builtin_amdgcn_s_sleep(1); \
    if ((++_sp & 255u) == 0u) { if (xb_ld(&(bar)[XB_TMO])) break; if (_sp > XB_SPIN_CAP) { atomicAdd(&(bar)[XB_TMO], 1u); break; } } } } while (0)
struct XcdBarrier { unsigned* bar; unsigned x; volatile LAS unsigned* st; };
__device__ __forceinline__ XcdBarrier xcd_barrier_post(unsigned* bar, volatile LAS unsigned* st) {
    XcdBarrier b; b.bar = bar; b.x = xb_xcc_id(); b.st = st;
    if (threadIdx.x == 0) (void)xb_add(&bar[XB_XCNT(b.x)], 1u);
    return b;
}
__device__ __forceinline__ void xcd_barrier_complete(unsigned* bar, unsigned x, unsigned& nloc, unsigned& nx) {
    const unsigned G = gridDim.x * gridDim.y * gridDim.z;
    unsigned sum, cnt, mine, sp = 0u;
    for (;;) {
        sum = 0u; cnt = 0u; mine = 0u;
#pragma unroll
        for (unsigned j = 0; j < 16; ++j) { const unsigned c = xb_ld(&bar[XB_XCNT(j)]); sum += c; cnt += (c > 0u) ? 1u : 0u; mine = (j == x) ? c : mine; }
        if (sum == G) break;
        __builtin_amdgcn_s_sleep(1);
        if ((++sp & 255u) == 0u) { if (xb_ld(&bar[XB_TMO])) break; if (sp > XB_SPIN_CAP) { atomicAdd(&bar[XB_TMO], 1u); break; } }
    }
    nloc = mine > 0u ? mine : 1u; nx = cnt > 0u ? cnt : 1u;
}
__device__ __forceinline__ void xcd_barrier(const XcdBarrier& b) {
    asm volatile("s_waitcnt vmcnt(0)" ::: "memory");
    __syncthreads();
    if (threadIdx.x == 0) {
        unsigned* bar = b.bar;
        __builtin_amdgcn_s_waitcnt(0);
        unsigned nloc = b.st[0], nx = b.st[1];
        if (nloc == 0u) { xcd_barrier_complete(bar, b.x, nloc, nx); b.st[0] = nloc; b.st[1] = nx; }
        const unsigned old = xb_add(&bar[XB_XSUB(b.x)], 1u);
        const unsigned gen = old / nloc;
        if (old + 1u == (gen + 1u) * nloc) {
            __builtin_amdgcn_fence(__ATOMIC_RELEASE, "agent");
            asm volatile("s_waitcnt vmcnt(0)" ::: "memory");
            const unsigned og = xb_add(&bar[XB_TOP], 1u);
            const unsigned tg = og / nx;
            if (og + 1u == (tg + 1u) * nx) xb_add(&bar[XB_TOPGEN], 1u);
            else XB_SPIN(xb_ld(&bar[XB_TOPGEN]) == tg, bar);
            __builtin_amdgcn_fence(__ATOMIC_ACQUIRE, "agent");
            xb_add(&bar[XB_XGEN(b.x)], 1u);
            asm volatile("s_waitcnt vmcnt(0)" ::: "memory");
        } else {
            XB_SPIN(xb_ld(&bar[XB_XGEN(b.x)]) == gen, bar);
            __builtin_amdgcn_fence(__ATOMIC_ACQUIRE, "agent");
            asm volatile("s_waitcnt vmcnt(0)" ::: "memory");
        }
    }
    __syncthreads();
}

#define GEMM_PHASE(SUB, MTILES, NTILES, SM, SN, CALL) do { \
    const int nsn_ = (NTILES) / (SN), nsuper_ = ((MTILES) / (SM)) * nsn_, per_ = (SM) * (SN); \
    const int xcd_ = blockIdx.x & 7; \
    const int total_ = ((nsuper_ - xcd_ + 7) >> 3) * per_;            \
    unsigned* q_ = p.bar + XCD_BAR_WORDS + 64 + (ph * 3 + (SUB)) * 8 + xcd_; \
    for (;;) { \
      if (threadIdx.x == 0) xb_words[2] = atomicAdd(q_, 1u); \
      __syncthreads(); const int idx_ = (int)xb_words[2]; __syncthreads(); \
      if (idx_ >= total_) break; \
      const int r_ = idx_ / per_, l_ = idx_ - r_ * per_, s_ = xcd_ + 8 * r_, sm_ = s_ / nsn_, sn_ = s_ - sm_ * nsn_; \
      const int mt = sm_ * (SM) + l_ / (SN), nt = sn_ * (SN) + l_ % (SN); CALL; } } while (0)

__global__ void __launch_bounds__(NTHR, LB2) mega(const Params p_unused, int ph_lo, int ph_hi) {
  __shared__ __attribute__((aligned(16))) char lds[SMEM_BYTES];
  volatile LAS unsigned* xb_words = (volatile LAS unsigned*)(lds + SMEM_BYTES - 16);
  constexpr int MT = T_TOK / 128;
  XcdBarrier xb;
  { const __attribute__((address_space(4))) Params* pp0 = (const __attribute__((address_space(4))) Params*)__builtin_amdgcn_kernarg_segment_ptr();
    if (threadIdx.x < 4) xb_words[threadIdx.x] = 0u;
    __syncthreads();
    xb = xcd_barrier_post(pp0->bar, xb_words); }
  for (int ph = ph_lo; ph < ph_hi; ++ph) {
    const __attribute__((address_space(4))) Params* pp = (const __attribute__((address_space(4))) Params*)__builtin_amdgcn_kernarg_segment_ptr();
    asm volatile("" : "+s"(pp));
    KP p = *pp;
    const int type = p.prog_type[ph], layer = p.prog_layer[ph];
    const int j = layer >> 1;
    switch (type) {
      case PH_PREP: if (!PHON(PH_PREP)) break; phase_prep(p, lds); break;
      case PH_MLA_A: if (!PHON(PH_MLA_A)) break;
        GEMM_PHASE(0, MT / 2, 6, 8, 6, (gemm_big<EPI_A>(p, j, p.xb, DM, p.wa_t[j], 1024, mt * 256, nt * 128, lds)));
        break;
      case PH_MLA_B: if (!PHON(PH_MLA_B)) break;
        GEMM_PHASE(0, MT / 2, 12, 16, 4, (gemm_big<EPI_UQ>(p, j, p.cqkv, 768, p.wuq_t[j], 384, mt * 256, nt * 128, lds)));
        GEMM_PHASE(1, MT / 2, 8, 8, 8, (gemm_big<EPI_UK>(p, j, p.cqkv + 384, 768, p.wukv_t[j], 256, mt * 256, nt * 256, lds)));
        GEMM_PHASE(2, MT, 8, 8, 8, (gemm_tile<EPI_UV, true>(p, j, p.cqkv + 384, 768, p.wukv_t[j], 256, mt * 128, nt * 256 + 128, lds)));
        break;
      case PH_MLA_ATT: if (!PHON(PH_MLA_ATT)) break;
#ifndef SKEW_BIT
#define SKEW_BIT 256
#endif
        if (blockIdx.x & SKEW_BIT) { __builtin_amdgcn_s_sleep(24); __builtin_amdgcn_s_setprio(1); }
        {
          unsigned* ctr = p.bar + XCD_BAR_WORDS + ph;
          for (;;) {
            if (threadIdx.x == 0) xb_words[2] = atomicAdd(ctr, 1u);
            __syncthreads();
            const int t = (int)xb_words[2];
            __syncthreads();
            if (t < 3072) attn_mla(p, t, lds);
            else if (PEER_FP4 && layer == 0 && t < 3072 + TBL_NCHUNK) convert_tables_chunk(p, t - 3072);
            else if (PEER_FP4 && layer == 0 && t < 3072 + TBL_NCHUNK + (p.ntiles_prep - p.jobs[4].tile0)) prep_transpose_tile(p, t - 3072 - TBL_NCHUNK + p.jobs[4].tile0, lds);
            else break;
          } }
        __builtin_amdgcn_s_setprio(0);
        break;
      case PH_MLA_O: if (!PHON(PH_MLA_O)) break;
        GEMM_PHASE(0, MT, 8, 8, 8, (gemm_tile<EPI_O, false>(p, j, p.o, 1024, p.mla_wo_t[j], 1024, mt * 128, nt * 128, lds)));
        break;
      case PH_NA_QKV: if (!PHON(PH_NA_QKV)) break;
        GEMM_PHASE(0, MT / 2, 24, 8, 8, (gemm_big<EPI_QKV>(p, j, p.xb, DM, p.na_wqkv_t[j], 1024, mt * 256, nt * 128, lds)));
        break;
      case PH_NA_ATT: if (!PHON(PH_NA_ATT)) break;
        if (blockIdx.x & SKEW_BIT) { __builtin_amdgcn_s_sleep(12); }
        { unsigned* ctr = p.bar + XCD_BAR_WORDS + ph;
          for (;;) {
            if (threadIdx.x == 0) xb_words[2] = atomicAdd(ctr, 1u);
            __syncthreads();
            const int t = (int)xb_words[2];
            __syncthreads();
            if (t >= 6144) break;
            attn_item<1>(p, j, t, lds);
          } }
        break;
      case PH_NA_O: if (!PHON(PH_NA_O)) break;
        GEMM_PHASE(0, MT, 8, 8, 8, (gemm_tile<EPI_O, false>(p, j, p.o, 1024, p.na_wo_t[j], 1024, mt * 128, nt * 128, lds)));
        break;
      case PH_PEER_Q: if (!PHON(PH_PEER_Q)) break;
        GEMM_PHASE(0, MT, 16, 8, 8, (gemm_tile<EPI_PEER, true>(p, layer, p.xb, DM, p.peer_wq_t[layer], 1024, mt * 128, nt * 128, lds)));
        break;
      case PH_PEER_C: if (!PHON(PH_PEER_C)) break; phase_peer_combine(p, layer, lds, p.bar + XCD_BAR_WORDS + ph); break;
      case PH_FINAL: if (!PHON(PH_FINAL)) break; phase_final(p); break;
      default: break;
    }
    if (ph + 1 < ph_hi) { if (ph_hi > 1000) cg::this_grid().sync(); else xcd_barrier(xb); }
  }
}

extern "C" void kernel_launch(void* const* d_in, const int* in_sizes, int n_in, void* d_out, int out_size, void* d_ws, size_t ws_size, hipStream_t stream) {
  static int grid_blocks = 0, n_cus = 0;
  if (!grid_blocks) {
    int dev = 0, cus = 0;
    (void)hipGetDevice(&dev);
    (void)hipDeviceGetAttribute(&cus, hipDeviceAttributeMultiprocessorCount, dev);
    if (cus < 8) cus = 256;
    n_cus = cus;
    grid_blocks = cus * 2;
  }
  Params p; memset(&p, 0, sizeof(p));
  const float* const* in = (const float* const*)d_in;
  char* ws = (char*)d_ws; size_t off = 0;
  auto alloc = [&](size_t bytes) -> void* { void* r = ws + off; off += (bytes + 255) & ~(size_t)255; return r; };
  p.xin0 = in[0]; p.xin1 = in[1]; p.x = (float*)d_out; p.norm_final = in[4];
  for (int l = 0; l < 2; ++l) {
    p.wa_t[l] = (u16*)alloc(768UL * 1024 * 2); p.wuq_t[l] = (u16*)alloc(1536UL * 384 * 2); p.wukv_t[l] = (u16*)alloc(2048UL * 256 * 2); p.mla_wo_t[l] = (u16*)alloc(1024UL * 1024 * 2);
    p.na_wqkv_t[l] = (u16*)alloc(3072UL * 1024 * 2); p.na_wo_t[l] = (u16*)alloc(1024UL * 1024 * 2);
  }
  for (int l = 0; l < 4; ++l) p.peer_wq_t[l] = (u16*)alloc(2048UL * 1024 * 2);
  p.na_bias_s = (float*)alloc(2 * 3072 * 4); p.na_rpb_s = (float*)alloc(2 * 16 * 465 * 4);
  p.peer_sk = (u16*)alloc(4UL * 8 * 2 * 128 * 128 * 2);
  p.peer_u8 = (unsigned char*)alloc(4UL * 16384 * 1024); p.peer_v8 = (unsigned char*)alloc(4UL * 16384 * 1024);
  p.ropeC = (float*)alloc(16384UL * 32 * 4); p.ropeS = (float*)alloc(16384UL * 32 * 4);
  p.bar = (unsigned*)alloc((XCD_BAR_WORDS + 1024) * 4);
  p.o = (u16*)alloc((size_t)T_TOK * 1024 * 2); p.xb = (u16*)alloc((size_t)T_TOK * 1024 * 2);
  char* un = (char*)alloc((size_t)T_TOK * (768 + 1536 + 2048) * 2);
  p.cqkv = (u16*)un; p.q = (u16*)(un + (size_t)T_TOK * 768 * 2); p.kv = (u16*)(un + (size_t)T_TOK * (768 + 1536) * 2);
  { unsigned char* b8 = (unsigned char*)un + (size_t)T_TOK * 768 * 2; p.q8 = b8; p.k8 = b8 + (size_t)T_TOK * 1536; p.kpe8 = p.k8; p.vT8 = p.k8 + (size_t)T_TOK * 1088; }
  p.qkv = (u16*)un; p.pkeys = (u32*)un;
  if (off > ws_size) { fprintf(stderr, "kernel_launch: workspace too small: need %zu have %zu\n", off, ws_size); return; }
  p.in_sub_keys = in[17]; p.in_peer_u = in[18]; p.in_peer_v = in[19]; p.in_norm_ffn = in[3]; p.in_na_bias = in[13]; p.in_na_rpb = in[14];
  for (int jf = 0; jf < 32; ++jf) p.inv_freq[jf] = pow(10000.0, -(double)(2 * jf) / 64.0);
  int nj = 0, tile = 0;
  auto job = [&](const float* src, u16* dst, const float* gain, int K, int N, float scale, int scale_cols) {
    PrepJob& J = p.jobs[nj++]; J.src = src; J.dst = dst; J.gain = gain; J.K = K; J.N = N; J.tile0 = tile; J.scale = scale; J.scale_cols = scale_cols; J.pad = 0; tile += (K / 64) * (N / 64); };
  const float sc_mla = (float)(pow(192.0, -0.5) * 1.4426950408889634);
  for (int l = 0; l < 2; ++l) {
    job(in[5] + (size_t)l * 1024 * 384, p.wa_t[l], in[2] + (2 * l) * 1024, 1024, 384, 1.f, 0);
    job(in[8] + (size_t)l * 1024 * 320, p.wa_t[l] + 384UL * 1024, in[2] + (2 * l) * 1024, 1024, 320, 1.f, 0);
    job(in[7] + (size_t)l * 384 * 1536, p.wuq_t[l], in[6] + l * 384, 384, 1536, sc_mla, 1536);
    job(in[10] + (size_t)l * 256 * 2048, p.wukv_t[l], in[9] + l * 256, 256, 2048, 1.f, 0);
    job(in[11] + (size_t)l * 1024 * 1024, p.mla_wo_t[l], nullptr, 1024, 1024, 1.f, 0);
    job(in[12] + (size_t)l * 1024 * 3072, p.na_wqkv_t[l], in[2] + (2 * l + 1) * 1024, 1024, 3072, 0.125f * 1.4426950408889634f, 1024);
    job(in[15] + (size_t)l * 1024 * 1024, p.na_wo_t[l], nullptr, 1024, 1024, 1.f, 0);
  }
  for (int l = 0; l < 4; ++l) job(in[16] + (size_t)l * 1024 * 2048, p.peer_wq_t[l], in[3] + l * 1024, 1024, 2048, 1.f, 0);
  p.njobs = nj; p.ntiles_prep = tile;
  int np = 0;
#ifndef DUPMASK
#define DUPMASK 0
#endif
  auto ph = [&](int type, int layer) { p.prog_type[np] = type; p.prog_layer[np] = layer; ++np;
    if ((DUPMASK >> type) & 1) { p.prog_type[np] = type; p.prog_layer[np] = layer; ++np; } };
  ph(PH_PREP, 0);
  for (int i = 0; i < 4; ++i) {
    if ((i & 1) == 0) { ph(PH_MLA_A, i); ph(PH_MLA_B, i); ph(PH_MLA_ATT, i); ph(PH_MLA_O, i); }
    else { ph(PH_NA_QKV, i); ph(PH_NA_ATT, i); ph(PH_NA_O, i); }
    ph(PH_PEER_Q, i); ph(PH_PEER_C, i);
  }
  p.nprog = np;
#if COOP
  (void)hipMemsetAsync(p.bar, 0, (XCD_BAR_WORDS + 1024) * 4, stream);
  int lo = 0, hi = np;
  void* args[] = {(void*)&p, (void*)&lo, (void*)&hi};
  hipError_t e = hipLaunchCooperativeKernel((const void*)mega, dim3(grid_blocks), dim3(NTHR), args, 0, stream);
  if (e != hipSuccess && grid_blocks != n_cus) {
    (void)hipGetLastError(); grid_blocks = n_cus;
    e = hipLaunchCooperativeKernel((const void*)mega, dim3(grid_blocks), dim3(NTHR), args, 0, stream);
  }
  if (e != hipSuccess) fprintf(stderr, "cooperative launch failed: %s (grid %d)\n", hipGetErrorString(e), grid_blocks);
#else
  for (int i = 0; i < np; ++i) hipLaunchKernelGGL(mega, dim3(grid_blocks), dim3(NTHR), 0, stream, p, i, i + 1);
#endif
}
```

```cpp
#include <hip/hip_runtime.h>
#include <hip/hip_cooperative_groups.h>
#include <stdint.h>
#include <string.h>
#include <math.h>
#include <cstdio>
namespace cg = cooperative_groups;

#ifndef COOP
#define COOP 1
#endif
#ifndef PHMASK
#define PHMASK 0xFFFF
#endif
#ifndef LB2
#define LB2 2
#endif
#define PHON(t) ((PHMASK >> (t)) & 1)

typedef unsigned short u16;
typedef unsigned int u32;
using bf16x8 = __attribute__((ext_vector_type(8))) short;
using s16x4  = __attribute__((ext_vector_type(4))) short;
using f32x16 = __attribute__((ext_vector_type(16))) float;
using f32x4  = __attribute__((ext_vector_type(4))) float;
using u32x4  = __attribute__((ext_vector_type(4))) unsigned;
using u32x2  = __attribute__((ext_vector_type(2))) unsigned;
typedef __attribute__((ext_vector_type(2))) __bf16 v2bf;

constexpr int T_TOK = 49152, T_PROMPT = 16384, DM = 1024;
constexpr int NTHR = 256;
constexpr float LOG2E = 1.4426950408889634f;
constexpr float RMS_EPS = 1e-6f;

enum { PH_PREP = 0, PH_MLA_A, PH_MLA_B, PH_MLA_ATT, PH_MLA_O, PH_NA_QKV, PH_NA_ATT, PH_NA_O, PH_PEER_Q, PH_PEER_C, PH_FINAL };

struct PrepJob { const float* src; u16* dst; const float* gain; int K, N, tile0, scale_cols; float scale; int pad; };

struct Params {
  const float* xin0; const float* xin1;
  float* x; u16* xb;
  const float* norm_final;
  u16* wa_t[2]; u16* wuq_t[2]; u16* wukv_t[2]; u16* mla_wo_t[2];
  u16* na_wqkv_t[2]; u16* na_wo_t[2]; float* na_bias_s; float* na_rpb_s;
  u16* peer_wq_t[4]; u16* peer_sk; unsigned char* peer_u8; unsigned char* peer_v8;
  u16* cqkv; u16* q; u16* kv; u16* o; u16* qkv; u32* pkeys;
  unsigned char* q8; unsigned char* k8; unsigned char* kpe8; unsigned char* vT8;
  float* ropeC; float* ropeS; unsigned* bar;
  const float* in_sub_keys; const float* in_peer_u; const float* in_peer_v; const float* in_norm_ffn; const float* in_na_bias; const float* in_na_rpb;
  PrepJob jobs[24];
  double inv_freq[32];
  int njobs, ntiles_prep;
  int prog_type[48]; int prog_layer[48];
  int nprog, pad0;
};

typedef const __attribute__((address_space(4))) Params& KP;

__device__ __forceinline__ int crow(int r, int hi) { return (r & 3) + 8 * (r >> 2) + 4 * hi; }
__device__ __forceinline__ u32 cvtpk(float lo, float hi) { u32 r; asm("v_cvt_pk_bf16_f32 %0, %1, %2" : "=v"(r) : "v"(lo), "v"(hi)); return r; }
__device__ __forceinline__ float bf_lo(u32 v) { return __uint_as_float(v << 16); }
__device__ __forceinline__ float bf_hi(u32 v) { return __uint_as_float(v & 0xffff0000u); }
__device__ __forceinline__ int tok_pos(int t) { return t < T_PROMPT ? (t & 2047) : (t & 16383); }
__device__ __forceinline__ f32x16 mfma32(bf16x8 a, bf16x8 b, f32x16 c) { return __builtin_amdgcn_mfma_f32_32x32x16_bf16(a, b, c, 0, 0, 0); }
__device__ __forceinline__ float shx(float v, int m) { return __shfl_xor(v, m, 64); }

constexpr int BK = 64;
constexpr int OPB = 16384;
constexpr int GEMM_LDS = 4 * OPB;
constexpr int SMEM_BYTES = 81920;
constexpr int RSTD_OFF = 73728;

enum { EPI_A = 0, EPI_UQ, EPI_UK, EPI_UV, EPI_O, EPI_QKV, EPI_PEER };
constexpr float KEY_BIAS = 16.f;
constexpr float Q8_SCALE = 16.f, K8_SCALE = 4.f, V8_SCALE = 4.f, P8_SCALE = 128.f;
__device__ __forceinline__ u32 pack4_fp8(float a, float b, float c, float d) { int v = 0; v = __builtin_amdgcn_cvt_pk_fp8_f32(a, b, v, false); v = __builtin_amdgcn_cvt_pk_fp8_f32(c, d, v, true); return (u32)v; }

__device__ __forceinline__ float dot2bf(u32 a, u32 b, float c) { return __builtin_amdgcn_fdot2_f32_bf16(__builtin_bit_cast(v2bf, a), __builtin_bit_cast(v2bf, b), c, false); }

template <int EPI, bool NORM>
__device__ __forceinline__ void gemm_tile(KP p, int layer, const u16* Ap, int lda, const u16* Bt, int K, int m0, int n0, char* lds) {
  int tid_ = threadIdx.x; asm volatile("" : "+v"(tid_));
  const int tid = tid_, lane = tid & 63, w = tid >> 6;
  const int wm = w >> 1, wn = w & 1, r32 = lane & 31, hi = lane >> 5;
  float* rstd_l = (float*)(lds + RSTD_OFF);
  const int srow = w * 32 + (lane >> 2);
  const int scol = ((lane & 3) ^ ((lane >> 4) & 3)) * 8;
  const u16* Ag = Ap + (long)(m0 + srow) * lda + scol;
  const u16* Bg = Bt + (long)(n0 + srow) * K + scol;
#define GSTAGE(st, kt) do { _Pragma("unroll") for (int j = 0; j < 2; ++j) { \
    __builtin_amdgcn_global_load_lds((const unsigned*)(Ag + (long)j * 16 * lda + (kt) * 32), (unsigned*)(lds + (st) * 16384 + (w * 2 + j) * 1024), 16, 0, 0); \
    __builtin_amdgcn_global_load_lds((const unsigned*)(Bg + (long)j * 16 * K + (kt) * 32), (unsigned*)(lds + (st) * 16384 + 8192 + (w * 2 + j) * 1024), 16, 0, 0); } } while (0)
  f32x16 acc[2][2];
#pragma unroll
  for (int i = 0; i < 2; ++i)
#pragma unroll
    for (int j = 0; j < 2; ++j)
#pragma unroll
      for (int r = 0; r < 16; ++r) acc[i][j][r] = 0.f;
  float ssq0 = 0.f, ssq1 = 0.f;
  bf16x8 skr[8];
  const int sw = (r32 >> 2) & 3;
  const int arow = (wm * 64 + r32) * 64, brow = 8192 + (wn * 64 + r32) * 64;
  const int co0 = ((0 + hi) ^ sw) << 4, co1 = ((2 + hi) ^ sw) << 4;
  const int nk = K / 32;

#ifndef KREP
#define KREP 1
#endif
  for (int rep_ = 0; rep_ < KREP; ++rep_) {
  if (KREP > 1) {
#pragma unroll
    for (int i = 0; i < 2; ++i)
#pragma unroll
      for (int j = 0; j < 2; ++j)
#pragma unroll
        for (int r = 0; r < 16; ++r) acc[i][j][r] = 0.f;
    ssq0 = 0.f; ssq1 = 0.f; }
  __syncthreads();
  GSTAGE(0, 0); GSTAGE(1, 1); GSTAGE(2, 2);
  if constexpr (EPI == EPI_PEER) {
    const u16* sk = p.peer_sk + ((long)layer * 16 + (n0 >> 7)) * 16384;
#pragma unroll
    for (int i = 0; i < 8; ++i) { const int c = tid + 256 * i; skr[i] = *(const bf16x8*)(sk + (c >> 4) * 128 + (c & 15) * 8); }
  }
  for (int kt = 0; kt < nk; ++kt) {
    if (kt + 2 < nk) asm volatile("s_waitcnt vmcnt(8)" ::: "memory");
    else if (kt + 1 < nk) asm volatile("s_waitcnt vmcnt(4)" ::: "memory");
    else asm volatile("s_waitcnt vmcnt(0)" ::: "memory");
    asm volatile("s_waitcnt lgkmcnt(0)" ::: "memory");
    __builtin_amdgcn_s_barrier();
    if (kt + 3 < nk) GSTAGE((kt + 3) & 3, kt + 3);
    const char* base = lds + (kt & 3) * 16384;
    {
      const bf16x8 a0 = *(const bf16x8*)(base + arow + co0), a1 = *(const bf16x8*)(base + arow + 32 * 64 + co0);
      const bf16x8 b0 = *(const bf16x8*)(base + brow + co0), b1 = *(const bf16x8*)(base + brow + 32 * 64 + co0);
      const bf16x8 c0 = *(const bf16x8*)(base + arow + co1), c1 = *(const bf16x8*)(base + arow + 32 * 64 + co1);
      const bf16x8 d0 = *(const bf16x8*)(base + brow + co1), d1 = *(const bf16x8*)(base + brow + 32 * 64 + co1);
      if constexpr (EPI != EPI_UV) {
        acc[0][0] = mfma32(b0, a0, acc[0][0]); acc[0][1] = mfma32(b1, a0, acc[0][1]);
        acc[1][0] = mfma32(b0, a1, acc[1][0]); acc[1][1] = mfma32(b1, a1, acc[1][1]);
        acc[0][0] = mfma32(d0, c0, acc[0][0]); acc[0][1] = mfma32(d1, c0, acc[0][1]);
        acc[1][0] = mfma32(d0, c1, acc[1][0]); acc[1][1] = mfma32(d1, c1, acc[1][1]);
      } else {
        acc[0][0] = mfma32(a0, b0, acc[0][0]); acc[0][1] = mfma32(a0, b1, acc[0][1]);
        acc[1][0] = mfma32(a1, b0, acc[1][0]); acc[1][1] = mfma32(a1, b1, acc[1][1]);
        acc[0][0] = mfma32(c0, d0, acc[0][0]); acc[0][1] = mfma32(c0, d1, acc[0][1]);
        acc[1][0] = mfma32(c1, d0, acc[1][0]); acc[1][1] = mfma32(c1, d1, acc[1][1]);
      }
      if constexpr (NORM) {
        const u32x4 x0 = __builtin_bit_cast(u32x4, a0), x1 = __builtin_bit_cast(u32x4, a1), y0 = __builtin_bit_cast(u32x4, c0), y1 = __builtin_bit_cast(u32x4, c1);
#pragma unroll
        for (int q = 0; q < 4; ++q) { ssq0 = dot2bf(x0[q], x0[q], ssq0); ssq1 = dot2bf(x1[q], x1[q], ssq1); ssq0 = dot2bf(y0[q], y0[q], ssq0); ssq1 = dot2bf(y1[q], y1[q], ssq1); }
      }
    }
  }
  }
#undef GSTAGE
  __syncthreads();
  float rs[2] = {1.f, 1.f};
  if constexpr (NORM) {
    ssq0 += shx(ssq0, 32); ssq1 += shx(ssq1, 32);
    rs[0] = rsqrtf(ssq0 / (float)K + RMS_EPS); rs[1] = rsqrtf(ssq1 / (float)K + RMS_EPS);
  }
  const int rowb = wm * 64, colb = wn * 64;
  if constexpr (EPI == EPI_A || EPI == EPI_QKV) {
    constexpr int OROW = 272;
    u16* outp; int ldo; bool rope = false;
    if constexpr (EPI == EPI_A) { outp = p.cqkv; ldo = 768; rope = (n0 + colb == 640); }
    else { outp = p.qkv; ldo = 3072; }
#pragma unroll
    for (int mi = 0; mi < 2; ++mi) {
      const int rl = rowb + mi * 32 + r32; const int pos = tok_pos(m0 + rl);
#pragma unroll
      for (int g = 0; g < 4; ++g) {
        f32x4 v0, v1;
#pragma unroll
        for (int e = 0; e < 4; ++e) { v0[e] = acc[mi][0][4 * g + e] * rs[mi]; v1[e] = acc[mi][1][4 * g + e] * rs[mi]; }
        if constexpr (EPI == EPI_QKV) {
          const f32x4 b0 = *(const f32x4*)(p.na_bias_s + layer * 3072 + n0 + colb + 8 * g + 4 * hi), b1 = *(const f32x4*)(p.na_bias_s + layer * 3072 + n0 + colb + 32 + 8 * g + 4 * hi);
          v0 += b0; v1 += b1;
        }
        if (rope) {
          const f32x4 c = *(const f32x4*)(p.ropeC + pos * 32 + 8 * g + 4 * hi), sn = *(const f32x4*)(p.ropeS + pos * 32 + 8 * g + 4 * hi);
          const f32x4 t0 = (v0 * c - v1 * sn) * K8_SCALE, t1 = (v0 * sn + v1 * c) * K8_SCALE;
          unsigned char* kp_ = p.k8 + (long)(m0 + rl) * 1088 + 1024 + 8 * g + 4 * hi;
          *(u32*)kp_ = pack4_fp8(t0[0], t0[1], t0[2], t0[3]); *(u32*)(kp_ + 32) = pack4_fp8(t1[0], t1[1], t1[2], t1[3]);
        }
        char* e_ = lds + rl * OROW + (colb + 8 * g + 4 * hi) * 2;
        *(u32x2*)e_ = (u32x2){cvtpk(v0[0], v0[1]), cvtpk(v0[2], v0[3])};
        *(u32x2*)(e_ + 64) = (u32x2){cvtpk(v1[0], v1[1]), cvtpk(v1[2], v1[3])};
      }
    }
    __syncthreads();
#pragma unroll
    for (int i = 0; i < 8; ++i) { const int c = tid + 256 * i, row = c >> 4, ch = c & 15;
      *(u32x4*)(outp + (long)(m0 + row) * ldo + n0 + ch * 8) = *(const u32x4*)(lds + row * OROW + ch * 16); }
  } else if constexpr (EPI == EPI_UQ || EPI == EPI_UK) {
    constexpr int BROW = 144;
    const bool rope = (EPI == EPI_UQ) && ((n0 + colb) % 192 == 128);
    const float sc = (EPI == EPI_UQ) ? Q8_SCALE : K8_SCALE;
#pragma unroll
    for (int mi = 0; mi < 2; ++mi) {
      const int rl = rowb + mi * 32 + r32; const int pos = tok_pos(m0 + rl);
#pragma unroll
      for (int g = 0; g < 4; ++g) {
        f32x4 v0, v1;
#pragma unroll
        for (int e = 0; e < 4; ++e) { v0[e] = acc[mi][0][4 * g + e] * rs[mi] * sc; v1[e] = acc[mi][1][4 * g + e] * rs[mi] * sc; }
        if (rope) {
          const f32x4 c = *(const f32x4*)(p.ropeC + pos * 32 + 8 * g + 4 * hi), sn = *(const f32x4*)(p.ropeS + pos * 32 + 8 * g + 4 * hi);
          const f32x4 t0 = v0 * c - v1 * sn, t1 = v0 * sn + v1 * c; v0 = t0; v1 = t1;
        }
        char* e_ = lds + rl * BROW + (colb + 8 * g + 4 * hi);
        *(u32*)e_ = pack4_fp8(v0[0], v0[1], v0[2], v0[3]); *(u32*)(e_ + 32) = pack4_fp8(v1[0], v1[1], v1[2], v1[3]);
      }
    }
    __syncthreads();
    unsigned char* outb; long ldo;
    if constexpr (EPI == EPI_UQ) { outb = p.q8 + n0; ldo = 1536; } else { outb = p.k8 + (n0 >> 8) * 128; ldo = 1088; }
#pragma unroll
    for (int i = 0; i < 4; ++i) { const int c = tid + 256 * i, row = c >> 3, ch = c & 7;
      *(u32x4*)(outb + (long)(m0 + row) * ldo + ch * 16) = *(const u32x4*)(lds + row * BROW + ch * 16); }
  } else if constexpr (EPI == EPI_UV) {
    constexpr int BROW = 144;
#pragma unroll
    for (int mi = 0; mi < 2; ++mi) {
#pragma unroll
      for (int g = 0; g < 4; ++g) {
        float rr[4];
#pragma unroll
        for (int e = 0; e < 4; ++e) rr[e] = __int_as_float(__builtin_amdgcn_ds_bpermute((8 * g + 4 * hi + e) << 2, __float_as_int(rs[mi]))) * V8_SCALE;
#pragma unroll
        for (int ni = 0; ni < 2; ++ni) {
          char* e_ = lds + (colb + ni * 32 + r32) * BROW + rowb + mi * 32 + 8 * g + 4 * hi;
          *(u32*)e_ = pack4_fp8(acc[mi][ni][4 * g] * rr[0], acc[mi][ni][4 * g + 1] * rr[1], acc[mi][ni][4 * g + 2] * rr[2], acc[mi][ni][4 * g + 3] * rr[3]);
        }
      }
    }
    __syncthreads();
    unsigned char* outb = p.vT8 + (long)((n0 >> 8) * 128) * T_TOK + m0;
#pragma unroll
    for (int i = 0; i < 4; ++i) { const int c = tid + 256 * i, d = c >> 3, ch = c & 7;
      *(u32x4*)(outb + (long)d * T_TOK + ch * 16) = *(const u32x4*)(lds + d * BROW + ch * 16); }
  } else if constexpr (EPI == EPI_O) {
    constexpr int FROW = 528;
#pragma unroll
    for (int mi = 0; mi < 2; ++mi) {
      const int rl = rowb + mi * 32 + r32;
#pragma unroll
      for (int ni = 0; ni < 2; ++ni)
#pragma unroll
        for (int g = 0; g < 4; ++g)
          *(f32x4*)(lds + rl * FROW + (colb + ni * 32 + 8 * g + 4 * hi) * 4) = (f32x4){acc[mi][ni][4 * g], acc[mi][ni][4 * g + 1], acc[mi][ni][4 * g + 2], acc[mi][ni][4 * g + 3]};
    }
    __syncthreads();
#pragma unroll 4
    for (int i = 0; i < 16; ++i) { const int c = tid + 256 * i, row = c >> 5, ch = c & 31;
      const f32x4 a = *(const f32x4*)(lds + row * FROW + ch * 16);
      float* xp = p.x + (long)(m0 + row) * DM + n0 + ch * 4;
      const float* xsrc = xp;
      if (layer < 0) xsrc = (m0 < T_PROMPT ? p.xin0 + (long)(m0 + row) * DM : p.xin1 + (long)(m0 + row - T_PROMPT) * DM) + n0 + ch * 4;
      f32x4 xv = *(const f32x4*)xsrc; xv += a; *(f32x4*)xp = xv;
      *(u32x2*)(p.xb + (long)(m0 + row) * DM + n0 + ch * 4) = (u32x2){cvtpk(xv[0], xv[1]), cvtpk(xv[2], xv[3])}; }
  } else {
    constexpr int QROW = 272;
    char* Qs = lds; char* Ss = lds + 128 * QROW;
    const int hp = n0 >> 7;
#pragma unroll
    for (int mi = 0; mi < 2; ++mi) {
      const int rl = rowb + mi * 32 + r32;
#pragma unroll
      for (int g = 0; g < 4; ++g) {
        char* e_ = Qs + rl * QROW + (colb + 8 * g + 4 * hi) * 2;
        *(u32x2*)e_ = (u32x2){cvtpk(acc[mi][0][4 * g] * rs[mi], acc[mi][0][4 * g + 1] * rs[mi]), cvtpk(acc[mi][0][4 * g + 2] * rs[mi], acc[mi][0][4 * g + 3] * rs[mi])};
        *(u32x2*)(e_ + 64) = (u32x2){cvtpk(acc[mi][1][4 * g] * rs[mi], acc[mi][1][4 * g + 1] * rs[mi]), cvtpk(acc[mi][1][4 * g + 2] * rs[mi], acc[mi][1][4 * g + 3] * rs[mi])};
      }
    }
#pragma unroll
    for (int i = 0; i < 8; ++i) { const int c = tid + 256 * i, kr = c >> 4, ch = c & 15; *(bf16x8*)(Ss + kr * QROW + ch * 16) = skr[i]; }
    __syncthreads();
    f32x16 a2[2][2];
#pragma unroll
    for (int i = 0; i < 2; ++i)
#pragma unroll
      for (int j = 0; j < 2; ++j)
#pragma unroll
        for (int r = 0; r < 16; ++r) a2[i][j][r] = 0.f;
    { const char* Ar = Qs + (rowb + r32) * QROW + hi * 16; const char* Br = Ss + (colb + r32) * QROW + hi * 16;
#pragma unroll
      for (int ks = 0; ks < 8; ++ks) {
        bf16x8 a0 = *(const bf16x8*)(Ar + ks * 32), a1 = *(const bf16x8*)(Ar + 32 * QROW + ks * 32);
        bf16x8 b0 = *(const bf16x8*)(Br + ks * 32), b1 = *(const bf16x8*)(Br + 32 * QROW + ks * 32);
        a2[0][0] = mfma32(b0, a0, a2[0][0]); a2[0][1] = mfma32(b1, a0, a2[0][1]);
        a2[1][0] = mfma32(b0, a1, a2[1][0]); a2[1][1] = mfma32(b1, a1, a2[1][1]);
      } }
    __syncthreads();
    constexpr int SROW = 544;
    char* Sc = lds;
#pragma unroll
    for (int mi = 0; mi < 2; ++mi) {
      const int rl = rowb + mi * 32 + r32;
#pragma unroll
      for (int ni = 0; ni < 2; ++ni)
#pragma unroll
        for (int g = 0; g < 4; ++g)
          *(f32x4*)(Sc + rl * SROW + (colb + ni * 32 + 8 * g + 4 * hi) * 4) = (f32x4){a2[mi][ni][4 * g], a2[mi][ni][4 * g + 1], a2[mi][ni][4 * g + 2], a2[mi][ni][4 * g + 3]};
    }
    __syncthreads();
    { const int row = tid >> 1, hf = tid & 1;
      u32 kv[64];
#pragma unroll
      for (int i = 0; i < 16; ++i) {
        const f32x4 v = *(const f32x4*)(Sc + row * SROW + (2 * i + hf) * 16);
#pragma unroll
        for (int e = 0; e < 4; ++e) { const u32 b = __float_as_uint(v[e] + KEY_BIAS);
          kv[i * 4 + e] = (b & ~127u) | (u32)((2 * i + hf) * 4 + e); }
      }
      u32 mprev = 0xffffffffu;
      u32* outk = p.pkeys + (long)(m0 + row) * 256 + hp * 16;
#pragma unroll 1
      for (int ps = 0; ps < 16; ++ps) {
        u32 best = 0;
#pragma unroll
        for (int i = 0; i < 64; ++i) { const u32 d = kv[i] - mprev; best = d > best ? d : best; }
        u32 cand = mprev + best;
        if (best < (0u - mprev)) cand = 0u;
        const u32 oth = (u32)__shfl_xor((int)cand, 1, 64);
        mprev = cand > oth ? cand : oth;
        if (hf == 0) outk[ps] = mprev;
      }
    }
  }
}

template <int OFF> __device__ __forceinline__ s16x4 tr_read(int vb) {
  s16x4 r; asm volatile("ds_read_b64_tr_b16 %0, %1 offset:%2" : "=&v"(r) : "v"(vb), "i"(OFF) : "memory"); return r;
}
__device__ __forceinline__ int v_st(int k, int c) { const int kk = (k & ~0xC) | ((k & 4) << 1) | ((k & 8) >> 1); return ((kk >> 3) * 4 + (c >> 5)) * 512 + ((kk & 7) * 32 + (c & 31)) * 2; }
__device__ __forceinline__ int v_rd_base(int lane) { return ((lane & 3) << 3) | (((lane >> 2) & 3) << 6) | (((lane >> 4) & 1) << 5) | (((lane >> 5) & 1) << 8); }
constexpr int v_rd_off(int d0, int ks, int half) { return d0 * 512 + ks * 4096 + half * 2048; }
template <int D0> __device__ __forceinline__ void pv_one(f32x16& od, int vb, bf16x8 pa0, bf16x8 pa1, bf16x8 pa2, bf16x8 pa3) {
  const s16x4 l0 = tr_read<v_rd_off(D0, 0, 0)>(vb), h0 = tr_read<v_rd_off(D0, 0, 1)>(vb), l1 = tr_read<v_rd_off(D0, 1, 0)>(vb), h1 = tr_read<v_rd_off(D0, 1, 1)>(vb);
  const s16x4 l2 = tr_read<v_rd_off(D0, 2, 0)>(vb), h2 = tr_read<v_rd_off(D0, 2, 1)>(vb), l3 = tr_read<v_rd_off(D0, 3, 0)>(vb), h3 = tr_read<v_rd_off(D0, 3, 1)>(vb);
  asm volatile("s_waitcnt lgkmcnt(0)" ::: "memory"); __builtin_amdgcn_sched_barrier(0);
#define PKV(L, H) (bf16x8){L[0], L[1], L[2], L[3], H[0], H[1], H[2], H[3]}
  od = mfma32(pa0, PKV(l0, h0), od); od = mfma32(pa1, PKV(l1, h1), od); od = mfma32(pa2, PKV(l2, h2), od); od = mfma32(pa3, PKV(l3, h3), od);
#undef PKV
}

constexpr float THR_L2 = 11.5f;

__device__ __forceinline__ void partialSM(f32x16& p0, f32x16& p1, float& m_reg, float& alpha) {
  float pmax = p0[0];
#pragma unroll
  for (int r = 1; r < 16; ++r) pmax = fmaxf(pmax, p0[r]);
#pragma unroll
  for (int r = 0; r < 16; ++r) pmax = fmaxf(pmax, p1[r]);
  { auto rr = __builtin_amdgcn_permlane32_swap(__float_as_uint(pmax), __float_as_uint(pmax), false, false);
    pmax = fmaxf(__uint_as_float(rr[0]), __uint_as_float(rr[1])); }
  float mn;
  if (__all(pmax - m_reg <= THR_L2)) { mn = m_reg; alpha = 1.f; }
  else { mn = fmaxf(m_reg, pmax); alpha = __builtin_amdgcn_exp2f(m_reg - mn); m_reg = mn; }
#pragma unroll
  for (int r = 0; r < 16; ++r) { p0[r] = __builtin_amdgcn_exp2f(p0[r] - mn); p1[r] = __builtin_amdgcn_exp2f(p1[r] - mn); }
}
__device__ __forceinline__ void finishSM(f32x16& p0, f32x16& p1, float alpha, float& l_reg, bf16x8& pa0, bf16x8& pa1, bf16x8& pa2, bf16x8& pa3) {
  float ps = 0.f;
#pragma unroll
  for (int r = 0; r < 16; ++r) ps += p0[r];
#pragma unroll
  for (int r = 0; r < 16; ++r) ps += p1[r];
  { auto rr = __builtin_amdgcn_permlane32_swap(__float_as_uint(ps), __float_as_uint(ps), false, false);
    ps = __uint_as_float(rr[0]) + __uint_as_float(rr[1]); }
  l_reg = l_reg * alpha + ps;
#define PK4(P, BASE, OUT) do { unsigned a0 = cvtpk(P[BASE + 0], P[BASE + 1]), a1 = cvtpk(P[BASE + 2], P[BASE + 3]);   \
    unsigned b0 = cvtpk(P[BASE + 4], P[BASE + 5]), b1 = cvtpk(P[BASE + 6], P[BASE + 7]);                              \
    auto r0 = __builtin_amdgcn_permlane32_swap(a0, b0, false, false); auto r1 = __builtin_amdgcn_permlane32_swap(a1, b1, false, false); \
    u32x4 w_ = {r0[0], r1[0], r0[1], r1[1]}; OUT = __builtin_bit_cast(bf16x8, w_); } while (0)
  PK4(p0, 0, pa0); PK4(p0, 8, pa1); PK4(p1, 0, pa2); PK4(p1, 8, pa3);
#undef PK4
}

constexpr int ATT_K_OFF = 0, ATT_V_OFF = 25600, ATT_WS_OFF = 41984, ATT_RPB_OFF = 43008;

template <int MODE>
__device__ __forceinline__ void attn_item(KP p, int layer, int item, char* lds) {
  constexpr int KST = MODE == 0 ? 12 : 4;
  constexpr int KROW = MODE == 0 ? 400 : 272;
  constexpr int ND0 = MODE == 0 ? 4 : 2;
  int tid_ = threadIdx.x; asm volatile("" : "+v"(tid_));
  const int tid = tid_, lane = tid & 63, w = tid >> 6, r32 = lane & 31, hi = lane >> 5;
  char* Kl = lds + ATT_K_OFF; char* Vl = lds + ATT_V_OFF;
  float* wsl = (float*)(lds + ATT_WS_OFF) + w * 64; float* al_l = wsl; float* li_l = wsl + 32;
  float* rpbl = (float*)(lds + ATT_RPB_OFF);

  int NT, qtok, ktok0, head, kcolB = 0; long obase;
  int na_c = 0, na_c0 = 0, na_relrow0 = 0, na_hl = 0;
  const u16* Qp;
  if constexpr (MODE == 0) {
    int seq, qb;
    if (item < 2048) { const int sh = item >> 7; seq = 8 + (sh >> 3); head = sh & 7; qb = item & 127; ktok0 = T_PROMPT + (seq - 8) * 16384; NT = 256; }
    else { const int it = item - 2048; const int sh = it >> 4; seq = sh >> 3; head = sh & 7; qb = it & 15; ktok0 = seq * 2048; NT = 32; }
    qtok = ktok0 + qb * 128 + w * 32 + r32;
    Qp = p.q + (long)qtok * 1536 + head * 192 + hi * 8;
    obase = (long)(ktok0 + qb * 128 + w * 32) * 1024 + head * 128;
  } else {
    const int Rg = item >> 3, hpair = item & 7;
    int grow0, r, rows;
    if (Rg < 256) { grow0 = (Rg >> 5) << 5; r = Rg & 31; rows = 32; } else { grow0 = 256 + (((Rg - 256) >> 8) << 8); r = (Rg - 256) & 255; rows = 256; }
    int r0 = r - 4; r0 = r0 < 0 ? 0 : r0; r0 = r0 > rows - 8 ? rows - 8 : r0;
    ktok0 = (grow0 + r0) * 64; NT = 8;
    na_hl = w >> 1; head = hpair * 2 + na_hl;
    na_c = (w & 1) * 32 + r32; na_c0 = na_c - 8; na_c0 = na_c0 < 0 ? 0 : na_c0; na_c0 = na_c0 > 48 ? 48 : na_c0;
    na_relrow0 = r0 - r + 7;
    qtok = Rg * 64 + na_c;
    Qp = p.qkv + (long)qtok * 3072 + head * 64 + hi * 8;
    obase = (long)(Rg * 64 + (w & 1) * 32) * 1024 + head * 64;
    kcolB = na_hl * 128;
    __syncthreads();
    { const float* src = p.na_rpb_s + ((long)layer * 16 + hpair * 2) * 465;
      for (int e = tid; e < 930; e += 256) rpbl[e] = src[e]; }
  }
  bf16x8 qr[KST];
#pragma unroll
  for (int d = 0; d < KST; ++d) qr[d] = *(const bf16x8*)(Qp + d * 16);

  bf16x8 sk[MODE == 0 ? 6 : 4], sv[4];
  const int s_key = tid >> 4, s_ch = tid & 15;
  const int s_key8 = tid >> 3, s_ch8 = tid & 7;
#define ALOAD(j) do { const long kt_ = (long)ktok0 + (j) * 64; \
    if constexpr (MODE == 0) { \
      _Pragma("unroll") for (int i = 0; i < 4; ++i) { const u16* b_ = p.kv + (kt_ + s_key + 16 * i) * 2048 + head * 256 + s_ch * 8; sk[i] = *(const bf16x8*)b_; sv[i] = *(const bf16x8*)(b_ + 128); } \
      _Pragma("unroll") for (int i = 0; i < 2; ++i) sk[4 + i] = *(const bf16x8*)(p.cqkv + (kt_ + s_key8 + 32 * i) * 768 + 640 + s_ch8 * 8); \
    } else { \
      _Pragma("unroll") for (int i = 0; i < 4; ++i) { const u16* b_ = p.qkv + (kt_ + s_key + 16 * i) * 3072 + 1024 + (head & ~1) * 64 + s_ch * 8; sk[i] = *(const bf16x8*)b_; sv[i] = *(const bf16x8*)(b_ + 1024); } \
    } } while (0)
#define AWRITE() do { \
    _Pragma("unroll") for (int i = 0; i < 4; ++i) { *(bf16x8*)(Kl + (s_key + 16 * i) * KROW + s_ch * 16) = sk[i]; *(bf16x8*)(Vl + v_st(s_key + 16 * i, s_ch * 8)) = sv[i]; } \
    if constexpr (MODE == 0) { _Pragma("unroll") for (int i = 0; i < 2; ++i) *(bf16x8*)(Kl + (s_key8 + 32 * i) * KROW + 256 + s_ch8 * 16) = sk[4 + i]; } } while (0)

  float m_reg = -1e30f, l_reg = 0.f;
  f32x16 o[ND0];
#pragma unroll
  for (int d = 0; d < ND0; ++d)
#pragma unroll
    for (int r = 0; r < 16; ++r) o[d][r] = 0.f;
  const int vb0 = (int)(uintptr_t)Vl + v_rd_base(lane) + (MODE == 1 ? na_hl * 1024 : 0);

  ALOAD(0);
  for (int j = 0; j < NT; ++j) {
    __syncthreads();
    AWRITE();
    __syncthreads();
    if (j + 1 < NT) ALOAD(j + 1);
    f32x16 p0, p1;
#pragma unroll
    for (int r = 0; r < 16; ++r) { p0[r] = 0.f; p1[r] = 0.f; }
#pragma unroll
    for (int d = 0; d < KST; ++d) {
      const int cb = kcolB + (d * 16 + hi * 8) * 2;
      bf16x8 b0 = *(const bf16x8*)(Kl + r32 * KROW + cb), b1 = *(const bf16x8*)(Kl + (32 + r32) * KROW + cb);
      p0 = mfma32(b0, qr[d], p0); p1 = mfma32(b1, qr[d], p1);
    }
    if constexpr (MODE == 1) {
      const float* rb = rpbl + (na_hl * 15 + na_relrow0 + j) * 31;
#pragma unroll
      for (int r = 0; r < 16; ++r) {
        const int kc0 = crow(r, hi), kc1 = 32 + kc0;
        int i0 = kc0 - na_c + 15, i1 = kc1 - na_c + 15;
        i0 = i0 < 0 ? 0 : (i0 > 30 ? 30 : i0); i1 = i1 < 0 ? 0 : (i1 > 30 ? 30 : i1);
        const float b0 = rb[i0], b1 = rb[i1];
        p0[r] = ((unsigned)(kc0 - na_c0) < 16u) ? p0[r] + b0 : -1e30f;
        p1[r] = ((unsigned)(kc1 - na_c0) < 16u) ? p1[r] + b1 : -1e30f;
      }
    }
    float alpha;
    partialSM(p0, p1, m_reg, alpha);
    if (__any(alpha < 1.f)) {
      if (hi == 0) al_l[r32] = alpha;
      __builtin_amdgcn_wave_barrier();
#pragma unroll
      for (int r = 0; r < 16; ++r) { const float a = al_l[crow(r, hi)];
#pragma unroll
        for (int d = 0; d < ND0; ++d) o[d][r] *= a; }
      __builtin_amdgcn_wave_barrier();
    }
    bf16x8 pa0, pa1, pa2, pa3;
    finishSM(p0, p1, alpha, l_reg, pa0, pa1, pa2, pa3);
    pv_one<0>(o[0], vb0, pa0, pa1, pa2, pa3); pv_one<1>(o[1], vb0, pa0, pa1, pa2, pa3);
    if constexpr (MODE == 0) { pv_one<2>(o[2], vb0, pa0, pa1, pa2, pa3); pv_one<3>(o[3], vb0, pa0, pa1, pa2, pa3); }
  }
#undef ALOAD
#undef AWRITE
  if (hi == 0) li_l[r32] = l_reg;
  __builtin_amdgcn_wave_barrier();
#pragma unroll
  for (int r = 0; r < 16; ++r) {
    const int qrow = crow(r, hi); const float rl = 1.f / li_l[qrow];
    u16* o_ = p.o + obase + (long)qrow * 1024 + r32;
#pragma unroll
    for (int d = 0; d < ND0; ++d) o_[d * 32] = (u16)(cvtpk(o[d][r] * rl, 0.f) & 0xffffu);
  }
  __builtin_amdgcn_wave_barrier();
}

__device__ __forceinline__ float lane_bcast(float v, int src_lane) { return __int_as_float(__builtin_amdgcn_ds_bpermute(src_lane << 2, __float_as_int(v))); }
__device__ __forceinline__ float rowmax32(const f32x16& p0, const f32x16& p1) {
  float pmax = p0[0];
#pragma unroll
  for (int r = 1; r < 16; ++r) pmax = fmaxf(pmax, p0[r]);
#pragma unroll
  for (int r = 0; r < 16; ++r) pmax = fmaxf(pmax, p1[r]);
  auto rr = __builtin_amdgcn_permlane32_swap(__float_as_uint(pmax), __float_as_uint(pmax), false, false);
  return fmaxf(__uint_as_float(rr[0]), __uint_as_float(rr[1]));
}

typedef __attribute__((ext_vector_type(8))) int i32x8;
#define MFMA8(A, B, C, SA, SB_) __builtin_amdgcn_mfma_scale_f32_32x32x64_f8f6f4(A, B, C, 0, 0, 0, SA, 0, SB_)
constexpr int SC_K = 0x7D7D7D7D, SC_Q = 0x7B7B7B7B, SC_P = 0x7F7F7F7F, SC_V = 0x7D7D7D7D;
constexpr float THR8_L2 = 1.5f;

__device__ __forceinline__ void attn_mla(KP p, int item, char* lds) {
  constexpr int KSTAGE = 64 * 192, VSTAGE = 128 * 64, VOFF = 2 * KSTAGE;
  int tid_ = threadIdx.x; asm volatile("" : "+v"(tid_));
  const int tid = tid_, lane = tid & 63, w = tid >> 6, r32 = lane & 31, hi = lane >> 5;
  int NT, ktok0, head, seq, qb;
  if (item < 2048) { const int sh = item >> 7; seq = 8 + (sh >> 3); head = sh & 7; qb = item & 127; ktok0 = T_PROMPT + (seq - 8) * 16384; NT = 256; }
  else { const int it = item - 2048; const int sh = it >> 4; seq = sh >> 3; head = sh & 7; qb = it & 15; ktok0 = seq * 2048; NT = 32; }
  const int qtok = ktok0 + qb * 128 + w * 32 + r32;
  const long obase = (long)(ktok0 + qb * 128 + w * 32) * 1024 + head * 128;
  i32x8 qf[3];
  { const unsigned char* Qp = p.q8 + (long)qtok * 1536 + head * 192 + hi * 32;
#pragma unroll
    for (int s3 = 0; s3 < 3; ++s3) { const u32x4 a = *(const u32x4*)(Qp + s3 * 64), b = *(const u32x4*)(Qp + s3 * 64 + 16);
      qf[s3] = (i32x8){(int)a[0], (int)a[1], (int)a[2], (int)a[3], (int)b[0], (int)b[1], (int)b[2], (int)b[3]}; } }
  unsigned ko[3], vo[2];
#pragma unroll
  for (int i = 0; i < 3; ++i) {
    const int g = (w * 3 + i) * 64 + lane, key = g / 12, pc = g - key * 12, c = pc ^ ((key >> 2) & 3);
    ko[i] = (c < 8) ? (unsigned)(key * 1088 + head * 128 + c * 16) : (unsigned)(key * 1088 + 1024 + (c - 8) * 16);
  }
#pragma unroll
  for (int i = 0; i < 2; ++i) {
    const int g = (w * 2 + i) * 64 + lane, d = g >> 2, pc = g & 3, c = pc ^ ((d >> 2) & 3);
    vo[i] = (unsigned)(d * T_TOK + c * 16);
  }
  const unsigned char* k8b = p.k8 + (long)ktok0 * 1088;
  const unsigned char* vtb = p.vT8 + (long)head * 128 * T_TOK + ktok0;
#define GLK(st, jt) do { const unsigned char* kt_ = k8b + (long)(jt) * (64 * 1088); int w_ = w; asm volatile("" : "+v"(w_)); \
    _Pragma("unroll") for (int i = 0; i < 3; ++i) { unsigned k_ = ko[i]; asm volatile("" : "+v"(k_)); \
    __builtin_amdgcn_global_load_lds((const unsigned*)(kt_ + k_), (unsigned*)(lds + (st) * KSTAGE + (w_ * 3 + i) * 1024), 16, 0, 0); } } while (0)
#define GLV(st, jt) do { const unsigned char* vt_ = vtb + (long)(jt) * 64; int w_ = w; asm volatile("" : "+v"(w_)); \
    _Pragma("unroll") for (int i = 0; i < 2; ++i) { unsigned v_ = vo[i]; asm volatile("" : "+v"(v_)); \
    __builtin_amdgcn_global_load_lds((const unsigned*)(vt_ + v_), (unsigned*)(lds + VOFF + (st) * VSTAGE + (w_ * 2 + i) * 1024), 16, 0, 0); } } while (0)
#define QK8(P0, P1, st) do { const int r_ = r32, h_ = hi, sw_ = (r_ >> 2) & 3; const char* Kr_ = lds + (st) * KSTAGE + r_ * 192; \
    const f32x16 z_ = {0.f, 0.f, 0.f, 0.f, 0.f, 0.f, 0.f, 0.f, 0.f, 0.f, 0.f, 0.f, 0.f, 0.f, 0.f, 0.f}; \
    _Pragma("unroll") for (int s3 = 0; s3 < 3; ++s3) { const int c0_ = ((s3 * 4 + h_ * 2) ^ sw_) << 4, c1_ = ((s3 * 4 + h_ * 2 + 1) ^ sw_) << 4; \
      const u32x4 a0_ = *(const u32x4*)(Kr_ + c0_), a1_ = *(const u32x4*)(Kr_ + c1_), b0_ = *(const u32x4*)(Kr_ + 32 * 192 + c0_), b1_ = *(const u32x4*)(Kr_ + 32 * 192 + c1_); \
      const i32x8 ka_ = {(int)a0_[0], (int)a0_[1], (int)a0_[2], (int)a0_[3], (int)a1_[0], (int)a1_[1], (int)a1_[2], (int)a1_[3]}; \
      const i32x8 kb_ = {(int)b0_[0], (int)b0_[1], (int)b0_[2], (int)b0_[3], (int)b1_[0], (int)b1_[1], (int)b1_[2], (int)b1_[3]}; \
      P0 = MFMA8(ka_, qf[s3], (s3 == 0 ? z_ : P0), SC_K, SC_Q); P1 = MFMA8(kb_, qf[s3], (s3 == 0 ? z_ : P1), SC_K, SC_Q); } } while (0)
#define PZERO(P0, P1) do { _Pragma("unroll") for (int r = 0; r < 16; ++r) { P0[r] = 0.f; P1[r] = 0.f; } } while (0)
#define EXPC(P, mn, R0, R1) do { _Pragma("unroll") for (int r = (R0); r < (R1); ++r) P[r] = __builtin_amdgcn_exp2f(P[r] - (mn)); } while (0)
#define SB() do {} while (0)

  float m_reg = -1e30f, l_reg = 0.f;
  f32x16 o[4];
#pragma unroll
  for (int d = 0; d < 4; ++d)
#pragma unroll
    for (int r = 0; r < 16; ++r) o[d][r] = 0.f;
  f32x16 pA0, pA1, pB0, pB1; float pmaxA, pmaxB;

  __syncthreads();
  GLK(0, 0); GLV(0, 0); GLK(1, 1);
  asm volatile("s_waitcnt vmcnt(0)" ::: "memory");
  __syncthreads();
  QK8(pA0, pA1, 0); pmaxA = rowmax32(pA0, pA1);

#define STEP(j, PX0, PX1, PMX, PY0, PY1, PMY, LAST) do { \
    asm volatile("s_waitcnt lgkmcnt(0)" ::: "memory"); __builtin_amdgcn_s_barrier(); \
    if ((j) + 2 < NT) GLK((j) & 1, (j) + 2); \
    if (!(LAST)) GLV(((j) + 1) & 1, (j) + 1); \
    const bool keep_ = __all(PMX - m_reg <= THR8_L2); \
    const float mn_ = keep_ ? m_reg : fmaxf(m_reg, PMX); \
    const float alpha_ = keep_ ? 1.f : __builtin_amdgcn_exp2f(m_reg - mn_); m_reg = mn_; \
    if (!keep_) { _Pragma("unroll") for (int r = 0; r < 16; ++r) { const float a_ = lane_bcast(alpha_, crow(r, hi)); \
      _Pragma("unroll") for (int d = 0; d < 4; ++d) o[d][r] *= a_; } } \
    SB(); \
    if (!(LAST)) { QK8(PY0, PY1, ((j) + 1) & 1); } \
    { const float mnp_ = mn_ - 7.f; EXPC(PX0, mnp_, 0, 16); EXPC(PX1, mnp_, 0, 16); }     \
    SB(); \
    { float ps_ = 0.f; \
      _Pragma("unroll") for (int r = 0; r < 16; ++r) ps_ += PX0[r] + PX1[r]; \
      auto rr_ = __builtin_amdgcn_permlane32_swap(__float_as_uint(ps_), __float_as_uint(ps_), false, false); \
      l_reg = l_reg * alpha_ + __uint_as_float(rr_[0]) + __uint_as_float(rr_[1]); } \
    i32x8 pf_; \
    _Pragma("unroll") for (int g = 0; g < 4; ++g) { \
      const u32 x_ = pack4_fp8(PX0[4 * g], PX0[4 * g + 1], PX0[4 * g + 2], PX0[4 * g + 3]); \
      const u32 y_ = pack4_fp8(PX1[4 * g], PX1[4 * g + 1], PX1[4 * g + 2], PX1[4 * g + 3]); \
      auto sw_ = __builtin_amdgcn_permlane32_swap(x_, y_, false, false); pf_[2 * g] = (int)sw_[0]; pf_[2 * g + 1] = (int)sw_[1]; } \
    SB(); \
    { const int r_ = r32, h_ = hi, sw2_ = (r_ >> 2) & 3; \
      const char* Vr_ = lds + VOFF + ((j) & 1) * VSTAGE + r_ * 64; const int c0_ = ((h_ * 2) ^ sw2_) << 4, c1_ = ((h_ * 2 + 1) ^ sw2_) << 4; \
      _Pragma("unroll") for (int d0 = 0; d0 < 4; ++d0) { \
        const u32x4 a0_ = *(const u32x4*)(Vr_ + d0 * 2048 + c0_), a1_ = *(const u32x4*)(Vr_ + d0 * 2048 + c1_); \
        const i32x8 vf_ = {(int)a0_[0], (int)a0_[1], (int)a0_[2], (int)a0_[3], (int)a1_[0], (int)a1_[1], (int)a1_[2], (int)a1_[3]}; \
        o[d0] = MFMA8(pf_, vf_, o[d0], SC_P, SC_V); } } \
    if (!(LAST)) PMY = rowmax32(PY0, PY1); \
    asm volatile("s_waitcnt vmcnt(0)" ::: "memory"); } while (0)

  for (int j = 0; j < NT - 2; j += 2) {
    STEP(j, pA0, pA1, pmaxA, pB0, pB1, pmaxB, false);
    STEP(j + 1, pB0, pB1, pmaxB, pA0, pA1, pmaxA, false);
  }
  STEP(NT - 2, pA0, pA1, pmaxA, pB0, pB1, pmaxB, false);
  STEP(NT - 1, pB0, pB1, pmaxB, pA0, pA1, pmaxA, true);
#undef STEP
#undef QK8
#undef PZERO
#undef EXPC
#undef SB
#undef GLK
#undef GLV
#pragma unroll
  for (int r = 0; r < 16; ++r) {
    const int qrow = crow(r, hi); const float rl = 1.f / lane_bcast(l_reg, qrow);
    u16* o_ = p.o + obase + (long)qrow * 1024 + r32;
#pragma unroll
    for (int d = 0; d < 4; ++d) o_[d * 32] = (u16)(cvtpk(o[d][r] * rl, 0.f) & 0xffffu);
  }
}

typedef __attribute__((ext_vector_type(2))) float f32x2;
constexpr float U_SCALE = 256.f, V_SCALE = 64.f;
__device__ __forceinline__ float keyval(u32 k) { return __uint_as_float(k & ~127u) - KEY_BIAS; }
template <int CTRL> __device__ __forceinline__ float dppf(float v) { return __int_as_float(__builtin_amdgcn_update_dpp(0, __float_as_int(v), CTRL, 0xF, 0xF, true)); }
__device__ __forceinline__ float red16(float v) { v += dppf<0xB1>(v); v += dppf<0x4E>(v); v += dppf<0x141>(v); v += dppf<0x140>(v); return v; }
__device__ __forceinline__ void fp8dot(u32 dw, const f32x4& x, f32x2& acc) {
  const f32x2 lo = __builtin_amdgcn_cvt_pk_f32_fp8((int)dw, false), hi = __builtin_amdgcn_cvt_pk_f32_fp8((int)dw, true);
  acc = __builtin_elementwise_fma(lo, (f32x2){x[0], x[1]}, acc); acc = __builtin_elementwise_fma(hi, (f32x2){x[2], x[3]}, acc);
}

#ifndef PEER_FP4
#define PEER_FP4 1
#endif
#if PEER_FP4
constexpr float U4_SCALE = 96.f, V4_SCALE = 22.f;
__device__ __forceinline__ void fp4dot(u32 dw, const f32x4& x0, const f32x4& x1, f32x2& acc) {
  acc = __builtin_elementwise_fma(__builtin_amdgcn_cvt_scalef32_pk_f32_fp4(dw, 1.0f, 0), (f32x2){x0[0], x0[1]}, acc);
  acc = __builtin_elementwise_fma(__builtin_amdgcn_cvt_scalef32_pk_f32_fp4(dw, 1.0f, 1), (f32x2){x0[2], x0[3]}, acc);
  acc = __builtin_elementwise_fma(__builtin_amdgcn_cvt_scalef32_pk_f32_fp4(dw, 1.0f, 2), (f32x2){x1[0], x1[1]}, acc);
  acc = __builtin_elementwise_fma(__builtin_amdgcn_cvt_scalef32_pk_f32_fp4(dw, 1.0f, 3), (f32x2){x1[2], x1[3]}, acc);
}
__device__ __forceinline__ void phase_peer_combine(KP p, int layer, char* lds, unsigned* ctr) {
  const bool last = (layer == 3);
  int tid_ = threadIdx.x; asm volatile("" : "+v"(tid_));
  const int tid = tid_, lane = tid & 63, w = tid >> 6;
  int* eL = (int*)(lds + w * 1536); float* gL = (float*)(lds + w * 1536 + 512); float* wL = (float*)(lds + w * 1536 + 1024);
  int ci = 0, cj = 0; bool cvalid = false;
  { int cnt = 0;
#pragma unroll
    for (int i = 0; i < 16; ++i) { const int n = 16 / (i + 1); if (!cvalid && lane < cnt + n) { ci = i; cj = lane - cnt; cvalid = true; } cnt += n; } }
  const unsigned char* U = p.peer_u8 + (long)layer * 16384 * 512; const unsigned char* V = p.peer_v8 + (long)layer * 16384 * 512;
  const int sub = lane & 15, grp = lane >> 4, l32 = lane & 31, hf = lane >> 5;
  __syncthreads();
  for (;;) {
   int base_ = 0; if (lane == 0) base_ = (int)atomicAdd(ctr, 4u);
   base_ = __builtin_amdgcn_readfirstlane(base_);
   if (base_ >= T_TOK) break;
#pragma unroll 1
   for (int t = base_; t < base_ + 4; ++t) {
    float* xr = p.x + (long)t * DM;
    const u32* pk = p.pkeys + (long)t * 256;
    u32 ka[8], kb[8];
#pragma unroll
    for (int hd = 0; hd < 8; ++hd) { ka[hd] = pk[hd * 32 + ci]; kb[hd] = pk[hd * 32 + 16 + cj]; }
    u32 xe[2][4], xo[2][4]; int sumx = 0; float rstd, sx;
    f32x4 xs[2][8];
#pragma unroll
    for (int j = 0; j < 2; ++j)
#pragma unroll
      for (int q = 0; q < 8; ++q) xs[j][q] = *(const f32x4*)(xr + (sub + 16 * j) * 32 + q * 4);
#pragma unroll
    for (int hd = 0; hd < 8; ++hd) {
      const float cand = cvalid ? keyval(ka[hd]) + keyval(kb[hd]) : -3.0e38f;
      u32 ck = __float_as_uint(cand); ck = (ck & 0x80000000u) ? ~ck : (ck | 0x80000000u); ck = (ck & ~63u) | (u32)(63 - lane);
      int rank = 0;
#pragma unroll
      for (int m = 0; m < 50; ++m) { const u32 c = __builtin_amdgcn_readlane(ck, m); rank += (c > ck) ? 1 : 0; }
      const float cmax = __uint_as_float(__builtin_amdgcn_readlane(__float_as_uint(cand), 0));
      if (cvalid && rank < 16) { eL[hd * 16 + rank] = (int)((ka[hd] & 127u) * 128u + (kb[hd] & 127u)); gL[hd * 16 + rank] = __expf(cand - cmax); }
    }
    __builtin_amdgcn_wave_barrier();
    { const float g0 = gL[lane], g1 = gL[lane + 64]; const float s0 = red16(g0), s1 = red16(g1);
      __builtin_amdgcn_wave_barrier();
      gL[lane] = g0 / s0; gL[lane + 64] = g1 / s1; }
    __builtin_amdgcn_wave_barrier();
    u32x4 cA[8], cB[8];
#define LOADU(C, it) do { const int k0_ = (it) * 16 + grp * 4; \
      _Pragma("unroll") for (int rr = 0; rr < 4; ++rr) { const int e_ = eL[k0_ + rr]; const unsigned char* u_ = U + (long)e_ * 512 + sub * 16; \
        C[rr * 2] = *(const u32x4*)u_; C[rr * 2 + 1] = *(const u32x4*)(u_ + 256); } } while (0)
#define COMPU(C, it) do { const int k0_ = (it) * 16 + grp * 4; \
      _Pragma("unroll") for (int rr = 0; rr < 4; ++rr) { int a_ = 0; \
        _Pragma("unroll") for (int j = 0; j < 2; ++j) { _Pragma("unroll") for (int d = 0; d < 4; ++d) { const u32 dw_ = C[rr * 2 + j][d]; \
          a_ = __builtin_amdgcn_sdot4((int)(dw_ & 0x0F0F0F0Fu), (int)xe[j][d], a_, false); a_ = __builtin_amdgcn_sdot4((int)((dw_ >> 4) & 0x0F0F0F0Fu), (int)xo[j][d], a_, false); } } \
        const float r_ = red16((float)(a_ - 8 * sumx)); \
        if (sub == 0) wL[k0_ + rr] = r_; } } while (0)
#define LOADV(C, g) do { _Pragma("unroll") for (int i = 0; i < 8; ++i) { const int e_ = eL[(g) * 16 + 2 * i + hf]; \
      C[i] = *(const u32x4*)(V + (long)e_ * 512 + l32 * 16); } } while (0)
#define COMPV(C, g) do { _Pragma("unroll") for (int i = 0; i < 8; ++i) { const float wk_ = wL[(g) * 16 + 2 * i + hf]; const f32x2 w2_ = {wk_, wk_}; \
      _Pragma("unroll") for (int d = 0; d < 4; ++d) { const u32 dw_ = C[i][d]; \
        out[d * 4 + 0] = __builtin_elementwise_fma(__builtin_amdgcn_cvt_scalef32_pk_f32_fp4(dw_, 1.0f, 0), w2_, out[d * 4 + 0]); \
        out[d * 4 + 1] = __builtin_elementwise_fma(__builtin_amdgcn_cvt_scalef32_pk_f32_fp4(dw_, 1.0f, 1), w2_, out[d * 4 + 1]); \
        out[d * 4 + 2] = __builtin_elementwise_fma(__builtin_amdgcn_cvt_scalef32_pk_f32_fp4(dw_, 1.0f, 2), w2_, out[d * 4 + 2]); \
        out[d * 4 + 3] = __builtin_elementwise_fma(__builtin_amdgcn_cvt_scalef32_pk_f32_fp4(dw_, 1.0f, 3), w2_, out[d * 4 + 3]); } } } while (0)
    LOADU(cA, 0);
    { float ss = 0.f, am = 0.f;
#pragma unroll
      for (int j = 0; j < 2; ++j)
#pragma unroll
        for (int q = 0; q < 8; ++q) { const f32x4 a = xs[j][q]; ss += a[0] * a[0] + a[1] * a[1] + a[2] * a[2] + a[3] * a[3];
          am = fmaxf(fmaxf(am, fmaxf(fabsf(a[0]), fabsf(a[1]))), fmaxf(fabsf(a[2]), fabsf(a[3]))); }
      ss = red16(ss);
      am = fmaxf(am, dppf<0xB1>(am)); am = fmaxf(am, dppf<0x4E>(am)); am = fmaxf(am, dppf<0x141>(am)); am = fmaxf(am, dppf<0x140>(am));
      rstd = rsqrtf(ss * (1.f / DM) + RMS_EPS);
      am = fmaxf(am, 1e-20f); sx = am * (1.f / 127.f); const float inv = 127.f / am;
#pragma unroll
      for (int j = 0; j < 2; ++j)
#pragma unroll
        for (int d = 0; d < 4; ++d) {
          const f32x4 lo4 = xs[j][2 * d], hi4 = xs[j][2 * d + 1];
          const int i0 = (int)__builtin_rintf(lo4[0] * inv), i1 = (int)__builtin_rintf(lo4[1] * inv), i2 = (int)__builtin_rintf(lo4[2] * inv), i3 = (int)__builtin_rintf(lo4[3] * inv);
          const int i4 = (int)__builtin_rintf(hi4[0] * inv), i5 = (int)__builtin_rintf(hi4[1] * inv), i6 = (int)__builtin_rintf(hi4[2] * inv), i7 = (int)__builtin_rintf(hi4[3] * inv);
          sumx += i0 + i1 + i2 + i3 + i4 + i5 + i6 + i7;
          xe[j][d] = (u32)(i0 & 0xFF) | ((u32)(i2 & 0xFF) << 8) | ((u32)(i4 & 0xFF) << 16) | ((u32)i6 << 24);
          xo[j][d] = (u32)(i1 & 0xFF) | ((u32)(i3 & 0xFF) << 8) | ((u32)(i5 & 0xFF) << 16) | ((u32)i7 << 24);
        } }
#pragma unroll 1
    for (int it = 0; it < 6; it += 2) { LOADU(cB, it + 1); COMPU(cA, it); LOADU(cA, it + 2); COMPU(cB, it + 1); }
    LOADU(cB, 7); COMPU(cA, 6);
    LOADV(cA, 0);
    COMPU(cB, 7);
    __builtin_amdgcn_wave_barrier();
    { const float sc_ = rstd * sx * (1.f / U4_SCALE); const float a0 = wL[lane] * sc_, a1 = wL[lane + 64] * sc_;
      const float w0 = gL[lane] * 0.5f * a0 * (1.f + erff(a0 * 0.70710678118654752f)), w1 = gL[lane + 64] * 0.5f * a1 * (1.f + erff(a1 * 0.70710678118654752f));
      __builtin_amdgcn_wave_barrier();
      wL[lane] = w0; wL[lane + 64] = w1; }
    __builtin_amdgcn_wave_barrier();
    f32x2 out[16];
#pragma unroll
    for (int i = 0; i < 16; ++i) out[i] = (f32x2){0.f, 0.f};
#pragma unroll 1
    for (int g = 0; g < 6; g += 2) { LOADV(cB, g + 1); COMPV(cA, g); LOADV(cA, g + 2); COMPV(cB, g + 1); }
    LOADV(cB, 7); COMPV(cA, 6); COMPV(cB, 7);
#undef LOADU
#undef COMPU
#undef LOADV
#undef COMPV
    {
      f32x4 v[4];
#pragma unroll
      for (int q = 0; q < 4; ++q) {
        const f32x2 m0 = hf ? out[8 + 2 * q] : out[2 * q], o0 = hf ? out[2 * q] : out[8 + 2 * q];
        const f32x2 m1 = hf ? out[8 + 2 * q + 1] : out[2 * q + 1], o1 = hf ? out[2 * q + 1] : out[8 + 2 * q + 1];
        v[q] = (f32x4){m0[0] + shx(o0[0], 32), m0[1] + shx(o0[1], 32), m1[0] + shx(o1[0], 32), m1[1] + shx(o1[1], 32)};
      }
      f32x4* xo = (f32x4*)(xr + l32 * 32 + hf * 16);
#pragma unroll
      for (int q = 0; q < 4; ++q) { const f32x4 xv = xo[q]; v[q] = xv + v[q] * (1.f / V4_SCALE); }
      __builtin_amdgcn_wave_barrier();
      if (last) {
        float s2 = 0.f;
#pragma unroll
        for (int q = 0; q < 4; ++q) s2 += v[q][0] * v[q][0] + v[q][1] * v[q][1] + v[q][2] * v[q][2] + v[q][3] * v[q][3];
        s2 = red16(s2); s2 += shx(s2, 16); s2 += shx(s2, 32);
        const float rf = rsqrtf(s2 * (1.f / DM) + RMS_EPS);
#pragma unroll
        for (int q = 0; q < 4; ++q) { const f32x4 gf = *(const f32x4*)(p.norm_final + l32 * 32 + hf * 16 + q * 4); v[q] = v[q] * rf * gf; }
      }
#pragma unroll
      for (int q = 0; q < 4; ++q) xo[q] = v[q];
      u32x4* xbo = (u32x4*)(p.xb + (long)t * DM + l32 * 32 + hf * 16);
      xbo[0] = (u32x4){cvtpk(v[0][0], v[0][1]), cvtpk(v[0][2], v[0][3]), cvtpk(v[1][0], v[1][1]), cvtpk(v[1][2], v[1][3])};
      xbo[1] = (u32x4){cvtpk(v[2][0], v[2][1]), cvtpk(v[2][2], v[2][3]), cvtpk(v[3][0], v[3][1]), cvtpk(v[3][2], v[3][3])}; }
    __builtin_amdgcn_wave_barrier();
   }
  }
}
#else
__device__ __forceinline__ void phase_peer_combine(KP p, int layer, char* lds, unsigned*) {
  const bool last = (layer == 3);
  int tid_ = threadIdx.x; asm volatile("" : "+v"(tid_));
  const int tid = tid_, lane = tid & 63, w = tid >> 6;
  int* eL = (int*)(lds + w * 1536); float* gL = (float*)(lds + w * 1536 + 512); float* wL = (float*)(lds + w * 1536 + 1024);
  int ci = 0, cj = 0; bool cvalid = false;
  { int cnt = 0;
#pragma unroll
    for (int i = 0; i < 16; ++i) { const int n = 16 / (i + 1); if (!cvalid && lane < cnt + n) { ci = i; cj = lane - cnt; cvalid = true; } cnt += n; } }
  const unsigned char* U = p.peer_u8 + (long)layer * 16384 * 1024; const unsigned char* V = p.peer_v8 + (long)layer * 16384 * 1024;
  const int sub = lane & 15, grp = lane >> 4;
  __syncthreads();
  for (int t = blockIdx.x * 4 + w; t < T_TOK; t += gridDim.x * 4) {
    float* xr = p.x + (long)t * DM;
    const u32* pk = p.pkeys + (long)t * 256;
    u32 ka[8], kb[8];
#pragma unroll
    for (int hd = 0; hd < 8; ++hd) { ka[hd] = pk[hd * 32 + ci]; kb[hd] = pk[hd * 32 + 16 + cj]; }
    f32x4 xs[4][4]; float ss = 0.f;
#pragma unroll
    for (int i = 0; i < 4; ++i)
#pragma unroll
      for (int q = 0; q < 4; ++q) { const f32x4 a = *(const f32x4*)(xr + (sub + 16 * i) * 16 + q * 4); xs[i][q] = a; ss += a[0] * a[0] + a[1] * a[1] + a[2] * a[2] + a[3] * a[3]; }
    ss = red16(ss);
    const float rstd = rsqrtf(ss * (1.f / DM) + RMS_EPS);
#pragma unroll
    for (int hd = 0; hd < 8; ++hd) {
      const float cand = cvalid ? keyval(ka[hd]) + keyval(kb[hd]) : -3.0e38f;
      u32 ck = __float_as_uint(cand); ck = (ck & 0x80000000u) ? ~ck : (ck | 0x80000000u); ck = (ck & ~63u) | (u32)(63 - lane);
      int rank = 0;
#pragma unroll
      for (int m = 0; m < 50; ++m) { const u32 c = __builtin_amdgcn_readlane(ck, m); rank += (c > ck) ? 1 : 0; }
      const float cmax = __uint_as_float(__builtin_amdgcn_readlane(__float_as_uint(cand), 0));
      if (cvalid && rank < 16) { eL[hd * 16 + rank] = (int)((ka[hd] & 127u) * 128u + (kb[hd] & 127u)); gL[hd * 16 + rank] = __expf(cand - cmax); }
    }
    __builtin_amdgcn_wave_barrier();
    { const float g0 = gL[lane], g1 = gL[lane + 64]; const float s0 = red16(g0), s1 = red16(g1);
      __builtin_amdgcn_wave_barrier();
      gL[lane] = g0 / s0; gL[lane + 64] = g1 / s1; }
    __builtin_amdgcn_wave_barrier();
    u32x4 cA[8], cB[8];
#define LOADU(C, it) do { const int k0_ = (it) * 8 + grp * 2; const int e0_ = eL[k0_], e1_ = eL[k0_ + 1]; \
      const unsigned char* u0_ = U + (long)e0_ * 1024 + sub * 16; const unsigned char* u1_ = U + (long)e1_ * 1024 + sub * 16; \
      _Pragma("unroll") for (int i = 0; i < 4; ++i) { C[i] = *(const u32x4*)(u0_ + i * 256); C[4 + i] = *(const u32x4*)(u1_ + i * 256); } } while (0)
#define COMPU(C, it) do { const int k0_ = (it) * 8 + grp * 2; f32x2 a0_ = {0.f, 0.f}, a1_ = {0.f, 0.f}; \
      _Pragma("unroll") for (int i = 0; i < 4; ++i) { _Pragma("unroll") for (int q = 0; q < 4; ++q) { fp8dot(C[i][q], xs[i][q], a0_); fp8dot(C[4 + i][q], xs[i][q], a1_); } } \
      const float r0_ = red16(a0_[0] + a0_[1]), r1_ = red16(a1_[0] + a1_[1]); \
      if (sub == 0) { const float aa_ = r0_ * rstd * (1.f / U_SCALE), ab_ = r1_ * rstd * (1.f / U_SCALE); \
        wL[k0_] = gL[k0_] * 0.5f * aa_ * (1.f + erff(aa_ * 0.70710678118654752f)); \
        wL[k0_ + 1] = gL[k0_ + 1] * 0.5f * ab_ * (1.f + erff(ab_ * 0.70710678118654752f)); } } while (0)
#define LOADV(C, g) do { _Pragma("unroll") for (int i = 0; i < 8; ++i) { const int e_ = eL[(g) * 8 + i]; C[i] = *(const u32x4*)(V + (long)e_ * 1024 + lane * 16); } } while (0)
#define COMPV(C, g) do { _Pragma("unroll") for (int i = 0; i < 8; ++i) { const float wk_ = wL[(g) * 8 + i]; const f32x2 w2_ = {wk_, wk_}; \
      _Pragma("unroll") for (int q = 0; q < 4; ++q) { \
        const f32x2 lo_ = __builtin_amdgcn_cvt_pk_f32_fp8((int)C[i][q], false), hi_ = __builtin_amdgcn_cvt_pk_f32_fp8((int)C[i][q], true); \
        out[2 * q] = __builtin_elementwise_fma(lo_, w2_, out[2 * q]); out[2 * q + 1] = __builtin_elementwise_fma(hi_, w2_, out[2 * q + 1]); } } } while (0)
    LOADU(cA, 0);
#pragma unroll 1
    for (int it = 0; it < 14; it += 2) { LOADU(cB, it + 1); COMPU(cA, it); LOADU(cA, it + 2); COMPU(cB, it + 1); }
    LOADU(cB, 15); COMPU(cA, 14);
    LOADV(cA, 0);
    COMPU(cB, 15);
    __builtin_amdgcn_wave_barrier();
    f32x2 out[8];
#pragma unroll
    for (int i = 0; i < 8; ++i) out[i] = (f32x2){0.f, 0.f};
#pragma unroll 1
    for (int g = 0; g < 14; g += 2) { LOADV(cB, g + 1); COMPV(cA, g); LOADV(cA, g + 2); COMPV(cB, g + 1); }
    LOADV(cB, 15); COMPV(cA, 14); COMPV(cB, 15);
#undef LOADU
#undef COMPU
#undef LOADV
#undef COMPV
    { f32x4* xo = (f32x4*)(xr + lane * 16);
      f32x4 v[4];
#pragma unroll
      for (int q = 0; q < 4; ++q) { v[q] = xo[q]; v[q][0] += out[2 * q][0] * (1.f / V_SCALE); v[q][1] += out[2 * q][1] * (1.f / V_SCALE); v[q][2] += out[2 * q + 1][0] * (1.f / V_SCALE); v[q][3] += out[2 * q + 1][1] * (1.f / V_SCALE); }
      __builtin_amdgcn_wave_barrier();
      if (last) {
        float s2 = 0.f;
#pragma unroll
        for (int q = 0; q < 4; ++q) s2 += v[q][0] * v[q][0] + v[q][1] * v[q][1] + v[q][2] * v[q][2] + v[q][3] * v[q][3];
        s2 = red16(s2); s2 += shx(s2, 16); s2 += shx(s2, 32);
        const float rf = rsqrtf(s2 * (1.f / DM) + RMS_EPS);
#pragma unroll
        for (int q = 0; q < 4; ++q) { const f32x4 gf = *(const f32x4*)(p.norm_final + lane * 16 + q * 4); v[q] = v[q] * rf * gf; }
      }
#pragma unroll
      for (int q = 0; q < 4; ++q) xo[q] = v[q];
      u32x4* xbo = (u32x4*)(p.xb + (long)t * DM + lane * 16);
      xbo[0] = (u32x4){cvtpk(v[0][0], v[0][1]), cvtpk(v[0][2], v[0][3]), cvtpk(v[1][0], v[1][1]), cvtpk(v[1][2], v[1][3])};
      xbo[1] = (u32x4){cvtpk(v[2][0], v[2][1]), cvtpk(v[2][2], v[2][3]), cvtpk(v[3][0], v[3][1]), cvtpk(v[3][2], v[3][3])}; }
    __builtin_amdgcn_wave_barrier();
  }
}

#endif

#if PEER_FP4
constexpr long TBL_ITERS = 4L * 16384 * 1024 / 16; constexpr int TBL_NCHUNK = 512; constexpr long TBL_CHUNK = TBL_ITERS / TBL_NCHUNK;
__device__ __forceinline__ void convert_tables_chunk(KP p, int chunk) {
  int tid_ = threadIdx.x; asm volatile("" : "+v"(tid_));
#define Q4(val) ((u32)(int)(fminf(fmaxf(__builtin_rintf((val) * U4_SCALE), -8.f), 7.f) + 8.f))
  for (long i = (long)chunk * TBL_CHUNK + tid_; i < (long)(chunk + 1) * TBL_CHUNK; i += NTHR) {
    const long e = i * 16; const int layer = (int)(e >> 24); const int d = (int)(e & 1023);
    u32 uo[2], vo[2];
#pragma unroll
    for (int h = 0; h < 2; ++h) {
      u32 a = 0, b = 0;
#pragma unroll
      for (int q = 0; q < 2; ++q) {
        const f32x4 g = *(const f32x4*)(p.in_norm_ffn + layer * 1024 + d + h * 8 + q * 4);
        const f32x4 u = *(const f32x4*)(p.in_peer_u + e + h * 8 + q * 4), v = *(const f32x4*)(p.in_peer_v + e + h * 8 + q * 4);
        if (q == 0) {
          a |= Q4(u[0] * g[0]) | (Q4(u[1] * g[1]) << 4) | (Q4(u[2] * g[2]) << 8) | (Q4(u[3] * g[3]) << 12);
          b = __builtin_amdgcn_cvt_scalef32_pk_fp4_f32(b, v[0] * V4_SCALE, v[1] * V4_SCALE, 1.0f, 0); b = __builtin_amdgcn_cvt_scalef32_pk_fp4_f32(b, v[2] * V4_SCALE, v[3] * V4_SCALE, 1.0f, 1);
        } else {
          a |= (Q4(u[0] * g[0]) << 16) | (Q4(u[1] * g[1]) << 20) | (Q4(u[2] * g[2]) << 24) | (Q4(u[3] * g[3]) << 28);
          b = __builtin_amdgcn_cvt_scalef32_pk_fp4_f32(b, v[0] * V4_SCALE, v[1] * V4_SCALE, 1.0f, 2); b = __builtin_amdgcn_cvt_scalef32_pk_fp4_f32(b, v[2] * V4_SCALE, v[3] * V4_SCALE, 1.0f, 3);
        }
      }
      uo[h] = a; vo[h] = b;
    }
    *(u32x2*)(p.peer_u8 + (e >> 1)) = (u32x2){uo[0], uo[1]}; *(u32x2*)(p.peer_v8 + (e >> 1)) = (u32x2){vo[0], vo[1]};
  }
}

#endif
__device__ __forceinline__ void prep_transpose_tile(KP p, int t, char* lds) {
  int tid_ = threadIdx.x; asm volatile("" : "+v"(tid_));
  const int tid = tid_;
  float* tl = (float*)lds;
  int j = 0;
  while (j + 1 < p.njobs && t >= p.jobs[j + 1].tile0) ++j;
  const float* src = p.jobs[j].src; u16* dst = p.jobs[j].dst; const float* gain = p.jobs[j].gain;
  const int K = p.jobs[j].K, N = p.jobs[j].N, scale_cols = p.jobs[j].scale_cols; const float scale = p.jobs[j].scale;
  const int lt = t - p.jobs[j].tile0, ntn = N >> 6, kt = lt / ntn, nt = lt - kt * ntn;
  __syncthreads();
  for (int e = tid; e < 4096; e += 256) { const int kk = e >> 6, nn = e & 63, k = kt * 64 + kk; const float g = gain ? gain[k] : 1.f; tl[kk * 65 + nn] = src[(long)k * N + nt * 64 + nn] * g; }
  __syncthreads();
  for (int e = tid; e < 2048; e += 256) { const int nn = e >> 5, kp = (e & 31) * 2, n = nt * 64 + nn; const float s = (n < scale_cols) ? scale : 1.f;
    *(u32*)(dst + (long)n * K + kt * 64 + kp) = cvtpk(tl[kp * 65 + nn] * s, tl[(kp + 1) * 65 + nn] * s); }
  __syncthreads();
}

__device__ __forceinline__ void phase_prep(KP p, char* lds) {
  int tid_ = threadIdx.x; asm volatile("" : "+v"(tid_));
  const int tid = tid_;
  const long gtid = (long)blockIdx.x * NTHR + tid, gsz = (long)gridDim.x * NTHR;
  float* tl = (float*)lds;
  for (int t = blockIdx.x; t < p.jobs[4].tile0; t += gridDim.x) prep_transpose_tile(p, t, lds);
  for (long i = gtid; i < (long)T_TOK * DM / 4; i += gsz) {
    const long e = i * 4; const f32x4 v = e < (long)T_PROMPT * DM ? *(const f32x4*)(p.xin0 + e) : *(const f32x4*)(p.xin1 + (e - (long)T_PROMPT * DM));
    *(u32*)(p.xb + e) = cvtpk(v[0], v[1]); *(u32*)(p.xb + e + 2) = cvtpk(v[2], v[3]); }
  for (long i = gtid; i < 4L * 8 * 2 * 128 * 128 / 2; i += gsz) { const float a = p.in_sub_keys[2 * i], b = p.in_sub_keys[2 * i + 1]; *(u32*)(p.peer_sk + 2 * i) = cvtpk(a, b); }
#if PEER_FP4
#else
  for (long i = gtid; i < 4L * 16384 * 1024 / 16; i += gsz) {
    const long e = i * 16; const int layer = (int)(e >> 24); const int d = (int)(e & 1023);
    u32x4 uo, vo;
#pragma unroll
    for (int q = 0; q < 4; ++q) {
      const f32x4 g = *(const f32x4*)(p.in_norm_ffn + layer * 1024 + d + q * 4);
      const f32x4 u = *(const f32x4*)(p.in_peer_u + e + q * 4), v = *(const f32x4*)(p.in_peer_v + e + q * 4);
      int a = 0, b = 0;
      a = __builtin_amdgcn_cvt_pk_fp8_f32(u[0] * g[0] * U_SCALE, u[1] * g[1] * U_SCALE, a, false); a = __builtin_amdgcn_cvt_pk_fp8_f32(u[2] * g[2] * U_SCALE, u[3] * g[3] * U_SCALE, a, true);
      b = __builtin_amdgcn_cvt_pk_fp8_f32(v[0] * V_SCALE, v[1] * V_SCALE, b, false); b = __builtin_amdgcn_cvt_pk_fp8_f32(v[2] * V_SCALE, v[3] * V_SCALE, b, true);
      uo[q] = (u32)a; vo[q] = (u32)b;
    }
    *(u32x4*)(p.peer_u8 + e) = uo; *(u32x4*)(p.peer_v8 + e) = vo;
  }
#endif
  for (long i = gtid; i < 2 * 3072; i += gsz) { const int c = (int)(i % 3072); p.na_bias_s[i] = p.in_na_bias[i] * (c < 1024 ? 0.125f * LOG2E : 1.f); }
  for (long i = gtid; i < 2 * 16 * 465; i += gsz) p.na_rpb_s[i] = p.in_na_rpb[i] * LOG2E;
  for (long i = gtid; i < 16384L * 32; i += gsz) {
    const int pos = (int)(i >> 5), jf = (int)(i & 31);
    const double a = (double)pos * p.inv_freq[jf] * 0.15915494309189535;
    const double fr = a - rint(a);
    const float f = (float)fr;
    p.ropeC[i] = __builtin_amdgcn_cosf(f); p.ropeS[i] = __builtin_amdgcn_sinf(f);
  }
  for (long i = gtid; i < 2L * 64 * 1024 / 2; i += gsz) { const int l = (int)(i >> 15); const long e = (i & 32767) * 2; *(u32*)(p.wa_t[l] + 704L * 1024 + e) = 0u; }
}

__device__ __forceinline__ void phase_final(KP p) {
  int tid_ = threadIdx.x; asm volatile("" : "+v"(tid_));
  const int lane = tid_ & 63, w = tid_ >> 6;
  for (int t = blockIdx.x * 4 + w; t < T_TOK; t += gridDim.x * 4) {
    float* xr = p.x + (long)t * DM;
    f32x4 v[4]; float ss = 0.f;
#pragma unroll
    for (int i = 0; i < 4; ++i) { v[i] = *(const f32x4*)(xr + i * 256 + lane * 4); ss += v[i][0] * v[i][0] + v[i][1] * v[i][1] + v[i][2] * v[i][2] + v[i][3] * v[i][3]; }
    ss += shx(ss, 1); ss += shx(ss, 2); ss += shx(ss, 4); ss += shx(ss, 8); ss += shx(ss, 16); ss += shx(ss, 32);
    const float rs = rsqrtf(ss * (1.f / DM) + RMS_EPS);
#pragma unroll
    for (int i = 0; i < 4; ++i) { const f32x4 g = *(const f32x4*)(p.norm_final + i * 256 + lane * 4); f32x4 o_ = {v[i][0] * rs * g[0], v[i][1] * rs * g[1], v[i][2] * rs * g[2], v[i][3] * rs * g[3]}; *(f32x4*)(xr + i * 256 + lane * 4) = o_; }
  }
}

template <int EPI>
__device__ __forceinline__ void gemm_big(KP p, int layer, const u16* Ap, int lda, const u16* Bt, int K, int m0, int n0, char* lds) {
  int tid_ = threadIdx.x; asm volatile("" : "+v"(tid_));
  const int tid = tid_, lane = tid & 63, w = tid >> 6;
  const int wm = w >> 1, wn = w & 1, r32 = lane & 31, hi = lane >> 5;
  constexpr int STG = 24576;
  const int scol = ((lane & 3) ^ ((lane >> 4) & 3)) * 8;
  const u16* Ag = Ap + (long)(m0 + w * 64 + (lane >> 2)) * lda + scol;
  const u16* Bg = Bt + (long)(n0 + w * 32 + (lane >> 2)) * K + scol;
#define GST(st, kt) do { int w_ = w; asm volatile("" : "+v"(w_)); \
    _Pragma("unroll") for (int i = 0; i < 4; ++i) __builtin_amdgcn_global_load_lds((const unsigned*)(Ag + (long)i * 16 * lda + (kt) * 32), (unsigned*)(lds + (st) * STG + (w_ * 4 + i) * 1024), 16, 0, 0); \
    _Pragma("unroll") for (int i = 0; i < 2; ++i) __builtin_amdgcn_global_load_lds((const unsigned*)(Bg + (long)i * 16 * K + (kt) * 32), (unsigned*)(lds + (st) * STG + 16384 + (w_ * 2 + i) * 1024), 16, 0, 0); } while (0)
  f32x16 acc[4][2];
#pragma unroll
  for (int i = 0; i < 4; ++i)
#pragma unroll
    for (int j = 0; j < 2; ++j)
#pragma unroll
      for (int r = 0; r < 16; ++r) acc[i][j][r] = 0.f;
  float ssq[4] = {0.f, 0.f, 0.f, 0.f};
  const int sw = (r32 >> 2) & 3;
  const int arow = (wm * 128 + r32) * 64, brow = 16384 + (wn * 64 + r32) * 64;
  const int nk = K / 32;
  __syncthreads();
  GST(0, 0); GST(1, 1);
  int st = 0;
  for (int kt = 0; kt < nk; ++kt) {
    if (kt + 1 < nk) asm volatile("s_waitcnt vmcnt(6)" ::: "memory"); else asm volatile("s_waitcnt vmcnt(0)" ::: "memory");
    asm volatile("s_waitcnt lgkmcnt(0)" ::: "memory");
    __builtin_amdgcn_s_barrier();
    if (kt + 2 < nk) { const int s2 = st + 2 >= 3 ? st - 1 : st + 2; GST(s2, kt + 2); }
    const char* base = lds + st * STG;
#pragma unroll
    for (int ks = 0; ks < 2; ++ks) {
      const int co = ((ks * 2 + hi) ^ sw) << 4;
      bf16x8 a[4], b[2];
#pragma unroll
      for (int mi = 0; mi < 4; ++mi) a[mi] = *(const bf16x8*)(base + arow + mi * 2048 + co);
#pragma unroll
      for (int ni = 0; ni < 2; ++ni) b[ni] = *(const bf16x8*)(base + brow + ni * 2048 + co);
#pragma unroll
      for (int mi = 0; mi < 4; ++mi) { acc[mi][0] = mfma32(b[0], a[mi], acc[mi][0]); acc[mi][1] = mfma32(b[1], a[mi], acc[mi][1]); }
#pragma unroll
      for (int mi = 0; mi < 4; ++mi) { const u32x4 x = __builtin_bit_cast(u32x4, a[mi]);
#pragma unroll
        for (int q = 0; q < 4; ++q) ssq[mi] = dot2bf(x[q], x[q], ssq[mi]); }
    }
    st = st == 2 ? 0 : st + 1;
  }
#undef GST
  __syncthreads();
  float rs[4];
#pragma unroll
  for (int mi = 0; mi < 4; ++mi) { const float t = ssq[mi] + shx(ssq[mi], 32); rs[mi] = rsqrtf(t / (float)K + RMS_EPS); }
  const int rowb = wm * 128, colb = wn * 64;
  if constexpr (EPI == EPI_A || EPI == EPI_QKV) {
    constexpr int OROW = 272;
    u16* outp; int ldo; bool rope = false;
    if constexpr (EPI == EPI_A) { outp = p.cqkv; ldo = 768; rope = (n0 + colb == 640); }
    else { outp = p.qkv; ldo = 3072; }
#pragma unroll
    for (int mi = 0; mi < 4; ++mi) {
      const int rl = rowb + mi * 32 + r32; const int pos = tok_pos(m0 + rl);
#pragma unroll
      for (int g = 0; g < 4; ++g) {
        f32x4 v0, v1;
#pragma unroll
        for (int e = 0; e < 4; ++e) { v0[e] = acc[mi][0][4 * g + e] * rs[mi]; v1[e] = acc[mi][1][4 * g + e] * rs[mi]; }
        if constexpr (EPI == EPI_QKV) {
          const f32x4 b0 = *(const f32x4*)(p.na_bias_s + layer * 3072 + n0 + colb + 8 * g + 4 * hi), b1 = *(const f32x4*)(p.na_bias_s + layer * 3072 + n0 + colb + 32 + 8 * g + 4 * hi);
          v0 += b0; v1 += b1;
        }
        if (rope) {
          const f32x4 c = *(const f32x4*)(p.ropeC + pos * 32 + 8 * g + 4 * hi), sn = *(const f32x4*)(p.ropeS + pos * 32 + 8 * g + 4 * hi);
          const f32x4 t0 = (v0 * c - v1 * sn) * K8_SCALE, t1 = (v0 * sn + v1 * c) * K8_SCALE;
          unsigned char* kp_ = p.k8 + (long)(m0 + rl) * 1088 + 1024 + 8 * g + 4 * hi;
          *(u32*)kp_ = pack4_fp8(t0[0], t0[1], t0[2], t0[3]); *(u32*)(kp_ + 32) = pack4_fp8(t1[0], t1[1], t1[2], t1[3]);
        }
        char* e_ = lds + rl * OROW + (colb + 8 * g + 4 * hi) * 2;
        *(u32x2*)e_ = (u32x2){cvtpk(v0[0], v0[1]), cvtpk(v0[2], v0[3])};
        *(u32x2*)(e_ + 64) = (u32x2){cvtpk(v1[0], v1[1]), cvtpk(v1[2], v1[3])};
      }
    }
    __syncthreads();
#pragma unroll 4
    for (int i = 0; i < 16; ++i) { const int c = tid + 256 * i, row = c >> 4, ch = c & 15;
      *(u32x4*)(outp + (long)(m0 + row) * ldo + n0 + ch * 8) = *(const u32x4*)(lds + row * OROW + ch * 16); }
  } else {
    constexpr int BROW = 144;
    const bool rope = (EPI == EPI_UQ) && ((n0 + colb) % 192 == 128);
    const float sc = (EPI == EPI_UQ) ? Q8_SCALE : K8_SCALE;
#pragma unroll
    for (int mi = 0; mi < 4; ++mi) {
      const int rl = rowb + mi * 32 + r32; const int pos = tok_pos(m0 + rl);
#pragma unroll
      for (int g = 0; g < 4; ++g) {
        f32x4 v0, v1;
#pragma unroll
        for (int e = 0; e < 4; ++e) { v0[e] = acc[mi][0][4 * g + e] * rs[mi] * sc; v1[e] = acc[mi][1][4 * g + e] * rs[mi] * sc; }
        if (rope) {
          const f32x4 c = *(const f32x4*)(p.ropeC + pos * 32 + 8 * g + 4 * hi), sn = *(const f32x4*)(p.ropeS + pos * 32 + 8 * g + 4 * hi);
          const f32x4 t0 = v0 * c - v1 * sn, t1 = v0 * sn + v1 * c; v0 = t0; v1 = t1;
        }
        char* e_ = lds + rl * BROW + (colb + 8 * g + 4 * hi);
        *(u32*)e_ = pack4_fp8(v0[0], v0[1], v0[2], v0[3]); *(u32*)(e_ + 32) = pack4_fp8(v1[0], v1[1], v1[2], v1[3]);
      }
    }
    __syncthreads();
    unsigned char* outb; long ldo;
    if constexpr (EPI == EPI_UQ) { outb = p.q8 + n0; ldo = 1536; } else { outb = p.k8 + (n0 >> 8) * 128; ldo = 1088; }
#pragma unroll 2
    for (int i = 0; i < 8; ++i) { const int c = tid + 256 * i, row = c >> 3, ch = c & 7;
      *(u32x4*)(outb + (long)(m0 + row) * ldo + ch * 16) = *(const u32x4*)(lds + row * BROW + ch * 16); }
  }
}

__device__ __forceinline__ void ukv_tile(KP p, int j, int mt, int nt, char* lds) {
  if (nt & 1) gemm_tile<EPI_UV, true>(p, j, p.cqkv + 384, 768, p.wukv_t[j], 256, mt * 128, nt * 128, lds);
  else gemm_tile<EPI_UK, true>(p, j, p.cqkv + 384, 768, p.wukv_t[j], 256, mt * 128, nt * 128, lds);
}
#define XB_TMO      128
#define XB_XCNT(j)  (256  + 64 * (j))
#define XB_XSUB(j)  (1280 + 64 * (j))
#define XB_XGEN(j)  (2304 + 64 * (j))
#define XB_TOP      3328
#define XB_TOPGEN   3392
#define XCD_BAR_WORDS 3456
#define XB_SPIN_CAP (1u << 18)
#define LAS __attribute__((address_space(3)))
__device__ __forceinline__ unsigned xb_ld(unsigned* p)              { return __hip_atomic_load(p, __ATOMIC_RELAXED, __HIP_MEMORY_SCOPE_AGENT); }
__device__ __forceinline__ unsigned xb_add(unsigned* p, unsigned v) { return __hip_atomic_fetch_add(p, v, __ATOMIC_RELAXED, __HIP_MEMORY_SCOPE_AGENT); }
__device__ __forceinline__ unsigned xb_xcc_id() { return (unsigned)__builtin_amdgcn_s_getreg((3 << 11) | 20) & 0xFu; }
#define XB_SPIN(cond, bar) do { unsigned _sp = 0; while (cond) { __builtin_amdgcn_s_sleep(1); \
    if ((++_sp & 255u) == 0u) { if (xb_ld(&(bar)[XB_TMO])) break; if (_sp > XB_SPIN_CAP) { atomicAdd(&(bar)[XB_TMO], 1u); break; } } } } while (0)
struct XcdBarrier { unsigned* bar; unsigned x; volatile LAS unsigned* st; };
__device__ __forceinline__ XcdBarrier xcd_barrier_post(unsigned* bar, volatile LAS unsigned* st) {
    XcdBarrier b; b.bar = bar; b.x = xb_xcc_id(); b.st = st;
    if (threadIdx.x == 0) (void)xb_add(&bar[XB_XCNT(b.x)], 1u);
    return b;
}
__device__ __forceinline__ void xcd_barrier_complete(unsigned* bar, unsigned x, unsigned& nloc, unsigned& nx) {
    const unsigned G = gridDim.x * gridDim.y * gridDim.z;
    unsigned sum, cnt, mine, sp = 0u;
    for (;;) {
        sum = 0u; cnt = 0u; mine = 0u;
#pragma unroll
        for (unsigned j = 0; j < 16; ++j) { const unsigned c = xb_ld(&bar[XB_XCNT(j)]); sum += c; cnt += (c > 0u) ? 1u : 0u; mine = (j == x) ? c : mine; }
        if (sum == G) break;
        __builtin_amdgcn_s_sleep(1);
        if ((++sp & 255u) == 0u) { if (xb_ld(&bar[XB_TMO])) break; if (sp > XB_SPIN_CAP) { atomicAdd(&bar[XB_TMO], 1u); break; } }
    }
    nloc = mine > 0u ? mine : 1u; nx = cnt > 0u ? cnt : 1u;
}
__device__ __forceinline__ void xcd_barrier(const XcdBarrier& b) {
    asm volatile("s_waitcnt vmcnt(0)" ::: "memory");
    __syncthreads();
    if (threadIdx.x == 0) {
        unsigned* bar = b.bar;
        __builtin_amdgcn_s_waitcnt(0);
        unsigned nloc = b.st[0], nx = b.st[1];
        if (nloc == 0u) { xcd_barrier_complete(bar, b.x, nloc, nx); b.st[0] = nloc; b.st[1] = nx; }
        const unsigned old = xb_add(&bar[XB_XSUB(b.x)], 1u);
        const unsigned gen = old / nloc;
        if (old + 1u == (gen + 1u) * nloc) {
            __builtin_amdgcn_fence(__ATOMIC_RELEASE, "agent");
            asm volatile("s_waitcnt vmcnt(0)" ::: "memory");
            const unsigned og = xb_add(&bar[XB_TOP], 1u);
            const unsigned tg = og / nx;
            if (og + 1u == (tg + 1u) * nx) xb_add(&bar[XB_TOPGEN], 1u);
            else XB_SPIN(xb_ld(&bar[XB_TOPGEN]) == tg, bar);
            __builtin_amdgcn_fence(__ATOMIC_ACQUIRE, "agent");
            xb_add(&bar[XB_XGEN(b.x)], 1u);
            asm volatile("s_waitcnt vmcnt(0)" ::: "memory");
        } else {
            XB_SPIN(xb_ld(&bar[XB_XGEN(b.x)]) == gen, bar);
            __builtin_amdgcn_fence(__ATOMIC_ACQUIRE, "agent");
            asm volatile("s_waitcnt vmcnt(0)" ::: "memory");
        }
    }
    __syncthreads();
}

#define GEMM_PHASE(SUB, MTILES, NTILES, SM, SN, CALL) do { \
    const int nsn_ = (NTILES) / (SN), nsuper_ = ((MTILES) / (SM)) * nsn_, per_ = (SM) * (SN); \
    const int xcd_ = blockIdx.x & 7; \
    const int total_ = ((nsuper_ - xcd_ + 7) >> 3) * per_;            \
    unsigned* q_ = p.bar + XCD_BAR_WORDS + 64 + (ph * 3 + (SUB)) * 8 + xcd_; \
    for (;;) { \
      if (threadIdx.x == 0) xb_words[2] = atomicAdd(q_, 1u); \
      __syncthreads(); const int idx_ = (int)xb_words[2]; __syncthreads(); \
      if (idx_ >= total_) break; \
      const int r_ = idx_ / per_, l_ = idx_ - r_ * per_, s_ = xcd_ + 8 * r_, sm_ = s_ / nsn_, sn_ = s_ - sm_ * nsn_; \
      const int mt = sm_ * (SM) + l_ / (SN), nt = sn_ * (SN) + l_ % (SN); CALL; } } while (0)

__global__ void __launch_bounds__(NTHR, LB2) mega(const Params p_unused, int ph_lo, int ph_hi) {
  __shared__ __attribute__((aligned(16))) char lds[SMEM_BYTES];
  volatile LAS unsigned* xb_words = (volatile LAS unsigned*)(lds + SMEM_BYTES - 16);
  constexpr int MT = T_TOK / 128;
  XcdBarrier xb;
  { const __attribute__((address_space(4))) Params* pp0 = (const __attribute__((address_space(4))) Params*)__builtin_amdgcn_kernarg_segment_ptr();
    if (threadIdx.x < 4) xb_words[threadIdx.x] = 0u;
    __syncthreads();
    xb = xcd_barrier_post(pp0->bar, xb_words); }
  for (int ph = ph_lo; ph < ph_hi; ++ph) {
    const __attribute__((address_space(4))) Params* pp = (const __attribute__((address_space(4))) Params*)__builtin_amdgcn_kernarg_segment_ptr();
    asm volatile("" : "+s"(pp));
    KP p = *pp;
    const int type = p.prog_type[ph], layer = p.prog_layer[ph];
    const int j = layer >> 1;
    switch (type) {
      case PH_PREP: if (!PHON(PH_PREP)) break; phase_prep(p, lds); break;
      case PH_MLA_A: if (!PHON(PH_MLA_A)) break;
        GEMM_PHASE(0, MT / 2, 6, 8, 6, (gemm_big<EPI_A>(p, j, p.xb, DM, p.wa_t[j], 1024, mt * 256, nt * 128, lds)));
        break;
      case PH_MLA_B: if (!PHON(PH_MLA_B)) break;
        GEMM_PHASE(0, MT / 2, 12, 16, 4, (gemm_big<EPI_UQ>(p, j, p.cqkv, 768, p.wuq_t[j], 384, mt * 256, nt * 128, lds)));
        GEMM_PHASE(1, MT / 2, 8, 8, 8, (gemm_big<EPI_UK>(p, j, p.cqkv + 384, 768, p.wukv_t[j], 256, mt * 256, nt * 256, lds)));
        GEMM_PHASE(2, MT, 8, 8, 8, (gemm_tile<EPI_UV, true>(p, j, p.cqkv + 384, 768, p.wukv_t[j], 256, mt * 128, nt * 256 + 128, lds)));
        break;
      case PH_MLA_ATT: if (!PHON(PH_MLA_ATT)) break;
#ifndef SKEW_BIT
#define SKEW_BIT 256
#endif
        if (blockIdx.x & SKEW_BIT) { __builtin_amdgcn_s_sleep(24); __builtin_amdgcn_s_setprio(1); }
        {
          unsigned* ctr = p.bar + XCD_BAR_WORDS + ph;
          for (;;) {
            if (threadIdx.x == 0) xb_words[2] = atomicAdd(ctr, 1u);
            __syncthreads();
            const int t = (int)xb_words[2];
            __syncthreads();
            if (t < 3072) attn_mla(p, t, lds);
            else if (PEER_FP4 && layer == 0 && t < 3072 + TBL_NCHUNK) convert_tables_chunk(p, t - 3072);
            else if (PEER_FP4 && layer == 0 && t < 3072 + TBL_NCHUNK + (p.ntiles_prep - p.jobs[4].tile0)) prep_transpose_tile(p, t - 3072 - TBL_NCHUNK + p.jobs[4].tile0, lds);
            else break;
          } }
        __builtin_amdgcn_s_setprio(0);
        break;
      case PH_MLA_O: if (!PHON(PH_MLA_O)) break;
        GEMM_PHASE(0, MT, 8, 8, 8, (gemm_tile<EPI_O, false>(p, layer == 0 ? -1 : j, p.o, 1024, p.mla_wo_t[j], 1024, mt * 128, nt * 128, lds)));
        break;
      case PH_NA_QKV: if (!PHON(PH_NA_QKV)) break;
        GEMM_PHASE(0, MT / 2, 24, 8, 8, (gemm_big<EPI_QKV>(p, j, p.xb, DM, p.na_wqkv_t[j], 1024, mt * 256, nt * 128, lds)));
        break;
      case PH_NA_ATT: if (!PHON(PH_NA_ATT)) break;
        if (blockIdx.x & SKEW_BIT) { __builtin_amdgcn_s_sleep(12); }
        { unsigned* ctr = p.bar + XCD_BAR_WORDS + ph;
          for (;;) {
            if (threadIdx.x == 0) xb_words[2] = atomicAdd(ctr, 1u);
            __syncthreads();
            const int t = (int)xb_words[2];
            __syncthreads();
            if (t >= 6144) break;
            attn_item<1>(p, j, t, lds);
          } }
        break;
      case PH_NA_O: if (!PHON(PH_NA_O)) break;
        GEMM_PHASE(0, MT, 8, 8, 8, (gemm_tile<EPI_O, false>(p, j, p.o, 1024, p.na_wo_t[j], 1024, mt * 128, nt * 128, lds)));
        break;
      case PH_PEER_Q: if (!PHON(PH_PEER_Q)) break;
        GEMM_PHASE(0, MT, 16, 8, 8, (gemm_tile<EPI_PEER, true>(p, layer, p.xb, DM, p.peer_wq_t[layer], 1024, mt * 128, nt * 128, lds)));
        break;
      case PH_PEER_C: if (!PHON(PH_PEER_C)) break; phase_peer_combine(p, layer, lds, p.bar + XCD_BAR_WORDS + ph); break;
      case PH_FINAL: if (!PHON(PH_FINAL)) break; phase_final(p); break;
      default: break;
    }
    if (ph + 1 < ph_hi) { if (ph_hi > 1000) cg::this_grid().sync(); else xcd_barrier(xb); }
  }
}

extern "C" void kernel_launch(void* const* d_in, const int* in_sizes, int n_in, void* d_out, int out_size, void* d_ws, size_t ws_size, hipStream_t stream) {
  static int grid_blocks = 0, n_cus = 0;
  if (!grid_blocks) {
    int dev = 0, cus = 0;
    (void)hipGetDevice(&dev);
    (void)hipDeviceGetAttribute(&cus, hipDeviceAttributeMultiprocessorCount, dev);
    if (cus < 8) cus = 256;
    n_cus = cus;
    grid_blocks = cus * 2;
  }
  Params p; memset(&p, 0, sizeof(p));
  const float* const* in = (const float* const*)d_in;
  char* ws = (char*)d_ws; size_t off = 0;
  auto alloc = [&](size_t bytes) -> void* { void* r = ws + off; off += (bytes + 255) & ~(size_t)255; return r; };
  p.xin0 = in[0]; p.xin1 = in[1]; p.x = (float*)d_out; p.norm_final = in[4];
  for (int l = 0; l < 2; ++l) {
    p.wa_t[l] = (u16*)alloc(768UL * 1024 * 2); p.wuq_t[l] = (u16*)alloc(1536UL * 384 * 2); p.wukv_t[l] = (u16*)alloc(2048UL * 256 * 2); p.mla_wo_t[l] = (u16*)alloc(1024UL * 1024 * 2);
    p.na_wqkv_t[l] = (u16*)alloc(3072UL * 1024 * 2); p.na_wo_t[l] = (u16*)alloc(1024UL * 1024 * 2);
  }
  for (int l = 0; l < 4; ++l) p.peer_wq_t[l] = (u16*)alloc(2048UL * 1024 * 2);
  p.na_bias_s = (float*)alloc(2 * 3072 * 4); p.na_rpb_s = (float*)alloc(2 * 16 * 465 * 4);
  p.peer_sk = (u16*)alloc(4UL * 8 * 2 * 128 * 128 * 2);
  p.peer_u8 = (unsigned char*)alloc(4UL * 16384 * 1024); p.peer_v8 = (unsigned char*)alloc(4UL * 16384 * 1024);
  p.ropeC = (float*)alloc(16384UL * 32 * 4); p.ropeS = (float*)alloc(16384UL * 32 * 4);
  p.bar = (unsigned*)alloc((XCD_BAR_WORDS + 1024) * 4);
  p.o = (u16*)alloc((size_t)T_TOK * 1024 * 2); p.xb = (u16*)alloc((size_t)T_TOK * 1024 * 2);
  char* un = (char*)alloc((size_t)T_TOK * (768 + 1536 + 2048) * 2);
  p.cqkv = (u16*)un; p.q = (u16*)(un + (size_t)T_TOK * 768 * 2); p.kv = (u16*)(un + (size_t)T_TOK * (768 + 1536) * 2);
  { unsigned char* b8 = (unsigned char*)un + (size_t)T_TOK * 768 * 2; p.q8 = b8; p.k8 = b8 + (size_t)T_TOK * 1536; p.kpe8 = p.k8; p.vT8 = p.k8 + (size_t)T_TOK * 1088; }
  p.qkv = (u16*)un; p.pkeys = (u32*)un;
  if (off > ws_size) { fprintf(stderr, "kernel_launch: workspace too small: need %zu have %zu\n", off, ws_size); return; }
  p.in_sub_keys = in[17]; p.in_peer_u = in[18]; p.in_peer_v = in[19]; p.in_norm_ffn = in[3]; p.in_na_bias = in[13]; p.in_na_rpb = in[14];
  for (int jf = 0; jf < 32; ++jf) p.inv_freq[jf] = pow(10000.0, -(double)(2 * jf) / 64.0);
  int nj = 0, tile = 0;
  auto job = [&](const float* src, u16* dst, const float* gain, int K, int N, float scale, int scale_cols) {
    PrepJob& J = p.jobs[nj++]; J.src = src; J.dst = dst; J.gain = gain; J.K = K; J.N = N; J.tile0 = tile; J.scale = scale; J.scale_cols = scale_cols; J.pad = 0; tile += (K / 64) * (N / 64); };
  const float sc_mla = (float)(pow(192.0, -0.5) * 1.4426950408889634);
  for (int l = 0; l < 2; ++l) {
    job(in[5] + (size_t)l * 1024 * 384, p.wa_t[l], in[2] + (2 * l) * 1024, 1024, 384, 1.f, 0);
    job(in[8] + (size_t)l * 1024 * 320, p.wa_t[l] + 384UL * 1024, in[2] + (2 * l) * 1024, 1024, 320, 1.f, 0);
    job(in[7] + (size_t)l * 384 * 1536, p.wuq_t[l], in[6] + l * 384, 384, 1536, sc_mla, 1536);
    job(in[10] + (size_t)l * 256 * 2048, p.wukv_t[l], in[9] + l * 256, 256, 2048, 1.f, 0);
    job(in[11] + (size_t)l * 1024 * 1024, p.mla_wo_t[l], nullptr, 1024, 1024, 1.f, 0);
    job(in[12] + (size_t)l * 1024 * 3072, p.na_wqkv_t[l], in[2] + (2 * l + 1) * 1024, 1024, 3072, 0.125f * 1.4426950408889634f, 1024);
    job(in[15] + (size_t)l * 1024 * 1024, p.na_wo_t[l], nullptr, 1024, 1024, 1.f, 0);
  }
  for (int l = 0; l < 4; ++l) job(in[16] + (size_t)l * 1024 * 2048, p.peer_wq_t[l], in[3] + l * 1024, 1024, 2048, 1.f, 0);
  p.njobs = nj; p.ntiles_prep = tile;
  int np = 0;
#ifndef DUPMASK
#define DUPMASK 0
#endif
  auto ph = [&](int type, int layer) { p.prog_type[np] = type; p.prog_layer[np] = layer; ++np;
    if ((DUPMASK >> type) & 1) { p.prog_type[np] = type; p.prog_layer[np] = layer; ++np; } };
  ph(PH_PREP, 0);
  for (int i = 0; i < 4; ++i) {
    if ((i & 1) == 0) { ph(PH_MLA_A, i); ph(PH_MLA_B, i); ph(PH_MLA_ATT, i); ph(PH_MLA_O, i); }
    else { ph(PH_NA_QKV, i); ph(PH_NA_ATT, i); ph(PH_NA_O, i); }
    ph(PH_PEER_Q, i); ph(PH_PEER_C, i);
  }
  p.nprog = np;
#if COOP
  (void)hipMemsetAsync(p.bar, 0, (XCD_BAR_WORDS + 1024) * 4, stream);
  int lo = 0, hi = np;
  void* args[] = {(void*)&p, (void*)&lo, (void*)&hi};
  hipError_t e = hipLaunchCooperativeKernel((const void*)mega, dim3(grid_blocks), dim3(NTHR), args, 0, stream);
  if (e != hipSuccess && grid_blocks != n_cus) {
    (void)hipGetLastError(); grid_blocks = n_cus;
    e = hipLaunchCooperativeKernel((const void*)mega, dim3(grid_blocks), dim3(NTHR), args, 0, stream);
  }
  if (e != hipSuccess) fprintf(stderr, "cooperative launch failed: %s (grid %d)\n", hipGetErrorString(e), grid_blocks);
#else
  for (int i = 0; i < np; ++i) hipLaunchKernelGGL(mega, dim3(grid_blocks), dim3(NTHR), 0, stream, p, i, i + 1);
#endif
}
```

```cpp
#include <hip/hip_runtime.h>
#include <hip/hip_cooperative_groups.h>
#include <stdint.h>
#include <string.h>
#include <math.h>
#include <cstdio>
namespace cg = cooperative_groups;

#ifndef COOP
#define COOP 1
#endif
#ifndef PHMASK
#define PHMASK 0xFFFF
#endif
#ifndef LB2
#define LB2 2
#endif
#define PHON(t) ((PHMASK >> (t)) & 1)

typedef unsigned short u16;
typedef unsigned int u32;
using bf16x8 = __attribute__((ext_vector_type(8))) short;
using s16x4  = __attribute__((ext_vector_type(4))) short;
using f32x16 = __attribute__((ext_vector_type(16))) float;
using f32x4  = __attribute__((ext_vector_type(4))) float;
using u32x4  = __attribute__((ext_vector_type(4))) unsigned;
using u32x2  = __attribute__((ext_vector_type(2))) unsigned;
typedef __attribute__((ext_vector_type(2))) __bf16 v2bf;

constexpr int T_TOK = 49152, T_PROMPT = 16384, DM = 1024;
constexpr int NTHR = 256;
constexpr float LOG2E = 1.4426950408889634f;
constexpr float RMS_EPS = 1e-6f;

enum { PH_PREP = 0, PH_MLA_A, PH_MLA_B, PH_MLA_ATT, PH_MLA_O, PH_NA_QKV, PH_NA_ATT, PH_NA_O, PH_PEER_Q, PH_PEER_C, PH_FINAL };

struct PrepJob { const float* src; u16* dst; const float* gain; int K, N, tile0, scale_cols; float scale; int pad; };

struct Params {
  const float* xin0; const float* xin1;
  float* x; u16* xb;
  const float* norm_final;
  u16* wa_t[2]; u16* wuq_t[2]; u16* wukv_t[2]; u16* mla_wo_t[2];
  u16* na_wqkv_t[2]; u16* na_wo_t[2]; float* na_bias_s; float* na_rpb_s;
  u16* peer_wq_t[4]; u16* peer_sk; unsigned char* peer_u8; unsigned char* peer_v8;
  u16* cqkv; u16* q; u16* kv; u16* o; u16* qkv; u32* pkeys;
  unsigned char* q8; unsigned char* k8; unsigned char* kpe8; unsigned char* vT8;
  float* ropeC; float* ropeS; unsigned* bar;
  const float* in_sub_keys; const float* in_peer_u; const float* in_peer_v; const float* in_norm_ffn; const float* in_na_bias; const float* in_na_rpb;
  PrepJob jobs[24];
  double inv_freq[32];
  int njobs, ntiles_prep;
  int prog_type[48]; int prog_layer[48];
  int nprog, pad0;
};

typedef const __attribute__((address_space(4))) Params& KP;

__device__ __forceinline__ int crow(int r, int hi) { return (r & 3) + 8 * (r >> 2) + 4 * hi; }
__device__ __forceinline__ u32 cvtpk(float lo, float hi) { u32 r; asm("v_cvt_pk_bf16_f32 %0, %1, %2" : "=v"(r) : "v"(lo), "v"(hi)); return r; }
__device__ __forceinline__ float bf_lo(u32 v) { return __uint_as_float(v << 16); }
__device__ __forceinline__ float bf_hi(u32 v) { return __uint_as_float(v & 0xffff0000u); }
__device__ __forceinline__ int tok_pos(int t) { return t < T_PROMPT ? (t & 2047) : (t & 16383); }
__device__ __forceinline__ f32x16 mfma32(bf16x8 a, bf16x8 b, f32x16 c) { return __builtin_amdgcn_mfma_f32_32x32x16_bf16(a, b, c, 0, 0, 0); }
__device__ __forceinline__ float shx(float v, int m) { return __shfl_xor(v, m, 64); }

constexpr int BK = 64;
constexpr int OPB = 16384;
constexpr int GEMM_LDS = 4 * OPB;
constexpr int SMEM_BYTES = 81920;
constexpr int RSTD_OFF = 73728;

enum { EPI_A = 0, EPI_UQ, EPI_UK, EPI_UV, EPI_O, EPI_QKV, EPI_PEER };
constexpr float KEY_BIAS = 16.f;
constexpr float Q8_SCALE = 16.f, K8_SCALE = 4.f, V8_SCALE = 4.f, P8_SCALE = 128.f;
__device__ __forceinline__ u32 pack4_fp8(float a, float b, float c, float d) { int v = 0; v = __builtin_amdgcn_cvt_pk_fp8_f32(a, b, v, false); v = __builtin_amdgcn_cvt_pk_fp8_f32(c, d, v, true); return (u32)v; }

__device__ __forceinline__ float dot2bf(u32 a, u32 b, float c) { return __builtin_amdgcn_fdot2_f32_bf16(__builtin_bit_cast(v2bf, a), __builtin_bit_cast(v2bf, b), c, false); }

template <int EPI, bool NORM>
__device__ __forceinline__ void gemm_tile(KP p, int layer, const u16* Ap, int lda, const u16* Bt, int K, int m0, int n0, char* lds) {
  int tid_ = threadIdx.x; asm volatile("" : "+v"(tid_));
  const int tid = tid_, lane = tid & 63, w = tid >> 6;
  const int wm = w >> 1, wn = w & 1, r32 = lane & 31, hi = lane >> 5;
  float* rstd_l = (float*)(lds + RSTD_OFF);
  const int srow = w * 32 + (lane >> 2);
  const int scol = ((lane & 3) ^ ((lane >> 4) & 3)) * 8;
  const u16* Ag = Ap + (long)(m0 + srow) * lda + scol;
  const u16* Bg = Bt + (long)(n0 + srow) * K + scol;
#define GSTAGE(st, kt) do { _Pragma("unroll") for (int j = 0; j < 2; ++j) { \
    __builtin_amdgcn_global_load_lds((const unsigned*)(Ag + (long)j * 16 * lda + (kt) * 32), (unsigned*)(lds + (st) * 16384 + (w * 2 + j) * 1024), 16, 0, 0); \
    __builtin_amdgcn_global_load_lds((const unsigned*)(Bg + (long)j * 16 * K + (kt) * 32), (unsigned*)(lds + (st) * 16384 + 8192 + (w * 2 + j) * 1024), 16, 0, 0); } } while (0)
  f32x16 acc[2][2];
#pragma unroll
  for (int i = 0; i < 2; ++i)
#pragma unroll
    for (int j = 0; j < 2; ++j)
#pragma unroll
      for (int r = 0; r < 16; ++r) acc[i][j][r] = 0.f;
  float ssq0 = 0.f, ssq1 = 0.f;
  bf16x8 skr[8];
  const int sw = (r32 >> 2) & 3;
  const int arow = (wm * 64 + r32) * 64, brow = 8192 + (wn * 64 + r32) * 64;
  const int co0 = ((0 + hi) ^ sw) << 4, co1 = ((2 + hi) ^ sw) << 4;
  const int nk = K / 32;

#ifndef KREP
#define KREP 1
#endif
  for (int rep_ = 0; rep_ < KREP; ++rep_) {
  if (KREP > 1) {
#pragma unroll
    for (int i = 0; i < 2; ++i)
#pragma unroll
      for (int j = 0; j < 2; ++j)
#pragma unroll
        for (int r = 0; r < 16; ++r) acc[i][j][r] = 0.f;
    ssq0 = 0.f; ssq1 = 0.f; }
  __syncthreads();
  GSTAGE(0, 0); GSTAGE(1, 1); GSTAGE(2, 2);
  if constexpr (EPI == EPI_PEER) {
    const u16* sk = p.peer_sk + ((long)layer * 16 + (n0 >> 7)) * 16384;
#pragma unroll
    for (int i = 0; i < 8; ++i) { const int c = tid + 256 * i; skr[i] = *(const bf16x8*)(sk + (c >> 4) * 128 + (c & 15) * 8); }
  }
  for (int kt = 0; kt < nk; ++kt) {
    if (kt + 2 < nk) asm volatile("s_waitcnt vmcnt(8)" ::: "memory");
    else if (kt + 1 < nk) asm volatile("s_waitcnt vmcnt(4)" ::: "memory");
    else asm volatile("s_waitcnt vmcnt(0)" ::: "memory");
    asm volatile("s_waitcnt lgkmcnt(0)" ::: "memory");
    __builtin_amdgcn_s_barrier();
    if (kt + 3 < nk) GSTAGE((kt + 3) & 3, kt + 3);
    const char* base = lds + (kt & 3) * 16384;
    {
      const bf16x8 a0 = *(const bf16x8*)(base + arow + co0), a1 = *(const bf16x8*)(base + arow + 32 * 64 + co0);
      const bf16x8 b0 = *(const bf16x8*)(base + brow + co0), b1 = *(const bf16x8*)(base + brow + 32 * 64 + co0);
      const bf16x8 c0 = *(const bf16x8*)(base + arow + co1), c1 = *(const bf16x8*)(base + arow + 32 * 64 + co1);
      const bf16x8 d0 = *(const bf16x8*)(base + brow + co1), d1 = *(const bf16x8*)(base + brow + 32 * 64 + co1);
      if constexpr (EPI != EPI_UV) {
        acc[0][0] = mfma32(b0, a0, acc[0][0]); acc[0][1] = mfma32(b1, a0, acc[0][1]);
        acc[1][0] = mfma32(b0, a1, acc[1][0]); acc[1][1] = mfma32(b1, a1, acc[1][1]);
        acc[0][0] = mfma32(d0, c0, acc[0][0]); acc[0][1] = mfma32(d1, c0, acc[0][1]);
        acc[1][0] = mfma32(d0, c1, acc[1][0]); acc[1][1] = mfma32(d1, c1, acc[1][1]);
      } else {
        acc[0][0] = mfma32(a0, b0, acc[0][0]); acc[0][1] = mfma32(a0, b1, acc[0][1]);
        acc[1][0] = mfma32(a1, b0, acc[1][0]); acc[1][1] = mfma32(a1, b1, acc[1][1]);
        acc[0][0] = mfma32(c0, d0, acc[0][0]); acc[0][1] = mfma32(c0, d1, acc[0][1]);
        acc[1][0] = mfma32(c1, d0, acc[1][0]); acc[1][1] = mfma32(c1, d1, acc[1][1]);
      }
      if constexpr (NORM) {
        const u32x4 x0 = __builtin_bit_cast(u32x4, a0), x1 = __builtin_bit_cast(u32x4, a1), y0 = __builtin_bit_cast(u32x4, c0), y1 = __builtin_bit_cast(u32x4, c1);
#pragma unroll
        for (int q = 0; q < 4; ++q) { ssq0 = dot2bf(x0[q], x0[q], ssq0); ssq1 = dot2bf(x1[q], x1[q], ssq1); ssq0 = dot2bf(y0[q], y0[q], ssq0); ssq1 = dot2bf(y1[q], y1[q], ssq1); }
      }
    }
  }
  }
#undef GSTAGE
  __syncthreads();
  float rs[2] = {1.f, 1.f};
  if constexpr (NORM) {
    ssq0 += shx(ssq0, 32); ssq1 += shx(ssq1, 32);
    rs[0] = rsqrtf(ssq0 / (float)K + RMS_EPS); rs[1] = rsqrtf(ssq1 / (float)K + RMS_EPS);
  }
  const int rowb = wm * 64, colb = wn * 64;
  if constexpr (EPI == EPI_A || EPI == EPI_QKV) {
    constexpr int OROW = 272;
    u16* outp; int ldo; bool rope = false;
    if constexpr (EPI == EPI_A) { outp = p.cqkv; ldo = 768; rope = (n0 + colb == 640); }
    else { outp = p.qkv; ldo = 3072; }
#pragma unroll
    for (int mi = 0; mi < 2; ++mi) {
      const int rl = rowb + mi * 32 + r32; const int pos = tok_pos(m0 + rl);
#pragma unroll
      for (int g = 0; g < 4; ++g) {
        f32x4 v0, v1;
#pragma unroll
        for (int e = 0; e < 4; ++e) { v0[e] = acc[mi][0][4 * g + e] * rs[mi]; v1[e] = acc[mi][1][4 * g + e] * rs[mi]; }
        if constexpr (EPI == EPI_QKV) {
          const f32x4 b0 = *(const f32x4*)(p.na_bias_s + layer * 3072 + n0 + colb + 8 * g + 4 * hi), b1 = *(const f32x4*)(p.na_bias_s + layer * 3072 + n0 + colb + 32 + 8 * g + 4 * hi);
          v0 += b0; v1 += b1;
        }
        if (rope) {
          const f32x4 c = *(const f32x4*)(p.ropeC + pos * 32 + 8 * g + 4 * hi), sn = *(const f32x4*)(p.ropeS + pos * 32 + 8 * g + 4 * hi);
          const f32x4 t0 = (v0 * c - v1 * sn) * K8_SCALE, t1 = (v0 * sn + v1 * c) * K8_SCALE;
          unsigned char* kp_ = p.k8 + (long)(m0 + rl) * 1088 + 1024 + 8 * g + 4 * hi;
          *(u32*)kp_ = pack4_fp8(t0[0], t0[1], t0[2], t0[3]); *(u32*)(kp_ + 32) = pack4_fp8(t1[0], t1[1], t1[2], t1[3]);
        }
        char* e_ = lds + rl * OROW + (colb + 8 * g + 4 * hi) * 2;
        *(u32x2*)e_ = (u32x2){cvtpk(v0[0], v0[1]), cvtpk(v0[2], v0[3])};
        *(u32x2*)(e_ + 64) = (u32x2){cvtpk(v1[0], v1[1]), cvtpk(v1[2], v1[3])};
      }
    }
    __syncthreads();
#pragma unroll
    for (int i = 0; i < 8; ++i) { const int c = tid + 256 * i, row = c >> 4, ch = c & 15;
      *(u32x4*)(outp + (long)(m0 + row) * ldo + n0 + ch * 8) = *(const u32x4*)(lds + row * OROW + ch * 16); }
  } else if constexpr (EPI == EPI_UQ || EPI == EPI_UK) {
    constexpr int BROW = 144;
    const bool rope = (EPI == EPI_UQ) && ((n0 + colb) % 192 == 128);
    const float sc = (EPI == EPI_UQ) ? Q8_SCALE : K8_SCALE;
#pragma unroll
    for (int mi = 0; mi < 2; ++mi) {
      const int rl = rowb + mi * 32 + r32; const int pos = tok_pos(m0 + rl);
#pragma unroll
      for (int g = 0; g < 4; ++g) {
        f32x4 v0, v1;
#pragma unroll
        for (int e = 0; e < 4; ++e) { v0[e] = acc[mi][0][4 * g + e] * rs[mi] * sc; v1[e] = acc[mi][1][4 * g + e] * rs[mi] * sc; }
        if (rope) {
          const f32x4 c = *(const f32x4*)(p.ropeC + pos * 32 + 8 * g + 4 * hi), sn = *(const f32x4*)(p.ropeS + pos * 32 + 8 * g + 4 * hi);
          const f32x4 t0 = v0 * c - v1 * sn, t1 = v0 * sn + v1 * c; v0 = t0; v1 = t1;
        }
        char* e_ = lds + rl * BROW + (colb + 8 * g + 4 * hi);
        *(u32*)e_ = pack4_fp8(v0[0], v0[1], v0[2], v0[3]); *(u32*)(e_ + 32) = pack4_fp8(v1[0], v1[1], v1[2], v1[3]);
      }
    }
    __syncthreads();
    unsigned char* outb; long ldo;
    if constexpr (EPI == EPI_UQ) { outb = p.q8 + n0; ldo = 1536; } else { outb = p.k8 + (n0 >> 8) * 128; ldo = 1088; }
#pragma unroll
    for (int i = 0; i < 4; ++i) { const int c = tid + 256 * i, row = c >> 3, ch = c & 7;
      *(u32x4*)(outb + (long)(m0 + row) * ldo + ch * 16) = *(const u32x4*)(lds + row * BROW + ch * 16); }
  } else if constexpr (EPI == EPI_UV) {
    constexpr int BROW = 144;
#pragma unroll
    for (int mi = 0; mi < 2; ++mi) {
#pragma unroll
      for (int g = 0; g < 4; ++g) {
        float rr[4];
#pragma unroll
        for (int e = 0; e < 4; ++e) rr[e] = __int_as_float(__builtin_amdgcn_ds_bpermute((8 * g + 4 * hi + e) << 2, __float_as_int(rs[mi]))) * V8_SCALE;
#pragma unroll
        for (int ni = 0; ni < 2; ++ni) {
          char* e_ = lds + (colb + ni * 32 + r32) * BROW + rowb + mi * 32 + 8 * g + 4 * hi;
          *(u32*)e_ = pack4_fp8(acc[mi][ni][4 * g] * rr[0], acc[mi][ni][4 * g + 1] * rr[1], acc[mi][ni][4 * g + 2] * rr[2], acc[mi][ni][4 * g + 3] * rr[3]);
        }
      }
    }
    __syncthreads();
    unsigned char* outb = p.vT8 + (long)((n0 >> 8) * 128) * T_TOK + m0;
#pragma unroll
    for (int i = 0; i < 4; ++i) { const int c = tid + 256 * i, d = c >> 3, ch = c & 7;
      *(u32x4*)(outb + (long)d * T_TOK + ch * 16) = *(const u32x4*)(lds + d * BROW + ch * 16); }
  } else if constexpr (EPI == EPI_O) {
    constexpr int FROW = 528;
#pragma unroll
    for (int mi = 0; mi < 2; ++mi) {
      const int rl = rowb + mi * 32 + r32;
#pragma unroll
      for (int ni = 0; ni < 2; ++ni)
#pragma unroll
        for (int g = 0; g < 4; ++g)
          *(f32x4*)(lds + rl * FROW + (colb + ni * 32 + 8 * g + 4 * hi) * 4) = (f32x4){acc[mi][ni][4 * g], acc[mi][ni][4 * g + 1], acc[mi][ni][4 * g + 2], acc[mi][ni][4 * g + 3]};
    }
    __syncthreads();
#pragma unroll 4
    for (int i = 0; i < 16; ++i) { const int c = tid + 256 * i, row = c >> 5, ch = c & 31;
      const f32x4 a = *(const f32x4*)(lds + row * FROW + ch * 16);
      float* xp = p.x + (long)(m0 + row) * DM + n0 + ch * 4;
      const float* xsrc = xp;
      if (layer < 0) xsrc = (m0 < T_PROMPT ? p.xin0 + (long)(m0 + row) * DM : p.xin1 + (long)(m0 + row - T_PROMPT) * DM) + n0 + ch * 4;
      f32x4 xv = *(const f32x4*)xsrc; xv += a; *(f32x4*)xp = xv;
      *(u32x2*)(p.xb + (long)(m0 + row) * DM + n0 + ch * 4) = (u32x2){cvtpk(xv[0], xv[1]), cvtpk(xv[2], xv[3])}; }
  } else {
    constexpr int QROW = 272;
    char* Qs = lds; char* Ss = lds + 128 * QROW;
    const int hp = n0 >> 7;
#pragma unroll
    for (int mi = 0; mi < 2; ++mi) {
      const int rl = rowb + mi * 32 + r32;
#pragma unroll
      for (int g = 0; g < 4; ++g) {
        char* e_ = Qs + rl * QROW + (colb + 8 * g + 4 * hi) * 2;
        *(u32x2*)e_ = (u32x2){cvtpk(acc[mi][0][4 * g] * rs[mi], acc[mi][0][4 * g + 1] * rs[mi]), cvtpk(acc[mi][0][4 * g + 2] * rs[mi], acc[mi][0][4 * g + 3] * rs[mi])};
        *(u32x2*)(e_ + 64) = (u32x2){cvtpk(acc[mi][1][4 * g] * rs[mi], acc[mi][1][4 * g + 1] * rs[mi]), cvtpk(acc[mi][1][4 * g + 2] * rs[mi], acc[mi][1][4 * g + 3] * rs[mi])};
      }
    }
#pragma unroll
    for (int i = 0; i < 8; ++i) { const int c = tid + 256 * i, kr = c >> 4, ch = c & 15; *(bf16x8*)(Ss + kr * QROW + ch * 16) = skr[i]; }
    __syncthreads();
    f32x16 a2[2][2];
#pragma unroll
    for (int i = 0; i < 2; ++i)
#pragma unroll
      for (int j = 0; j < 2; ++j)
#pragma unroll
        for (int r = 0; r < 16; ++r) a2[i][j][r] = 0.f;
    { const char* Ar = Qs + (rowb + r32) * QROW + hi * 16; const char* Br = Ss + (colb + r32) * QROW + hi * 16;
#pragma unroll
      for (int ks = 0; ks < 8; ++ks) {
        bf16x8 a0 = *(const bf16x8*)(Ar + ks * 32), a1 = *(const bf16x8*)(Ar + 32 * QROW + ks * 32);
        bf16x8 b0 = *(const bf16x8*)(Br + ks * 32), b1 = *(const bf16x8*)(Br + 32 * QROW + ks * 32);
        a2[0][0] = mfma32(b0, a0, a2[0][0]); a2[0][1] = mfma32(b1, a0, a2[0][1]);
        a2[1][0] = mfma32(b0, a1, a2[1][0]); a2[1][1] = mfma32(b1, a1, a2[1][1]);
      } }
    __syncthreads();
    constexpr int SROW = 544;
    char* Sc = lds;
#pragma unroll
    for (int mi = 0; mi < 2; ++mi) {
      const int rl = rowb + mi * 32 + r32;
#pragma unroll
      for (int ni = 0; ni < 2; ++ni)
#pragma unroll
        for (int g = 0; g < 4; ++g)
          *(f32x4*)(Sc + rl * SROW + (colb + ni * 32 + 8 * g + 4 * hi) * 4) = (f32x4){a2[mi][ni][4 * g], a2[mi][ni][4 * g + 1], a2[mi][ni][4 * g + 2], a2[mi][ni][4 * g + 3]};
    }
    __syncthreads();
    { const int row = tid >> 1, hf = tid & 1;
      u32 kv[64];
#pragma unroll
      for (int i = 0; i < 16; ++i) {
        const f32x4 v = *(const f32x4*)(Sc + row * SROW + (2 * i + hf) * 16);
#pragma unroll
        for (int e = 0; e < 4; ++e) { const u32 b = __float_as_uint(v[e] + KEY_BIAS);
          kv[i * 4 + e] = (b & ~127u) | (u32)((2 * i + hf) * 4 + e); }
      }
      u32 mprev = 0xffffffffu;
      u32* outk = p.pkeys + (long)(m0 + row) * 256 + hp * 16;
#pragma unroll 1
      for (int ps = 0; ps < 16; ++ps) {
        u32 best = 0;
#pragma unroll
        for (int i = 0; i < 64; ++i) { const u32 d = kv[i] - mprev; best = d > best ? d : best; }
        u32 cand = mprev + best;
        if (best < (0u - mprev)) cand = 0u;
        const u32 oth = (u32)__shfl_xor((int)cand, 1, 64);
        mprev = cand > oth ? cand : oth;
        if (hf == 0) outk[ps] = mprev;
      }
    }
  }
}

template <int OFF> __device__ __forceinline__ s16x4 tr_read(int vb) {
  s16x4 r; asm volatile("ds_read_b64_tr_b16 %0, %1 offset:%2" : "=&v"(r) : "v"(vb), "i"(OFF) : "memory"); return r;
}
__device__ __forceinline__ int v_st(int k, int c) { const int kk = (k & ~0xC) | ((k & 4) << 1) | ((k & 8) >> 1); return ((kk >> 3) * 4 + (c >> 5)) * 512 + ((kk & 7) * 32 + (c & 31)) * 2; }
__device__ __forceinline__ int v_rd_base(int lane) { return ((lane & 3) << 3) | (((lane >> 2) & 3) << 6) | (((lane >> 4) & 1) << 5) | (((lane >> 5) & 1) << 8); }
constexpr int v_rd_off(int d0, int ks, int half) { return d0 * 512 + ks * 4096 + half * 2048; }
template <int D0> __device__ __forceinline__ void pv_one(f32x16& od, int vb, bf16x8 pa0, bf16x8 pa1, bf16x8 pa2, bf16x8 pa3) {
  const s16x4 l0 = tr_read<v_rd_off(D0, 0, 0)>(vb), h0 = tr_read<v_rd_off(D0, 0, 1)>(vb), l1 = tr_read<v_rd_off(D0, 1, 0)>(vb), h1 = tr_read<v_rd_off(D0, 1, 1)>(vb);
  const s16x4 l2 = tr_read<v_rd_off(D0, 2, 0)>(vb), h2 = tr_read<v_rd_off(D0, 2, 1)>(vb), l3 = tr_read<v_rd_off(D0, 3, 0)>(vb), h3 = tr_read<v_rd_off(D0, 3, 1)>(vb);
  asm volatile("s_waitcnt lgkmcnt(0)" ::: "memory"); __builtin_amdgcn_sched_barrier(0);
#define PKV(L, H) (bf16x8){L[0], L[1], L[2], L[3], H[0], H[1], H[2], H[3]}
  od = mfma32(pa0, PKV(l0, h0), od); od = mfma32(pa1, PKV(l1, h1), od); od = mfma32(pa2, PKV(l2, h2), od); od = mfma32(pa3, PKV(l3, h3), od);
#undef PKV
}

constexpr float THR_L2 = 11.5f;

__device__ __forceinline__ void partialSM(f32x16& p0, f32x16& p1, float& m_reg, float& alpha) {
  float pmax = p0[0];
#pragma unroll
  for (int r = 1; r < 16; ++r) pmax = fmaxf(pmax, p0[r]);
#pragma unroll
  for (int r = 0; r < 16; ++r) pmax = fmaxf(pmax, p1[r]);
  { auto rr = __builtin_amdgcn_permlane32_swap(__float_as_uint(pmax), __float_as_uint(pmax), false, false);
    pmax = fmaxf(__uint_as_float(rr[0]), __uint_as_float(rr[1])); }
  float mn;
  if (__all(pmax - m_reg <= THR_L2)) { mn = m_reg; alpha = 1.f; }
  else { mn = fmaxf(m_reg, pmax); alpha = __builtin_amdgcn_exp2f(m_reg - mn); m_reg = mn; }
#pragma unroll
  for (int r = 0; r < 16; ++r) { p0[r] = __builtin_amdgcn_exp2f(p0[r] - mn); p1[r] = __builtin_amdgcn_exp2f(p1[r] - mn); }
}
__device__ __forceinline__ void finishSM(f32x16& p0, f32x16& p1, float alpha, float& l_reg, bf16x8& pa0, bf16x8& pa1, bf16x8& pa2, bf16x8& pa3) {
  float ps = 0.f;
#pragma unroll
  for (int r = 0; r < 16; ++r) ps += p0[r];
#pragma unroll
  for (int r = 0; r < 16; ++r) ps += p1[r];
  { auto rr = __builtin_amdgcn_permlane32_swap(__float_as_uint(ps), __float_as_uint(ps), false, false);
    ps = __uint_as_float(rr[0]) + __uint_as_float(rr[1]); }
  l_reg = l_reg * alpha + ps;
#define PK4(P, BASE, OUT) do { unsigned a0 = cvtpk(P[BASE + 0], P[BASE + 1]), a1 = cvtpk(P[BASE + 2], P[BASE + 3]);   \
    unsigned b0 = cvtpk(P[BASE + 4], P[BASE + 5]), b1 = cvtpk(P[BASE + 6], P[BASE + 7]);                              \
    auto r0 = __builtin_amdgcn_permlane32_swap(a0, b0, false, false); auto r1 = __builtin_amdgcn_permlane32_swap(a1, b1, false, false); \
    u32x4 w_ = {r0[0], r1[0], r0[1], r1[1]}; OUT = __builtin_bit_cast(bf16x8, w_); } while (0)
  PK4(p0, 0, pa0); PK4(p0, 8, pa1); PK4(p1, 0, pa2); PK4(p1, 8, pa3);
#undef PK4
}

constexpr int ATT_K_OFF = 0, ATT_V_OFF = 25600, ATT_WS_OFF = 41984, ATT_RPB_OFF = 43008;

template <int MODE>
__device__ __forceinline__ void attn_item(KP p, int layer, int item, char* lds) {
  constexpr int KST = MODE == 0 ? 12 : 4;
  constexpr int KROW = MODE == 0 ? 400 : 272;
  constexpr int ND0 = MODE == 0 ? 4 : 2;
  int tid_ = threadIdx.x; asm volatile("" : "+v"(tid_));
  const int tid = tid_, lane = tid & 63, w = tid >> 6, r32 = lane & 31, hi = lane >> 5;
  char* Kl = lds + ATT_K_OFF; char* Vl = lds + ATT_V_OFF;
  float* wsl = (float*)(lds + ATT_WS_OFF) + w * 64; float* al_l = wsl; float* li_l = wsl + 32;
  float* rpbl = (float*)(lds + ATT_RPB_OFF);

  int NT, qtok, ktok0, head, kcolB = 0; long obase;
  int na_c = 0, na_c0 = 0, na_relrow0 = 0, na_hl = 0;
  const u16* Qp;
  if constexpr (MODE == 0) {
    int seq, qb;
    if (item < 2048) { const int sh = item >> 7; seq = 8 + (sh >> 3); head = sh & 7; qb = item & 127; ktok0 = T_PROMPT + (seq - 8) * 16384; NT = 256; }
    else { const int it = item - 2048; const int sh = it >> 4; seq = sh >> 3; head = sh & 7; qb = it & 15; ktok0 = seq * 2048; NT = 32; }
    qtok = ktok0 + qb * 128 + w * 32 + r32;
    Qp = p.q + (long)qtok * 1536 + head * 192 + hi * 8;
    obase = (long)(ktok0 + qb * 128 + w * 32) * 1024 + head * 128;
  } else {
    const int Rg = item >> 3, hpair = item & 7;
    int grow0, r, rows;
    if (Rg < 256) { grow0 = (Rg >> 5) << 5; r = Rg & 31; rows = 32; } else { grow0 = 256 + (((Rg - 256) >> 8) << 8); r = (Rg - 256) & 255; rows = 256; }
    int r0 = r - 4; r0 = r0 < 0 ? 0 : r0; r0 = r0 > rows - 8 ? rows - 8 : r0;
    ktok0 = (grow0 + r0) * 64; NT = 8;
    na_hl = w >> 1; head = hpair * 2 + na_hl;
    na_c = (w & 1) * 32 + r32; na_c0 = na_c - 8; na_c0 = na_c0 < 0 ? 0 : na_c0; na_c0 = na_c0 > 48 ? 48 : na_c0;
    na_relrow0 = r0 - r + 7;
    qtok = Rg * 64 + na_c;
    Qp = p.qkv + (long)qtok * 3072 + head * 64 + hi * 8;
    obase = (long)(Rg * 64 + (w & 1) * 32) * 1024 + head * 64;
    kcolB = na_hl * 128;
    __syncthreads();
    { const float* src = p.na_rpb_s + ((long)layer * 16 + hpair * 2) * 465;
      for (int e = tid; e < 930; e += 256) rpbl[e] = src[e]; }
  }
  bf16x8 qr[KST];
#pragma unroll
  for (int d = 0; d < KST; ++d) qr[d] = *(const bf16x8*)(Qp + d * 16);

  bf16x8 sk[MODE == 0 ? 6 : 4], sv[4];
  const int s_key = tid >> 4, s_ch = tid & 15;
  const int s_key8 = tid >> 3, s_ch8 = tid & 7;
#define ALOAD(j) do { const long kt_ = (long)ktok0 + (j) * 64; \
    if constexpr (MODE == 0) { \
      _Pragma("unroll") for (int i = 0; i < 4; ++i) { const u16* b_ = p.kv + (kt_ + s_key + 16 * i) * 2048 + head * 256 + s_ch * 8; sk[i] = *(const bf16x8*)b_; sv[i] = *(const bf16x8*)(b_ + 128); } \
      _Pragma("unroll") for (int i = 0; i < 2; ++i) sk[4 + i] = *(const bf16x8*)(p.cqkv + (kt_ + s_key8 + 32 * i) * 768 + 640 + s_ch8 * 8); \
    } else { \
      _Pragma("unroll") for (int i = 0; i < 4; ++i) { const u16* b_ = p.qkv + (kt_ + s_key + 16 * i) * 3072 + 1024 + (head & ~1) * 64 + s_ch * 8; sk[i] = *(const bf16x8*)b_; sv[i] = *(const bf16x8*)(b_ + 1024); } \
    } } while (0)
#define AWRITE() do { \
    _Pragma("unroll") for (int i = 0; i < 4; ++i) { *(bf16x8*)(Kl + (s_key + 16 * i) * KROW + s_ch * 16) = sk[i]; *(bf16x8*)(Vl + v_st(s_key + 16 * i, s_ch * 8)) = sv[i]; } \
    if constexpr (MODE == 0) { _Pragma("unroll") for (int i = 0; i < 2; ++i) *(bf16x8*)(Kl + (s_key8 + 32 * i) * KROW + 256 + s_ch8 * 16) = sk[4 + i]; } } while (0)

  float m_reg = -1e30f, l_reg = 0.f;
  f32x16 o[ND0];
#pragma unroll
  for (int d = 0; d < ND0; ++d)
#pragma unroll
    for (int r = 0; r < 16; ++r) o[d][r] = 0.f;
  const int vb0 = (int)(uintptr_t)Vl + v_rd_base(lane) + (MODE == 1 ? na_hl * 1024 : 0);

  ALOAD(0);
  for (int j = 0; j < NT; ++j) {
    __syncthreads();
    AWRITE();
    __syncthreads();
    if (j + 1 < NT) ALOAD(j + 1);
    f32x16 p0, p1;
#pragma unroll
    for (int r = 0; r < 16; ++r) { p0[r] = 0.f; p1[r] = 0.f; }
#pragma unroll
    for (int d = 0; d < KST; ++d) {
      const int cb = kcolB + (d * 16 + hi * 8) * 2;
      bf16x8 b0 = *(const bf16x8*)(Kl + r32 * KROW + cb), b1 = *(const bf16x8*)(Kl + (32 + r32) * KROW + cb);
      p0 = mfma32(b0, qr[d], p0); p1 = mfma32(b1, qr[d], p1);
    }
    if constexpr (MODE == 1) {
      const float* rb = rpbl + (na_hl * 15 + na_relrow0 + j) * 31;
#pragma unroll
      for (int r = 0; r < 16; ++r) {
        const int kc0 = crow(r, hi), kc1 = 32 + kc0;
        int i0 = kc0 - na_c + 15, i1 = kc1 - na_c + 15;
        i0 = i0 < 0 ? 0 : (i0 > 30 ? 30 : i0); i1 = i1 < 0 ? 0 : (i1 > 30 ? 30 : i1);
        const float b0 = rb[i0], b1 = rb[i1];
        p0[r] = ((unsigned)(kc0 - na_c0) < 16u) ? p0[r] + b0 : -1e30f;
        p1[r] = ((unsigned)(kc1 - na_c0) < 16u) ? p1[r] + b1 : -1e30f;
      }
    }
    float alpha;
    partialSM(p0, p1, m_reg, alpha);
    if (__any(alpha < 1.f)) {
      if (hi == 0) al_l[r32] = alpha;
      __builtin_amdgcn_wave_barrier();
#pragma unroll
      for (int r = 0; r < 16; ++r) { const float a = al_l[crow(r, hi)];
#pragma unroll
        for (int d = 0; d < ND0; ++d) o[d][r] *= a; }
      __builtin_amdgcn_wave_barrier();
    }
    bf16x8 pa0, pa1, pa2, pa3;
    finishSM(p0, p1, alpha, l_reg, pa0, pa1, pa2, pa3);
    pv_one<0>(o[0], vb0, pa0, pa1, pa2, pa3); pv_one<1>(o[1], vb0, pa0, pa1, pa2, pa3);
    if constexpr (MODE == 0) { pv_one<2>(o[2], vb0, pa0, pa1, pa2, pa3); pv_one<3>(o[3], vb0, pa0, pa1, pa2, pa3); }
  }
#undef ALOAD
#undef AWRITE
  if (hi == 0) li_l[r32] = l_reg;
  __builtin_amdgcn_wave_barrier();
#pragma unroll
  for (int r = 0; r < 16; ++r) {
    const int qrow = crow(r, hi); const float rl = 1.f / li_l[qrow];
    u16* o_ = p.o + obase + (long)qrow * 1024 + r32;
#pragma unroll
    for (int d = 0; d < ND0; ++d) o_[d * 32] = (u16)(cvtpk(o[d][r] * rl, 0.f) & 0xffffu);
  }
  __builtin_amdgcn_wave_barrier();
}

__device__ __forceinline__ float lane_bcast(float v, int src_lane) { return __int_as_float(__builtin_amdgcn_ds_bpermute(src_lane << 2, __float_as_int(v))); }
__device__ __forceinline__ float rowmax32(const f32x16& p0, const f32x16& p1) {
  float pmax = p0[0];
#pragma unroll
  for (int r = 1; r < 16; ++r) pmax = fmaxf(pmax, p0[r]);
#pragma unroll
  for (int r = 0; r < 16; ++r) pmax = fmaxf(pmax, p1[r]);
  auto rr = __builtin_amdgcn_permlane32_swap(__float_as_uint(pmax), __float_as_uint(pmax), false, false);
  return fmaxf(__uint_as_float(rr[0]), __uint_as_float(rr[1]));
}

typedef __attribute__((ext_vector_type(8))) int i32x8;
#define MFMA8(A, B, C, SA, SB_) __builtin_amdgcn_mfma_scale_f32_32x32x64_f8f6f4(A, B, C, 0, 0, 0, SA, 0, SB_)
constexpr int SC_K = 0x7D7D7D7D, SC_Q = 0x7B7B7B7B, SC_P = 0x7F7F7F7F, SC_V = 0x7D7D7D7D;
constexpr float THR8_L2 = 1.5f;

__device__ __forceinline__ void attn_mla(KP p, int item, char* lds) {
  constexpr int KSTAGE = 64 * 192, VSTAGE = 128 * 64, VOFF = 2 * KSTAGE;
  int tid_ = threadIdx.x; asm volatile("" : "+v"(tid_));
  const int tid = tid_, lane = tid & 63, w = tid >> 6, r32 = lane & 31, hi = lane >> 5;
  int NT, ktok0, head, seq, qb;
  if (item < 2048) { const int sh = item >> 7; seq = 8 + (sh >> 3); head = sh & 7; qb = item & 127; ktok0 = T_PROMPT + (seq - 8) * 16384; NT = 256; }
  else { const int it = item - 2048; const int sh = it >> 4; seq = sh >> 3; head = sh & 7; qb = it & 15; ktok0 = seq * 2048; NT = 32; }
  const int qtok = ktok0 + qb * 128 + w * 32 + r32;
  const long obase = (long)(ktok0 + qb * 128 + w * 32) * 1024 + head * 128;
  i32x8 qf[3];
  { const unsigned char* Qp = p.q8 + (long)qtok * 1536 + head * 192 + hi * 32;
#pragma unroll
    for (int s3 = 0; s3 < 3; ++s3) { const u32x4 a = *(const u32x4*)(Qp + s3 * 64), b = *(const u32x4*)(Qp + s3 * 64 + 16);
      qf[s3] = (i32x8){(int)a[0], (int)a[1], (int)a[2], (int)a[3], (int)b[0], (int)b[1], (int)b[2], (int)b[3]}; } }
  unsigned ko[3], vo[2];
#pragma unroll
  for (int i = 0; i < 3; ++i) {
    const int g = (w * 3 + i) * 64 + lane, key = g / 12, pc = g - key * 12, c = pc ^ ((key >> 2) & 3);
    ko[i] = (c < 8) ? (unsigned)(key * 1088 + head * 128 + c * 16) : (unsigned)(key * 1088 + 1024 + (c - 8) * 16);
  }
#pragma unroll
  for (int i = 0; i < 2; ++i) {
    const int g = (w * 2 + i) * 64 + lane, d = g >> 2, pc = g & 3, c = pc ^ ((d >> 2) & 3);
    vo[i] = (unsigned)(d * T_TOK + c * 16);
  }
  const unsigned char* k8b = p.k8 + (long)ktok0 * 1088;
  const unsigned char* vtb = p.vT8 + (long)head * 128 * T_TOK + ktok0;
#define GLK(st, jt) do { const unsigned char* kt_ = k8b + (long)(jt) * (64 * 1088); int w_ = w; asm volatile("" : "+v"(w_)); \
    _Pragma("unroll") for (int i = 0; i < 3; ++i) { unsigned k_ = ko[i]; asm volatile("" : "+v"(k_)); \
    __builtin_amdgcn_global_load_lds((const unsigned*)(kt_ + k_), (unsigned*)(lds + (st) * KSTAGE + (w_ * 3 + i) * 1024), 16, 0, 0); } } while (0)
#define GLV(st, jt) do { const unsigned char* vt_ = vtb + (long)(jt) * 64; int w_ = w; asm volatile("" : "+v"(w_)); \
    _Pragma("unroll") for (int i = 0; i < 2; ++i) { unsigned v_ = vo[i]; asm volatile("" : "+v"(v_)); \
    __builtin_amdgcn_global_load_lds((const unsigned*)(vt_ + v_), (unsigned*)(lds + VOFF + (st) * VSTAGE + (w_ * 2 + i) * 1024), 16, 0, 0); } } while (0)
#define QK8(P0, P1, st) do { const int r_ = r32, h_ = hi, sw_ = (r_ >> 2) & 3; const char* Kr_ = lds + (st) * KSTAGE + r_ * 192; \
    const f32x16 z_ = {0.f, 0.f, 0.f, 0.f, 0.f, 0.f, 0.f, 0.f, 0.f, 0.f, 0.f, 0.f, 0.f, 0.f, 0.f, 0.f}; \
    _Pragma("unroll") for (int s3 = 0; s3 < 3; ++s3) { const int c0_ = ((s3 * 4 + h_ * 2) ^ sw_) << 4, c1_ = ((s3 * 4 + h_ * 2 + 1) ^ sw_) << 4; \
      const u32x4 a0_ = *(const u32x4*)(Kr_ + c0_), a1_ = *(const u32x4*)(Kr_ + c1_), b0_ = *(const u32x4*)(Kr_ + 32 * 192 + c0_), b1_ = *(const u32x4*)(Kr_ + 32 * 192 + c1_); \
      const i32x8 ka_ = {(int)a0_[0], (int)a0_[1], (int)a0_[2], (int)a0_[3], (int)a1_[0], (int)a1_[1], (int)a1_[2], (int)a1_[3]}; \
      const i32x8 kb_ = {(int)b0_[0], (int)b0_[1], (int)b0_[2], (int)b0_[3], (int)b1_[0], (int)b1_[1], (int)b1_[2], (int)b1_[3]}; \
      P0 = MFMA8(ka_, qf[s3], (s3 == 0 ? z_ : P0), SC_K, SC_Q); P1 = MFMA8(kb_, qf[s3], (s3 == 0 ? z_ : P1), SC_K, SC_Q); } } while (0)
#define PZERO(P0, P1) do { _Pragma("unroll") for (int r = 0; r < 16; ++r) { P0[r] = 0.f; P1[r] = 0.f; } } while (0)
#define EXPC(P, mn, R0, R1) do { _Pragma("unroll") for (int r = (R0); r < (R1); ++r) P[r] = __builtin_amdgcn_exp2f(P[r] - (mn)); } while (0)
#define SB() do {} while (0)

  float m_reg = -1e30f, l_reg = 0.f;
  f32x16 o[4];
#pragma unroll
  for (int d = 0; d < 4; ++d)
#pragma unroll
    for (int r = 0; r < 16; ++r) o[d][r] = 0.f;
  f32x16 pA0, pA1, pB0, pB1; float pmaxA, pmaxB;

  __syncthreads();
  GLK(0, 0); GLV(0, 0); GLK(1, 1);
  asm volatile("s_waitcnt vmcnt(0)" ::: "memory");
  __syncthreads();
  QK8(pA0, pA1, 0); pmaxA = rowmax32(pA0, pA1);

#define STEP(j, PX0, PX1, PMX, PY0, PY1, PMY, LAST) do { \
    asm volatile("s_waitcnt lgkmcnt(0)" ::: "memory"); __builtin_amdgcn_s_barrier(); \
    if ((j) + 2 < NT) GLK((j) & 1, (j) + 2); \
    if (!(LAST)) GLV(((j) + 1) & 1, (j) + 1); \
    const bool keep_ = __all(PMX - m_reg <= THR8_L2); \
    const float mn_ = keep_ ? m_reg : fmaxf(m_reg, PMX); \
    const float alpha_ = keep_ ? 1.f : __builtin_amdgcn_exp2f(m_reg - mn_); m_reg = mn_; \
    if (!keep_) { _Pragma("unroll") for (int r = 0; r < 16; ++r) { const float a_ = lane_bcast(alpha_, crow(r, hi)); \
      _Pragma("unroll") for (int d = 0; d < 4; ++d) o[d][r] *= a_; } } \
    SB(); \
    if (!(LAST)) { QK8(PY0, PY1, ((j) + 1) & 1); } \
    { const float mnp_ = mn_ - 7.f; EXPC(PX0, mnp_, 0, 16); EXPC(PX1, mnp_, 0, 16); }     \
    SB(); \
    { float ps_ = 0.f; \
      _Pragma("unroll") for (int r = 0; r < 16; ++r) ps_ += PX0[r] + PX1[r]; \
      auto rr_ = __builtin_amdgcn_permlane32_swap(__float_as_uint(ps_), __float_as_uint(ps_), false, false); \
      l_reg = l_reg * alpha_ + __uint_as_float(rr_[0]) + __uint_as_float(rr_[1]); } \
    i32x8 pf_; \
    _Pragma("unroll") for (int g = 0; g < 4; ++g) { \
      const u32 x_ = pack4_fp8(PX0[4 * g], PX0[4 * g + 1], PX0[4 * g + 2], PX0[4 * g + 3]); \
      const u32 y_ = pack4_fp8(PX1[4 * g], PX1[4 * g + 1], PX1[4 * g + 2], PX1[4 * g + 3]); \
      auto sw_ = __builtin_amdgcn_permlane32_swap(x_, y_, false, false); pf_[2 * g] = (int)sw_[0]; pf_[2 * g + 1] = (int)sw_[1]; } \
    SB(); \
    { const int r_ = r32, h_ = hi, sw2_ = (r_ >> 2) & 3; \
      const char* Vr_ = lds + VOFF + ((j) & 1) * VSTAGE + r_ * 64; const int c0_ = ((h_ * 2) ^ sw2_) << 4, c1_ = ((h_ * 2 + 1) ^ sw2_) << 4; \
      _Pragma("unroll") for (int d0 = 0; d0 < 4; ++d0) { \
        const u32x4 a0_ = *(const u32x4*)(Vr_ + d0 * 2048 + c0_), a1_ = *(const u32x4*)(Vr_ + d0 * 2048 + c1_); \
        const i32x8 vf_ = {(int)a0_[0], (int)a0_[1], (int)a0_[2], (int)a0_[3], (int)a1_[0], (int)a1_[1], (int)a1_[2], (int)a1_[3]}; \
        o[d0] = MFMA8(pf_, vf_, o[d0], SC_P, SC_V); } } \
    if (!(LAST)) PMY = rowmax32(PY0, PY1); \
    asm volatile("s_waitcnt vmcnt(0)" ::: "memory"); } while (0)

  for (int j = 0; j < NT - 2; j += 2) {
    STEP(j, pA0, pA1, pmaxA, pB0, pB1, pmaxB, false);
    STEP(j + 1, pB0, pB1, pmaxB, pA0, pA1, pmaxA, false);
  }
  STEP(NT - 2, pA0, pA1, pmaxA, pB0, pB1, pmaxB, false);
  STEP(NT - 1, pB0, pB1, pmaxB, pA0, pA1, pmaxA, true);
#undef STEP
#undef QK8
#undef PZERO
#undef EXPC
#undef SB
#undef GLK
#undef GLV
#pragma unroll
  for (int r = 0; r < 16; ++r) {
    const int qrow = crow(r, hi); const float rl = 1.f / lane_bcast(l_reg, qrow);
    u16* o_ = p.o + obase + (long)qrow * 1024 + r32;
#pragma unroll
    for (int d = 0; d < 4; ++d) o_[d * 32] = (u16)(cvtpk(o[d][r] * rl, 0.f) & 0xffffu);
  }
}

typedef __attribute__((ext_vector_type(2))) float f32x2;
constexpr float U_SCALE = 256.f, V_SCALE = 64.f;
__device__ __forceinline__ float keyval(u32 k) { return __uint_as_float(k & ~127u) - KEY_BIAS; }
template <int CTRL> __device__ __forceinline__ float dppf(float v) { return __int_as_float(__builtin_amdgcn_update_dpp(0, __float_as_int(v), CTRL, 0xF, 0xF, true)); }
__device__ __forceinline__ float red16(float v) { v += dppf<0xB1>(v); v += dppf<0x4E>(v); v += dppf<0x141>(v); v += dppf<0x140>(v); return v; }
__device__ __forceinline__ void fp8dot(u32 dw, const f32x4& x, f32x2& acc) {
  const f32x2 lo = __builtin_amdgcn_cvt_pk_f32_fp8((int)dw, false), hi = __builtin_amdgcn_cvt_pk_f32_fp8((int)dw, true);
  acc = __builtin_elementwise_fma(lo, (f32x2){x[0], x[1]}, acc); acc = __builtin_elementwise_fma(hi, (f32x2){x[2], x[3]}, acc);
}

#ifndef PEER_FP4
#define PEER_FP4 1
#endif
#if PEER_FP4
constexpr float U4_SCALE = 96.f, V4_SCALE = 22.f;
__device__ __forceinline__ void fp4dot(u32 dw, const f32x4& x0, const f32x4& x1, f32x2& acc) {
  acc = __builtin_elementwise_fma(__builtin_amdgcn_cvt_scalef32_pk_f32_fp4(dw, 1.0f, 0), (f32x2){x0[0], x0[1]}, acc);
  acc = __builtin_elementwise_fma(__builtin_amdgcn_cvt_scalef32_pk_f32_fp4(dw, 1.0f, 1), (f32x2){x0[2], x0[3]}, acc);
  acc = __builtin_elementwise_fma(__builtin_amdgcn_cvt_scalef32_pk_f32_fp4(dw, 1.0f, 2), (f32x2){x1[0], x1[1]}, acc);
  acc = __builtin_elementwise_fma(__builtin_amdgcn_cvt_scalef32_pk_f32_fp4(dw, 1.0f, 3), (f32x2){x1[2], x1[3]}, acc);
}
__device__ __forceinline__ void phase_peer_combine(KP p, int layer, char* lds, unsigned* ctr) {
  const bool last = (layer == 3);
  int tid_ = threadIdx.x; asm volatile("" : "+v"(tid_));
  const int tid = tid_, lane = tid & 63, w = tid >> 6;
  int* eL = (int*)(lds + w * 1536); float* gL = (float*)(lds + w * 1536 + 512); float* wL = (float*)(lds + w * 1536 + 1024);
  int ci = 0, cj = 0; bool cvalid = false;
  { int cnt = 0;
#pragma unroll
    for (int i = 0; i < 16; ++i) { const int n = 16 / (i + 1); if (!cvalid && lane < cnt + n) { ci = i; cj = lane - cnt; cvalid = true; } cnt += n; } }
  const unsigned char* U = p.peer_u8 + (long)layer * 16384 * 512; const unsigned char* V = p.peer_v8 + (long)layer * 16384 * 512;
  const int sub = lane & 15, grp = lane >> 4, l32 = lane & 31, hf = lane >> 5;
  __syncthreads();
  for (;;) {
   int base_ = 0; if (lane == 0) base_ = (int)atomicAdd(ctr, 8u);
   base_ = __builtin_amdgcn_readfirstlane(base_);
   if (base_ >= T_TOK) break;
#pragma unroll 1
   for (int t = base_; t < base_ + 8; ++t) {
    float* xr = p.x + (long)t * DM;
    const u32* pk = p.pkeys + (long)t * 256;
    u32 ka[8], kb[8];
#pragma unroll
    for (int hd = 0; hd < 8; ++hd) { ka[hd] = pk[hd * 32 + ci]; kb[hd] = pk[hd * 32 + 16 + cj]; }
    u32 xe[2][4], xo[2][4]; int sumx = 0; float rstd, sx;
    f32x4 xs[2][8];
#pragma unroll
    for (int j = 0; j < 2; ++j)
#pragma unroll
      for (int q = 0; q < 8; ++q) xs[j][q] = *(const f32x4*)(xr + (sub + 16 * j) * 32 + q * 4);
#pragma unroll
    for (int hd = 0; hd < 8; ++hd) {
      const float cand = cvalid ? keyval(ka[hd]) + keyval(kb[hd]) : -3.0e38f;
      u32 ck = __float_as_uint(cand); ck = (ck & 0x80000000u) ? ~ck : (ck | 0x80000000u); ck = (ck & ~63u) | (u32)(63 - lane);
      int rank = 0;
#pragma unroll
      for (int m = 0; m < 50; ++m) { const u32 c = __builtin_amdgcn_readlane(ck, m); rank += (c > ck) ? 1 : 0; }
      const float cmax = __uint_as_float(__builtin_amdgcn_readlane(__float_as_uint(cand), 0));
      if (cvalid && rank < 16) { eL[hd * 16 + rank] = (int)((ka[hd] & 127u) * 128u + (kb[hd] & 127u)); gL[hd * 16 + rank] = __expf(cand - cmax); }
    }
    __builtin_amdgcn_wave_barrier();
    { const float g0 = gL[lane], g1 = gL[lane + 64]; const float s0 = red16(g0), s1 = red16(g1);
      __builtin_amdgcn_wave_barrier();
      gL[lane] = g0 / s0; gL[lane + 64] = g1 / s1; }
    __builtin_amdgcn_wave_barrier();
    u32x4 cA[8], cB[8];
#define LOADU(C, it) do { const int k0_ = (it) * 16 + grp * 4; \
      _Pragma("unroll") for (int rr = 0; rr < 4; ++rr) { const int e_ = eL[k0_ + rr]; const unsigned char* u_ = U + (long)e_ * 512 + sub * 16; \
        C[rr * 2] = *(const u32x4*)u_; C[rr * 2 + 1] = *(const u32x4*)(u_ + 256); } } while (0)
#define COMPU(C, it) do { const int k0_ = (it) * 16 + grp * 4; \
      _Pragma("unroll") for (int rr = 0; rr < 4; ++rr) { int a_ = 0; \
        _Pragma("unroll") for (int j = 0; j < 2; ++j) { _Pragma("unroll") for (int d = 0; d < 4; ++d) { const u32 dw_ = C[rr * 2 + j][d]; \
          a_ = __builtin_amdgcn_sdot4((int)(dw_ & 0x0F0F0F0Fu), (int)xe[j][d], a_, false); a_ = __builtin_amdgcn_sdot4((int)((dw_ >> 4) & 0x0F0F0F0Fu), (int)xo[j][d], a_, false); } } \
        const float r_ = red16((float)(a_ - 8 * sumx)); \
        if (sub == 0) wL[k0_ + rr] = r_; } } while (0)
#define LOADV(C, g) do { _Pragma("unroll") for (int i = 0; i < 8; ++i) { const int e_ = eL[(g) * 16 + 2 * i + hf]; \
      C[i] = *(const u32x4*)(V + (long)e_ * 512 + l32 * 16); } } while (0)
#define COMPV(C, g) do { _Pragma("unroll") for (int i = 0; i < 8; ++i) { const float wk_ = wL[(g) * 16 + 2 * i + hf]; const f32x2 w2_ = {wk_, wk_}; \
      _Pragma("unroll") for (int d = 0; d < 4; ++d) { const u32 dw_ = C[i][d]; \
        out[d * 4 + 0] = __builtin_elementwise_fma(__builtin_amdgcn_cvt_scalef32_pk_f32_fp4(dw_, 1.0f, 0), w2_, out[d * 4 + 0]); \
        out[d * 4 + 1] = __builtin_elementwise_fma(__builtin_amdgcn_cvt_scalef32_pk_f32_fp4(dw_, 1.0f, 1), w2_, out[d * 4 + 1]); \
        out[d * 4 + 2] = __builtin_elementwise_fma(__builtin_amdgcn_cvt_scalef32_pk_f32_fp4(dw_, 1.0f, 2), w2_, out[d * 4 + 2]); \
        out[d * 4 + 3] = __builtin_elementwise_fma(__builtin_amdgcn_cvt_scalef32_pk_f32_fp4(dw_, 1.0f, 3), w2_, out[d * 4 + 3]); } } } while (0)
    LOADU(cA, 0);
    { float ss = 0.f, am = 0.f;
#pragma unroll
      for (int j = 0; j < 2; ++j)
#pragma unroll
        for (int q = 0; q < 8; ++q) { const f32x4 a = xs[j][q]; ss += a[0] * a[0] + a[1] * a[1] + a[2] * a[2] + a[3] * a[3];
          am = fmaxf(fmaxf(am, fmaxf(fabsf(a[0]), fabsf(a[1]))), fmaxf(fabsf(a[2]), fabsf(a[3]))); }
      ss = red16(ss);
      am = fmaxf(am, dppf<0xB1>(am)); am = fmaxf(am, dppf<0x4E>(am)); am = fmaxf(am, dppf<0x141>(am)); am = fmaxf(am, dppf<0x140>(am));
      rstd = rsqrtf(ss * (1.f / DM) + RMS_EPS);
      am = fmaxf(am, 1e-20f); sx = am * (1.f / 127.f); const float inv = 127.f / am;
#pragma unroll
      for (int j = 0; j < 2; ++j)
#pragma unroll
        for (int d = 0; d < 4; ++d) {
          const f32x4 lo4 = xs[j][2 * d], hi4 = xs[j][2 * d + 1];
          const int i0 = (int)__builtin_rintf(lo4[0] * inv), i1 = (int)__builtin_rintf(lo4[1] * inv), i2 = (int)__builtin_rintf(lo4[2] * inv), i3 = (int)__builtin_rintf(lo4[3] * inv);
          const int i4 = (int)__builtin_rintf(hi4[0] * inv), i5 = (int)__builtin_rintf(hi4[1] * inv), i6 = (int)__builtin_rintf(hi4[2] * inv), i7 = (int)__builtin_rintf(hi4[3] * inv);
          sumx += i0 + i1 + i2 + i3 + i4 + i5 + i6 + i7;
          xe[j][d] = (u32)(i0 & 0xFF) | ((u32)(i2 & 0xFF) << 8) | ((u32)(i4 & 0xFF) << 16) | ((u32)i6 << 24);
          xo[j][d] = (u32)(i1 & 0xFF) | ((u32)(i3 & 0xFF) << 8) | ((u32)(i5 & 0xFF) << 16) | ((u32)i7 << 24);
        } }
#pragma unroll 1
    for (int it = 0; it < 6; it += 2) { LOADU(cB, it + 1); COMPU(cA, it); LOADU(cA, it + 2); COMPU(cB, it + 1); }
    LOADU(cB, 7); COMPU(cA, 6);
    LOADV(cA, 0);
    COMPU(cB, 7);
    __builtin_amdgcn_wave_barrier();
    { const float sc_ = rstd * sx * (1.f / U4_SCALE); const float a0 = wL[lane] * sc_, a1 = wL[lane + 64] * sc_;
      const float w0 = gL[lane] * 0.5f * a0 * (1.f + erff(a0 * 0.70710678118654752f)), w1 = gL[lane + 64] * 0.5f * a1 * (1.f + erff(a1 * 0.70710678118654752f));
      __builtin_amdgcn_wave_barrier();
      wL[lane] = w0; wL[lane + 64] = w1; }
    __builtin_amdgcn_wave_barrier();
    f32x2 out[16];
#pragma unroll
    for (int i = 0; i < 16; ++i) out[i] = (f32x2){0.f, 0.f};
#pragma unroll 1
    for (int g = 0; g < 6; g += 2) { LOADV(cB, g + 1); COMPV(cA, g); LOADV(cA, g + 2); COMPV(cB, g + 1); }
    LOADV(cB, 7); COMPV(cA, 6); COMPV(cB, 7);
#undef LOADU
#undef COMPU
#undef LOADV
#undef COMPV
    {
      f32x4 v[4];
#pragma unroll
      for (int q = 0; q < 4; ++q) {
        const f32x2 m0 = hf ? out[8 + 2 * q] : out[2 * q], o0 = hf ? out[2 * q] : out[8 + 2 * q];
        const f32x2 m1 = hf ? out[8 + 2 * q + 1] : out[2 * q + 1], o1 = hf ? out[2 * q + 1] : out[8 + 2 * q + 1];
        v[q] = (f32x4){m0[0] + shx(o0[0], 32), m0[1] + shx(o0[1], 32), m1[0] + shx(o1[0], 32), m1[1] + shx(o1[1], 32)};
      }
      f32x4* xo = (f32x4*)(xr + l32 * 32 + hf * 16);
#pragma unroll
      for (int q = 0; q < 4; ++q) { const f32x4 xv = xo[q]; v[q] = xv + v[q] * (1.f / V4_SCALE); }
      __builtin_amdgcn_wave_barrier();
      if (last) {
        float s2 = 0.f;
#pragma unroll
        for (int q = 0; q < 4; ++q) s2 += v[q][0] * v[q][0] + v[q][1] * v[q][1] + v[q][2] * v[q][2] + v[q][3] * v[q][3];
        s2 = red16(s2); s2 += shx(s2, 16); s2 += shx(s2, 32);
        const float rf = rsqrtf(s2 * (1.f / DM) + RMS_EPS);
#pragma unroll
        for (int q = 0; q < 4; ++q) { const f32x4 gf = *(const f32x4*)(p.norm_final + l32 * 32 + hf * 16 + q * 4); v[q] = v[q] * rf * gf; }
      }
#pragma unroll
      for (int q = 0; q < 4; ++q) xo[q] = v[q];
      u32x4* xbo = (u32x4*)(p.xb + (long)t * DM + l32 * 32 + hf * 16);
      xbo[0] = (u32x4){cvtpk(v[0][0], v[0][1]), cvtpk(v[0][2], v[0][3]), cvtpk(v[1][0], v[1][1]), cvtpk(v[1][2], v[1][3])};
      xbo[1] = (u32x4){cvtpk(v[2][0], v[2][1]), cvtpk(v[2][2], v[2][3]), cvtpk(v[3][0], v[3][1]), cvtpk(v[3][2], v[3][3])}; }
    __builtin_amdgcn_wave_barrier();
   }
  }
}
#else
__device__ __forceinline__ void phase_peer_combine(KP p, int layer, char* lds, unsigned*) {
  const bool last = (layer == 3);
  int tid_ = threadIdx.x; asm volatile("" : "+v"(tid_));
  const int tid = tid_, lane = tid & 63, w = tid >> 6;
  int* eL = (int*)(lds + w * 1536); float* gL = (float*)(lds + w * 1536 + 512); float* wL = (float*)(lds + w * 1536 + 1024);
  int ci = 0, cj = 0; bool cvalid = false;
  { int cnt = 0;
#pragma unroll
    for (int i = 0; i < 16; ++i) { const int n = 16 / (i + 1); if (!cvalid && lane < cnt + n) { ci = i; cj = lane - cnt; cvalid = true; } cnt += n; } }
  const unsigned char* U = p.peer_u8 + (long)layer * 16384 * 1024; const unsigned char* V = p.peer_v8 + (long)layer * 16384 * 1024;
  const int sub = lane & 15, grp = lane >> 4;
  __syncthreads();
  for (int t = blockIdx.x * 4 + w; t < T_TOK; t += gridDim.x * 4) {
    float* xr = p.x + (long)t * DM;
    const u32* pk = p.pkeys + (long)t * 256;
    u32 ka[8], kb[8];
#pragma unroll
    for (int hd = 0; hd < 8; ++hd) { ka[hd] = pk[hd * 32 + ci]; kb[hd] = pk[hd * 32 + 16 + cj]; }
    f32x4 xs[4][4]; float ss = 0.f;
#pragma unroll
    for (int i = 0; i < 4; ++i)
#pragma unroll
      for (int q = 0; q < 4; ++q) { const f32x4 a = *(const f32x4*)(xr + (sub + 16 * i) * 16 + q * 4); xs[i][q] = a; ss += a[0] * a[0] + a[1] * a[1] + a[2] * a[2] + a[3] * a[3]; }
    ss = red16(ss);
    const float rstd = rsqrtf(ss * (1.f / DM) + RMS_EPS);
#pragma unroll
    for (int hd = 0; hd < 8; ++hd) {
      const float cand = cvalid ? keyval(ka[hd]) + keyval(kb[hd]) : -3.0e38f;
      u32 ck = __float_as_uint(cand); ck = (ck & 0x80000000u) ? ~ck : (ck | 0x80000000u); ck = (ck & ~63u) | (u32)(63 - lane);
      int rank = 0;
#pragma unroll
      for (int m = 0; m < 50; ++m) { const u32 c = __builtin_amdgcn_readlane(ck, m); rank += (c > ck) ? 1 : 0; }
      const float cmax = __uint_as_float(__builtin_amdgcn_readlane(__float_as_uint(cand), 0));
      if (cvalid && rank < 16) { eL[hd * 16 + rank] = (int)((ka[hd] & 127u) * 128u + (kb[hd] & 127u)); gL[hd * 16 + rank] = __expf(cand - cmax); }
    }
    __builtin_amdgcn_wave_barrier();
    { const float g0 = gL[lane], g1 = gL[lane + 64]; const float s0 = red16(g0), s1 = red16(g1);
      __builtin_amdgcn_wave_barrier();
      gL[lane] = g0 / s0; gL[lane + 64] = g1 / s1; }
    __builtin_amdgcn_wave_barrier();
    u32x4 cA[8], cB[8];
#define LOADU(C, it) do { const int k0_ = (it) * 8 + grp * 2; const int e0_ = eL[k0_], e1_ = eL[k0_ + 1]; \
      const unsigned char* u0_ = U + (long)e0_ * 1024 + sub * 16; const unsigned char* u1_ = U + (long)e1_ * 1024 + sub * 16; \
      _Pragma("unroll") for (int i = 0; i < 4; ++i) { C[i] = *(const u32x4*)(u0_ + i * 256); C[4 + i] = *(const u32x4*)(u1_ + i * 256); } } while (0)
#define COMPU(C, it) do { const int k0_ = (it) * 8 + grp * 2; f32x2 a0_ = {0.f, 0.f}, a1_ = {0.f, 0.f}; \
      _Pragma("unroll") for (int i = 0; i < 4; ++i) { _Pragma("unroll") for (int q = 0; q < 4; ++q) { fp8dot(C[i][q], xs[i][q], a0_); fp8dot(C[4 + i][q], xs[i][q], a1_); } } \
      const float r0_ = red16(a0_[0] + a0_[1]), r1_ = red16(a1_[0] + a1_[1]); \
      if (sub == 0) { const float aa_ = r0_ * rstd * (1.f / U_SCALE), ab_ = r1_ * rstd * (1.f / U_SCALE); \
        wL[k0_] = gL[k0_] * 0.5f * aa_ * (1.f + erff(aa_ * 0.70710678118654752f)); \
        wL[k0_ + 1] = gL[k0_ + 1] * 0.5f * ab_ * (1.f + erff(ab_ * 0.70710678118654752f)); } } while (0)
#define LOADV(C, g) do { _Pragma("unroll") for (int i = 0; i < 8; ++i) { const int e_ = eL[(g) * 8 + i]; C[i] = *(const u32x4*)(V + (long)e_ * 1024 + lane * 16); } } while (0)
#define COMPV(C, g) do { _Pragma("unroll") for (int i = 0; i < 8; ++i) { const float wk_ = wL[(g) * 8 + i]; const f32x2 w2_ = {wk_, wk_}; \
      _Pragma("unroll") for (int q = 0; q < 4; ++q) { \
        const f32x2 lo_ = __builtin_amdgcn_cvt_pk_f32_fp8((int)C[i][q], false), hi_ = __builtin_amdgcn_cvt_pk_f32_fp8((int)C[i][q], true); \
        out[2 * q] = __builtin_elementwise_fma(lo_, w2_, out[2 * q]); out[2 * q + 1] = __builtin_elementwise_fma(hi_, w2_, out[2 * q + 1]); } } } while (0)
    LOADU(cA, 0);
#pragma unroll 1
    for (int it = 0; it < 14; it += 2) { LOADU(cB, it + 1); COMPU(cA, it); LOADU(cA, it + 2); COMPU(cB, it + 1); }
    LOADU(cB, 15); COMPU(cA, 14);
    LOADV(cA, 0);
    COMPU(cB, 15);
    __builtin_amdgcn_wave_barrier();
    f32x2 out[8];
#pragma unroll
    for (int i = 0; i < 8; ++i) out[i] = (f32x2){0.f, 0.f};
#pragma unroll 1
    for (int g = 0; g < 14; g += 2) { LOADV(cB, g + 1); COMPV(cA, g); LOADV(cA, g + 2); COMPV(cB, g + 1); }
    LOADV(cB, 15); COMPV(cA, 14); COMPV(cB, 15);
#undef LOADU
#undef COMPU
#undef LOADV
#undef COMPV
    { f32x4* xo = (f32x4*)(xr + lane * 16);
      f32x4 v[4];
#pragma unroll
      for (int q = 0; q < 4; ++q) { v[q] = xo[q]; v[q][0] += out[2 * q][0] * (1.f / V_SCALE); v[q][1] += out[2 * q][1] * (1.f / V_SCALE); v[q][2] += out[2 * q + 1][0] * (1.f / V_SCALE); v[q][3] += out[2 * q + 1][1] * (1.f / V_SCALE); }
      __builtin_amdgcn_wave_barrier();
      if (last) {
        float s2 = 0.f;
#pragma unroll
        for (int q = 0; q < 4; ++q) s2 += v[q][0] * v[q][0] + v[q][1] * v[q][1] + v[q][2] * v[q][2] + v[q][3] * v[q][3];
        s2 = red16(s2); s2 += shx(s2, 16); s2 += shx(s2, 32);
        const float rf = rsqrtf(s2 * (1.f / DM) + RMS_EPS);
#pragma unroll
        for (int q = 0; q < 4; ++q) { const f32x4 gf = *(const f32x4*)(p.norm_final + lane * 16 + q * 4); v[q] = v[q] * rf * gf; }
      }
#pragma unroll
      for (int q = 0; q < 4; ++q) xo[q] = v[q];
      u32x4* xbo = (u32x4*)(p.xb + (long)t * DM + lane * 16);
      xbo[0] = (u32x4){cvtpk(v[0][0], v[0][1]), cvtpk(v[0][2], v[0][3]), cvtpk(v[1][0], v[1][1]), cvtpk(v[1][2], v[1][3])};
      xbo[1] = (u32x4){cvtpk(v[2][0], v[2][1]), cvtpk(v[2][2], v[2][3]), cvtpk(v[3][0], v[3][1]), cvtpk(v[3][2], v[3][3])}; }
    __builtin_amdgcn_wave_barrier();
  }
}

#endif

#if PEER_FP4
constexpr long TBL_ITERS = 4L * 16384 * 1024 / 16; constexpr int TBL_NCHUNK = 512; constexpr long TBL_CHUNK = TBL_ITERS / TBL_NCHUNK;
__device__ __forceinline__ void convert_tables_chunk(KP p, int chunk) {
  int tid_ = threadIdx.x; asm volatile("" : "+v"(tid_));
#define Q4(val) ((u32)(int)(fminf(fmaxf(__builtin_rintf((val) * U4_SCALE), -8.f), 7.f) + 8.f))
  for (long i = (long)chunk * TBL_CHUNK + tid_; i < (long)(chunk + 1) * TBL_CHUNK; i += NTHR) {
    const long e = i * 16; const int layer = (int)(e >> 24); const int d = (int)(e & 1023);
    u32 uo[2], vo[2];
#pragma unroll
    for (int h = 0; h < 2; ++h) {
      u32 a = 0, b = 0;
#pragma unroll
      for (int q = 0; q < 2; ++q) {
        const f32x4 g = *(const f32x4*)(p.in_norm_ffn + layer * 1024 + d + h * 8 + q * 4);
        const f32x4 u = *(const f32x4*)(p.in_peer_u + e + h * 8 + q * 4), v = *(const f32x4*)(p.in_peer_v + e + h * 8 + q * 4);
        if (q == 0) {
          a |= Q4(u[0] * g[0]) | (Q4(u[1] * g[1]) << 4) | (Q4(u[2] * g[2]) << 8) | (Q4(u[3] * g[3]) << 12);
          b = __builtin_amdgcn_cvt_scalef32_pk_fp4_f32(b, v[0] * V4_SCALE, v[1] * V4_SCALE, 1.0f, 0); b = __builtin_amdgcn_cvt_scalef32_pk_fp4_f32(b, v[2] * V4_SCALE, v[3] * V4_SCALE, 1.0f, 1);
        } else {
          a |= (Q4(u[0] * g[0]) << 16) | (Q4(u[1] * g[1]) << 20) | (Q4(u[2] * g[2]) << 24) | (Q4(u[3] * g[3]) << 28);
          b = __builtin_amdgcn_cvt_scalef32_pk_fp4_f32(b, v[0] * V4_SCALE, v[1] * V4_SCALE, 1.0f, 2); b = __builtin_amdgcn_cvt_scalef32_pk_fp4_f32(b, v[2] * V4_SCALE, v[3] * V4_SCALE, 1.0f, 3);
        }
      }
      uo[h] = a; vo[h] = b;
    }
    *(u32x2*)(p.peer_u8 + (e >> 1)) = (u32x2){uo[0], uo[1]}; *(u32x2*)(p.peer_v8 + (e >> 1)) = (u32x2){vo[0], vo[1]};
  }
}

#endif
__device__ __forceinline__ void prep_transpose_tile(KP p, int t, char* lds) {
  int tid_ = threadIdx.x; asm volatile("" : "+v"(tid_));
  const int tid = tid_;
  float* tl = (float*)lds;
  int j = 0;
  while (j + 1 < p.njobs && t >= p.jobs[j + 1].tile0) ++j;
  const float* src = p.jobs[j].src; u16* dst = p.jobs[j].dst; const float* gain = p.jobs[j].gain;
  const int K = p.jobs[j].K, N = p.jobs[j].N, scale_cols = p.jobs[j].scale_cols; const float scale = p.jobs[j].scale;
  const int lt = t - p.jobs[j].tile0, ntn = N >> 6, kt = lt / ntn, nt = lt - kt * ntn;
  __syncthreads();
  for (int e = tid; e < 4096; e += 256) { const int kk = e >> 6, nn = e & 63, k = kt * 64 + kk; const float g = gain ? gain[k] : 1.f; tl[kk * 65 + nn] = src[(long)k * N + nt * 64 + nn] * g; }
  __syncthreads();
  for (int e = tid; e < 2048; e += 256) { const int nn = e >> 5, kp = (e & 31) * 2, n = nt * 64 + nn; const float s = (n < scale_cols) ? scale : 1.f;
    *(u32*)(dst + (long)n * K + kt * 64 + kp) = cvtpk(tl[kp * 65 + nn] * s, tl[(kp + 1) * 65 + nn] * s); }
  __syncthreads();
}

__device__ __forceinline__ void phase_prep(KP p, char* lds) {
  int tid_ = threadIdx.x; asm volatile("" : "+v"(tid_));
  const int tid = tid_;
  const long gtid = (long)blockIdx.x * NTHR + tid, gsz = (long)gridDim.x * NTHR;
  float* tl = (float*)lds;
  for (int t = blockIdx.x; t < p.jobs[4].tile0; t += gridDim.x) prep_transpose_tile(p, t, lds);
  for (long i = gtid; i < (long)T_TOK * DM / 4; i += gsz) {
    const long e = i * 4; const f32x4 v = e < (long)T_PROMPT * DM ? *(const f32x4*)(p.xin0 + e) : *(const f32x4*)(p.xin1 + (e - (long)T_PROMPT * DM));
    *(u32*)(p.xb + e) = cvtpk(v[0], v[1]); *(u32*)(p.xb + e + 2) = cvtpk(v[2], v[3]); }
  for (long i = gtid; i < 4L * 8 * 2 * 128 * 128 / 2; i += gsz) { const float a = p.in_sub_keys[2 * i], b = p.in_sub_keys[2 * i + 1]; *(u32*)(p.peer_sk + 2 * i) = cvtpk(a, b); }
#if PEER_FP4
#else
  for (long i = gtid; i < 4L * 16384 * 1024 / 16; i += gsz) {
    const long e = i * 16; const int layer = (int)(e >> 24); const int d = (int)(e & 1023);
    u32x4 uo, vo;
#pragma unroll
    for (int q = 0; q < 4; ++q) {
      const f32x4 g = *(const f32x4*)(p.in_norm_ffn + layer * 1024 + d + q * 4);
      const f32x4 u = *(const f32x4*)(p.in_peer_u + e + q * 4), v = *(const f32x4*)(p.in_peer_v + e + q * 4);
      int a = 0, b = 0;
      a = __builtin_amdgcn_cvt_pk_fp8_f32(u[0] * g[0] * U_SCALE, u[1] * g[1] * U_SCALE, a, false); a = __builtin_amdgcn_cvt_pk_fp8_f32(u[2] * g[2] * U_SCALE, u[3] * g[3] * U_SCALE, a, true);
      b = __builtin_amdgcn_cvt_pk_fp8_f32(v[0] * V_SCALE, v[1] * V_SCALE, b, false); b = __builtin_amdgcn_cvt_pk_fp8_f32(v[2] * V_SCALE, v[3] * V_SCALE, b, true);
      uo[q] = (u32)a; vo[q] = (u32)b;
    }
    *(u32x4*)(p.peer_u8 + e) = uo; *(u32x4*)(p.peer_v8 + e) = vo;
  }
#endif
  for (long i = gtid; i < 2 * 3072; i += gsz) { const int c = (int)(i % 3072); p.na_bias_s[i] = p.in_na_bias[i] * (c < 1024 ? 0.125f * LOG2E : 1.f); }
  for (long i = gtid; i < 2 * 16 * 465; i += gsz) p.na_rpb_s[i] = p.in_na_rpb[i] * LOG2E;
  for (long i = gtid; i < 16384L * 32; i += gsz) {
    const int pos = (int)(i >> 5), jf = (int)(i & 31);
    const double a = (double)pos * p.inv_freq[jf] * 0.15915494309189535;
    const double fr = a - rint(a);
    const float f = (float)fr;
    p.ropeC[i] = __builtin_amdgcn_cosf(f); p.ropeS[i] = __builtin_amdgcn_sinf(f);
  }
  for (long i = gtid; i < 2L * 64 * 1024 / 2; i += gsz) { const int l = (int)(i >> 15); const long e = (i & 32767) * 2; *(u32*)(p.wa_t[l] + 704L * 1024 + e) = 0u; }
}

__device__ __forceinline__ void phase_final(KP p) {
  int tid_ = threadIdx.x; asm volatile("" : "+v"(tid_));
  const int lane = tid_ & 63, w = tid_ >> 6;
  for (int t = blockIdx.x * 4 + w; t < T_TOK; t += gridDim.x * 4) {
    float* xr = p.x + (long)t * DM;
    f32x4 v[4]; float ss = 0.f;
#pragma unroll
    for (int i = 0; i < 4; ++i) { v[i] = *(const f32x4*)(xr + i * 256 + lane * 4); ss += v[i][0] * v[i][0] + v[i][1] * v[i][1] + v[i][2] * v[i][2] + v[i][3] * v[i][3]; }
    ss += shx(ss, 1); ss += shx(ss, 2); ss += shx(ss, 4); ss += shx(ss, 8); ss += shx(ss, 16); ss += shx(ss, 32);
    const float rs = rsqrtf(ss * (1.f / DM) + RMS_EPS);
#pragma unroll
    for (int i = 0; i < 4; ++i) { const f32x4 g = *(const f32x4*)(p.norm_final + i * 256 + lane * 4); f32x4 o_ = {v[i][0] * rs * g[0], v[i][1] * rs * g[1], v[i][2] * rs * g[2], v[i][3] * rs * g[3]}; *(f32x4*)(xr + i * 256 + lane * 4) = o_; }
  }
}

template <int EPI>
__device__ __forceinline__ void gemm_big(KP p, int layer, const u16* Ap, int lda, const u16* Bt, int K, int m0, int n0, char* lds) {
  int tid_ = threadIdx.x; asm volatile("" : "+v"(tid_));
  const int tid = tid_, lane = tid & 63, w = tid >> 6;
  const int wm = w >> 1, wn = w & 1, r32 = lane & 31, hi = lane >> 5;
  constexpr int STG = 24576;
  const int scol = ((lane & 3) ^ ((lane >> 4) & 3)) * 8;
  const u16* Ag = Ap + (long)(m0 + w * 64 + (lane >> 2)) * lda + scol;
  const u16* Bg = Bt + (long)(n0 + w * 32 + (lane >> 2)) * K + scol;
#define GST(st, kt) do { int w_ = w; asm volatile("" : "+v"(w_)); \
    _Pragma("unroll") for (int i = 0; i < 4; ++i) __builtin_amdgcn_global_load_lds((const unsigned*)(Ag + (long)i * 16 * lda + (kt) * 32), (unsigned*)(lds + (st) * STG + (w_ * 4 + i) * 1024), 16, 0, 0); \
    _Pragma("unroll") for (int i = 0; i < 2; ++i) __builtin_amdgcn_global_load_lds((const unsigned*)(Bg + (long)i * 16 * K + (kt) * 32), (unsigned*)(lds + (st) * STG + 16384 + (w_ * 2 + i) * 1024), 16, 0, 0); } while (0)
  f32x16 acc[4][2];
#pragma unroll
  for (int i = 0; i < 4; ++i)
#pragma unroll
    for (int j = 0; j < 2; ++j)
#pragma unroll
      for (int r = 0; r < 16; ++r) acc[i][j][r] = 0.f;
  float ssq[4] = {0.f, 0.f, 0.f, 0.f};
  const int sw = (r32 >> 2) & 3;
  const int arow = (wm * 128 + r32) * 64, brow = 16384 + (wn * 64 + r32) * 64;
  const int nk = K / 32;
  __syncthreads();
  GST(0, 0); GST(1, 1);
  int st = 0;
  for (int kt = 0; kt < nk; ++kt) {
    if (kt + 1 < nk) asm volatile("s_waitcnt vmcnt(6)" ::: "memory"); else asm volatile("s_waitcnt vmcnt(0)" ::: "memory");
    asm volatile("s_waitcnt lgkmcnt(0)" ::: "memory");
    __builtin_amdgcn_s_barrier();
    if (kt + 2 < nk) { const int s2 = st + 2 >= 3 ? st - 1 : st + 2; GST(s2, kt + 2); }
    const char* base = lds + st * STG;
#pragma unroll
    for (int ks = 0; ks < 2; ++ks) {
      const int co = ((ks * 2 + hi) ^ sw) << 4;
      bf16x8 a[4], b[2];
#pragma unroll
      for (int mi = 0; mi < 4; ++mi) a[mi] = *(const bf16x8*)(base + arow + mi * 2048 + co);
#pragma unroll
      for (int ni = 0; ni < 2; ++ni) b[ni] = *(const bf16x8*)(base + brow + ni * 2048 + co);
#pragma unroll
      for (int mi = 0; mi < 4; ++mi) { acc[mi][0] = mfma32(b[0], a[mi], acc[mi][0]); acc[mi][1] = mfma32(b[1], a[mi], acc[mi][1]); }
#pragma unroll
      for (int mi = 0; mi < 4; ++mi) { const u32x4 x = __builtin_bit_cast(u32x4, a[mi]);
#pragma unroll
        for (int q = 0; q < 4; ++q) ssq[mi] = dot2bf(x[q], x[q], ssq[mi]); }
    }
    st = st == 2 ? 0 : st + 1;
  }
#undef GST
  __syncthreads();
  float rs[4];
#pragma unroll
  for (int mi = 0; mi < 4; ++mi) { const float t = ssq[mi] + shx(ssq[mi], 32); rs[mi] = rsqrtf(t / (float)K + RMS_EPS); }
  const int rowb = wm * 128, colb = wn * 64;
  if constexpr (EPI == EPI_A || EPI == EPI_QKV) {
    constexpr int OROW = 272;
    u16* outp; int ldo; bool rope = false;
    if constexpr (EPI == EPI_A) { outp = p.cqkv; ldo = 768; rope = (n0 + colb == 640); }
    else { outp = p.qkv; ldo = 3072; }
#pragma unroll
    for (int mi = 0; mi < 4; ++mi) {
      const int rl = rowb + mi * 32 + r32; const int pos = tok_pos(m0 + rl);
#pragma unroll
      for (int g = 0; g < 4; ++g) {
        f32x4 v0, v1;
#pragma unroll
        for (int e = 0; e < 4; ++e) { v0[e] = acc[mi][0][4 * g + e] * rs[mi]; v1[e] = acc[mi][1][4 * g + e] * rs[mi]; }
        if constexpr (EPI == EPI_QKV) {
          const f32x4 b0 = *(const f32x4*)(p.na_bias_s + layer * 3072 + n0 + colb + 8 * g + 4 * hi), b1 = *(const f32x4*)(p.na_bias_s + layer * 3072 + n0 + colb + 32 + 8 * g + 4 * hi);
          v0 += b0; v1 += b1;
        }
        if (rope) {
          const f32x4 c = *(const f32x4*)(p.ropeC + pos * 32 + 8 * g + 4 * hi), sn = *(const f32x4*)(p.ropeS + pos * 32 + 8 * g + 4 * hi);
          const f32x4 t0 = (v0 * c - v1 * sn) * K8_SCALE, t1 = (v0 * sn + v1 * c) * K8_SCALE;
          unsigned char* kp_ = p.k8 + (long)(m0 + rl) * 1088 + 1024 + 8 * g + 4 * hi;
          *(u32*)kp_ = pack4_fp8(t0[0], t0[1], t0[2], t0[3]); *(u32*)(kp_ + 32) = pack4_fp8(t1[0], t1[1], t1[2], t1[3]);
        }
        char* e_ = lds + rl * OROW + (colb + 8 * g + 4 * hi) * 2;
        *(u32x2*)e_ = (u32x2){cvtpk(v0[0], v0[1]), cvtpk(v0[2], v0[3])};
        *(u32x2*)(e_ + 64) = (u32x2){cvtpk(v1[0], v1[1]), cvtpk(v1[2], v1[3])};
      }
    }
    __syncthreads();
#pragma unroll 4
    for (int i = 0; i < 16; ++i) { const int c = tid + 256 * i, row = c >> 4, ch = c & 15;
      *(u32x4*)(outp + (long)(m0 + row) * ldo + n0 + ch * 8) = *(const u32x4*)(lds + row * OROW + ch * 16); }
  } else {
    constexpr int BROW = 144;
    const bool rope = (EPI == EPI_UQ) && ((n0 + colb) % 192 == 128);
    const float sc = (EPI == EPI_UQ) ? Q8_SCALE : K8_SCALE;
#pragma unroll
    for (int mi = 0; mi < 4; ++mi) {
      const int rl = rowb + mi * 32 + r32; const int pos = tok_pos(m0 + rl);
#pragma unroll
      for (int g = 0; g < 4; ++g) {
        f32x4 v0, v1;
#pragma unroll
        for (int e = 0; e < 4; ++e) { v0[e] = acc[mi][0][4 * g + e] * rs[mi] * sc; v1[e] = acc[mi][1][4 * g + e] * rs[mi] * sc; }
        if (rope) {
          const f32x4 c = *(const f32x4*)(p.ropeC + pos * 32 + 8 * g + 4 * hi), sn = *(const f32x4*)(p.ropeS + pos * 32 + 8 * g + 4 * hi);
          const f32x4 t0 = v0 * c - v1 * sn, t1 = v0 * sn + v1 * c; v0 = t0; v1 = t1;
        }
        char* e_ = lds + rl * BROW + (colb + 8 * g + 4 * hi);
        *(u32*)e_ = pack4_fp8(v0[0], v0[1], v0[2], v0[3]); *(u32*)(e_ + 32) = pack4_fp8(v1[0], v1[1], v1[2], v1[3]);
      }
    }
    __syncthreads();
    unsigned char* outb; long ldo;
    if constexpr (EPI == EPI_UQ) { outb = p.q8 + n0; ldo = 1536; } else { outb = p.k8 + (n0 >> 8) * 128; ldo = 1088; }
#pragma unroll 2
    for (int i = 0; i < 8; ++i) { const int c = tid + 256 * i, row = c >> 3, ch = c & 7;
      *(u32x4*)(outb + (long)(m0 + row) * ldo + ch * 16) = *(const u32x4*)(lds + row * BROW + ch * 16); }
  }
}

__device__ __forceinline__ void ukv_tile(KP p, int j, int mt, int nt, char* lds) {
  if (nt & 1) gemm_tile<EPI_UV, true>(p, j, p.cqkv + 384, 768, p.wukv_t[j], 256, mt * 128, nt * 128, lds);
  else gemm_tile<EPI_UK, true>(p, j, p.cqkv + 384, 768, p.wukv_t[j], 256, mt * 128, nt * 128, lds);
}
#define XB_TMO      128
#define XB_XCNT(j)  (256  + 64 * (j))
#define XB_XSUB(j)  (1280 + 64 * (j))
#define XB_XGEN(j)  (2304 + 64 * (j))
#define XB_TOP      3328
#define XB_TOPGEN   3392
#define XCD_BAR_WORDS 3456
#define XB_SPIN_CAP (1u << 18)
#define LAS __attribute__((address_space(3)))
__device__ __forceinline__ unsigned xb_ld(unsigned* p)              { return __hip_atomic_load(p, __ATOMIC_RELAXED, __HIP_MEMORY_SCOPE_AGENT); }
__device__ __forceinline__ unsigned xb_add(unsigned* p, unsigned v) { return __hip_atomic_fetch_add(p, v, __ATOMIC_RELAXED, __HIP_MEMORY_SCOPE_AGENT); }
__device__ __forceinline__ unsigned xb_xcc_id() { return (unsigned)__builtin_amdgcn_s_getreg((3 << 11) | 20) & 0xFu; }
#define XB_SPIN(cond, bar) do { unsigned _sp = 0; while (cond) { __builtin_amdgcn_s_sleep(1); \
    if ((++_sp & 255u) == 0u) { if (xb_ld(&(bar)[XB_TMO])) break; if (_sp > XB_SPIN_CAP) { atomicAdd(&(bar)[XB_TMO], 1u); break; } } } } while (0)
struct XcdBarrier { unsigned* bar; unsigned x; volatile LAS unsigned* st; };
__device__ __forceinline__ XcdBarrier xcd_barrier_post(unsigned* bar, volatile LAS unsigned* st) {
    XcdBarrier b; b.bar = bar; b.x = xb_xcc_id(); b.st = st;
    if (threadIdx.x == 0) (void)xb_add(&bar[XB_XCNT(b.x)], 1u);
    return b;
}
__device__ __forceinline__ void xcd_barrier_complete(unsigned* bar, unsigned x, unsigned& nloc, unsigned& nx) {
    const unsigned G = gridDim.x * gridDim.y * gridDim.z;
    unsigned sum, cnt, mine, sp = 0u;
    for (;;) {
        sum = 0u; cnt = 0u; mine = 0u;
#pragma unroll
        for (unsigned j = 0; j < 16; ++j) { const unsigned c = xb_ld(&bar[XB_XCNT(j)]); sum += c; cnt += (c > 0u) ? 1u : 0u; mine = (j == x) ? c : mine; }
        if (sum == G) break;
        __builtin_amdgcn_s_sleep(1);
        if ((++sp & 255u) == 0u) { if (xb_ld(&bar[XB_TMO])) break; if (sp > XB_SPIN_CAP) { atomicAdd(&bar[XB_TMO], 1u); break; } }
    }
    nloc = mine > 0u ? mine : 1u; nx = cnt > 0u ? cnt : 1u;
}
__device__ __forceinline__ void xcd_barrier(const XcdBarrier& b) {
    asm volatile("s_waitcnt vmcnt(0)" ::: "memory");
    __syncthreads();
    if (threadIdx.x == 0) {
        unsigned* bar = b.bar;
        __builtin_amdgcn_s_waitcnt(0);
        unsigned nloc = b.st[0], nx = b.st[1];
        if (nloc == 0u) { xcd_barrier_complete(bar, b.x, nloc, nx); b.st[0] = nloc; b.st[1] = nx; }
        const unsigned old = xb_add(&bar[XB_XSUB(b.x)], 1u);
        const unsigned gen = old / nloc;
        if (old + 1u == (gen + 1u) * nloc) {
            __builtin_amdgcn_fence(__ATOMIC_RELEASE, "agent");
            asm volatile("s_waitcnt vmcnt(0)" ::: "memory");
            const unsigned og = xb_add(&bar[XB_TOP], 1u);
            const unsigned tg = og / nx;
            if (og + 1u == (tg + 1u) * nx) xb_add(&bar[XB_TOPGEN], 1u);
            else XB_SPIN(xb_ld(&bar[XB_TOPGEN]) == tg, bar);
            __builtin_amdgcn_fence(__ATOMIC_ACQUIRE, "agent");
            xb_add(&bar[XB_XGEN(b.x)], 1u);
            asm volatile("s_waitcnt vmcnt(0)" ::: "memory");
        } else {
            XB_SPIN(xb_ld(&bar[XB_XGEN(b.x)]) == gen, bar);
            __builtin_amdgcn_fence(__ATOMIC_ACQUIRE, "agent");
            asm volatile("s_waitcnt vmcnt(0)" ::: "memory");
        }
    }
    __syncthreads();
}

#define GEMM_PHASE(SUB, MTILES, NTILES, SM, SN, CALL) do { \
    const int nsn_ = (NTILES) / (SN), nsuper_ = ((MTILES) / (SM)) * nsn_, per_ = (SM) * (SN); \
    const int xcd_ = blockIdx.x & 7; \
    const int total_ = ((nsuper_ - xcd_ + 7) >> 3) * per_;            \
    unsigned* q_ = p.bar + XCD_BAR_WORDS + 64 + (ph * 3 + (SUB)) * 8 + xcd_; \
    for (;;) { \
      if (threadIdx.x == 0) xb_words[2] = atomicAdd(q_, 1u); \
      __syncthreads(); const int idx_ = (int)xb_words[2]; __syncthreads(); \
      if (idx_ >= total_) break; \
      const int r_ = idx_ / per_, l_ = idx_ - r_ * per_, s_ = xcd_ + 8 * r_, sm_ = s_ / nsn_, sn_ = s_ - sm_ * nsn_; \
      const int mt = sm_ * (SM) + l_ / (SN), nt = sn_ * (SN) + l_ % (SN); CALL; } } while (0)

__global__ void __launch_bounds__(NTHR, LB2) mega(const Params p_unused, int ph_lo, int ph_hi) {
  __shared__ __attribute__((aligned(16))) char lds[SMEM_BYTES];
  volatile LAS unsigned* xb_words = (volatile LAS unsigned*)(lds + SMEM_BYTES - 16);
  constexpr int MT = T_TOK / 128;
  XcdBarrier xb;
  { const __attribute__((address_space(4))) Params* pp0 = (const __attribute__((address_space(4))) Params*)__builtin_amdgcn_kernarg_segment_ptr();
    if (threadIdx.x < 4) xb_words[threadIdx.x] = 0u;
    __syncthreads();
    xb = xcd_barrier_post(pp0->bar, xb_words); }
  for (int ph = ph_lo; ph < ph_hi; ++ph) {
    const __attribute__((address_space(4))) Params* pp = (const __attribute__((address_space(4))) Params*)__builtin_amdgcn_kernarg_segment_ptr();
    asm volatile("" : "+s"(pp));
    KP p = *pp;
    const int type = p.prog_type[ph], layer = p.prog_layer[ph];
    const int j = layer >> 1;
    switch (type) {
      case PH_PREP: if (!PHON(PH_PREP)) break; phase_prep(p, lds); break;
      case PH_MLA_A: if (!PHON(PH_MLA_A)) break;
        GEMM_PHASE(0, MT / 2, 6, 8, 6, (gemm_big<EPI_A>(p, j, p.xb, DM, p.wa_t[j], 1024, mt * 256, nt * 128, lds)));
        break;
      case PH_MLA_B: if (!PHON(PH_MLA_B)) break;
        GEMM_PHASE(0, MT / 2, 12, 16, 4, (gemm_big<EPI_UQ>(p, j, p.cqkv, 768, p.wuq_t[j], 384, mt * 256, nt * 128, lds)));
        GEMM_PHASE(1, MT / 2, 8, 8, 8, (gemm_big<EPI_UK>(p, j, p.cqkv + 384, 768, p.wukv_t[j], 256, mt * 256, nt * 256, lds)));
        GEMM_PHASE(2, MT, 8, 8, 8, (gemm_tile<EPI_UV, true>(p, j, p.cqkv + 384, 768, p.wukv_t[j], 256, mt * 128, nt * 256 + 128, lds)));
        break;
      case PH_MLA_ATT: if (!PHON(PH_MLA_ATT)) break;
#ifndef SKEW_BIT
#define SKEW_BIT 256
#endif
        if (blockIdx.x & SKEW_BIT) { __builtin_amdgcn_s_sleep(24); __builtin_amdgcn_s_setprio(1); }
        {
          unsigned* ctr = p.bar + XCD_BAR_WORDS + ph;
          for (;;) {
            if (threadIdx.x == 0) xb_words[2] = atomicAdd(ctr, 1u);
            __syncthreads();
            const int t = (int)xb_words[2];
            __syncthreads();
            if (t < 3072) attn_mla(p, t, lds);
            else if (PEER_FP4 && layer == 0 && t < 3072 + TBL_NCHUNK) convert_tables_chunk(p, t - 3072);
            else if (PEER_FP4 && layer == 0 && t < 3072 + TBL_NCHUNK + (p.ntiles_prep - p.jobs[4].tile0)) prep_transpose_tile(p, t - 3072 - TBL_NCHUNK + p.jobs[4].tile0, lds);
            else break;
          } }
        __builtin_amdgcn_s_setprio(0);
        break;
      case PH_MLA_O: if (!PHON(PH_MLA_O)) break;
        GEMM_PHASE(0, MT, 8, 8, 8, (gemm_tile<EPI_O, false>(p, layer == 0 ? -1 : j, p.o, 1024, p.mla_wo_t[j], 1024, mt * 128, nt * 128, lds)));
        break;
      case PH_NA_QKV: if (!PHON(PH_NA_QKV)) break;
        GEMM_PHASE(0, MT / 2, 24, 8, 8, (gemm_big<EPI_QKV>(p, j, p.xb, DM, p.na_wqkv_t[j], 1024, mt * 256, nt * 128, lds)));
        break;
      case PH_NA_ATT: if (!PHON(PH_NA_ATT)) break;
        if (blockIdx.x & SKEW_BIT) { __builtin_amdgcn_s_sleep(12); }
        { unsigned* ctr = p.bar + XCD_BAR_WORDS + ph;
          for (;;) {
            if (threadIdx.x == 0) xb_words[2] = atomicAdd(ctr, 1u);
            __syncthreads();
            const int t = (int)xb_words[2];
            __syncthreads();
            if (t >= 6144) break;
            attn_item<1>(p, j, t, lds);
          } }
        break;
      case PH_NA_O: if (!PHON(PH_NA_O)) break;
        GEMM_PHASE(0, MT, 8, 8, 8, (gemm_tile<EPI_O, false>(p, j, p.o, 1024, p.na_wo_t[j], 1024, mt * 128, nt * 128, lds)));
        break;
      case PH_PEER_Q: if (!PHON(PH_PEER_Q)) break;
        GEMM_PHASE(0, MT, 16, 8, 8, (gemm_tile<EPI_PEER, true>(p, layer, p.xb, DM, p.peer_wq_t[layer], 1024, mt * 128, nt * 128, lds)));
        break;
      case PH_PEER_C: if (!PHON(PH_PEER_C)) break; phase_peer_combine(p, layer, lds, p.bar + XCD_BAR_WORDS + ph); break;
      case PH_FINAL: if (!PHON(PH_FINAL)) break; phase_final(p); break;
      default: break;
    }
    if (ph + 1 < ph_hi) { if (ph_hi > 1000) cg::this_grid().sync(); else xcd_barrier(xb); }
  }
}

extern "C" void kernel_launch(void* const* d_in, const int* in_sizes, int n_in, void* d_out, int out_size, void* d_ws, size_t ws_size, hipStream_t stream) {
  static int grid_blocks = 0, n_cus = 0;
  if (!grid_blocks) {
    int dev = 0, cus = 0;
    (void)hipGetDevice(&dev);
    (void)hipDeviceGetAttribute(&cus, hipDeviceAttributeMultiprocessorCount, dev);
    if (cus < 8) cus = 256;
    n_cus = cus;
    grid_blocks = cus * 2;
  }
  Params p; memset(&p, 0, sizeof(p));
  const float* const* in = (const float* const*)d_in;
  char* ws = (char*)d_ws; size_t off = 0;
  auto alloc = [&](size_t bytes) -> void* { void* r = ws + off; off += (bytes + 255) & ~(size_t)255; return r; };
  p.xin0 = in[0]; p.xin1 = in[1]; p.x = (float*)d_out; p.norm_final = in[4];
  for (int l = 0; l < 2; ++l) {
    p.wa_t[l] = (u16*)alloc(768UL * 1024 * 2); p.wuq_t[l] = (u16*)alloc(1536UL * 384 * 2); p.wukv_t[l] = (u16*)alloc(2048UL * 256 * 2); p.mla_wo_t[l] = (u16*)alloc(1024UL * 1024 * 2);
    p.na_wqkv_t[l] = (u16*)alloc(3072UL * 1024 * 2); p.na_wo_t[l] = (u16*)alloc(1024UL * 1024 * 2);
  }
  for (int l = 0; l < 4; ++l) p.peer_wq_t[l] = (u16*)alloc(2048UL * 1024 * 2);
  p.na_bias_s = (float*)alloc(2 * 3072 * 4); p.na_rpb_s = (float*)alloc(2 * 16 * 465 * 4);
  p.peer_sk = (u16*)alloc(4UL * 8 * 2 * 128 * 128 * 2);
  p.peer_u8 = (unsigned char*)alloc(4UL * 16384 * 1024); p.peer_v8 = (unsigned char*)alloc(4UL * 16384 * 1024);
  p.ropeC = (float*)alloc(16384UL * 32 * 4); p.ropeS = (float*)alloc(16384UL * 32 * 4);
  p.bar = (unsigned*)alloc((XCD_BAR_WORDS + 1024) * 4);
  p.o = (u16*)alloc((size_t)T_TOK * 1024 * 2); p.xb = (u16*)alloc((size_t)T_TOK * 1024 * 2);
  char* un = (char*)alloc((size_t)T_TOK * (768 + 1536 + 2048) * 2);
  p.cqkv = (u16*)un; p.q = (u16*)(un + (size_t)T_TOK * 768 * 2); p.kv = (u16*)(un + (size_t)T_TOK * (768 + 1536) * 2);
  { unsigned char* b8 = (unsigned char*)un + (size_t)T_TOK * 768 * 2; p.q8 = b8; p.k8 = b8 + (size_t)T_TOK * 1536; p.kpe8 = p.k8; p.vT8 = p.k8 + (size_t)T_TOK * 1088; }
  p.qkv = (u16*)un; p.pkeys = (u32*)un;
  if (off > ws_size) { fprintf(stderr, "kernel_launch: workspace too small: need %zu have %zu\n", off, ws_size); return; }
  p.in_sub_keys = in[17]; p.in_peer_u = in[18]; p.in_peer_v = in[19]; p.in_norm_ffn = in[3]; p.in_na_bias = in[13]; p.in_na_rpb = in[14];
  for (int jf = 0; jf < 32; ++jf) p.inv_freq[jf] = pow(10000.0, -(double)(2 * jf) / 64.0);
  int nj = 0, tile = 0;
  auto job = [&](const float* src, u16* dst, const float* gain, int K, int N, float scale, int scale_cols) {
    PrepJob& J = p.jobs[nj++]; J.src = src; J.dst = dst; J.gain = gain; J.K = K; J.N = N; J.tile0 = tile; J.scale = scale; J.scale_cols = scale_cols; J.pad = 0; tile += (K / 64) * (N / 64); };
  const float sc_mla = (float)(pow(192.0, -0.5) * 1.4426950408889634);
  for (int l = 0; l < 2; ++l) {
    job(in[5] + (size_t)l * 1024 * 384, p.wa_t[l], in[2] + (2 * l) * 1024, 1024, 384, 1.f, 0);
    job(in[8] + (size_t)l * 1024 * 320, p.wa_t[l] + 384UL * 1024, in[2] + (2 * l) * 1024, 1024, 320, 1.f, 0);
    job(in[7] + (size_t)l * 384 * 1536, p.wuq_t[l], in[6] + l * 384, 384, 1536, sc_mla, 1536);
    job(in[10] + (size_t)l * 256 * 2048, p.wukv_t[l], in[9] + l * 256, 256, 2048, 1.f, 0);
    job(in[11] + (size_t)l * 1024 * 1024, p.mla_wo_t[l], nullptr, 1024, 1024, 1.f, 0);
    job(in[12] + (size_t)l * 1024 * 3072, p.na_wqkv_t[l], in[2] + (2 * l + 1) * 1024, 1024, 3072, 0.125f * 1.4426950408889634f, 1024);
    job(in[15] + (size_t)l * 1024 * 1024, p.na_wo_t[l], nullptr, 1024, 1024, 1.f, 0);
  }
  for (int l = 0; l < 4; ++l) job(in[16] + (size_t)l * 1024 * 2048, p.peer_wq_t[l], in[3] + l * 1024, 1024, 2048, 1.f, 0);
  p.njobs = nj; p.ntiles_prep = tile;
  int np = 0;
#ifndef DUPMASK
#define DUPMASK 0
#endif
  auto ph = [&](int type, int layer) { p.prog_type[np] = type; p.prog_layer[np] = layer; ++np;
    if ((DUPMASK >> type) & 1) { p.prog_type[np] = type; p.prog_layer[np] = layer; ++np; } };
  ph(PH_PREP, 0);
  for (int i = 0; i < 4; ++i) {
    if ((i & 1) == 0) { ph(PH_MLA_A, i); ph(PH_MLA_B, i); ph(PH_MLA_ATT, i); ph(PH_MLA_O, i); }
    else { ph(PH_NA_QKV, i); ph(PH_NA_ATT, i); ph(PH_NA_O, i); }
    ph(PH_PEER_Q, i); ph(PH_PEER_C, i);
  }
  p.nprog = np;
#if COOP
  (void)hipMemsetAsync(p.bar, 0, (XCD_BAR_WORDS + 1024) * 4, stream);
  int lo = 0, hi = np;
  void* args[] = {(void*)&p, (void*)&lo, (void*)&hi};
  hipError_t e = hipLaunchCooperativeKernel((const void*)mega, dim3(grid_blocks), dim3(NTHR), args, 0, stream);
  if (e != hipSuccess && grid_blocks != n_cus) {
    (void)hipGetLastError(); grid_blocks = n_cus;
    e = hipLaunchCooperativeKernel((const void*)mega, dim3(grid_blocks), dim3(NTHR), args, 0, stream);
  }
  if (e != hipSuccess) fprintf(stderr, "cooperative launch failed: %s (grid %d)\n", hipGetErrorString(e), grid_blocks);
#else
  for (int i = 0; i < np; ++i) hipLaunchKernelGGL(mega, dim3(grid_blocks), dim3(NTHR), 0, stream, p, i, i + 1);
#endif
}
```

```cpp
#include <hip/hip_runtime.h>
#include <hip/hip_cooperative_groups.h>
#include <stdint.h>
#include <string.h>
#include <math.h>
#include <cstdio>
namespace cg = cooperative_groups;

#ifndef COOP
#define COOP 1
#endif
#ifndef PHMASK
#define PHMASK 0xFFFF
#endif
#ifndef LB2
#define LB2 2
#endif
#define PHON(t) ((PHMASK >> (t)) & 1)

typedef unsigned short u16;
typedef unsigned int u32;
using bf16x8 = __attribute__((ext_vector_type(8))) short;
using s16x4  = __attribute__((ext_vector_type(4))) short;
using f32x16 = __attribute__((ext_vector_type(16))) float;
using f32x4  = __attribute__((ext_vector_type(4))) float;
using u32x4  = __attribute__((ext_vector_type(4))) unsigned;
using u32x2  = __attribute__((ext_vector_type(2))) unsigned;
typedef __attribute__((ext_vector_type(2))) __bf16 v2bf;

constexpr int T_TOK = 49152, T_PROMPT = 16384, DM = 1024;
constexpr int NTHR = 256;
constexpr float LOG2E = 1.4426950408889634f;
constexpr float RMS_EPS = 1e-6f;

enum { PH_PREP = 0, PH_MLA_A, PH_MLA_B, PH_MLA_ATT, PH_MLA_O, PH_NA_QKV, PH_NA_ATT, PH_NA_O, PH_PEER_Q, PH_PEER_C, PH_FINAL };

struct PrepJob { const float* src; u16* dst; const float* gain; int K, N, tile0, scale_cols; float scale; int pad; };

struct Params {
  const float* xin0; const float* xin1;
  float* x; u16* xb;
  const float* norm_final;
  u16* wa_t[2]; u16* wuq_t[2]; u16* wukv_t[2]; u16* mla_wo_t[2];
  u16* na_wqkv_t[2]; u16* na_wo_t[2]; float* na_bias_s; float* na_rpb_s;
  u16* peer_wq_t[4]; u16* peer_sk; unsigned char* peer_u8; unsigned char* peer_v8;
  u16* cqkv; u16* q; u16* kv; u16* o; u16* qkv; u32* pkeys;
  unsigned char* q8; unsigned char* k8; unsigned char* kpe8; unsigned char* vT8;
  float* ropeC; float* ropeS; unsigned* bar;
  const float* in_sub_keys; const float* in_peer_u; const float* in_peer_v; const float* in_norm_ffn; const float* in_na_bias; const float* in_na_rpb;
  PrepJob jobs[24];
  double inv_freq[32];
  int njobs, ntiles_prep;
  int prog_type[48]; int prog_layer[48];
  int nprog, pad0;
};

typedef const __attribute__((address_space(4))) Params& KP;

__device__ __forceinline__ int crow(int r, int hi) { return (r & 3) + 8 * (r >> 2) + 4 * hi; }
__device__ __forceinline__ u32 cvtpk(float lo, float hi) { u32 r; asm("v_cvt_pk_bf16_f32 %0, %1, %2" : "=v"(r) : "v"(lo), "v"(hi)); return r; }
__device__ __forceinline__ float bf_lo(u32 v) { return __uint_as_float(v << 16); }
__device__ __forceinline__ float bf_hi(u32 v) { return __uint_as_float(v & 0xffff0000u); }
__device__ __forceinline__ int tok_pos(int t) { return t < T_PROMPT ? (t & 2047) : (t & 16383); }
__device__ __forceinline__ f32x16 mfma32(bf16x8 a, bf16x8 b, f32x16 c) { return __builtin_amdgcn_mfma_f32_32x32x16_bf16(a, b, c, 0, 0, 0); }
__device__ __forceinline__ float shx(float v, int m) { return __shfl_xor(v, m, 64); }

constexpr int BK = 64;
constexpr int OPB = 16384;
constexpr int GEMM_LDS = 4 * OPB;
constexpr int SMEM_BYTES = 81920;
constexpr int RSTD_OFF = 73728;

enum { EPI_A = 0, EPI_UQ, EPI_UK, EPI_UV, EPI_O, EPI_QKV, EPI_PEER };
constexpr float KEY_BIAS = 16.f;
constexpr float Q8_SCALE = 16.f, K8_SCALE = 4.f, V8_SCALE = 4.f, P8_SCALE = 128.f;
__device__ __forceinline__ u32 pack4_fp8(float a, float b, float c, float d) { int v = 0; v = __builtin_amdgcn_cvt_pk_fp8_f32(a, b, v, false); v = __builtin_amdgcn_cvt_pk_fp8_f32(c, d, v, true); return (u32)v; }

__device__ __forceinline__ float dot2bf(u32 a, u32 b, float c) { return __builtin_amdgcn_fdot2_f32_bf16(__builtin_bit_cast(v2bf, a), __builtin_bit_cast(v2bf, b), c, false); }

template <int EPI, bool NORM>
__device__ __forceinline__ void gemm_tile(KP p, int layer, const u16* Ap, int lda, const u16* Bt, int K, int m0, int n0, char* lds) {
  int tid_ = threadIdx.x; asm volatile("" : "+v"(tid_));
  const int tid = tid_, lane = tid & 63, w = tid >> 6;
  const int wm = w >> 1, wn = w & 1, r32 = lane & 31, hi = lane >> 5;
  float* rstd_l = (float*)(lds + RSTD_OFF);
  const int srow = w * 32 + (lane >> 2);
  const int scol = ((lane & 3) ^ ((lane >> 4) & 3)) * 8;
  const u16* Ag = Ap + (long)(m0 + srow) * lda + scol;
  const u16* Bg = Bt + (long)(n0 + srow) * K + scol;
#define GSTAGE(st, kt) do { _Pragma("unroll") for (int j = 0; j < 2; ++j) { \
    __builtin_amdgcn_global_load_lds((const unsigned*)(Ag + (long)j * 16 * lda + (kt) * 32), (unsigned*)(lds + (st) * 16384 + (w * 2 + j) * 1024), 16, 0, 0); \
    __builtin_amdgcn_global_load_lds((const unsigned*)(Bg + (long)j * 16 * K + (kt) * 32), (unsigned*)(lds + (st) * 16384 + 8192 + (w * 2 + j) * 1024), 16, 0, 0); } } while (0)
  f32x16 acc[2][2];
#pragma unroll
  for (int i = 0; i < 2; ++i)
#pragma unroll
    for (int j = 0; j < 2; ++j)
#pragma unroll
      for (int r = 0; r < 16; ++r) acc[i][j][r] = 0.f;
  float ssq0 = 0.f, ssq1 = 0.f;
  bf16x8 skr[8];
  const int sw = (r32 >> 2) & 3;
  const int arow = (wm * 64 + r32) * 64, brow = 8192 + (wn * 64 + r32) * 64;
  const int co0 = ((0 + hi) ^ sw) << 4, co1 = ((2 + hi) ^ sw) << 4;
  const int nk = K / 32;

#ifndef KREP
#define KREP 1
#endif
  for (int rep_ = 0; rep_ < KREP; ++rep_) {
  if (KREP > 1) {
#pragma unroll
    for (int i = 0; i < 2; ++i)
#pragma unroll
      for (int j = 0; j < 2; ++j)
#pragma unroll
        for (int r = 0; r < 16; ++r) acc[i][j][r] = 0.f;
    ssq0 = 0.f; ssq1 = 0.f; }
  __syncthreads();
  GSTAGE(0, 0); GSTAGE(1, 1); GSTAGE(2, 2);
  if constexpr (EPI == EPI_PEER) {
    const u16* sk = p.peer_sk + ((long)layer * 16 + (n0 >> 7)) * 16384;
#pragma unroll
    for (int i = 0; i < 8; ++i) { const int c = tid + 256 * i; skr[i] = *(const bf16x8*)(sk + (c >> 4) * 128 + (c & 15) * 8); }
  }
  for (int kt = 0; kt < nk; ++kt) {
    if (kt + 2 < nk) asm volatile("s_waitcnt vmcnt(8)" ::: "memory");
    else if (kt + 1 < nk) asm volatile("s_waitcnt vmcnt(4)" ::: "memory");
    else asm volatile("s_waitcnt vmcnt(0)" ::: "memory");
    asm volatile("s_waitcnt lgkmcnt(0)" ::: "memory");
    __builtin_amdgcn_s_barrier();
    if (kt + 3 < nk) GSTAGE((kt + 3) & 3, kt + 3);
    const char* base = lds + (kt & 3) * 16384;
    {
      const bf16x8 a0 = *(const bf16x8*)(base + arow + co0), a1 = *(const bf16x8*)(base + arow + 32 * 64 + co0);
      const bf16x8 b0 = *(const bf16x8*)(base + brow + co0), b1 = *(const bf16x8*)(base + brow + 32 * 64 + co0);
      const bf16x8 c0 = *(const bf16x8*)(base + arow + co1), c1 = *(const bf16x8*)(base + arow + 32 * 64 + co1);
      const bf16x8 d0 = *(const bf16x8*)(base + brow + co1), d1 = *(const bf16x8*)(base + brow + 32 * 64 + co1);
      if constexpr (EPI != EPI_UV) {
        acc[0][0] = mfma32(b0, a0, acc[0][0]); acc[0][1] = mfma32(b1, a0, acc[0][1]);
        acc[1][0] = mfma32(b0, a1, acc[1][0]); acc[1][1] = mfma32(b1, a1, acc[1][1]);
        acc[0][0] = mfma32(d0, c0, acc[0][0]); acc[0][1] = mfma32(d1, c0, acc[0][1]);
        acc[1][0] = mfma32(d0, c1, acc[1][0]); acc[1][1] = mfma32(d1, c1, acc[1][1]);
      } else {
        acc[0][0] = mfma32(a0, b0, acc[0][0]); acc[0][1] = mfma32(a0, b1, acc[0][1]);
        acc[1][0] = mfma32(a1, b0, acc[1][0]); acc[1][1] = mfma32(a1, b1, acc[1][1]);
        acc[0][0] = mfma32(c0, d0, acc[0][0]); acc[0][1] = mfma32(c0, d1, acc[0][1]);
        acc[1][0] = mfma32(c1, d0, acc[1][0]); acc[1][1] = mfma32(c1, d1, acc[1][1]);
      }
      if constexpr (NORM) {
        const u32x4 x0 = __builtin_bit_cast(u32x4, a0), x1 = __builtin_bit_cast(u32x4, a1), y0 = __builtin_bit_cast(u32x4, c0), y1 = __builtin_bit_cast(u32x4, c1);
#pragma unroll
        for (int q = 0; q < 4; ++q) { ssq0 = dot2bf(x0[q], x0[q], ssq0); ssq1 = dot2bf(x1[q], x1[q], ssq1); ssq0 = dot2bf(y0[q], y0[q], ssq0); ssq1 = dot2bf(y1[q], y1[q], ssq1); }
      }
    }
  }
  }
#undef GSTAGE
  __syncthreads();
  float rs[2] = {1.f, 1.f};
  if constexpr (NORM) {
    ssq0 += shx(ssq0, 32); ssq1 += shx(ssq1, 32);
    rs[0] = rsqrtf(ssq0 / (float)K + RMS_EPS); rs[1] = rsqrtf(ssq1 / (float)K + RMS_EPS);
  }
  const int rowb = wm * 64, colb = wn * 64;
  if constexpr (EPI == EPI_A || EPI == EPI_QKV) {
    constexpr int OROW = 272;
    u16* outp; int ldo; bool rope = false;
    if constexpr (EPI == EPI_A) { outp = p.cqkv; ldo = 768; rope = (n0 + colb == 640); }
    else { outp = p.qkv; ldo = 3072; }
#pragma unroll
    for (int mi = 0; mi < 2; ++mi) {
      const int rl = rowb + mi * 32 + r32; const int pos = tok_pos(m0 + rl);
#pragma unroll
      for (int g = 0; g < 4; ++g) {
        f32x4 v0, v1;
#pragma unroll
        for (int e = 0; e < 4; ++e) { v0[e] = acc[mi][0][4 * g + e] * rs[mi]; v1[e] = acc[mi][1][4 * g + e] * rs[mi]; }
        if constexpr (EPI == EPI_QKV) {
          const f32x4 b0 = *(const f32x4*)(p.na_bias_s + layer * 3072 + n0 + colb + 8 * g + 4 * hi), b1 = *(const f32x4*)(p.na_bias_s + layer * 3072 + n0 + colb + 32 + 8 * g + 4 * hi);
          v0 += b0; v1 += b1;
        }
        if (rope) {
          const f32x4 c = *(const f32x4*)(p.ropeC + pos * 32 + 8 * g + 4 * hi), sn = *(const f32x4*)(p.ropeS + pos * 32 + 8 * g + 4 * hi);
          const f32x4 t0 = (v0 * c - v1 * sn) * K8_SCALE, t1 = (v0 * sn + v1 * c) * K8_SCALE;
          unsigned char* kp_ = p.k8 + (long)(m0 + rl) * 1088 + 1024 + 8 * g + 4 * hi;
          *(u32*)kp_ = pack4_fp8(t0[0], t0[1], t0[2], t0[3]); *(u32*)(kp_ + 32) = pack4_fp8(t1[0], t1[1], t1[2], t1[3]);
        }
        char* e_ = lds + rl * OROW + (colb + 8 * g + 4 * hi) * 2;
        *(u32x2*)e_ = (u32x2){cvtpk(v0[0], v0[1]), cvtpk(v0[2], v0[3])};
        *(u32x2*)(e_ + 64) = (u32x2){cvtpk(v1[0], v1[1]), cvtpk(v1[2], v1[3])};
      }
    }
    __syncthreads();
#pragma unroll
    for (int i = 0; i < 8; ++i) { const int c = tid + 256 * i, row = c >> 4, ch = c & 15;
      *(u32x4*)(outp + (long)(m0 + row) * ldo + n0 + ch * 8) = *(const u32x4*)(lds + row * OROW + ch * 16); }
  } else if constexpr (EPI == EPI_UQ || EPI == EPI_UK) {
    constexpr int BROW = 144;
    const bool rope = (EPI == EPI_UQ) && ((n0 + colb) % 192 == 128);
    const float sc = (EPI == EPI_UQ) ? Q8_SCALE : K8_SCALE;
#pragma unroll
    for (int mi = 0; mi < 2; ++mi) {
      const int rl = rowb + mi * 32 + r32; const int pos = tok_pos(m0 + rl);
#pragma unroll
      for (int g = 0; g < 4; ++g) {
        f32x4 v0, v1;
#pragma unroll
        for (int e = 0; e < 4; ++e) { v0[e] = acc[mi][0][4 * g + e] * rs[mi] * sc; v1[e] = acc[mi][1][4 * g + e] * rs[mi] * sc; }
        if (rope) {
          const f32x4 c = *(const f32x4*)(p.ropeC + pos * 32 + 8 * g + 4 * hi), sn = *(const f32x4*)(p.ropeS + pos * 32 + 8 * g + 4 * hi);
          const f32x4 t0 = v0 * c - v1 * sn, t1 = v0 * sn + v1 * c; v0 = t0; v1 = t1;
        }
        char* e_ = lds + rl * BROW + (colb + 8 * g + 4 * hi);
        *(u32*)e_ = pack4_fp8(v0[0], v0[1], v0[2], v0[3]); *(u32*)(e_ + 32) = pack4_fp8(v1[0], v1[1], v1[2], v1[3]);
      }
    }
    __syncthreads();
    unsigned char* outb; long ldo;
    if constexpr (EPI == EPI_UQ) { outb = p.q8 + n0; ldo = 1536; } else { outb = p.k8 + (n0 >> 8) * 128; ldo = 1088; }
#pragma unroll
    for (int i = 0; i < 4; ++i) { const int c = tid + 256 * i, row = c >> 3, ch = c & 7;
      *(u32x4*)(outb + (long)(m0 + row) * ldo + ch * 16) = *(const u32x4*)(lds + row * BROW + ch * 16); }
  } else if constexpr (EPI == EPI_UV) {
    constexpr int BROW = 144;
#pragma unroll
    for (int mi = 0; mi < 2; ++mi) {
#pragma unroll
      for (int g = 0; g < 4; ++g) {
        float rr[4];
#pragma unroll
        for (int e = 0; e < 4; ++e) rr[e] = __int_as_float(__builtin_amdgcn_ds_bpermute((8 * g + 4 * hi + e) << 2, __float_as_int(rs[mi]))) * V8_SCALE;
#pragma unroll
        for (int ni = 0; ni < 2; ++ni) {
          char* e_ = lds + (colb + ni * 32 + r32) * BROW + rowb + mi * 32 + 8 * g + 4 * hi;
          *(u32*)e_ = pack4_fp8(acc[mi][ni][4 * g] * rr[0], acc[mi][ni][4 * g + 1] * rr[1], acc[mi][ni][4 * g + 2] * rr[2], acc[mi][ni][4 * g + 3] * rr[3]);
        }
      }
    }
    __syncthreads();
    unsigned char* outb = p.vT8 + (long)((n0 >> 8) * 128) * T_TOK + m0;
#pragma unroll
    for (int i = 0; i < 4; ++i) { const int c = tid + 256 * i, d = c >> 3, ch = c & 7;
      *(u32x4*)(outb + (long)d * T_TOK + ch * 16) = *(const u32x4*)(lds + d * BROW + ch * 16); }
  } else if constexpr (EPI == EPI_O) {
    constexpr int FROW = 528;
#pragma unroll
    for (int mi = 0; mi < 2; ++mi) {
      const int rl = rowb + mi * 32 + r32;
#pragma unroll
      for (int ni = 0; ni < 2; ++ni)
#pragma unroll
        for (int g = 0; g < 4; ++g)
          *(f32x4*)(lds + rl * FROW + (colb + ni * 32 + 8 * g + 4 * hi) * 4) = (f32x4){acc[mi][ni][4 * g], acc[mi][ni][4 * g + 1], acc[mi][ni][4 * g + 2], acc[mi][ni][4 * g + 3]};
    }
    __syncthreads();
#pragma unroll 4
    for (int i = 0; i < 16; ++i) { const int c = tid + 256 * i, row = c >> 5, ch = c & 31;
      const f32x4 a = *(const f32x4*)(lds + row * FROW + ch * 16);
      float* xp = p.x + (long)(m0 + row) * DM + n0 + ch * 4;
      const float* xsrc = xp;
      if (layer < 0) xsrc = (m0 < T_PROMPT ? p.xin0 + (long)(m0 + row) * DM : p.xin1 + (long)(m0 + row - T_PROMPT) * DM) + n0 + ch * 4;
      f32x4 xv = *(const f32x4*)xsrc; xv += a; *(f32x4*)xp = xv;
      *(u32x2*)(p.xb + (long)(m0 + row) * DM + n0 + ch * 4) = (u32x2){cvtpk(xv[0], xv[1]), cvtpk(xv[2], xv[3])}; }
  } else {
    constexpr int QROW = 272;
    char* Qs = lds; char* Ss = lds + 128 * QROW;
    const int hp = n0 >> 7;
#pragma unroll
    for (int mi = 0; mi < 2; ++mi) {
      const int rl = rowb + mi * 32 + r32;
#pragma unroll
      for (int g = 0; g < 4; ++g) {
        char* e_ = Qs + rl * QROW + (colb + 8 * g + 4 * hi) * 2;
        *(u32x2*)e_ = (u32x2){cvtpk(acc[mi][0][4 * g] * rs[mi], acc[mi][0][4 * g + 1] * rs[mi]), cvtpk(acc[mi][0][4 * g + 2] * rs[mi], acc[mi][0][4 * g + 3] * rs[mi])};
        *(u32x2*)(e_ + 64) = (u32x2){cvtpk(acc[mi][1][4 * g] * rs[mi], acc[mi][1][4 * g + 1] * rs[mi]), cvtpk(acc[mi][1][4 * g + 2] * rs[mi], acc[mi][1][4 * g + 3] * rs[mi])};
      }
    }
#pragma unroll
    for (int i = 0; i < 8; ++i) { const int c = tid + 256 * i, kr = c >> 4, ch = c & 15; *(bf16x8*)(Ss + kr * QROW + ch * 16) = skr[i]; }
    __syncthreads();
    f32x16 a2[2][2];
#pragma unroll
    for (int i = 0; i < 2; ++i)
#pragma unroll
      for (int j = 0; j < 2; ++j)
#pragma unroll
        for (int r = 0; r < 16; ++r) a2[i][j][r] = 0.f;
    { const char* Ar = Qs + (rowb + r32) * QROW + hi * 16; const char* Br = Ss + (colb + r32) * QROW + hi * 16;
#pragma unroll
      for (int ks = 0; ks < 8; ++ks) {
        bf16x8 a0 = *(const bf16x8*)(Ar + ks * 32), a1 = *(const bf16x8*)(Ar + 32 * QROW + ks * 32);
        bf16x8 b0 = *(const bf16x8*)(Br + ks * 32), b1 = *(const bf16x8*)(Br + 32 * QROW + ks * 32);
        a2[0][0] = mfma32(b0, a0, a2[0][0]); a2[0][1] = mfma32(b1, a0, a2[0][1]);
        a2[1][0] = mfma32(b0, a1, a2[1][0]); a2[1][1] = mfma32(b1, a1, a2[1][1]);
      } }
    __syncthreads();
    constexpr int SROW = 544;
    char* Sc = lds;
#pragma unroll
    for (int mi = 0; mi < 2; ++mi) {
      const int rl = rowb + mi * 32 + r32;
#pragma unroll
      for (int ni = 0; ni < 2; ++ni)
#pragma unroll
        for (int g = 0; g < 4; ++g)
          *(f32x4*)(Sc + rl * SROW + (colb + ni * 32 + 8 * g + 4 * hi) * 4) = (f32x4){a2[mi][ni][4 * g], a2[mi][ni][4 * g + 1], a2[mi][ni][4 * g + 2], a2[mi][ni][4 * g + 3]};
    }
    __syncthreads();
    { const int row = tid >> 1, hf = tid & 1;
      u32 kv[64];
#pragma unroll
      for (int i = 0; i < 16; ++i) {
        const f32x4 v = *(const f32x4*)(Sc + row * SROW + (2 * i + hf) * 16);
#pragma unroll
        for (int e = 0; e < 4; ++e) { const u32 b = __float_as_uint(v[e] + KEY_BIAS);
          kv[i * 4 + e] = (b & ~127u) | (u32)((2 * i + hf) * 4 + e); }
      }
      u32 mprev = 0xffffffffu;
      u32* outk = p.pkeys + (long)(m0 + row) * 256 + hp * 16;
#pragma unroll 1
      for (int ps = 0; ps < 16; ++ps) {
        u32 best = 0;
#pragma unroll
        for (int i = 0; i < 64; ++i) { const u32 d = kv[i] - mprev; best = d > best ? d : best; }
        u32 cand = mprev + best;
        if (best < (0u - mprev)) cand = 0u;
        const u32 oth = (u32)__shfl_xor((int)cand, 1, 64);
        mprev = cand > oth ? cand : oth;
        if (hf == 0) outk[ps] = mprev;
      }
    }
  }
}

template <int OFF> __device__ __forceinline__ s16x4 tr_read(int vb) {
  s16x4 r; asm volatile("ds_read_b64_tr_b16 %0, %1 offset:%2" : "=&v"(r) : "v"(vb), "i"(OFF) : "memory"); return r;
}
__device__ __forceinline__ int v_st(int k, int c) { const int kk = (k & ~0xC) | ((k & 4) << 1) | ((k & 8) >> 1); return ((kk >> 3) * 4 + (c >> 5)) * 512 + ((kk & 7) * 32 + (c & 31)) * 2; }
__device__ __forceinline__ int v_rd_base(int lane) { return ((lane & 3) << 3) | (((lane >> 2) & 3) << 6) | (((lane >> 4) & 1) << 5) | (((lane >> 5) & 1) << 8); }
constexpr int v_rd_off(int d0, int ks, int half) { return d0 * 512 + ks * 4096 + half * 2048; }
template <int D0> __device__ __forceinline__ void pv_one(f32x16& od, int vb, bf16x8 pa0, bf16x8 pa1, bf16x8 pa2, bf16x8 pa3) {
  const s16x4 l0 = tr_read<v_rd_off(D0, 0, 0)>(vb), h0 = tr_read<v_rd_off(D0, 0, 1)>(vb), l1 = tr_read<v_rd_off(D0, 1, 0)>(vb), h1 = tr_read<v_rd_off(D0, 1, 1)>(vb);
  const s16x4 l2 = tr_read<v_rd_off(D0, 2, 0)>(vb), h2 = tr_read<v_rd_off(D0, 2, 1)>(vb), l3 = tr_read<v_rd_off(D0, 3, 0)>(vb), h3 = tr_read<v_rd_off(D0, 3, 1)>(vb);
  asm volatile("s_waitcnt lgkmcnt(0)" ::: "memory"); __builtin_amdgcn_sched_barrier(0);
#define PKV(L, H) (bf16x8){L[0], L[1], L[2], L[3], H[0], H[1], H[2], H[3]}
  od = mfma32(pa0, PKV(l0, h0), od); od = mfma32(pa1, PKV(l1, h1), od); od = mfma32(pa2, PKV(l2, h2), od); od = mfma32(pa3, PKV(l3, h3), od);
#undef PKV
}

constexpr float THR_L2 = 11.5f;

__device__ __forceinline__ void partialSM(f32x16& p0, f32x16& p1, float& m_reg, float& alpha) {
  float pmax = p0[0];
#pragma unroll
  for (int r = 1; r < 16; ++r) pmax = fmaxf(pmax, p0[r]);
#pragma unroll
  for (int r = 0; r < 16; ++r) pmax = fmaxf(pmax, p1[r]);
  { auto rr = __builtin_amdgcn_permlane32_swap(__float_as_uint(pmax), __float_as_uint(pmax), false, false);
    pmax = fmaxf(__uint_as_float(rr[0]), __uint_as_float(rr[1])); }
  float mn;
  if (__all(pmax - m_reg <= THR_L2)) { mn = m_reg; alpha = 1.f; }
  else { mn = fmaxf(m_reg, pmax); alpha = __builtin_amdgcn_exp2f(m_reg - mn); m_reg = mn; }
#pragma unroll
  for (int r = 0; r < 16; ++r) { p0[r] = __builtin_amdgcn_exp2f(p0[r] - mn); p1[r] = __builtin_amdgcn_exp2f(p1[r] - mn); }
}
__device__ __forceinline__ void finishSM(f32x16& p0, f32x16& p1, float alpha, float& l_reg, bf16x8& pa0, bf16x8& pa1, bf16x8& pa2, bf16x8& pa3) {
  float ps = 0.f;
#pragma unroll
  for (int r = 0; r < 16; ++r) ps += p0[r];
#pragma unroll
  for (int r = 0; r < 16; ++r) ps += p1[r];
  { auto rr = __builtin_amdgcn_permlane32_swap(__float_as_uint(ps), __float_as_uint(ps), false, false);
    ps = __uint_as_float(rr[0]) + __uint_as_float(rr[1]); }
  l_reg = l_reg * alpha + ps;
#define PK4(P, BASE, OUT) do { unsigned a0 = cvtpk(P[BASE + 0], P[BASE + 1]), a1 = cvtpk(P[BASE + 2], P[BASE + 3]);   \
    unsigned b0 = cvtpk(P[BASE + 4], P[BASE + 5]), b1 = cvtpk(P[BASE + 6], P[BASE + 7]);                              \
    auto r0 = __builtin_amdgcn_permlane32_swap(a0, b0, false, false); auto r1 = __builtin_amdgcn_permlane32_swap(a1, b1, false, false); \
    u32x4 w_ = {r0[0], r1[0], r0[1], r1[1]}; OUT = __builtin_bit_cast(bf16x8, w_); } while (0)
  PK4(p0, 0, pa0); PK4(p0, 8, pa1); PK4(p1, 0, pa2); PK4(p1, 8, pa3);
#undef PK4
}

constexpr int ATT_K_OFF = 0, ATT_V_OFF = 25600, ATT_WS_OFF = 41984, ATT_RPB_OFF = 43008;

template <int MODE>
__device__ __forceinline__ void attn_item(KP p, int layer, int item, char* lds) {
  constexpr int KST = MODE == 0 ? 12 : 4;
  constexpr int KROW = MODE == 0 ? 400 : 272;
  constexpr int ND0 = MODE == 0 ? 4 : 2;
  int tid_ = threadIdx.x; asm volatile("" : "+v"(tid_));
  const int tid = tid_, lane = tid & 63, w = tid >> 6, r32 = lane & 31, hi = lane >> 5;
  char* Kl = lds + ATT_K_OFF; char* Vl = lds + ATT_V_OFF;
  float* wsl = (float*)(lds + ATT_WS_OFF) + w * 64; float* al_l = wsl; float* li_l = wsl + 32;
  float* rpbl = (float*)(lds + ATT_RPB_OFF);

  int NT, qtok, ktok0, head, kcolB = 0; long obase;
  int na_c = 0, na_c0 = 0, na_relrow0 = 0, na_hl = 0;
  const u16* Qp;
  if constexpr (MODE == 0) {
    int seq, qb;
    if (item < 2048) { const int sh = item >> 7; seq = 8 + (sh >> 3); head = sh & 7; qb = item & 127; ktok0 = T_PROMPT + (seq - 8) * 16384; NT = 256; }
    else { const int it = item - 2048; const int sh = it >> 4; seq = sh >> 3; head = sh & 7; qb = it & 15; ktok0 = seq * 2048; NT = 32; }
    qtok = ktok0 + qb * 128 + w * 32 + r32;
    Qp = p.q + (long)qtok * 1536 + head * 192 + hi * 8;
    obase = (long)(ktok0 + qb * 128 + w * 32) * 1024 + head * 128;
  } else {
    const int Rg = item >> 3, hpair = item & 7;
    int grow0, r, rows;
    if (Rg < 256) { grow0 = (Rg >> 5) << 5; r = Rg & 31; rows = 32; } else { grow0 = 256 + (((Rg - 256) >> 8) << 8); r = (Rg - 256) & 255; rows = 256; }
    int r0 = r - 4; r0 = r0 < 0 ? 0 : r0; r0 = r0 > rows - 8 ? rows - 8 : r0;
    ktok0 = (grow0 + r0) * 64; NT = 8;
    na_hl = w >> 1; head = hpair * 2 + na_hl;
    na_c = (w & 1) * 32 + r32; na_c0 = na_c - 8; na_c0 = na_c0 < 0 ? 0 : na_c0; na_c0 = na_c0 > 48 ? 48 : na_c0;
    na_relrow0 = r0 - r + 7;
    qtok = Rg * 64 + na_c;
    Qp = p.qkv + (long)qtok * 3072 + head * 64 + hi * 8;
    obase = (long)(Rg * 64 + (w & 1) * 32) * 1024 + head * 64;
    kcolB = na_hl * 128;
    __syncthreads();
    { const float* src = p.na_rpb_s + ((long)layer * 16 + hpair * 2) * 465;
      for (int e = tid; e < 930; e += 256) rpbl[e] = src[e]; }
  }
  bf16x8 qr[KST];
#pragma unroll
  for (int d = 0; d < KST; ++d) qr[d] = *(const bf16x8*)(Qp + d * 16);

  bf16x8 sk[MODE == 0 ? 6 : 4], sv[4];
  const int s_key = tid >> 4, s_ch = tid & 15;
  const int s_key8 = tid >> 3, s_ch8 = tid & 7;
#define ALOAD(j) do { const long kt_ = (long)ktok0 + (j) * 64; \
    if constexpr (MODE == 0) { \
      _Pragma("unroll") for (int i = 0; i < 4; ++i) { const u16* b_ = p.kv + (kt_ + s_key + 16 * i) * 2048 + head * 256 + s_ch * 8; sk[i] = *(const bf16x8*)b_; sv[i] = *(const bf16x8*)(b_ + 128); } \
      _Pragma("unroll") for (int i = 0; i < 2; ++i) sk[4 + i] = *(const bf16x8*)(p.cqkv + (kt_ + s_key8 + 32 * i) * 768 + 640 + s_ch8 * 8); \
    } else { \
      _Pragma("unroll") for (int i = 0; i < 4; ++i) { const u16* b_ = p.qkv + (kt_ + s_key + 16 * i) * 3072 + 1024 + (head & ~1) * 64 + s_ch * 8; sk[i] = *(const bf16x8*)b_; sv[i] = *(const bf16x8*)(b_ + 1024); } \
    } } while (0)
#define AWRITE() do { \
    _Pragma("unroll") for (int i = 0; i < 4; ++i) { *(bf16x8*)(Kl + (s_key + 16 * i) * KROW + s_ch * 16) = sk[i]; *(bf16x8*)(Vl + v_st(s_key + 16 * i, s_ch * 8)) = sv[i]; } \
    if constexpr (MODE == 0) { _Pragma("unroll") for (int i = 0; i < 2; ++i) *(bf16x8*)(Kl + (s_key8 + 32 * i) * KROW + 256 + s_ch8 * 16) = sk[4 + i]; } } while (0)

  float m_reg = -1e30f, l_reg = 0.f;
  f32x16 o[ND0];
#pragma unroll
  for (int d = 0; d < ND0; ++d)
#pragma unroll
    for (int r = 0; r < 16; ++r) o[d][r] = 0.f;
  const int vb0 = (int)(uintptr_t)Vl + v_rd_base(lane) + (MODE == 1 ? na_hl * 1024 : 0);

  ALOAD(0);
  for (int j = 0; j < NT; ++j) {
    __syncthreads();
    AWRITE();
    __syncthreads();
    if (j + 1 < NT) ALOAD(j + 1);
    f32x16 p0, p1;
#pragma unroll
    for (int r = 0; r < 16; ++r) { p0[r] = 0.f; p1[r] = 0.f; }
#pragma unroll
    for (int d = 0; d < KST; ++d) {
      const int cb = kcolB + (d * 16 + hi * 8) * 2;
      bf16x8 b0 = *(const bf16x8*)(Kl + r32 * KROW + cb), b1 = *(const bf16x8*)(Kl + (32 + r32) * KROW + cb);
      p0 = mfma32(b0, qr[d], p0); p1 = mfma32(b1, qr[d], p1);
    }
    if constexpr (MODE == 1) {
      const float* rb = rpbl + (na_hl * 15 + na_relrow0 + j) * 31;
#pragma unroll
      for (int r = 0; r < 16; ++r) {
        const int kc0 = crow(r, hi), kc1 = 32 + kc0;
        int i0 = kc0 - na_c + 15, i1 = kc1 - na_c + 15;
        i0 = i0 < 0 ? 0 : (i0 > 30 ? 30 : i0); i1 = i1 < 0 ? 0 : (i1 > 30 ? 30 : i1);
        const float b0 = rb[i0], b1 = rb[i1];
        p0[r] = ((unsigned)(kc0 - na_c0) < 16u) ? p0[r] + b0 : -1e30f;
        p1[r] = ((unsigned)(kc1 - na_c0) < 16u) ? p1[r] + b1 : -1e30f;
      }
    }
    float alpha;
    partialSM(p0, p1, m_reg, alpha);
    if (__any(alpha < 1.f)) {
      if (hi == 0) al_l[r32] = alpha;
      __builtin_amdgcn_wave_barrier();
#pragma unroll
      for (int r = 0; r < 16; ++r) { const float a = al_l[crow(r, hi)];
#pragma unroll
        for (int d = 0; d < ND0; ++d) o[d][r] *= a; }
      __builtin_amdgcn_wave_barrier();
    }
    bf16x8 pa0, pa1, pa2, pa3;
    finishSM(p0, p1, alpha, l_reg, pa0, pa1, pa2, pa3);
    pv_one<0>(o[0], vb0, pa0, pa1, pa2, pa3); pv_one<1>(o[1], vb0, pa0, pa1, pa2, pa3);
    if constexpr (MODE == 0) { pv_one<2>(o[2], vb0, pa0, pa1, pa2, pa3); pv_one<3>(o[3], vb0, pa0, pa1, pa2, pa3); }
  }
#undef ALOAD
#undef AWRITE
  if (hi == 0) li_l[r32] = l_reg;
  __builtin_amdgcn_wave_barrier();
#pragma unroll
  for (int r = 0; r < 16; ++r) {
    const int qrow = crow(r, hi); const float rl = 1.f / li_l[qrow];
    u16* o_ = p.o + obase + (long)qrow * 1024 + r32;
#pragma unroll
    for (int d = 0; d < ND0; ++d) o_[d * 32] = (u16)(cvtpk(o[d][r] * rl, 0.f) & 0xffffu);
  }
  __builtin_amdgcn_wave_barrier();
}

__device__ __forceinline__ float lane_bcast(float v, int src_lane) { return __int_as_float(__builtin_amdgcn_ds_bpermute(src_lane << 2, __float_as_int(v))); }
__device__ __forceinline__ float rowmax32(const f32x16& p0, const f32x16& p1) {
  float pmax = p0[0];
#pragma unroll
  for (int r = 1; r < 16; ++r) pmax = fmaxf(pmax, p0[r]);
#pragma unroll
  for (int r = 0; r < 16; ++r) pmax = fmaxf(pmax, p1[r]);
  auto rr = __builtin_amdgcn_permlane32_swap(__float_as_uint(pmax), __float_as_uint(pmax), false, false);
  return fmaxf(__uint_as_float(rr[0]), __uint_as_float(rr[1]));
}

typedef __attribute__((ext_vector_type(8))) int i32x8;
#define MFMA8(A, B, C, SA, SB_) __builtin_amdgcn_mfma_scale_f32_32x32x64_f8f6f4(A, B, C, 0, 0, 0, SA, 0, SB_)
constexpr int SC_K = 0x7D7D7D7D, SC_Q = 0x7B7B7B7B, SC_P = 0x7F7F7F7F, SC_V = 0x7D7D7D7D;
constexpr float THR8_L2 = 1.5f;

__device__ __forceinline__ void attn_mla(KP p, int item, char* lds) {
  constexpr int KSTAGE = 64 * 192, VSTAGE = 128 * 64, VOFF = 2 * KSTAGE;
  int tid_ = threadIdx.x; asm volatile("" : "+v"(tid_));
  const int tid = tid_, lane = tid & 63, w = tid >> 6, r32 = lane & 31, hi = lane >> 5;
  int NT, ktok0, head, seq, qb;
  if (item < 2048) { const int sh = item >> 7; seq = 8 + (sh >> 3); head = sh & 7; qb = item & 127; ktok0 = T_PROMPT + (seq - 8) * 16384; NT = 256; }
  else { const int it = item - 2048; const int sh = it >> 4; seq = sh >> 3; head = sh & 7; qb = it & 15; ktok0 = seq * 2048; NT = 32; }
  const int qtok = ktok0 + qb * 128 + w * 32 + r32;
  const long obase = (long)(ktok0 + qb * 128 + w * 32) * 1024 + head * 128;
  i32x8 qf[3];
  { const unsigned char* Qp = p.q8 + (long)qtok * 1536 + head * 192 + hi * 32;
#pragma unroll
    for (int s3 = 0; s3 < 3; ++s3) { const u32x4 a = *(const u32x4*)(Qp + s3 * 64), b = *(const u32x4*)(Qp + s3 * 64 + 16);
      qf[s3] = (i32x8){(int)a[0], (int)a[1], (int)a[2], (int)a[3], (int)b[0], (int)b[1], (int)b[2], (int)b[3]}; } }
  unsigned ko[3], vo[2];
#pragma unroll
  for (int i = 0; i < 3; ++i) {
    const int g = (w * 3 + i) * 64 + lane, key = g / 12, pc = g - key * 12, c = pc ^ ((key >> 2) & 3);
    ko[i] = (c < 8) ? (unsigned)(key * 1088 + head * 128 + c * 16) : (unsigned)(key * 1088 + 1024 + (c - 8) * 16);
  }
#pragma unroll
  for (int i = 0; i < 2; ++i) {
    const int g = (w * 2 + i) * 64 + lane, d = g >> 2, pc = g & 3, c = pc ^ ((d >> 2) & 3);
    vo[i] = (unsigned)(d * T_TOK + c * 16);
  }
  const unsigned char* k8b = p.k8 + (long)ktok0 * 1088;
  const unsigned char* vtb = p.vT8 + (long)head * 128 * T_TOK + ktok0;
#define GLK(st, jt) do { const unsigned char* kt_ = k8b + (long)(jt) * (64 * 1088); int w_ = w; asm volatile("" : "+v"(w_)); \
    _Pragma("unroll") for (int i = 0; i < 3; ++i) { unsigned k_ = ko[i]; asm volatile("" : "+v"(k_)); \
    __builtin_amdgcn_global_load_lds((const unsigned*)(kt_ + k_), (unsigned*)(lds + (st) * KSTAGE + (w_ * 3 + i) * 1024), 16, 0, 0); } } while (0)
#define GLV(st, jt) do { const unsigned char* vt_ = vtb + (long)(jt) * 64; int w_ = w; asm volatile("" : "+v"(w_)); \
    _Pragma("unroll") for (int i = 0; i < 2; ++i) { unsigned v_ = vo[i]; asm volatile("" : "+v"(v_)); \
    __builtin_amdgcn_global_load_lds((const unsigned*)(vt_ + v_), (unsigned*)(lds + VOFF + (st) * VSTAGE + (w_ * 2 + i) * 1024), 16, 0, 0); } } while (0)
#define QK8(P0, P1, st) do { const int r_ = r32, h_ = hi, sw_ = (r_ >> 2) & 3; const char* Kr_ = lds + (st) * KSTAGE + r_ * 192; \
    const f32x16 z_ = {0.f, 0.f, 0.f, 0.f, 0.f, 0.f, 0.f, 0.f, 0.f, 0.f, 0.f, 0.f, 0.f, 0.f, 0.f, 0.f}; \
    _Pragma("unroll") for (int s3 = 0; s3 < 3; ++s3) { const int c0_ = ((s3 * 4 + h_ * 2) ^ sw_) << 4, c1_ = ((s3 * 4 + h_ * 2 + 1) ^ sw_) << 4; \
      const u32x4 a0_ = *(const u32x4*)(Kr_ + c0_), a1_ = *(const u32x4*)(Kr_ + c1_), b0_ = *(const u32x4*)(Kr_ + 32 * 192 + c0_), b1_ = *(const u32x4*)(Kr_ + 32 * 192 + c1_); \
      const i32x8 ka_ = {(int)a0_[0], (int)a0_[1], (int)a0_[2], (int)a0_[3], (int)a1_[0], (int)a1_[1], (int)a1_[2], (int)a1_[3]}; \
      const i32x8 kb_ = {(int)b0_[0], (int)b0_[1], (int)b0_[2], (int)b0_[3], (int)b1_[0], (int)b1_[1], (int)b1_[2], (int)b1_[3]}; \
      P0 = MFMA8(ka_, qf[s3], (s3 == 0 ? z_ : P0), SC_K, SC_Q); P1 = MFMA8(kb_, qf[s3], (s3 == 0 ? z_ : P1), SC_K, SC_Q); } } while (0)
#define PZERO(P0, P1) do { _Pragma("unroll") for (int r = 0; r < 16; ++r) { P0[r] = 0.f; P1[r] = 0.f; } } while (0)
#define EXPC(P, mn, R0, R1) do { _Pragma("unroll") for (int r = (R0); r < (R1); ++r) P[r] = __builtin_amdgcn_exp2f(P[r] - (mn)); } while (0)
#define SB() do {} while (0)

  float m_reg = -1e30f, l_reg = 0.f;
  f32x16 o[4];
#pragma unroll
  for (int d = 0; d < 4; ++d)
#pragma unroll
    for (int r = 0; r < 16; ++r) o[d][r] = 0.f;
  f32x16 pA0, pA1, pB0, pB1; float pmaxA, pmaxB;

  __syncthreads();
  GLK(0, 0); GLV(0, 0); GLK(1, 1);
  asm volatile("s_waitcnt vmcnt(0)" ::: "memory");
  __syncthreads();
  QK8(pA0, pA1, 0); pmaxA = rowmax32(pA0, pA1);

#define STEP(j, PX0, PX1, PMX, PY0, PY1, PMY, LAST) do { \
    asm volatile("s_waitcnt lgkmcnt(0)" ::: "memory"); __builtin_amdgcn_s_barrier(); \
    if ((j) + 2 < NT) GLK((j) & 1, (j) + 2); \
    if (!(LAST)) GLV(((j) + 1) & 1, (j) + 1); \
    const bool keep_ = __all(PMX - m_reg <= THR8_L2); \
    const float mn_ = keep_ ? m_reg : fmaxf(m_reg, PMX); \
    const float alpha_ = keep_ ? 1.f : __builtin_amdgcn_exp2f(m_reg - mn_); m_reg = mn_; \
    if (!keep_) { _Pragma("unroll") for (int r = 0; r < 16; ++r) { const float a_ = lane_bcast(alpha_, crow(r, hi)); \
      _Pragma("unroll") for (int d = 0; d < 4; ++d) o[d][r] *= a_; } } \
    SB(); \
    if (!(LAST)) { QK8(PY0, PY1, ((j) + 1) & 1); } \
    { const float mnp_ = mn_ - 7.f; EXPC(PX0, mnp_, 0, 16); EXPC(PX1, mnp_, 0, 16); }     \
    SB(); \
    { float ps_ = 0.f; \
      _Pragma("unroll") for (int r = 0; r < 16; ++r) ps_ += PX0[r] + PX1[r]; \
      auto rr_ = __builtin_amdgcn_permlane32_swap(__float_as_uint(ps_), __float_as_uint(ps_), false, false); \
      l_reg = l_reg * alpha_ + __uint_as_float(rr_[0]) + __uint_as_float(rr_[1]); } \
    i32x8 pf_; \
    _Pragma("unroll") for (int g = 0; g < 4; ++g) { \
      const u32 x_ = pack4_fp8(PX0[4 * g], PX0[4 * g + 1], PX0[4 * g + 2], PX0[4 * g + 3]); \
      const u32 y_ = pack4_fp8(PX1[4 * g], PX1[4 * g + 1], PX1[4 * g + 2], PX1[4 * g + 3]); \
      auto sw_ = __builtin_amdgcn_permlane32_swap(x_, y_, false, false); pf_[2 * g] = (int)sw_[0]; pf_[2 * g + 1] = (int)sw_[1]; } \
    SB(); \
    { const int r_ = r32, h_ = hi, sw2_ = (r_ >> 2) & 3; \
      const char* Vr_ = lds + VOFF + ((j) & 1) * VSTAGE + r_ * 64; const int c0_ = ((h_ * 2) ^ sw2_) << 4, c1_ = ((h_ * 2 + 1) ^ sw2_) << 4; \
      _Pragma("unroll") for (int d0 = 0; d0 < 4; ++d0) { \
        const u32x4 a0_ = *(const u32x4*)(Vr_ + d0 * 2048 + c0_), a1_ = *(const u32x4*)(Vr_ + d0 * 2048 + c1_); \
        const i32x8 vf_ = {(int)a0_[0], (int)a0_[1], (int)a0_[2], (int)a0_[3], (int)a1_[0], (int)a1_[1], (int)a1_[2], (int)a1_[3]}; \
        o[d0] = MFMA8(pf_, vf_, o[d0], SC_P, SC_V); } } \
    if (!(LAST)) PMY = rowmax32(PY0, PY1); \
    asm volatile("s_waitcnt vmcnt(0)" ::: "memory"); } while (0)

  for (int j = 0; j < NT - 2; j += 2) {
    STEP(j, pA0, pA1, pmaxA, pB0, pB1, pmaxB, false);
    STEP(j + 1, pB0, pB1, pmaxB, pA0, pA1, pmaxA, false);
  }
  STEP(NT - 2, pA0, pA1, pmaxA, pB0, pB1, pmaxB, false);
  STEP(NT - 1, pB0, pB1, pmaxB, pA0, pA1, pmaxA, true);
#undef STEP
#undef QK8
#undef PZERO
#undef EXPC
#undef SB
#undef GLK
#undef GLV
#pragma unroll
  for (int r = 0; r < 16; ++r) {
    const int qrow = crow(r, hi); const float rl = 1.f / lane_bcast(l_reg, qrow);
    u16* o_ = p.o + obase + (long)qrow * 1024 + r32;
#pragma unroll
    for (int d = 0; d < 4; ++d) o_[d * 32] = (u16)(cvtpk(o[d][r] * rl, 0.f) & 0xffffu);
  }
}

typedef __attribute__((ext_vector_type(2))) float f32x2;
constexpr float U_SCALE = 256.f, V_SCALE = 64.f;
__device__ __forceinline__ float keyval(u32 k) { return __uint_as_float(k & ~127u) - KEY_BIAS; }
template <int CTRL> __device__ __forceinline__ float dppf(float v) { return __int_as_float(__builtin_amdgcn_update_dpp(0, __float_as_int(v), CTRL, 0xF, 0xF, true)); }
__device__ __forceinline__ float red16(float v) { v += dppf<0xB1>(v); v += dppf<0x4E>(v); v += dppf<0x141>(v); v += dppf<0x140>(v); return v; }
__device__ __forceinline__ void fp8dot(u32 dw, const f32x4& x, f32x2& acc) {
  const f32x2 lo = __builtin_amdgcn_cvt_pk_f32_fp8((int)dw, false), hi = __builtin_amdgcn_cvt_pk_f32_fp8((int)dw, true);
  acc = __builtin_elementwise_fma(lo, (f32x2){x[0], x[1]}, acc); acc = __builtin_elementwise_fma(hi, (f32x2){x[2], x[3]}, acc);
}

#ifndef PEER_FP4
#define PEER_FP4 1
#endif
#if PEER_FP4
constexpr float U4_SCALE = 96.f, V4_SCALE = 22.f;
__device__ __forceinline__ void fp4dot(u32 dw, const f32x4& x0, const f32x4& x1, f32x2& acc) {
  acc = __builtin_elementwise_fma(__builtin_amdgcn_cvt_scalef32_pk_f32_fp4(dw, 1.0f, 0), (f32x2){x0[0], x0[1]}, acc);
  acc = __builtin_elementwise_fma(__builtin_amdgcn_cvt_scalef32_pk_f32_fp4(dw, 1.0f, 1), (f32x2){x0[2], x0[3]}, acc);
  acc = __builtin_elementwise_fma(__builtin_amdgcn_cvt_scalef32_pk_f32_fp4(dw, 1.0f, 2), (f32x2){x1[0], x1[1]}, acc);
  acc = __builtin_elementwise_fma(__builtin_amdgcn_cvt_scalef32_pk_f32_fp4(dw, 1.0f, 3), (f32x2){x1[2], x1[3]}, acc);
}
__device__ __forceinline__ void phase_peer_combine(KP p, int layer, char* lds, unsigned* ctr) {
  const bool last = (layer == 3);
  int tid_ = threadIdx.x; asm volatile("" : "+v"(tid_));
  const int tid = tid_, lane = tid & 63, w = tid >> 6;
  int* eL = (int*)(lds + w * 1536); float* gL = (float*)(lds + w * 1536 + 512); float* wL = (float*)(lds + w * 1536 + 1024);
  int ci = 0, cj = 0; bool cvalid = false;
  { int cnt = 0;
#pragma unroll
    for (int i = 0; i < 16; ++i) { const int n = 16 / (i + 1); if (!cvalid && lane < cnt + n) { ci = i; cj = lane - cnt; cvalid = true; } cnt += n; } }
  const unsigned char* U = p.peer_u8 + (long)layer * 16384 * 512; const unsigned char* V = p.peer_v8 + (long)layer * 16384 * 512;
  const int sub = lane & 15, grp = lane >> 4, l32 = lane & 31, hf = lane >> 5;
  __syncthreads();
  for (;;) {
   int base_ = 0; if (lane == 0) base_ = (int)atomicAdd(ctr, 8u);
   base_ = __builtin_amdgcn_readfirstlane(base_);
   if (base_ >= T_TOK) break;
#pragma unroll 1
   for (int t = base_; t < base_ + 8; ++t) {
    float* xr = p.x + (long)t * DM;
    const u32* pk = p.pkeys + (long)t * 256;
    u32 ka[8], kb[8];
#pragma unroll
    for (int hd = 0; hd < 8; ++hd) { ka[hd] = pk[hd * 32 + ci]; kb[hd] = pk[hd * 32 + 16 + cj]; }
    u32 xe[2][4], xo[2][4]; int sumx = 0; float rstd, sx;
    f32x4 xs[2][8];
#pragma unroll
    for (int j = 0; j < 2; ++j)
#pragma unroll
      for (int q = 0; q < 8; ++q) xs[j][q] = *(const f32x4*)(xr + (sub + 16 * j) * 32 + q * 4);
#pragma unroll
    for (int hd = 0; hd < 8; ++hd) {
      const float cand = cvalid ? keyval(ka[hd]) + keyval(kb[hd]) : -3.0e38f;
      u32 ck = __float_as_uint(cand); ck = (ck & 0x80000000u) ? ~ck : (ck | 0x80000000u); ck = (ck & ~63u) | (u32)(63 - lane);
      int rank = 0;
#pragma unroll
      for (int m = 0; m < 50; ++m) { const u32 c = __builtin_amdgcn_readlane(ck, m); rank += (c > ck) ? 1 : 0; }
      const float cmax = __uint_as_float(__builtin_amdgcn_readlane(__float_as_uint(cand), 0));
      if (cvalid && rank < 16) { eL[hd * 16 + rank] = (int)((ka[hd] & 127u) * 128u + (kb[hd] & 127u)); gL[hd * 16 + rank] = __expf(cand - cmax); }
    }
    __builtin_amdgcn_wave_barrier();
    { const float g0 = gL[lane], g1 = gL[lane + 64]; const float s0 = red16(g0), s1 = red16(g1);
      __builtin_amdgcn_wave_barrier();
      gL[lane] = g0 / s0; gL[lane + 64] = g1 / s1; }
    __builtin_amdgcn_wave_barrier();
    u32x4 cA[8], cB[8];
#define LOADU(C, it) do { const int k0_ = (it) * 16 + grp * 4; \
      _Pragma("unroll") for (int rr = 0; rr < 4; ++rr) { const int e_ = eL[k0_ + rr]; const unsigned char* u_ = U + (long)e_ * 512 + sub * 16; \
        C[rr * 2] = *(const u32x4*)u_; C[rr * 2 + 1] = *(const u32x4*)(u_ + 256); } } while (0)
#define COMPU(C, it) do { const int k0_ = (it) * 16 + grp * 4; \
      _Pragma("unroll") for (int rr = 0; rr < 4; ++rr) { int a_ = 0; \
        _Pragma("unroll") for (int j = 0; j < 2; ++j) { _Pragma("unroll") for (int d = 0; d < 4; ++d) { const u32 dw_ = C[rr * 2 + j][d]; \
          a_ = __builtin_amdgcn_sdot4((int)(dw_ & 0x0F0F0F0Fu), (int)xe[j][d], a_, false); a_ = __builtin_amdgcn_sdot4((int)((dw_ >> 4) & 0x0F0F0F0Fu), (int)xo[j][d], a_, false); } } \
        const float r_ = red16((float)(a_ - 8 * sumx)); \
        if (sub == 0) wL[k0_ + rr] = r_; } } while (0)
#define LOADV(C, g) do { _Pragma("unroll") for (int i = 0; i < 8; ++i) { const int e_ = eL[(g) * 16 + 2 * i + hf]; \
      C[i] = *(const u32x4*)(V + (long)e_ * 512 + l32 * 16); } } while (0)
#define COMPV(C, g) do { _Pragma("unroll") for (int i = 0; i < 8; ++i) { const float wk_ = wL[(g) * 16 + 2 * i + hf]; const f32x2 w2_ = {wk_, wk_}; \
      _Pragma("unroll") for (int d = 0; d < 4; ++d) { const u32 dw_ = C[i][d]; \
        out[d * 4 + 0] = __builtin_elementwise_fma(__builtin_amdgcn_cvt_scalef32_pk_f32_fp4(dw_, 1.0f, 0), w2_, out[d * 4 + 0]); \
        out[d * 4 + 1] = __builtin_elementwise_fma(__builtin_amdgcn_cvt_scalef32_pk_f32_fp4(dw_, 1.0f, 1), w2_, out[d * 4 + 1]); \
        out[d * 4 + 2] = __builtin_elementwise_fma(__builtin_amdgcn_cvt_scalef32_pk_f32_fp4(dw_, 1.0f, 2), w2_, out[d * 4 + 2]); \
        out[d * 4 + 3] = __builtin_elementwise_fma(__builtin_amdgcn_cvt_scalef32_pk_f32_fp4(dw_, 1.0f, 3), w2_, out[d * 4 + 3]); } } } while (0)
    LOADU(cA, 0);
    { float ss = 0.f, am = 0.f;
#pragma unroll
      for (int j = 0; j < 2; ++j)
#pragma unroll
        for (int q = 0; q < 8; ++q) { const f32x4 a = xs[j][q]; ss += a[0] * a[0] + a[1] * a[1] + a[2] * a[2] + a[3] * a[3];
          am = fmaxf(fmaxf(am, fmaxf(fabsf(a[0]), fabsf(a[1]))), fmaxf(fabsf(a[2]), fabsf(a[3]))); }
      ss = red16(ss);
      am = fmaxf(am, dppf<0xB1>(am)); am = fmaxf(am, dppf<0x4E>(am)); am = fmaxf(am, dppf<0x141>(am)); am = fmaxf(am, dppf<0x140>(am));
      rstd = rsqrtf(ss * (1.f / DM) + RMS_EPS);
      am = fmaxf(am, 1e-20f); sx = am * (1.f / 127.f); const float inv = 127.f / am;
#pragma unroll
      for (int j = 0; j < 2; ++j)
#pragma unroll
        for (int d = 0; d < 4; ++d) {
          const f32x4 lo4 = xs[j][2 * d], hi4 = xs[j][2 * d + 1];
          const int i0 = (int)__builtin_rintf(lo4[0] * inv), i1 = (int)__builtin_rintf(lo4[1] * inv), i2 = (int)__builtin_rintf(lo4[2] * inv), i3 = (int)__builtin_rintf(lo4[3] * inv);
          const int i4 = (int)__builtin_rintf(hi4[0] * inv), i5 = (int)__builtin_rintf(hi4[1] * inv), i6 = (int)__builtin_rintf(hi4[2] * inv), i7 = (int)__builtin_rintf(hi4[3] * inv);
          sumx += i0 + i1 + i2 + i3 + i4 + i5 + i6 + i7;
          xe[j][d] = (u32)(i0 & 0xFF) | ((u32)(i2 & 0xFF) << 8) | ((u32)(i4 & 0xFF) << 16) | ((u32)i6 << 24);
          xo[j][d] = (u32)(i1 & 0xFF) | ((u32)(i3 & 0xFF) << 8) | ((u32)(i5 & 0xFF) << 16) | ((u32)i7 << 24);
        } }
#pragma unroll 1
    for (int it = 0; it < 6; it += 2) { LOADU(cB, it + 1); COMPU(cA, it); LOADU(cA, it + 2); COMPU(cB, it + 1); }
    LOADU(cB, 7); COMPU(cA, 6);
    LOADV(cA, 0);
    COMPU(cB, 7);
    __builtin_amdgcn_wave_barrier();
    { const float sc_ = rstd * sx * (1.f / U4_SCALE); const float a0 = wL[lane] * sc_, a1 = wL[lane + 64] * sc_;
      const float w0 = gL[lane] * 0.5f * a0 * (1.f + erff(a0 * 0.70710678118654752f)), w1 = gL[lane + 64] * 0.5f * a1 * (1.f + erff(a1 * 0.70710678118654752f));
      __builtin_amdgcn_wave_barrier();
      wL[lane] = w0; wL[lane + 64] = w1; }
    __builtin_amdgcn_wave_barrier();
    f32x2 out[16];
#pragma unroll
    for (int i = 0; i < 16; ++i) out[i] = (f32x2){0.f, 0.f};
#pragma unroll 1
    for (int g = 0; g < 6; g += 2) { LOADV(cB, g + 1); COMPV(cA, g); LOADV(cA, g + 2); COMPV(cB, g + 1); }
    LOADV(cB, 7); COMPV(cA, 6); COMPV(cB, 7);
#undef LOADU
#undef COMPU
#undef LOADV
#undef COMPV
    {
      f32x4 v[4];
#pragma unroll
      for (int q = 0; q < 4; ++q) {
        const f32x2 m0 = hf ? out[8 + 2 * q] : out[2 * q], o0 = hf ? out[2 * q] : out[8 + 2 * q];
        const f32x2 m1 = hf ? out[8 + 2 * q + 1] : out[2 * q + 1], o1 = hf ? out[2 * q + 1] : out[8 + 2 * q + 1];
        v[q] = (f32x4){m0[0] + shx(o0[0], 32), m0[1] + shx(o0[1], 32), m1[0] + shx(o1[0], 32), m1[1] + shx(o1[1], 32)};
      }
      f32x4* xo = (f32x4*)(xr + l32 * 32 + hf * 16);
#pragma unroll
      for (int q = 0; q < 4; ++q) { const f32x4 xv = xo[q]; v[q] = xv + v[q] * (1.f / V4_SCALE); }
      __builtin_amdgcn_wave_barrier();
      if (last) {
        float s2 = 0.f;
#pragma unroll
        for (int q = 0; q < 4; ++q) s2 += v[q][0] * v[q][0] + v[q][1] * v[q][1] + v[q][2] * v[q][2] + v[q][3] * v[q][3];
        s2 = red16(s2); s2 += shx(s2, 16); s2 += shx(s2, 32);
        const float rf = rsqrtf(s2 * (1.f / DM) + RMS_EPS);
#pragma unroll
        for (int q = 0; q < 4; ++q) { const f32x4 gf = *(const f32x4*)(p.norm_final + l32 * 32 + hf * 16 + q * 4); v[q] = v[q] * rf * gf; }
      }
#pragma unroll
      for (int q = 0; q < 4; ++q) xo[q] = v[q];
      u32x4* xbo = (u32x4*)(p.xb + (long)t * DM + l32 * 32 + hf * 16);
      xbo[0] = (u32x4){cvtpk(v[0][0], v[0][1]), cvtpk(v[0][2], v[0][3]), cvtpk(v[1][0], v[1][1]), cvtpk(v[1][2], v[1][3])};
      xbo[1] = (u32x4){cvtpk(v[2][0], v[2][1]), cvtpk(v[2][2], v[2][3]), cvtpk(v[3][0], v[3][1]), cvtpk(v[3][2], v[3][3])}; }
    __builtin_amdgcn_wave_barrier();
   }
  }
}
#else
__device__ __forceinline__ void phase_peer_combine(KP p, int layer, char* lds, unsigned*) {
  const bool last = (layer == 3);
  int tid_ = threadIdx.x; asm volatile("" : "+v"(tid_));
  const int tid = tid_, lane = tid & 63, w = tid >> 6;
  int* eL = (int*)(lds + w * 1536); float* gL = (float*)(lds + w * 1536 + 512); float* wL = (float*)(lds + w * 1536 + 1024);
  int ci = 0, cj = 0; bool cvalid = false;
  { int cnt = 0;
#pragma unroll
    for (int i = 0; i < 16; ++i) { const int n = 16 / (i + 1); if (!cvalid && lane < cnt + n) { ci = i; cj = lane - cnt; cvalid = true; } cnt += n; } }
  const unsigned char* U = p.peer_u8 + (long)layer * 16384 * 1024; const unsigned char* V = p.peer_v8 + (long)layer * 16384 * 1024;
  const int sub = lane & 15, grp = lane >> 4;
  __syncthreads();
  for (int t = blockIdx.x * 4 + w; t < T_TOK; t += gridDim.x * 4) {
    float* xr = p.x + (long)t * DM;
    const u32* pk = p.pkeys + (long)t * 256;
    u32 ka[8], kb[8];
#pragma unroll
    for (int hd = 0; hd < 8; ++hd) { ka[hd] = pk[hd * 32 + ci]; kb[hd] = pk[hd * 32 + 16 + cj]; }
    f32x4 xs[4][4]; float ss = 0.f;
#pragma unroll
    for (int i = 0; i < 4; ++i)
#pragma unroll
      for (int q = 0; q < 4; ++q) { const f32x4 a = *(const f32x4*)(xr + (sub + 16 * i) * 16 + q * 4); xs[i][q] = a; ss += a[0] * a[0] + a[1] * a[1] + a[2] * a[2] + a[3] * a[3]; }
    ss = red16(ss);
    const float rstd = rsqrtf(ss * (1.f / DM) + RMS_EPS);
#pragma unroll
    for (int hd = 0; hd < 8; ++hd) {
      const float cand = cvalid ? keyval(ka[hd]) + keyval(kb[hd]) : -3.0e38f;
      u32 ck = __float_as_uint(cand); ck = (ck & 0x80000000u) ? ~ck : (ck | 0x80000000u); ck = (ck & ~63u) | (u32)(63 - lane);
      int rank = 0;
#pragma unroll
      for (int m = 0; m < 50; ++m) { const u32 c = __builtin_amdgcn_readlane(ck, m); rank += (c > ck) ? 1 : 0; }
      const float cmax = __uint_as_float(__builtin_amdgcn_readlane(__float_as_uint(cand), 0));
      if (cvalid && rank < 16) { eL[hd * 16 + rank] = (int)((ka[hd] & 127u) * 128u + (kb[hd] & 127u)); gL[hd * 16 + rank] = __expf(cand - cmax); }
    }
    __builtin_amdgcn_wave_barrier();
    { const float g0 = gL[lane], g1 = gL[lane + 64]; const float s0 = red16(g0), s1 = red16(g1);
      __builtin_amdgcn_wave_barrier();
      gL[lane] = g0 / s0; gL[lane + 64] = g1 / s1; }
    __builtin_amdgcn_wave_barrier();
    u32x4 cA[8], cB[8];
#define LOADU(C, it) do { const int k0_ = (it) * 8 + grp * 2; const int e0_ = eL[k0_], e1_ = eL[k0_ + 1]; \
      const unsigned char* u0_ = U + (long)e0_ * 1024 + sub * 16; const unsigned char* u1_ = U + (long)e1_ * 1024 + sub * 16; \
      _Pragma("unroll") for (int i = 0; i < 4; ++i) { C[i] = *(const u32x4*)(u0_ + i * 256); C[4 + i] = *(const u32x4*)(u1_ + i * 256); } } while (0)
#define COMPU(C, it) do { const int k0_ = (it) * 8 + grp * 2; f32x2 a0_ = {0.f, 0.f}, a1_ = {0.f, 0.f}; \
      _Pragma("unroll") for (int i = 0; i < 4; ++i) { _Pragma("unroll") for (int q = 0; q < 4; ++q) { fp8dot(C[i][q], xs[i][q], a0_); fp8dot(C[4 + i][q], xs[i][q], a1_); } } \
      const float r0_ = red16(a0_[0] + a0_[1]), r1_ = red16(a1_[0] + a1_[1]); \
      if (sub == 0) { const float aa_ = r0_ * rstd * (1.f / U_SCALE), ab_ = r1_ * rstd * (1.f / U_SCALE); \
        wL[k0_] = gL[k0_] * 0.5f * aa_ * (1.f + erff(aa_ * 0.70710678118654752f)); \
        wL[k0_ + 1] = gL[k0_ + 1] * 0.5f * ab_ * (1.f + erff(ab_ * 0.70710678118654752f)); } } while (0)
#define LOADV(C, g) do { _Pragma("unroll") for (int i = 0; i < 8; ++i) { const int e_ = eL[(g) * 8 + i]; C[i] = *(const u32x4*)(V + (long)e_ * 1024 + lane * 16); } } while (0)
#define COMPV(C, g) do { _Pragma("unroll") for (int i = 0; i < 8; ++i) { const float wk_ = wL[(g) * 8 + i]; const f32x2 w2_ = {wk_, wk_}; \
      _Pragma("unroll") for (int q = 0; q < 4; ++q) { \
        const f32x2 lo_ = __builtin_amdgcn_cvt_pk_f32_fp8((int)C[i][q], false), hi_ = __builtin_amdgcn_cvt_pk_f32_fp8((int)C[i][q], true); \
        out[2 * q] = __builtin_elementwise_fma(lo_, w2_, out[2 * q]); out[2 * q + 1] = __builtin_elementwise_fma(hi_, w2_, out[2 * q + 1]); } } } while (0)
    LOADU(cA, 0);
#pragma unroll 1
    for (int it = 0; it < 14; it += 2) { LOADU(cB, it + 1); COMPU(cA, it); LOADU(cA, it + 2); COMPU(cB, it + 1); }
    LOADU(cB, 15); COMPU(cA, 14);
    LOADV(cA, 0);
    COMPU(cB, 15);
    __builtin_amdgcn_wave_barrier();
    f32x2 out[8];
#pragma unroll
    for (int i = 0; i < 8; ++i) out[i] = (f32x2){0.f, 0.f};
#pragma unroll 1
    for (int g = 0; g < 14; g += 2) { LOADV(cB, g + 1); COMPV(cA, g); LOADV(cA, g + 2); COMPV(cB, g + 1); }
    LOADV(cB, 15); COMPV(cA, 14); COMPV(cB, 15);
#undef LOADU
#undef COMPU
#undef LOADV
#undef COMPV
    { f32x4* xo = (f32x4*)(xr + lane * 16);
      f32x4 v[4];
#pragma unroll
      for (int q = 0; q < 4; ++q) { v[q] = xo[q]; v[q][0] += out[2 * q][0] * (1.f / V_SCALE); v[q][1] += out[2 * q][1] * (1.f / V_SCALE); v[q][2] += out[2 * q + 1][0] * (1.f / V_SCALE); v[q][3] += out[2 * q + 1][1] * (1.f / V_SCALE); }
      __builtin_amdgcn_wave_barrier();
      if (last) {
        float s2 = 0.f;
#pragma unroll
        for (int q = 0; q < 4; ++q) s2 += v[q][0] * v[q][0] + v[q][1] * v[q][1] + v[q][2] * v[q][2] + v[q][3] * v[q][3];
        s2 = red16(s2); s2 += shx(s2, 16); s2 += shx(s2, 32);
        const float rf = rsqrtf(s2 * (1.f / DM) + RMS_EPS);
#pragma unroll
        for (int q = 0; q < 4; ++q) { const f32x4 gf = *(const f32x4*)(p.norm_final + lane * 16 + q * 4); v[q] = v[q] * rf * gf; }
      }
#pragma unroll
      for (int q = 0; q < 4; ++q) xo[q] = v[q];
      u32x4* xbo = (u32x4*)(p.xb + (long)t * DM + lane * 16);
      xbo[0] = (u32x4){cvtpk(v[0][0], v[0][1]), cvtpk(v[0][2], v[0][3]), cvtpk(v[1][0], v[1][1]), cvtpk(v[1][2], v[1][3])};
      xbo[1] = (u32x4){cvtpk(v[2][0], v[2][1]), cvtpk(v[2][2], v[2][3]), cvtpk(v[3][0], v[3][1]), cvtpk(v[3][2], v[3][3])}; }
    __builtin_amdgcn_wave_barrier();
  }
}

#endif

#if PEER_FP4
constexpr long TBL_ITERS = 4L * 16384 * 1024 / 16; constexpr int TBL_NCHUNK = 512; constexpr long TBL_CHUNK = TBL_ITERS / TBL_NCHUNK;
__device__ __forceinline__ void convert_tables_chunk(KP p, int chunk) {
  int tid_ = threadIdx.x; asm volatile("" : "+v"(tid_));
#define Q4(val) ((u32)(int)(fminf(fmaxf(__builtin_rintf((val) * U4_SCALE), -8.f), 7.f) + 8.f))
  for (long i = (long)chunk * TBL_CHUNK + tid_; i < (long)(chunk + 1) * TBL_CHUNK; i += NTHR) {
    const long e = i * 16; const int layer = (int)(e >> 24); const int d = (int)(e & 1023);
    u32 uo[2], vo[2];
#pragma unroll
    for (int h = 0; h < 2; ++h) {
      u32 a = 0, b = 0;
#pragma unroll
      for (int q = 0; q < 2; ++q) {
        const f32x4 g = *(const f32x4*)(p.in_norm_ffn + layer * 1024 + d + h * 8 + q * 4);
        const f32x4 u = *(const f32x4*)(p.in_peer_u + e + h * 8 + q * 4), v = *(const f32x4*)(p.in_peer_v + e + h * 8 + q * 4);
        if (q == 0) {
          a |= Q4(u[0] * g[0]) | (Q4(u[1] * g[1]) << 4) | (Q4(u[2] * g[2]) << 8) | (Q4(u[3] * g[3]) << 12);
          b = __builtin_amdgcn_cvt_scalef32_pk_fp4_f32(b, v[0] * V4_SCALE, v[1] * V4_SCALE, 1.0f, 0); b = __builtin_amdgcn_cvt_scalef32_pk_fp4_f32(b, v[2] * V4_SCALE, v[3] * V4_SCALE, 1.0f, 1);
        } else {
          a |= (Q4(u[0] * g[0]) << 16) | (Q4(u[1] * g[1]) << 20) | (Q4(u[2] * g[2]) << 24) | (Q4(u[3] * g[3]) << 28);
          b = __builtin_amdgcn_cvt_scalef32_pk_fp4_f32(b, v[0] * V4_SCALE, v[1] * V4_SCALE, 1.0f, 2); b = __builtin_amdgcn_cvt_scalef32_pk_fp4_f32(b, v[2] * V4_SCALE, v[3] * V4_SCALE, 1.0f, 3);
        }
      }
      uo[h] = a; vo[h] = b;
    }
    *(u32x2*)(p.peer_u8 + (e >> 1)) = (u32x2){uo[0], uo[1]}; *(u32x2*)(p.peer_v8 + (e >> 1)) = (u32x2){vo[0], vo[1]};
  }
}

#endif
__device__ __forceinline__ void prep_transpose_tile(KP p, int t, char* lds) {
  int tid_ = threadIdx.x; asm volatile("" : "+v"(tid_));
  const int tid = tid_;
  float* tl = (float*)lds;
  int j = 0;
  while (j + 1 < p.njobs && t >= p.jobs[j + 1].tile0) ++j;
  const float* src = p.jobs[j].src; u16* dst = p.jobs[j].dst; const float* gain = p.jobs[j].gain;
  const int K = p.jobs[j].K, N = p.jobs[j].N, scale_cols = p.jobs[j].scale_cols; const float scale = p.jobs[j].scale;
  const int lt = t - p.jobs[j].tile0, ntn = N >> 6, kt = lt / ntn, nt = lt - kt * ntn;
  __syncthreads();
  for (int e = tid; e < 4096; e += 256) { const int kk = e >> 6, nn = e & 63, k = kt * 64 + kk; const float g = gain ? gain[k] : 1.f; tl[kk * 65 + nn] = src[(long)k * N + nt * 64 + nn] * g; }
  __syncthreads();
  for (int e = tid; e < 2048; e += 256) { const int nn = e >> 5, kp = (e & 31) * 2, n = nt * 64 + nn; const float s = (n < scale_cols) ? scale : 1.f;
    *(u32*)(dst + (long)n * K + kt * 64 + kp) = cvtpk(tl[kp * 65 + nn] * s, tl[(kp + 1) * 65 + nn] * s); }
  __syncthreads();
}

__device__ __forceinline__ void phase_prep(KP p, char* lds) {
  int tid_ = threadIdx.x; asm volatile("" : "+v"(tid_));
  const int tid = tid_;
  const long gtid = (long)blockIdx.x * NTHR + tid, gsz = (long)gridDim.x * NTHR;
  float* tl = (float*)lds;
  for (int t = blockIdx.x; t < p.jobs[4].tile0; t += gridDim.x) prep_transpose_tile(p, t, lds);
  for (long i = gtid; i < (long)T_TOK * DM / 4; i += gsz) {
    const long e = i * 4; const f32x4 v = e < (long)T_PROMPT * DM ? *(const f32x4*)(p.xin0 + e) : *(const f32x4*)(p.xin1 + (e - (long)T_PROMPT * DM));
    *(u32*)(p.xb + e) = cvtpk(v[0], v[1]); *(u32*)(p.xb + e + 2) = cvtpk(v[2], v[3]); }
  for (long i = gtid; i < 4L * 8 * 2 * 128 * 128 / 2; i += gsz) { const float a = p.in_sub_keys[2 * i], b = p.in_sub_keys[2 * i + 1]; *(u32*)(p.peer_sk + 2 * i) = cvtpk(a, b); }
#if PEER_FP4
#else
  for (long i = gtid; i < 4L * 16384 * 1024 / 16; i += gsz) {
    const long e = i * 16; const int layer = (int)(e >> 24); const int d = (int)(e & 1023);
    u32x4 uo, vo;
#pragma unroll
    for (int q = 0; q < 4; ++q) {
      const f32x4 g = *(const f32x4*)(p.in_norm_ffn + layer * 1024 + d + q * 4);
      const f32x4 u = *(const f32x4*)(p.in_peer_u + e + q * 4), v = *(const f32x4*)(p.in_peer_v + e + q * 4);
      int a = 0, b = 0;
      a = __builtin_amdgcn_cvt_pk_fp8_f32(u[0] * g[0] * U_SCALE, u[1] * g[1] * U_SCALE, a, false); a = __builtin_amdgcn_cvt_pk_fp8_f32(u[2] * g[2] * U_SCALE, u[3] * g[3] * U_SCALE, a, true);
      b = __builtin_amdgcn_cvt_pk_fp8_f32(v[0] * V_SCALE, v[1] * V_SCALE, b, false); b = __builtin_amdgcn_cvt_pk_fp8_f32(v[2] * V_SCALE, v[3] * V_SCALE, b, true);
      uo[q] = (u32)a; vo[q] = (u32)b;
    }
    *(u32x4*)(p.peer_u8 + e) = uo; *(u32x4*)(p.peer_v8 + e) = vo;
  }
#endif
  for (long i = gtid; i < 2 * 3072; i += gsz) { const int c = (int)(i % 3072); p.na_bias_s[i] = p.in_na_bias[i] * (c < 1024 ? 0.125f * LOG2E : 1.f); }
  for (long i = gtid; i < 2 * 16 * 465; i += gsz) p.na_rpb_s[i] = p.in_na_rpb[i] * LOG2E;
  for (long i = gtid; i < 16384L * 32; i += gsz) {
    const int pos = (int)(i >> 5), jf = (int)(i & 31);
    const double a = (double)pos * p.inv_freq[jf] * 0.15915494309189535;
    const double fr = a - rint(a);
    const float f = (float)fr;
    p.ropeC[i] = __builtin_amdgcn_cosf(f); p.ropeS[i] = __builtin_amdgcn_sinf(f);
  }
  for (long i = gtid; i < 2L * 64 * 1024 / 2; i += gsz) { const int l = (int)(i >> 15); const long e = (i & 32767) * 2; *(u32*)(p.wa_t[l] + 704L * 1024 + e) = 0u; }
}

__device__ __forceinline__ void phase_final(KP p) {
  int tid_ = threadIdx.x; asm volatile("" : "+v"(tid_));
  const int lane = tid_ & 63, w = tid_ >> 6;
  for (int t = blockIdx.x * 4 + w; t < T_TOK; t += gridDim.x * 4) {
    float* xr = p.x + (long)t * DM;
    f32x4 v[4]; float ss = 0.f;
#pragma unroll
    for (int i = 0; i < 4; ++i) { v[i] = *(const f32x4*)(xr + i * 256 + lane * 4); ss += v[i][0] * v[i][0] + v[i][1] * v[i][1] + v[i][2] * v[i][2] + v[i][3] * v[i][3]; }
    ss += shx(ss, 1); ss += shx(ss, 2); ss += shx(ss, 4); ss += shx(ss, 8); ss += shx(ss, 16); ss += shx(ss, 32);
    const float rs = rsqrtf(ss * (1.f / DM) + RMS_EPS);
#pragma unroll
    for (int i = 0; i < 4; ++i) { const f32x4 g = *(const f32x4*)(p.norm_final + i * 256 + lane * 4); f32x4 o_ = {v[i][0] * rs * g[0], v[i][1] * rs * g[1], v[i][2] * rs * g[2], v[i][3] * rs * g[3]}; *(f32x4*)(xr + i * 256 + lane * 4) = o_; }
  }
}

template <int EPI>
__device__ __forceinline__ void gemm_big(KP p, int layer, const u16* Ap, int lda, const u16* Bt, int K, int m0, int n0, char* lds) {
  int tid_ = threadIdx.x; asm volatile("" : "+v"(tid_));
  const int tid = tid_, lane = tid & 63, w = tid >> 6;
  const int wm = w >> 1, wn = w & 1, r32 = lane & 31, hi = lane >> 5;
  constexpr int STG = 24576;
  const int scol = ((lane & 3) ^ ((lane >> 4) & 3)) * 8;
  const u16* Ag = Ap + (long)(m0 + w * 64 + (lane >> 2)) * lda + scol;
  const u16* Bg = Bt + (long)(n0 + w * 32 + (lane >> 2)) * K + scol;
#define GST(st, kt) do { int w_ = w; asm volatile("" : "+v"(w_)); \
    _Pragma("unroll") for (int i = 0; i < 4; ++i) __builtin_amdgcn_global_load_lds((const unsigned*)(Ag + (long)i * 16 * lda + (kt) * 32), (unsigned*)(lds + (st) * STG + (w_ * 4 + i) * 1024), 16, 0, 0); \
    _Pragma("unroll") for (int i = 0; i < 2; ++i) __builtin_amdgcn_global_load_lds((const unsigned*)(Bg + (long)i * 16 * K + (kt) * 32), (unsigned*)(lds + (st) * STG + 16384 + (w_ * 2 + i) * 1024), 16, 0, 0); } while (0)
  f32x16 acc[4][2];
#pragma unroll
  for (int i = 0; i < 4; ++i)
#pragma unroll
    for (int j = 0; j < 2; ++j)
#pragma unroll
      for (int r = 0; r < 16; ++r) acc[i][j][r] = 0.f;
  float ssq[4] = {0.f, 0.f, 0.f, 0.f};
  const int sw = (r32 >> 2) & 3;
  const int arow = (wm * 128 + r32) * 64, brow = 16384 + (wn * 64 + r32) * 64;
  const int nk = K / 32;
  __syncthreads();
  GST(0, 0); GST(1, 1);
  int st = 0;
  for (int kt = 0; kt < nk; ++kt) {
    if (kt + 1 < nk) asm volatile("s_waitcnt vmcnt(6)" ::: "memory"); else asm volatile("s_waitcnt vmcnt(0)" ::: "memory");
    asm volatile("s_waitcnt lgkmcnt(0)" ::: "memory");
    __builtin_amdgcn_s_barrier();
    if (kt + 2 < nk) { const int s2 = st + 2 >= 3 ? st - 1 : st + 2; GST(s2, kt + 2); }
    const char* base = lds + st * STG;
#pragma unroll
    for (int ks = 0; ks < 2; ++ks) {
      const int co = ((ks * 2 + hi) ^ sw) << 4;
      bf16x8 a[4], b[2];
#pragma unroll
      for (int mi = 0; mi < 4; ++mi) a[mi] = *(const bf16x8*)(base + arow + mi * 2048 + co);
#pragma unroll
      for (int ni = 0; ni < 2; ++ni) b[ni] = *(const bf16x8*)(base + brow + ni * 2048 + co);
#pragma unroll
      for (int mi = 0; mi < 4; ++mi) { acc[mi][0] = mfma32(b[0], a[mi], acc[mi][0]); acc[mi][1] = mfma32(b[1], a[mi], acc[mi][1]); }
#pragma unroll
      for (int mi = 0; mi < 4; ++mi) { const u32x4 x = __builtin_bit_cast(u32x4, a[mi]);
#pragma unroll
        for (int q = 0; q < 4; ++q) ssq[mi] = dot2bf(x[q], x[q], ssq[mi]); }
    }
    st = st == 2 ? 0 : st + 1;
  }
#undef GST
  __syncthreads();
  float rs[4];
#pragma unroll
  for (int mi = 0; mi < 4; ++mi) { const float t = ssq[mi] + shx(ssq[mi], 32); rs[mi] = rsqrtf(t / (float)K + RMS_EPS); }
  const int rowb = wm * 128, colb = wn * 64;
  if constexpr (EPI == EPI_A || EPI == EPI_QKV) {
    constexpr int OROW = 272;
    u16* outp; int ldo; bool rope = false;
    if constexpr (EPI == EPI_A) { outp = p.cqkv; ldo = 768; rope = (n0 + colb == 640); }
    else { outp = p.qkv; ldo = 3072; }
#pragma unroll
    for (int mi = 0; mi < 4; ++mi) {
      const int rl = rowb + mi * 32 + r32; const int pos = tok_pos(m0 + rl);
#pragma unroll
      for (int g = 0; g < 4; ++g) {
        f32x4 v0, v1;
#pragma unroll
        for (int e = 0; e < 4; ++e) { v0[e] = acc[mi][0][4 * g + e] * rs[mi]; v1[e] = acc[mi][1][4 * g + e] * rs[mi]; }
        if constexpr (EPI == EPI_QKV) {
          const f32x4 b0 = *(const f32x4*)(p.na_bias_s + layer * 3072 + n0 + colb + 8 * g + 4 * hi), b1 = *(const f32x4*)(p.na_bias_s + layer * 3072 + n0 + colb + 32 + 8 * g + 4 * hi);
          v0 += b0; v1 += b1;
        }
        if (rope) {
          const f32x4 c = *(const f32x4*)(p.ropeC + pos * 32 + 8 * g + 4 * hi), sn = *(const f32x4*)(p.ropeS + pos * 32 + 8 * g + 4 * hi);
          const f32x4 t0 = (v0 * c - v1 * sn) * K8_SCALE, t1 = (v0 * sn + v1 * c) * K8_SCALE;
          unsigned char* kp_ = p.k8 + (long)(m0 + rl) * 1088 + 1024 + 8 * g + 4 * hi;
          *(u32*)kp_ = pack4_fp8(t0[0], t0[1], t0[2], t0[3]); *(u32*)(kp_ + 32) = pack4_fp8(t1[0], t1[1], t1[2], t1[3]);
        }
        char* e_ = lds + rl * OROW + (colb + 8 * g + 4 * hi) * 2;
        *(u32x2*)e_ = (u32x2){cvtpk(v0[0], v0[1]), cvtpk(v0[2], v0[3])};
        *(u32x2*)(e_ + 64) = (u32x2){cvtpk(v1[0], v1[1]), cvtpk(v1[2], v1[3])};
      }
    }
    __syncthreads();
#pragma unroll 4
    for (int i = 0; i < 16; ++i) { const int c = tid + 256 * i, row = c >> 4, ch = c & 15;
      *(u32x4*)(outp + (long)(m0 + row) * ldo + n0 + ch * 8) = *(const u32x4*)(lds + row * OROW + ch * 16); }
  } else {
    constexpr int BROW = 144;
    const bool rope = (EPI == EPI_UQ) && ((n0 + colb) % 192 == 128);
    const float sc = (EPI == EPI_UQ) ? Q8_SCALE : K8_SCALE;
#pragma unroll
    for (int mi = 0; mi < 4; ++mi) {
      const int rl = rowb + mi * 32 + r32; const int pos = tok_pos(m0 + rl);
#pragma unroll
      for (int g = 0; g < 4; ++g) {
        f32x4 v0, v1;
#pragma unroll
        for (int e = 0; e < 4; ++e) { v0[e] = acc[mi][0][4 * g + e] * rs[mi] * sc; v1[e] = acc[mi][1][4 * g + e] * rs[mi] * sc; }
        if (rope) {
          const f32x4 c = *(const f32x4*)(p.ropeC + pos * 32 + 8 * g + 4 * hi), sn = *(const f32x4*)(p.ropeS + pos * 32 + 8 * g + 4 * hi);
          const f32x4 t0 = v0 * c - v1 * sn, t1 = v0 * sn + v1 * c; v0 = t0; v1 = t1;
        }
        char* e_ = lds + rl * BROW + (colb + 8 * g + 4 * hi);
        *(u32*)e_ = pack4_fp8(v0[0], v0[1], v0[2], v0[3]); *(u32*)(e_ + 32) = pack4_fp8(v1[0], v1[1], v1[2], v1[3]);
      }
    }
    __syncthreads();
    unsigned char* outb; long ldo;
    if constexpr (EPI == EPI_UQ) { outb = p.q8 + n0; ldo = 1536; } else { outb = p.k8 + (n0 >> 8) * 128; ldo = 1088; }
#pragma unroll 2
    for (int i = 0; i < 8; ++i) { const int c = tid + 256 * i, row = c >> 3, ch = c & 7;
      *(u32x4*)(outb + (long)(m0 + row) * ldo + ch * 16) = *(const u32x4*)(lds + row * BROW + ch * 16); }
  }
}

__device__ __forceinline__ void ukv_tile(KP p, int j, int mt, int nt, char* lds) {
  if (nt & 1) gemm_tile<EPI_UV, true>(p, j, p.cqkv + 384, 768, p.wukv_t[j], 256, mt * 128, nt * 128, lds);
  else gemm_tile<EPI_UK, true>(p, j, p.cqkv + 384, 768, p.wukv_t[j], 256, mt * 128, nt * 128, lds);
}
#define XB_TMO      128
#define XB_XCNT(j)  (256  + 64 * (j))
#define XB_XSUB(j)  (1280 + 64 * (j))
#define XB_XGEN(j)  (2304 + 64 * (j))
#define XB_TOP      3328
#define XB_TOPGEN   3392
#define XCD_BAR_WORDS 3456
#define XB_SPIN_CAP (1u << 18)
#define LAS __attribute__((address_space(3)))
__device__ __forceinline__ unsigned xb_ld(unsigned* p)              { return __hip_atomic_load(p, __ATOMIC_RELAXED, __HIP_MEMORY_SCOPE_AGENT); }
__device__ __forceinline__ unsigned xb_add(unsigned* p, unsigned v) { return __hip_atomic_fetch_add(p, v, __ATOMIC_RELAXED, __HIP_MEMORY_SCOPE_AGENT); }
__device__ __forceinline__ unsigned xb_xcc_id() { return (unsigned)__builtin_amdgcn_s_getreg((3 << 11) | 20) & 0xFu; }
#define XB_SPIN(cond, bar) do { unsigned _sp = 0; while (cond) { __builtin_amdgcn_s_sleep(1); \
    if ((++_sp & 255u) == 0u) { if (xb_ld(&(bar)[XB_TMO])) break; if (_sp > XB_SPIN_CAP) { atomicAdd(&(bar)[XB_TMO], 1u); break; } } } } while (0)
struct XcdBarrier { unsigned* bar; unsigned x; volatile LAS unsigned* st; };
__device__ __forceinline__ XcdBarrier xcd_barrier_post(unsigned* bar, volatile LAS unsigned* st) {
    XcdBarrier b; b.bar = bar; b.x = xb_xcc_id(); b.st = st;
    if (threadIdx.x == 0) (void)xb_add(&bar[XB_XCNT(b.x)], 1u);
    return b;
}
__device__ __forceinline__ void xcd_barrier_complete(unsigned* bar, unsigned x, unsigned& nloc, unsigned& nx) {
    const unsigned G = gridDim.x * gridDim.y * gridDim.z;
    unsigned sum, cnt, mine, sp = 0u;
    for (;;) {
        sum = 0u; cnt = 0u; mine = 0u;
#pragma unroll
        for (unsigned j = 0; j < 16; ++j) { const unsigned c = xb_ld(&bar[XB_XCNT(j)]); sum += c; cnt += (c > 0u) ? 1u : 0u; mine = (j == x) ? c : mine; }
        if (sum == G) break;
        __builtin_amdgcn_s_sleep(1);
        if ((++sp & 255u) == 0u) { if (xb_ld(&bar[XB_TMO])) break; if (sp > XB_SPIN_CAP) { atomicAdd(&bar[XB_TMO], 1u); break; } }
    }
    nloc = mine > 0u ? mine : 1u; nx = cnt > 0u ? cnt : 1u;
}
__device__ __forceinline__ void xcd_barrier(const XcdBarrier& b) {
    asm volatile("s_waitcnt vmcnt(0)" ::: "memory");
    __syncthreads();
    if (threadIdx.x == 0) {
        unsigned* bar = b.bar;
        __builtin_amdgcn_s_waitcnt(0);
        unsigned nloc = b.st[0], nx = b.st[1];
        if (nloc == 0u) { xcd_barrier_complete(bar, b.x, nloc, nx); b.st[0] = nloc; b.st[1] = nx; }
        const unsigned old = xb_add(&bar[XB_XSUB(b.x)], 1u);
        const unsigned gen = old / nloc;
        if (old + 1u == (gen + 1u) * nloc) {
            __builtin_amdgcn_fence(__ATOMIC_RELEASE, "agent");
            asm volatile("s_waitcnt vmcnt(0)" ::: "memory");
            const unsigned og = xb_add(&bar[XB_TOP], 1u);
            const unsigned tg = og / nx;
            if (og + 1u == (tg + 1u) * nx) xb_add(&bar[XB_TOPGEN], 1u);
            else XB_SPIN(xb_ld(&bar[XB_TOPGEN]) == tg, bar);
            __builtin_amdgcn_fence(__ATOMIC_ACQUIRE, "agent");
            xb_add(&bar[XB_XGEN(b.x)], 1u);
            asm volatile("s_waitcnt vmcnt(0)" ::: "memory");
        } else {
            XB_SPIN(xb_ld(&bar[XB_XGEN(b.x)]) == gen, bar);
            __builtin_amdgcn_fence(__ATOMIC_ACQUIRE, "agent");
            asm volatile("s_waitcnt vmcnt(0)" ::: "memory");
        }
    }
    __syncthreads();
}

#define GEMM_PHASE(SUB, MTILES, NTILES, SM, SN, CALL) do { \
    const int nsn_ = (NTILES) / (SN), nsuper_ = ((MTILES) / (SM)) * nsn_, per_ = (SM) * (SN); \
    const int xcd_ = blockIdx.x & 7; \
    const int total_ = ((nsuper_ - xcd_ + 7) >> 3) * per_;            \
    unsigned* q_ = p.bar + XCD_BAR_WORDS + 64 + (ph * 3 + (SUB)) * 8 + xcd_; \
    for (;;) { \
      if (threadIdx.x == 0) xb_words[2] = atomicAdd(q_, 1u); \
      __syncthreads(); const int idx_ = (int)xb_words[2]; __syncthreads(); \
      if (idx_ >= total_) break; \
      const int r_ = idx_ / per_, l_ = idx_ - r_ * per_, s_ = xcd_ + 8 * r_, sm_ = s_ / nsn_, sn_ = s_ - sm_ * nsn_; \
      const int mt = sm_ * (SM) + l_ / (SN), nt = sn_ * (SN) + l_ % (SN); CALL; } } while (0)

__global__ void __launch_bounds__(NTHR, LB2) mega(const Params p_unused, int ph_lo, int ph_hi) {
  __shared__ __attribute__((aligned(16))) char lds[SMEM_BYTES];
  volatile LAS unsigned* xb_words = (volatile LAS unsigned*)(lds + SMEM_BYTES - 16);
  constexpr int MT = T_TOK / 128;
  XcdBarrier xb;
  { const __attribute__((address_space(4))) Params* pp0 = (const __attribute__((address_space(4))) Params*)__builtin_amdgcn_kernarg_segment_ptr();
    if (threadIdx.x < 4) xb_words[threadIdx.x] = 0u;
    __syncthreads();
    xb = xcd_barrier_post(pp0->bar, xb_words); }
  for (int ph = ph_lo; ph < ph_hi; ++ph) {
    const __attribute__((address_space(4))) Params* pp = (const __attribute__((address_space(4))) Params*)__builtin_amdgcn_kernarg_segment_ptr();
    asm volatile("" : "+s"(pp));
    KP p = *pp;
    const int type = p.prog_type[ph], layer = p.prog_layer[ph];
    const int j = layer >> 1;
    switch (type) {
      case PH_PREP: if (!PHON(PH_PREP)) break; phase_prep(p, lds); break;
      case PH_MLA_A: if (!PHON(PH_MLA_A)) break;
        GEMM_PHASE(0, MT / 2, 6, 8, 6, (gemm_big<EPI_A>(p, j, p.xb, DM, p.wa_t[j], 1024, mt * 256, nt * 128, lds)));
        break;
      case PH_MLA_B: if (!PHON(PH_MLA_B)) break;
        GEMM_PHASE(0, MT / 2, 12, 16, 4, (gemm_big<EPI_UQ>(p, j, p.cqkv, 768, p.wuq_t[j], 384, mt * 256, nt * 128, lds)));
        GEMM_PHASE(1, MT / 2, 8, 8, 8, (gemm_big<EPI_UK>(p, j, p.cqkv + 384, 768, p.wukv_t[j], 256, mt * 256, nt * 256, lds)));
        GEMM_PHASE(2, MT, 8, 8, 8, (gemm_tile<EPI_UV, true>(p, j, p.cqkv + 384, 768, p.wukv_t[j], 256, mt * 128, nt * 256 + 128, lds)));
        break;
      case PH_MLA_ATT: if (!PHON(PH_MLA_ATT)) break;
#ifndef SKEW_BIT
#define SKEW_BIT 256
#endif
        if (blockIdx.x & SKEW_BIT) { __builtin_amdgcn_s_setprio(1); }
        {
          unsigned* ctr = p.bar + XCD_BAR_WORDS + ph;
          for (;;) {
            if (threadIdx.x == 0) xb_words[2] = atomicAdd(ctr, 1u);
            __syncthreads();
            const int t = (int)xb_words[2];
            __syncthreads();
            if (t < 3072) attn_mla(p, t, lds);
            else if (PEER_FP4 && layer == 0 && t < 3072 + TBL_NCHUNK) convert_tables_chunk(p, t - 3072);
            else if (PEER_FP4 && layer == 0 && t < 3072 + TBL_NCHUNK + (p.ntiles_prep - p.jobs[4].tile0)) prep_transpose_tile(p, t - 3072 - TBL_NCHUNK + p.jobs[4].tile0, lds);
            else break;
          } }
        __builtin_amdgcn_s_setprio(0);
        break;
      case PH_MLA_O: if (!PHON(PH_MLA_O)) break;
        GEMM_PHASE(0, MT, 8, 8, 8, (gemm_tile<EPI_O, false>(p, layer == 0 ? -1 : j, p.o, 1024, p.mla_wo_t[j], 1024, mt * 128, nt * 128, lds)));
        break;
      case PH_NA_QKV: if (!PHON(PH_NA_QKV)) break;
        GEMM_PHASE(0, MT / 2, 24, 8, 8, (gemm_big<EPI_QKV>(p, j, p.xb, DM, p.na_wqkv_t[j], 1024, mt * 256, nt * 128, lds)));
        break;
      case PH_NA_ATT: if (!PHON(PH_NA_ATT)) break;
        { unsigned* ctr = p.bar + XCD_BAR_WORDS + ph;
          for (;;) {
            if (threadIdx.x == 0) xb_words[2] = atomicAdd(ctr, 1u);
            __syncthreads();
            const int t = (int)xb_words[2];
            __syncthreads();
            if (t >= 6144) break;
            attn_item<1>(p, j, t, lds);
          } }
        break;
      case PH_NA_O: if (!PHON(PH_NA_O)) break;
        GEMM_PHASE(0, MT, 8, 8, 8, (gemm_tile<EPI_O, false>(p, j, p.o, 1024, p.na_wo_t[j], 1024, mt * 128, nt * 128, lds)));
        break;
      case PH_PEER_Q: if (!PHON(PH_PEER_Q)) break;
        GEMM_PHASE(0, MT, 16, 8, 8, (gemm_tile<EPI_PEER, true>(p, layer, p.xb, DM, p.peer_wq_t[layer], 1024, mt * 128, nt * 128, lds)));
        break;
      case PH_PEER_C: if (!PHON(PH_PEER_C)) break; phase_peer_combine(p, layer, lds, p.bar + XCD_BAR_WORDS + ph); break;
      case PH_FINAL: if (!PHON(PH_FINAL)) break; phase_final(p); break;
      default: break;
    }
    if (ph + 1 < ph_hi) { if (ph_hi > 1000) cg::this_grid().sync(); else xcd_barrier(xb); }
  }
}

extern "C" void kernel_launch(void* const* d_in, const int* in_sizes, int n_in, void* d_out, int out_size, void* d_ws, size_t ws_size, hipStream_t stream) {
  static int grid_blocks = 0, n_cus = 0;
  if (!grid_blocks) {
    int dev = 0, cus = 0;
    (void)hipGetDevice(&dev);
    (void)hipDeviceGetAttribute(&cus, hipDeviceAttributeMultiprocessorCount, dev);
    if (cus < 8) cus = 256;
    n_cus = cus;
    grid_blocks = cus * 2;
  }
  Params p; memset(&p, 0, sizeof(p));
  const float* const* in = (const float* const*)d_in;
  char* ws = (char*)d_ws; size_t off = 0;
  auto alloc = [&](size_t bytes) -> void* { void* r = ws + off; off += (bytes + 255) & ~(size_t)255; return r; };
  p.xin0 = in[0]; p.xin1 = in[1]; p.x = (float*)d_out; p.norm_final = in[4];
  for (int l = 0; l < 2; ++l) {
    p.wa_t[l] = (u16*)alloc(768UL * 1024 * 2); p.wuq_t[l] = (u16*)alloc(1536UL * 384 * 2); p.wukv_t[l] = (u16*)alloc(2048UL * 256 * 2); p.mla_wo_t[l] = (u16*)alloc(1024UL * 1024 * 2);
    p.na_wqkv_t[l] = (u16*)alloc(3072UL * 1024 * 2); p.na_wo_t[l] = (u16*)alloc(1024UL * 1024 * 2);
  }
  for (int l = 0; l < 4; ++l) p.peer_wq_t[l] = (u16*)alloc(2048UL * 1024 * 2);
  p.na_bias_s = (float*)alloc(2 * 3072 * 4); p.na_rpb_s = (float*)alloc(2 * 16 * 465 * 4);
  p.peer_sk = (u16*)alloc(4UL * 8 * 2 * 128 * 128 * 2);
  p.peer_u8 = (unsigned char*)alloc(4UL * 16384 * 1024); p.peer_v8 = (unsigned char*)alloc(4UL * 16384 * 1024);
  p.ropeC = (float*)alloc(16384UL * 32 * 4); p.ropeS = (float*)alloc(16384UL * 32 * 4);
  p.bar = (unsigned*)alloc((XCD_BAR_WORDS + 1024) * 4);
  p.o = (u16*)alloc((size_t)T_TOK * 1024 * 2); p.xb = (u16*)alloc((size_t)T_TOK * 1024 * 2);
  char* un = (char*)alloc((size_t)T_TOK * (768 + 1536 + 2048) * 2);
  p.cqkv = (u16*)un; p.q = (u16*)(un + (size_t)T_TOK * 768 * 2); p.kv = (u16*)(un + (size_t)T_TOK * (768 + 1536) * 2);
  { unsigned char* b8 = (unsigned char*)un + (size_t)T_TOK * 768 * 2; p.q8 = b8; p.k8 = b8 + (size_t)T_TOK * 1536; p.kpe8 = p.k8; p.vT8 = p.k8 + (size_t)T_TOK * 1088; }
  p.qkv = (u16*)un; p.pkeys = (u32*)un;
  if (off > ws_size) { fprintf(stderr, "kernel_launch: workspace too small: need %zu have %zu\n", off, ws_size); return; }
  p.in_sub_keys = in[17]; p.in_peer_u = in[18]; p.in_peer_v = in[19]; p.in_norm_ffn = in[3]; p.in_na_bias = in[13]; p.in_na_rpb = in[14];
  for (int jf = 0; jf < 32; ++jf) p.inv_freq[jf] = pow(10000.0, -(double)(2 * jf) / 64.0);
  int nj = 0, tile = 0;
  auto job = [&](const float* src, u16* dst, const float* gain, int K, int N, float scale, int scale_cols) {
    PrepJob& J = p.jobs[nj++]; J.src = src; J.dst = dst; J.gain = gain; J.K = K; J.N = N; J.tile0 = tile; J.scale = scale; J.scale_cols = scale_cols; J.pad = 0; tile += (K / 64) * (N / 64); };
  const float sc_mla = (float)(pow(192.0, -0.5) * 1.4426950408889634);
  for (int l = 0; l < 2; ++l) {
    job(in[5] + (size_t)l * 1024 * 384, p.wa_t[l], in[2] + (2 * l) * 1024, 1024, 384, 1.f, 0);
    job(in[8] + (size_t)l * 1024 * 320, p.wa_t[l] + 384UL * 1024, in[2] + (2 * l) * 1024, 1024, 320, 1.f, 0);
    job(in[7] + (size_t)l * 384 * 1536, p.wuq_t[l], in[6] + l * 384, 384, 1536, sc_mla, 1536);
    job(in[10] + (size_t)l * 256 * 2048, p.wukv_t[l], in[9] + l * 256, 256, 2048, 1.f, 0);
    job(in[11] + (size_t)l * 1024 * 1024, p.mla_wo_t[l], nullptr, 1024, 1024, 1.f, 0);
    job(in[12] + (size_t)l * 1024 * 3072, p.na_wqkv_t[l], in[2] + (2 * l + 1) * 1024, 1024, 3072, 0.125f * 1.4426950408889634f, 1024);
    job(in[15] + (size_t)l * 1024 * 1024, p.na_wo_t[l], nullptr, 1024, 1024, 1.f, 0);
  }
  for (int l = 0; l < 4; ++l) job(in[16] + (size_t)l * 1024 * 2048, p.peer_wq_t[l], in[3] + l * 1024, 1024, 2048, 1.f, 0);
  p.njobs = nj; p.ntiles_prep = tile;
  int np = 0;
#ifndef DUPMASK
#define DUPMASK 0
#endif
  auto ph = [&](int type, int layer) { p.prog_type[np] = type; p.prog_layer[np] = layer; ++np;
    if ((DUPMASK >> type) & 1) { p.prog_type[np] = type; p.prog_layer[np] = layer; ++np; } };
  ph(PH_PREP, 0);
  for (int i = 0; i < 4; ++i) {
    if ((i & 1) == 0) { ph(PH_MLA_A, i); ph(PH_MLA_B, i); ph(PH_MLA_ATT, i); ph(PH_MLA_O, i); }
    else { ph(PH_NA_QKV, i); ph(PH_NA_ATT, i); ph(PH_NA_O, i); }
    ph(PH_PEER_Q, i); ph(PH_PEER_C, i);
  }
  p.nprog = np;
#if COOP
  (void)hipMemsetAsync(p.bar, 0, (XCD_BAR_WORDS + 1024) * 4, stream);
  int lo = 0, hi = np;
  void* args[] = {(void*)&p, (void*)&lo, (void*)&hi};
  hipError_t e = hipLaunchCooperativeKernel((const void*)mega, dim3(grid_blocks), dim3(NTHR), args, 0, stream);
  if (e != hipSuccess && grid_blocks != n_cus) {
    (void)hipGetLastError(); grid_blocks = n_cus;
    e = hipLaunchCooperativeKernel((const void*)mega, dim3(grid_blocks), dim3(NTHR), args, 0, stream);
  }
  if (e != hipSuccess) fprintf(stderr, "cooperative launch failed: %s (grid %d)\n", hipGetErrorString(e), grid_blocks);
#else
  for (int i = 0; i < np; ++i) hipLaunchKernelGGL(mega, dim3(grid_blocks), dim3(NTHR), 0, stream, p, i, i + 1);
#endif
}
```

```cpp
#include <hip/hip_runtime.h>
#include <hip/hip_cooperative_groups.h>
#include <stdint.h>
#include <string.h>
#include <math.h>
#include <cstdio>
namespace cg = cooperative_groups;

#ifndef COOP
#define COOP 1
#endif
#ifndef PHMASK
#define PHMASK 0xFFFF
#endif
#ifndef LB2
#define LB2 2
#endif
#define PHON(t) ((PHMASK >> (t)) & 1)

typedef unsigned short u16;
typedef unsigned int u32;
using bf16x8 = __attribute__((ext_vector_type(8))) short;
using s16x4  = __attribute__((ext_vector_type(4))) short;
using f32x16 = __attribute__((ext_vector_type(16))) float;
using f32x4  = __attribute__((ext_vector_type(4))) float;
using u32x4  = __attribute__((ext_vector_type(4))) unsigned;
using u32x2  = __attribute__((ext_vector_type(2))) unsigned;
typedef __attribute__((ext_vector_type(2))) __bf16 v2bf;

constexpr int T_TOK = 49152, T_PROMPT = 16384, DM = 1024;
constexpr int NTHR = 256;
constexpr float LOG2E = 1.4426950408889634f;
constexpr float RMS_EPS = 1e-6f;

enum { PH_PREP = 0, PH_MLA_A, PH_MLA_B, PH_MLA_ATT, PH_MLA_O, PH_NA_QKV, PH_NA_ATT, PH_NA_O, PH_PEER_Q, PH_PEER_C, PH_FINAL };

struct PrepJob { const float* src; u16* dst; const float* gain; int K, N, tile0, scale_cols; float scale; int pad; };

struct Params {
  const float* xin0; const float* xin1;
  float* x; u16* xb;
  const float* norm_final;
  u16* wa_t[2]; u16* wuq_t[2]; u16* wukv_t[2]; u16* mla_wo_t[2];
  u16* na_wqkv_t[2]; u16* na_wo_t[2]; float* na_bias_s; float* na_rpb_s;
  u16* peer_wq_t[4]; u16* peer_sk; unsigned char* peer_u8; unsigned char* peer_v8;
  u16* cqkv; u16* q; u16* kv; u16* o; u16* qkv; u32* pkeys;
  unsigned char* q8; unsigned char* k8; unsigned char* kpe8; unsigned char* vT8;
  float* ropeC; float* ropeS; unsigned* bar;
  const float* in_sub_keys; const float* in_peer_u; const float* in_peer_v; const float* in_norm_ffn; const float* in_na_bias; const float* in_na_rpb;
  PrepJob jobs[24];
  double inv_freq[32];
  int njobs, ntiles_prep;
  int prog_type[48]; int prog_layer[48];
  int nprog, pad0;
};

typedef const __attribute__((address_space(4))) Params& KP;

__device__ __forceinline__ int crow(int r, int hi) { return (r & 3) + 8 * (r >> 2) + 4 * hi; }
__device__ __forceinline__ u32 cvtpk(float lo, float hi) { u32 r; asm("v_cvt_pk_bf16_f32 %0, %1, %2" : "=v"(r) : "v"(lo), "v"(hi)); return r; }
__device__ __forceinline__ float bf_lo(u32 v) { return __uint_as_float(v << 16); }
__device__ __forceinline__ float bf_hi(u32 v) { return __uint_as_float(v & 0xffff0000u); }
__device__ __forceinline__ int tok_pos(int t) { return t < T_PROMPT ? (t & 2047) : (t & 16383); }
__device__ __forceinline__ f32x16 mfma32(bf16x8 a, bf16x8 b, f32x16 c) { return __builtin_amdgcn_mfma_f32_32x32x16_bf16(a, b, c, 0, 0, 0); }
__device__ __forceinline__ float shx(float v, int m) { return __shfl_xor(v, m, 64); }

constexpr int BK = 64;
constexpr int OPB = 16384;
constexpr int GEMM_LDS = 4 * OPB;
constexpr int SMEM_BYTES = 81920;
constexpr int RSTD_OFF = 73728;

enum { EPI_A = 0, EPI_UQ, EPI_UK, EPI_UV, EPI_O, EPI_QKV, EPI_PEER };
constexpr float KEY_BIAS = 16.f;
constexpr float Q8_SCALE = 16.f, K8_SCALE = 4.f, V8_SCALE = 4.f, P8_SCALE = 128.f;
__device__ __forceinline__ u32 pack4_fp8(float a, float b, float c, float d) { int v = 0; v = __builtin_amdgcn_cvt_pk_fp8_f32(a, b, v, false); v = __builtin_amdgcn_cvt_pk_fp8_f32(c, d, v, true); return (u32)v; }

__device__ __forceinline__ float dot2bf(u32 a, u32 b, float c) { return __builtin_amdgcn_fdot2_f32_bf16(__builtin_bit_cast(v2bf, a), __builtin_bit_cast(v2bf, b), c, false); }

template <int EPI, bool NORM>
__device__ __forceinline__ void gemm_tile(KP p, int layer, const u16* Ap, int lda, const u16* Bt, int K, int m0, int n0, char* lds) {
  int tid_ = threadIdx.x; asm volatile("" : "+v"(tid_));
  const int tid = tid_, lane = tid & 63, w = tid >> 6;
  const int wm = w >> 1, wn = w & 1, r32 = lane & 31, hi = lane >> 5;
  float* rstd_l = (float*)(lds + RSTD_OFF);
  const int srow = w * 32 + (lane >> 2);
  const int scol = ((lane & 3) ^ ((lane >> 4) & 3)) * 8;
  const u16* Ag = Ap + (long)(m0 + srow) * lda + scol;
  const u16* Bg = Bt + (long)(n0 + srow) * K + scol;
#define GSTAGE(st, kt) do { _Pragma("unroll") for (int j = 0; j < 2; ++j) { \
    __builtin_amdgcn_global_load_lds((const unsigned*)(Ag + (long)j * 16 * lda + (kt) * 32), (unsigned*)(lds + (st) * 16384 + (w * 2 + j) * 1024), 16, 0, 0); \
    __builtin_amdgcn_global_load_lds((const unsigned*)(Bg + (long)j * 16 * K + (kt) * 32), (unsigned*)(lds + (st) * 16384 + 8192 + (w * 2 + j) * 1024), 16, 0, 0); } } while (0)
  f32x16 acc[2][2];
#pragma unroll
  for (int i = 0; i < 2; ++i)
#pragma unroll
    for (int j = 0; j < 2; ++j)
#pragma unroll
      for (int r = 0; r < 16; ++r) acc[i][j][r] = 0.f;
  float ssq0 = 0.f, ssq1 = 0.f;
  bf16x8 skr[8];
  const int sw = (r32 >> 2) & 3;
  const int arow = (wm * 64 + r32) * 64, brow = 8192 + (wn * 64 + r32) * 64;
  const int co0 = ((0 + hi) ^ sw) << 4, co1 = ((2 + hi) ^ sw) << 4;
  const int nk = K / 32;

#ifndef KREP
#define KREP 1
#endif
  for (int rep_ = 0; rep_ < KREP; ++rep_) {
  if (KREP > 1) {
#pragma unroll
    for (int i = 0; i < 2; ++i)
#pragma unroll
      for (int j = 0; j < 2; ++j)
#pragma unroll
        for (int r = 0; r < 16; ++r) acc[i][j][r] = 0.f;
    ssq0 = 0.f; ssq1 = 0.f; }
  __syncthreads();
  GSTAGE(0, 0); GSTAGE(1, 1); GSTAGE(2, 2);
  if constexpr (EPI == EPI_PEER) {
    const u16* sk = p.peer_sk + ((long)layer * 16 + (n0 >> 7)) * 16384;
#pragma unroll
    for (int i = 0; i < 8; ++i) { const int c = tid + 256 * i; skr[i] = *(const bf16x8*)(sk + (c >> 4) * 128 + (c & 15) * 8); }
  }
  for (int kt = 0; kt < nk; ++kt) {
    if (kt + 2 < nk) asm volatile("s_waitcnt vmcnt(8)" ::: "memory");
    else if (kt + 1 < nk) asm volatile("s_waitcnt vmcnt(4)" ::: "memory");
    else asm volatile("s_waitcnt vmcnt(0)" ::: "memory");
    asm volatile("s_waitcnt lgkmcnt(0)" ::: "memory");
    __builtin_amdgcn_s_barrier();
    if (kt + 3 < nk) GSTAGE((kt + 3) & 3, kt + 3);
    const char* base = lds + (kt & 3) * 16384;
    {
      const bf16x8 a0 = *(const bf16x8*)(base + arow + co0), a1 = *(const bf16x8*)(base + arow + 32 * 64 + co0);
      const bf16x8 b0 = *(const bf16x8*)(base + brow + co0), b1 = *(const bf16x8*)(base + brow + 32 * 64 + co0);
      const bf16x8 c0 = *(const bf16x8*)(base + arow + co1), c1 = *(const bf16x8*)(base + arow + 32 * 64 + co1);
      const bf16x8 d0 = *(const bf16x8*)(base + brow + co1), d1 = *(const bf16x8*)(base + brow + 32 * 64 + co1);
      if constexpr (EPI != EPI_UV) {
        acc[0][0] = mfma32(b0, a0, acc[0][0]); acc[0][1] = mfma32(b1, a0, acc[0][1]);
        acc[1][0] = mfma32(b0, a1, acc[1][0]); acc[1][1] = mfma32(b1, a1, acc[1][1]);
        acc[0][0] = mfma32(d0, c0, acc[0][0]); acc[0][1] = mfma32(d1, c0, acc[0][1]);
        acc[1][0] = mfma32(d0, c1, acc[1][0]); acc[1][1] = mfma32(d1, c1, acc[1][1]);
      } else {
        acc[0][0] = mfma32(a0, b0, acc[0][0]); acc[0][1] = mfma32(a0, b1, acc[0][1]);
        acc[1][0] = mfma32(a1, b0, acc[1][0]); acc[1][1] = mfma32(a1, b1, acc[1][1]);
        acc[0][0] = mfma32(c0, d0, acc[0][0]); acc[0][1] = mfma32(c0, d1, acc[0][1]);
        acc[1][0] = mfma32(c1, d0, acc[1][0]); acc[1][1] = mfma32(c1, d1, acc[1][1]);
      }
      if constexpr (NORM) {
        const u32x4 x0 = __builtin_bit_cast(u32x4, a0), x1 = __builtin_bit_cast(u32x4, a1), y0 = __builtin_bit_cast(u32x4, c0), y1 = __builtin_bit_cast(u32x4, c1);
#pragma unroll
        for (int q = 0; q < 4; ++q) { ssq0 = dot2bf(x0[q], x0[q], ssq0); ssq1 = dot2bf(x1[q], x1[q], ssq1); ssq0 = dot2bf(y0[q], y0[q], ssq0); ssq1 = dot2bf(y1[q], y1[q], ssq1); }
      }
    }
  }
  }
#undef GSTAGE
  __syncthreads();
  float rs[2] = {1.f, 1.f};
  if constexpr (NORM) {
    ssq0 += shx(ssq0, 32); ssq1 += shx(ssq1, 32);
    rs[0] = rsqrtf(ssq0 / (float)K + RMS_EPS); rs[1] = rsqrtf(ssq1 / (float)K + RMS_EPS);
  }
  const int rowb = wm * 64, colb = wn * 64;
  if constexpr (EPI == EPI_A || EPI == EPI_QKV) {
    constexpr int OROW = 272;
    u16* outp; int ldo; bool rope = false;
    if constexpr (EPI == EPI_A) { outp = p.cqkv; ldo = 768; rope = (n0 + colb == 640); }
    else { outp = p.qkv; ldo = 3072; }
#pragma unroll
    for (int mi = 0; mi < 2; ++mi) {
      const int rl = rowb + mi * 32 + r32; const int pos = tok_pos(m0 + rl);
#pragma unroll
      for (int g = 0; g < 4; ++g) {
        f32x4 v0, v1;
#pragma unroll
        for (int e = 0; e < 4; ++e) { v0[e] = acc[mi][0][4 * g + e] * rs[mi]; v1[e] = acc[mi][1][4 * g + e] * rs[mi]; }
        if constexpr (EPI == EPI_QKV) {
          const f32x4 b0 = *(const f32x4*)(p.na_bias_s + layer * 3072 + n0 + colb + 8 * g + 4 * hi), b1 = *(const f32x4*)(p.na_bias_s + layer * 3072 + n0 + colb + 32 + 8 * g + 4 * hi);
          v0 += b0; v1 += b1;
        }
        if (rope) {
          const f32x4 c = *(const f32x4*)(p.ropeC + pos * 32 + 8 * g + 4 * hi), sn = *(const f32x4*)(p.ropeS + pos * 32 + 8 * g + 4 * hi);
          const f32x4 t0 = (v0 * c - v1 * sn) * K8_SCALE, t1 = (v0 * sn + v1 * c) * K8_SCALE;
          unsigned char* kp_ = p.k8 + (long)(m0 + rl) * 1088 + 1024 + 8 * g + 4 * hi;
          *(u32*)kp_ = pack4_fp8(t0[0], t0[1], t0[2], t0[3]); *(u32*)(kp_ + 32) = pack4_fp8(t1[0], t1[1], t1[2], t1[3]);
        }
        char* e_ = lds + rl * OROW + (colb + 8 * g + 4 * hi) * 2;
        *(u32x2*)e_ = (u32x2){cvtpk(v0[0], v0[1]), cvtpk(v0[2], v0[3])};
        *(u32x2*)(e_ + 64) = (u32x2){cvtpk(v1[0], v1[1]), cvtpk(v1[2], v1[3])};
      }
    }
    __syncthreads();
#pragma unroll
    for (int i = 0; i < 8; ++i) { const int c = tid + 256 * i, row = c >> 4, ch = c & 15;
      *(u32x4*)(outp + (long)(m0 + row) * ldo + n0 + ch * 8) = *(const u32x4*)(lds + row * OROW + ch * 16); }
  } else if constexpr (EPI == EPI_UQ || EPI == EPI_UK) {
    constexpr int BROW = 144;
    const bool rope = (EPI == EPI_UQ) && ((n0 + colb) % 192 == 128);
    const float sc = (EPI == EPI_UQ) ? Q8_SCALE : K8_SCALE;
#pragma unroll
    for (int mi = 0; mi < 2; ++mi) {
      const int rl = rowb + mi * 32 + r32; const int pos = tok_pos(m0 + rl);
#pragma unroll
      for (int g = 0; g < 4; ++g) {
        f32x4 v0, v1;
#pragma unroll
        for (int e = 0; e < 4; ++e) { v0[e] = acc[mi][0][4 * g + e] * rs[mi] * sc; v1[e] = acc[mi][1][4 * g + e] * rs[mi] * sc; }
        if (rope) {
          const f32x4 c = *(const f32x4*)(p.ropeC + pos * 32 + 8 * g + 4 * hi), sn = *(const f32x4*)(p.ropeS + pos * 32 + 8 * g + 4 * hi);
          const f32x4 t0 = v0 * c - v1 * sn, t1 = v0 * sn + v1 * c; v0 = t0; v1 = t1;
        }
        char* e_ = lds + rl * BROW + (colb + 8 * g + 4 * hi);
        *(u32*)e_ = pack4_fp8(v0[0], v0[1], v0[2], v0[3]); *(u32*)(e_ + 32) = pack4_fp8(v1[0], v1[1], v1[2], v1[3]);
      }
    }
    __syncthreads();
    unsigned char* outb; long ldo;
    if constexpr (EPI == EPI_UQ) { outb = p.q8 + n0; ldo = 1536; } else { outb = p.k8 + (n0 >> 8) * 128; ldo = 1088; }
#pragma unroll
    for (int i = 0; i < 4; ++i) { const int c = tid + 256 * i, row = c >> 3, ch = c & 7;
      *(u32x4*)(outb + (long)(m0 + row) * ldo + ch * 16) = *(const u32x4*)(lds + row * BROW + ch * 16); }
  } else if constexpr (EPI == EPI_UV) {
    constexpr int BROW = 144;
#pragma unroll
    for (int mi = 0; mi < 2; ++mi) {
#pragma unroll
      for (int g = 0; g < 4; ++g) {
        float rr[4];
#pragma unroll
        for (int e = 0; e < 4; ++e) rr[e] = __int_as_float(__builtin_amdgcn_ds_bpermute((8 * g + 4 * hi + e) << 2, __float_as_int(rs[mi]))) * V8_SCALE;
#pragma unroll
        for (int ni = 0; ni < 2; ++ni) {
          char* e_ = lds + (colb + ni * 32 + r32) * BROW + rowb + mi * 32 + 8 * g + 4 * hi;
          *(u32*)e_ = pack4_fp8(acc[mi][ni][4 * g] * rr[0], acc[mi][ni][4 * g + 1] * rr[1], acc[mi][ni][4 * g + 2] * rr[2], acc[mi][ni][4 * g + 3] * rr[3]);
        }
      }
    }
    __syncthreads();
    unsigned char* outb = p.vT8 + (long)((n0 >> 8) * 128) * T_TOK + m0;
#pragma unroll
    for (int i = 0; i < 4; ++i) { const int c = tid + 256 * i, d = c >> 3, ch = c & 7;
      *(u32x4*)(outb + (long)d * T_TOK + ch * 16) = *(const u32x4*)(lds + d * BROW + ch * 16); }
  } else if constexpr (EPI == EPI_O) {
    constexpr int FROW = 528;
#pragma unroll
    for (int mi = 0; mi < 2; ++mi) {
      const int rl = rowb + mi * 32 + r32;
#pragma unroll
      for (int ni = 0; ni < 2; ++ni)
#pragma unroll
        for (int g = 0; g < 4; ++g)
          *(f32x4*)(lds + rl * FROW + (colb + ni * 32 + 8 * g + 4 * hi) * 4) = (f32x4){acc[mi][ni][4 * g], acc[mi][ni][4 * g + 1], acc[mi][ni][4 * g + 2], acc[mi][ni][4 * g + 3]};
    }
    __syncthreads();
#pragma unroll 4
    for (int i = 0; i < 16; ++i) { const int c = tid + 256 * i, row = c >> 5, ch = c & 31;
      const f32x4 a = *(const f32x4*)(lds + row * FROW + ch * 16);
      float* xp = p.x + (long)(m0 + row) * DM + n0 + ch * 4;
      const float* xsrc = xp;
      if (layer < 0) xsrc = (m0 < T_PROMPT ? p.xin0 + (long)(m0 + row) * DM : p.xin1 + (long)(m0 + row - T_PROMPT) * DM) + n0 + ch * 4;
      f32x4 xv = *(const f32x4*)xsrc; xv += a; *(f32x4*)xp = xv;
      *(u32x2*)(p.xb + (long)(m0 + row) * DM + n0 + ch * 4) = (u32x2){cvtpk(xv[0], xv[1]), cvtpk(xv[2], xv[3])}; }
  } else {
    constexpr int QROW = 272;
    char* Qs = lds; char* Ss = lds + 128 * QROW;
    const int hp = n0 >> 7;
#pragma unroll
    for (int mi = 0; mi < 2; ++mi) {
      const int rl = rowb + mi * 32 + r32;
#pragma unroll
      for (int g = 0; g < 4; ++g) {
        char* e_ = Qs + rl * QROW + (colb + 8 * g + 4 * hi) * 2;
        *(u32x2*)e_ = (u32x2){cvtpk(acc[mi][0][4 * g] * rs[mi], acc[mi][0][4 * g + 1] * rs[mi]), cvtpk(acc[mi][0][4 * g + 2] * rs[mi], acc[mi][0][4 * g + 3] * rs[mi])};
        *(u32x2*)(e_ + 64) = (u32x2){cvtpk(acc[mi][1][4 * g] * rs[mi], acc[mi][1][4 * g + 1] * rs[mi]), cvtpk(acc[mi][1][4 * g + 2] * rs[mi], acc[mi][1][4 * g + 3] * rs[mi])};
      }
    }
#pragma unroll
    for (int i = 0; i < 8; ++i) { const int c = tid + 256 * i, kr = c >> 4, ch = c & 15; *(bf16x8*)(Ss + kr * QROW + ch * 16) = skr[i]; }
    __syncthreads();
    f32x16 a2[2][2];
#pragma unroll
    for (int i = 0; i < 2; ++i)
#pragma unroll
      for (int j = 0; j < 2; ++j)
#pragma unroll
        for (int r = 0; r < 16; ++r) a2[i][j][r] = 0.f;
    { const char* Ar = Qs + (rowb + r32) * QROW + hi * 16; const char* Br = Ss + (colb + r32) * QROW + hi * 16;
#pragma unroll
      for (int ks = 0; ks < 8; ++ks) {
        bf16x8 a0 = *(const bf16x8*)(Ar + ks * 32), a1 = *(const bf16x8*)(Ar + 32 * QROW + ks * 32);
        bf16x8 b0 = *(const bf16x8*)(Br + ks * 32), b1 = *(const bf16x8*)(Br + 32 * QROW + ks * 32);
        a2[0][0] = mfma32(b0, a0, a2[0][0]); a2[0][1] = mfma32(b1, a0, a2[0][1]);
        a2[1][0] = mfma32(b0, a1, a2[1][0]); a2[1][1] = mfma32(b1, a1, a2[1][1]);
      } }
    __syncthreads();
    constexpr int SROW = 544;
    char* Sc = lds;
#pragma unroll
    for (int mi = 0; mi < 2; ++mi) {
      const int rl = rowb + mi * 32 + r32;
#pragma unroll
      for (int ni = 0; ni < 2; ++ni)
#pragma unroll
        for (int g = 0; g < 4; ++g)
          *(f32x4*)(Sc + rl * SROW + (colb + ni * 32 + 8 * g + 4 * hi) * 4) = (f32x4){a2[mi][ni][4 * g], a2[mi][ni][4 * g + 1], a2[mi][ni][4 * g + 2], a2[mi][ni][4 * g + 3]};
    }
    __syncthreads();
    { const int row = tid >> 1, hf = tid & 1;
      u32 kv[64];
#pragma unroll
      for (int i = 0; i < 16; ++i) {
        const f32x4 v = *(const f32x4*)(Sc + row * SROW + (2 * i + hf) * 16);
#pragma unroll
        for (int e = 0; e < 4; ++e) { const u32 b = __float_as_uint(v[e] + KEY_BIAS);
          kv[i * 4 + e] = (b & ~127u) | (u32)((2 * i + hf) * 4 + e); }
      }
      u32 mprev = 0xffffffffu;
      u32* outk = p.pkeys + (long)(m0 + row) * 256 + hp * 16;
#pragma unroll 1
      for (int ps = 0; ps < 16; ++ps) {
        u32 best = 0;
#pragma unroll
        for (int i = 0; i < 64; ++i) { const u32 d = kv[i] - mprev; best = d > best ? d : best; }
        u32 cand = mprev + best;
        if (best < (0u - mprev)) cand = 0u;
        const u32 oth = (u32)__shfl_xor((int)cand, 1, 64);
        mprev = cand > oth ? cand : oth;
        if (hf == 0) outk[ps] = mprev;
      }
    }
  }
}

template <int OFF> __device__ __forceinline__ s16x4 tr_read(int vb) {
  s16x4 r; asm volatile("ds_read_b64_tr_b16 %0, %1 offset:%2" : "=&v"(r) : "v"(vb), "i"(OFF) : "memory"); return r;
}
__device__ __forceinline__ int v_st(int k, int c) { const int kk = (k & ~0xC) | ((k & 4) << 1) | ((k & 8) >> 1); return ((kk >> 3) * 4 + (c >> 5)) * 512 + ((kk & 7) * 32 + (c & 31)) * 2; }
__device__ __forceinline__ int v_rd_base(int lane) { return ((lane & 3) << 3) | (((lane >> 2) & 3) << 6) | (((lane >> 4) & 1) << 5) | (((lane >> 5) & 1) << 8); }
constexpr int v_rd_off(int d0, int ks, int half) { return d0 * 512 + ks * 4096 + half * 2048; }
template <int D0> __device__ __forceinline__ void pv_one(f32x16& od, int vb, bf16x8 pa0, bf16x8 pa1, bf16x8 pa2, bf16x8 pa3) {
  const s16x4 l0 = tr_read<v_rd_off(D0, 0, 0)>(vb), h0 = tr_read<v_rd_off(D0, 0, 1)>(vb), l1 = tr_read<v_rd_off(D0, 1, 0)>(vb), h1 = tr_read<v_rd_off(D0, 1, 1)>(vb);
  const s16x4 l2 = tr_read<v_rd_off(D0, 2, 0)>(vb), h2 = tr_read<v_rd_off(D0, 2, 1)>(vb), l3 = tr_read<v_rd_off(D0, 3, 0)>(vb), h3 = tr_read<v_rd_off(D0, 3, 1)>(vb);
  asm volatile("s_waitcnt lgkmcnt(0)" ::: "memory"); __builtin_amdgcn_sched_barrier(0);
#define PKV(L, H) (bf16x8){L[0], L[1], L[2], L[3], H[0], H[1], H[2], H[3]}
  od = mfma32(pa0, PKV(l0, h0), od); od = mfma32(pa1, PKV(l1, h1), od); od = mfma32(pa2, PKV(l2, h2), od); od = mfma32(pa3, PKV(l3, h3), od);
#undef PKV
}

constexpr float THR_L2 = 11.5f;

__device__ __forceinline__ void partialSM(f32x16& p0, f32x16& p1, float& m_reg, float& alpha) {
  float pmax = p0[0];
#pragma unroll
  for (int r = 1; r < 16; ++r) pmax = fmaxf(pmax, p0[r]);
#pragma unroll
  for (int r = 0; r < 16; ++r) pmax = fmaxf(pmax, p1[r]);
  { auto rr = __builtin_amdgcn_permlane32_swap(__float_as_uint(pmax), __float_as_uint(pmax), false, false);
    pmax = fmaxf(__uint_as_float(rr[0]), __uint_as_float(rr[1])); }
  float mn;
  if (__all(pmax - m_reg <= THR_L2)) { mn = m_reg; alpha = 1.f; }
  else { mn = fmaxf(m_reg, pmax); alpha = __builtin_amdgcn_exp2f(m_reg - mn); m_reg = mn; }
#pragma unroll
  for (int r = 0; r < 16; ++r) { p0[r] = __builtin_amdgcn_exp2f(p0[r] - mn); p1[r] = __builtin_amdgcn_exp2f(p1[r] - mn); }
}
__device__ __forceinline__ void finishSM(f32x16& p0, f32x16& p1, float alpha, float& l_reg, bf16x8& pa0, bf16x8& pa1, bf16x8& pa2, bf16x8& pa3) {
  float ps = 0.f;
#pragma unroll
  for (int r = 0; r < 16; ++r) ps += p0[r];
#pragma unroll
  for (int r = 0; r < 16; ++r) ps += p1[r];
  { auto rr = __builtin_amdgcn_permlane32_swap(__float_as_uint(ps), __float_as_uint(ps), false, false);
    ps = __uint_as_float(rr[0]) + __uint_as_float(rr[1]); }
  l_reg = l_reg * alpha + ps;
#define PK4(P, BASE, OUT) do { unsigned a0 = cvtpk(P[BASE + 0], P[BASE + 1]), a1 = cvtpk(P[BASE + 2], P[BASE + 3]);   \
    unsigned b0 = cvtpk(P[BASE + 4], P[BASE + 5]), b1 = cvtpk(P[BASE + 6], P[BASE + 7]);                              \
    auto r0 = __builtin_amdgcn_permlane32_swap(a0, b0, false, false); auto r1 = __builtin_amdgcn_permlane32_swap(a1, b1, false, false); \
    u32x4 w_ = {r0[0], r1[0], r0[1], r1[1]}; OUT = __builtin_bit_cast(bf16x8, w_); } while (0)
  PK4(p0, 0, pa0); PK4(p0, 8, pa1); PK4(p1, 0, pa2); PK4(p1, 8, pa3);
#undef PK4
}

constexpr int ATT_K_OFF = 0, ATT_V_OFF = 25600, ATT_WS_OFF = 41984, ATT_RPB_OFF = 43008;

template <int MODE>
__device__ __forceinline__ void attn_item(KP p, int layer, int item, char* lds) {
  constexpr int KST = MODE == 0 ? 12 : 4;
  constexpr int KROW = MODE == 0 ? 400 : 272;
  constexpr int ND0 = MODE == 0 ? 4 : 2;
  int tid_ = threadIdx.x; asm volatile("" : "+v"(tid_));
  const int tid = tid_, lane = tid & 63, w = tid >> 6, r32 = lane & 31, hi = lane >> 5;
  char* Kl = lds + ATT_K_OFF; char* Vl = lds + ATT_V_OFF;
  float* wsl = (float*)(lds + ATT_WS_OFF) + w * 64; float* al_l = wsl; float* li_l = wsl + 32;
  float* rpbl = (float*)(lds + ATT_RPB_OFF);

  int NT, qtok, ktok0, head, kcolB = 0; long obase;
  int na_c = 0, na_c0 = 0, na_relrow0 = 0, na_hl = 0;
  const u16* Qp;
  if constexpr (MODE == 0) {
    int seq, qb;
    if (item < 2048) { const int sh = item >> 7; seq = 8 + (sh >> 3); head = sh & 7; qb = item & 127; ktok0 = T_PROMPT + (seq - 8) * 16384; NT = 256; }
    else { const int it = item - 2048; const int sh = it >> 4; seq = sh >> 3; head = sh & 7; qb = it & 15; ktok0 = seq * 2048; NT = 32; }
    qtok = ktok0 + qb * 128 + w * 32 + r32;
    Qp = p.q + (long)qtok * 1536 + head * 192 + hi * 8;
    obase = (long)(ktok0 + qb * 128 + w * 32) * 1024 + head * 128;
  } else {
    const int Rg = item >> 3, hpair = item & 7;
    int grow0, r, rows;
    if (Rg < 256) { grow0 = (Rg >> 5) << 5; r = Rg & 31; rows = 32; } else { grow0 = 256 + (((Rg - 256) >> 8) << 8); r = (Rg - 256) & 255; rows = 256; }
    int r0 = r - 4; r0 = r0 < 0 ? 0 : r0; r0 = r0 > rows - 8 ? rows - 8 : r0;
    ktok0 = (grow0 + r0) * 64; NT = 8;
    na_hl = w >> 1; head = hpair * 2 + na_hl;
    na_c = (w & 1) * 32 + r32; na_c0 = na_c - 8; na_c0 = na_c0 < 0 ? 0 : na_c0; na_c0 = na_c0 > 48 ? 48 : na_c0;
    na_relrow0 = r0 - r + 7;
    qtok = Rg * 64 + na_c;
    Qp = p.qkv + (long)qtok * 3072 + head * 64 + hi * 8;
    obase = (long)(Rg * 64 + (w & 1) * 32) * 1024 + head * 64;
    kcolB = na_hl * 128;
    __syncthreads();
    { const float* src = p.na_rpb_s + ((long)layer * 16 + hpair * 2) * 465;
      for (int e = tid; e < 930; e += 256) rpbl[e] = src[e]; }
  }
  bf16x8 qr[KST];
#pragma unroll
  for (int d = 0; d < KST; ++d) qr[d] = *(const bf16x8*)(Qp + d * 16);

  bf16x8 sk[MODE == 0 ? 6 : 4], sv[4];
  const int s_key = tid >> 4, s_ch = tid & 15;
  const int s_key8 = tid >> 3, s_ch8 = tid & 7;
#define ALOAD(j) do { const long kt_ = (long)ktok0 + (j) * 64; \
    if constexpr (MODE == 0) { \
      _Pragma("unroll") for (int i = 0; i < 4; ++i) { const u16* b_ = p.kv + (kt_ + s_key + 16 * i) * 2048 + head * 256 + s_ch * 8; sk[i] = *(const bf16x8*)b_; sv[i] = *(const bf16x8*)(b_ + 128); } \
      _Pragma("unroll") for (int i = 0; i < 2; ++i) sk[4 + i] = *(const bf16x8*)(p.cqkv + (kt_ + s_key8 + 32 * i) * 768 + 640 + s_ch8 * 8); \
    } else { \
      _Pragma("unroll") for (int i = 0; i < 4; ++i) { const u16* b_ = p.qkv + (kt_ + s_key + 16 * i) * 3072 + 1024 + (head & ~1) * 64 + s_ch * 8; sk[i] = *(const bf16x8*)b_; sv[i] = *(const bf16x8*)(b_ + 1024); } \
    } } while (0)
#define AWRITE() do { \
    _Pragma("unroll") for (int i = 0; i < 4; ++i) { *(bf16x8*)(Kl + (s_key + 16 * i) * KROW + s_ch * 16) = sk[i]; *(bf16x8*)(Vl + v_st(s_key + 16 * i, s_ch * 8)) = sv[i]; } \
    if constexpr (MODE == 0) { _Pragma("unroll") for (int i = 0; i < 2; ++i) *(bf16x8*)(Kl + (s_key8 + 32 * i) * KROW + 256 + s_ch8 * 16) = sk[4 + i]; } } while (0)

  float m_reg = -1e30f, l_reg = 0.f;
  f32x16 o[ND0];
#pragma unroll
  for (int d = 0; d < ND0; ++d)
#pragma unroll
    for (int r = 0; r < 16; ++r) o[d][r] = 0.f;
  const int vb0 = (int)(uintptr_t)Vl + v_rd_base(lane) + (MODE == 1 ? na_hl * 1024 : 0);

  ALOAD(0);
  for (int j = 0; j < NT; ++j) {
    __syncthreads();
    AWRITE();
    __syncthreads();
    if (j + 1 < NT) ALOAD(j + 1);
    f32x16 p0, p1;
#pragma unroll
    for (int r = 0; r < 16; ++r) { p0[r] = 0.f; p1[r] = 0.f; }
#pragma unroll
    for (int d = 0; d < KST; ++d) {
      const int cb = kcolB + (d * 16 + hi * 8) * 2;
      bf16x8 b0 = *(const bf16x8*)(Kl + r32 * KROW + cb), b1 = *(const bf16x8*)(Kl + (32 + r32) * KROW + cb);
      p0 = mfma32(b0, qr[d], p0); p1 = mfma32(b1, qr[d], p1);
    }
    if constexpr (MODE == 1) {
      const float* rb = rpbl + (na_hl * 15 + na_relrow0 + j) * 31;
#pragma unroll
      for (int r = 0; r < 16; ++r) {
        const int kc0 = crow(r, hi), kc1 = 32 + kc0;
        int i0 = kc0 - na_c + 15, i1 = kc1 - na_c + 15;
        i0 = i0 < 0 ? 0 : (i0 > 30 ? 30 : i0); i1 = i1 < 0 ? 0 : (i1 > 30 ? 30 : i1);
        const float b0 = rb[i0], b1 = rb[i1];
        p0[r] = ((unsigned)(kc0 - na_c0) < 16u) ? p0[r] + b0 : -1e30f;
        p1[r] = ((unsigned)(kc1 - na_c0) < 16u) ? p1[r] + b1 : -1e30f;
      }
    }
    float alpha;
    partialSM(p0, p1, m_reg, alpha);
    if (__any(alpha < 1.f)) {
      if (hi == 0) al_l[r32] = alpha;
      __builtin_amdgcn_wave_barrier();
#pragma unroll
      for (int r = 0; r < 16; ++r) { const float a = al_l[crow(r, hi)];
#pragma unroll
        for (int d = 0; d < ND0; ++d) o[d][r] *= a; }
      __builtin_amdgcn_wave_barrier();
    }
    bf16x8 pa0, pa1, pa2, pa3;
    finishSM(p0, p1, alpha, l_reg, pa0, pa1, pa2, pa3);
    pv_one<0>(o[0], vb0, pa0, pa1, pa2, pa3); pv_one<1>(o[1], vb0, pa0, pa1, pa2, pa3);
    if constexpr (MODE == 0) { pv_one<2>(o[2], vb0, pa0, pa1, pa2, pa3); pv_one<3>(o[3], vb0, pa0, pa1, pa2, pa3); }
  }
#undef ALOAD
#undef AWRITE
  if (hi == 0) li_l[r32] = l_reg;
  __builtin_amdgcn_wave_barrier();
#pragma unroll
  for (int r = 0; r < 16; ++r) {
    const int qrow = crow(r, hi); const float rl = 1.f / li_l[qrow];
    u16* o_ = p.o + obase + (long)qrow * 1024 + r32;
#pragma unroll
    for (int d = 0; d < ND0; ++d) o_[d * 32] = (u16)(cvtpk(o[d][r] * rl, 0.f) & 0xffffu);
  }
  __builtin_amdgcn_wave_barrier();
}

__device__ __forceinline__ float lane_bcast(float v, int src_lane) { return __int_as_float(__builtin_amdgcn_ds_bpermute(src_lane << 2, __float_as_int(v))); }
__device__ __forceinline__ float rowmax32(const f32x16& p0, const f32x16& p1) {
  float pmax = p0[0];
#pragma unroll
  for (int r = 1; r < 16; ++r) pmax = fmaxf(pmax, p0[r]);
#pragma unroll
  for (int r = 0; r < 16; ++r) pmax = fmaxf(pmax, p1[r]);
  auto rr = __builtin_amdgcn_permlane32_swap(__float_as_uint(pmax), __float_as_uint(pmax), false, false);
  return fmaxf(__uint_as_float(rr[0]), __uint_as_float(rr[1]));
}

typedef __attribute__((ext_vector_type(8))) int i32x8;
#define MFMA8(A, B, C, SA, SB_) __builtin_amdgcn_mfma_scale_f32_32x32x64_f8f6f4(A, B, C, 0, 0, 0, SA, 0, SB_)
constexpr int SC_K = 0x7D7D7D7D, SC_Q = 0x7B7B7B7B, SC_P = 0x7F7F7F7F, SC_V = 0x7D7D7D7D;
constexpr float THR8_L2 = 1.5f;

__device__ __forceinline__ void attn_mla(KP p, int item, char* lds) {
  constexpr int KSTAGE = 64 * 192, VSTAGE = 128 * 64, VOFF = 2 * KSTAGE;
  int tid_ = threadIdx.x; asm volatile("" : "+v"(tid_));
  const int tid = tid_, lane = tid & 63, w = tid >> 6, r32 = lane & 31, hi = lane >> 5;
  int NT, ktok0, head, seq, qb;
  if (item < 2048) { const int sh = item >> 7; seq = 8 + (sh >> 3); head = sh & 7; qb = item & 127; ktok0 = T_PROMPT + (seq - 8) * 16384; NT = 256; }
  else { const int it = item - 2048; const int sh = it >> 4; seq = sh >> 3; head = sh & 7; qb = it & 15; ktok0 = seq * 2048; NT = 32; }
  const int qtok = ktok0 + qb * 128 + w * 32 + r32;
  const long obase = (long)(ktok0 + qb * 128 + w * 32) * 1024 + head * 128;
  i32x8 qf[3];
  { const unsigned char* Qp = p.q8 + (long)qtok * 1536 + head * 192 + hi * 32;
#pragma unroll
    for (int s3 = 0; s3 < 3; ++s3) { const u32x4 a = *(const u32x4*)(Qp + s3 * 64), b = *(const u32x4*)(Qp + s3 * 64 + 16);
      qf[s3] = (i32x8){(int)a[0], (int)a[1], (int)a[2], (int)a[3], (int)b[0], (int)b[1], (int)b[2], (int)b[3]}; } }
  unsigned ko[3], vo[2];
#pragma unroll
  for (int i = 0; i < 3; ++i) {
    const int g = (w * 3 + i) * 64 + lane, key = g / 12, pc = g - key * 12, c = pc ^ ((key >> 2) & 3);
    ko[i] = (c < 8) ? (unsigned)(key * 1088 + head * 128 + c * 16) : (unsigned)(key * 1088 + 1024 + (c - 8) * 16);
  }
#pragma unroll
  for (int i = 0; i < 2; ++i) {
    const int g = (w * 2 + i) * 64 + lane, d = g >> 2, pc = g & 3, c = pc ^ ((d >> 2) & 3);
    vo[i] = (unsigned)(d * T_TOK + c * 16);
  }
  const unsigned char* k8b = p.k8 + (long)ktok0 * 1088;
  const unsigned char* vtb = p.vT8 + (long)head * 128 * T_TOK + ktok0;
#define GLK(st, jt) do { const unsigned char* kt_ = k8b + (long)(jt) * (64 * 1088); int w_ = w; asm volatile("" : "+v"(w_)); \
    _Pragma("unroll") for (int i = 0; i < 3; ++i) { unsigned k_ = ko[i]; asm volatile("" : "+v"(k_)); \
    __builtin_amdgcn_global_load_lds((const unsigned*)(kt_ + k_), (unsigned*)(lds + (st) * KSTAGE + (w_ * 3 + i) * 1024), 16, 0, 0); } } while (0)
#define GLV(st, jt) do { const unsigned char* vt_ = vtb + (long)(jt) * 64; int w_ = w; asm volatile("" : "+v"(w_)); \
    _Pragma("unroll") for (int i = 0; i < 2; ++i) { unsigned v_ = vo[i]; asm volatile("" : "+v"(v_)); \
    __builtin_amdgcn_global_load_lds((const unsigned*)(vt_ + v_), (unsigned*)(lds + VOFF + (st) * VSTAGE + (w_ * 2 + i) * 1024), 16, 0, 0); } } while (0)
#define QK8(P0, P1, st) do { const int r_ = r32, h_ = hi, sw_ = (r_ >> 2) & 3; const char* Kr_ = lds + (st) * KSTAGE + r_ * 192; \
    const f32x16 z_ = {0.f, 0.f, 0.f, 0.f, 0.f, 0.f, 0.f, 0.f, 0.f, 0.f, 0.f, 0.f, 0.f, 0.f, 0.f, 0.f}; \
    _Pragma("unroll") for (int s3 = 0; s3 < 3; ++s3) { const int c0_ = ((s3 * 4 + h_ * 2) ^ sw_) << 4, c1_ = ((s3 * 4 + h_ * 2 + 1) ^ sw_) << 4; \
      const u32x4 a0_ = *(const u32x4*)(Kr_ + c0_), a1_ = *(const u32x4*)(Kr_ + c1_), b0_ = *(const u32x4*)(Kr_ + 32 * 192 + c0_), b1_ = *(const u32x4*)(Kr_ + 32 * 192 + c1_); \
      const i32x8 ka_ = {(int)a0_[0], (int)a0_[1], (int)a0_[2], (int)a0_[3], (int)a1_[0], (int)a1_[1], (int)a1_[2], (int)a1_[3]}; \
      const i32x8 kb_ = {(int)b0_[0], (int)b0_[1], (int)b0_[2], (int)b0_[3], (int)b1_[0], (int)b1_[1], (int)b1_[2], (int)b1_[3]}; \
      P0 = MFMA8(ka_, qf[s3], (s3 == 0 ? z_ : P0), SC_K, SC_Q); P1 = MFMA8(kb_, qf[s3], (s3 == 0 ? z_ : P1), SC_K, SC_Q); } } while (0)
#define PZERO(P0, P1) do { _Pragma("unroll") for (int r = 0; r < 16; ++r) { P0[r] = 0.f; P1[r] = 0.f; } } while (0)
#define EXPC(P, mn, R0, R1) do { _Pragma("unroll") for (int r = (R0); r < (R1); ++r) P[r] = __builtin_amdgcn_exp2f(P[r] - (mn)); } while (0)
#define SB() do {} while (0)

  float m_reg = -1e30f, l_reg = 0.f;
  f32x16 o[4];
#pragma unroll
  for (int d = 0; d < 4; ++d)
#pragma unroll
    for (int r = 0; r < 16; ++r) o[d][r] = 0.f;
  f32x16 pA0, pA1, pB0, pB1; float pmaxA, pmaxB;

  __syncthreads();
  GLK(0, 0); GLV(0, 0); GLK(1, 1);
  asm volatile("s_waitcnt vmcnt(0)" ::: "memory");
  __syncthreads();
  QK8(pA0, pA1, 0); pmaxA = rowmax32(pA0, pA1);

#define STEP(j, PX0, PX1, PMX, PY0, PY1, PMY, LAST) do { \
    asm volatile("s_waitcnt lgkmcnt(0)" ::: "memory"); __builtin_amdgcn_s_barrier(); \
    if ((j) + 2 < NT) GLK((j) & 1, (j) + 2); \
    if (!(LAST)) GLV(((j) + 1) & 1, (j) + 1); \
    const bool keep_ = __all(PMX - m_reg <= THR8_L2); \
    const float mn_ = keep_ ? m_reg : fmaxf(m_reg, PMX); \
    const float alpha_ = keep_ ? 1.f : __builtin_amdgcn_exp2f(m_reg - mn_); m_reg = mn_; \
    if (!keep_) { _Pragma("unroll") for (int r = 0; r < 16; ++r) { const float a_ = lane_bcast(alpha_, crow(r, hi)); \
      _Pragma("unroll") for (int d = 0; d < 4; ++d) o[d][r] *= a_; } } \
    SB(); \
    if (!(LAST)) { QK8(PY0, PY1, ((j) + 1) & 1); } \
    { const float mnp_ = mn_ - 7.f; EXPC(PX0, mnp_, 0, 16); EXPC(PX1, mnp_, 0, 16); }     \
    SB(); \
    { float ps_ = 0.f; \
      _Pragma("unroll") for (int r = 0; r < 16; ++r) ps_ += PX0[r] + PX1[r]; \
      auto rr_ = __builtin_amdgcn_permlane32_swap(__float_as_uint(ps_), __float_as_uint(ps_), false, false); \
      l_reg = l_reg * alpha_ + __uint_as_float(rr_[0]) + __uint_as_float(rr_[1]); } \
    i32x8 pf_; \
    _Pragma("unroll") for (int g = 0; g < 4; ++g) { \
      const u32 x_ = pack4_fp8(PX0[4 * g], PX0[4 * g + 1], PX0[4 * g + 2], PX0[4 * g + 3]); \
      const u32 y_ = pack4_fp8(PX1[4 * g], PX1[4 * g + 1], PX1[4 * g + 2], PX1[4 * g + 3]); \
      auto sw_ = __builtin_amdgcn_permlane32_swap(x_, y_, false, false); pf_[2 * g] = (int)sw_[0]; pf_[2 * g + 1] = (int)sw_[1]; } \
    SB(); \
    { const int r_ = r32, h_ = hi, sw2_ = (r_ >> 2) & 3; \
      const char* Vr_ = lds + VOFF + ((j) & 1) * VSTAGE + r_ * 64; const int c0_ = ((h_ * 2) ^ sw2_) << 4, c1_ = ((h_ * 2 + 1) ^ sw2_) << 4; \
      _Pragma("unroll") for (int d0 = 0; d0 < 4; ++d0) { \
        const u32x4 a0_ = *(const u32x4*)(Vr_ + d0 * 2048 + c0_), a1_ = *(const u32x4*)(Vr_ + d0 * 2048 + c1_); \
        const i32x8 vf_ = {(int)a0_[0], (int)a0_[1], (int)a0_[2], (int)a0_[3], (int)a1_[0], (int)a1_[1], (int)a1_[2], (int)a1_[3]}; \
        o[d0] = MFMA8(pf_, vf_, o[d0], SC_P, SC_V); } } \
    if (!(LAST)) PMY = rowmax32(PY0, PY1); \
    asm volatile("s_waitcnt vmcnt(0)" ::: "memory"); } while (0)

  for (int j = 0; j < NT - 2; j += 2) {
    STEP(j, pA0, pA1, pmaxA, pB0, pB1, pmaxB, false);
    STEP(j + 1, pB0, pB1, pmaxB, pA0, pA1, pmaxA, false);
  }
  STEP(NT - 2, pA0, pA1, pmaxA, pB0, pB1, pmaxB, false);
  STEP(NT - 1, pB0, pB1, pmaxB, pA0, pA1, pmaxA, true);
#undef STEP
#undef QK8
#undef PZERO
#undef EXPC
#undef SB
#undef GLK
#undef GLV
#pragma unroll
  for (int r = 0; r < 16; ++r) {
    const int qrow = crow(r, hi); const float rl = 1.f / lane_bcast(l_reg, qrow);
    u16* o_ = p.o + obase + (long)qrow * 1024 + r32;
#pragma unroll
    for (int d = 0; d < 4; ++d) o_[d * 32] = (u16)(cvtpk(o[d][r] * rl, 0.f) & 0xffffu);
  }
}

typedef __attribute__((ext_vector_type(2))) float f32x2;
constexpr float U_SCALE = 256.f, V_SCALE = 64.f;
__device__ __forceinline__ float keyval(u32 k) { return __uint_as_float(k & ~127u) - KEY_BIAS; }
template <int CTRL> __device__ __forceinline__ float dppf(float v) { return __int_as_float(__builtin_amdgcn_update_dpp(0, __float_as_int(v), CTRL, 0xF, 0xF, true)); }
__device__ __forceinline__ float red16(float v) { v += dppf<0xB1>(v); v += dppf<0x4E>(v); v += dppf<0x141>(v); v += dppf<0x140>(v); return v; }
__device__ __forceinline__ void fp8dot(u32 dw, const f32x4& x, f32x2& acc) {
  const f32x2 lo = __builtin_amdgcn_cvt_pk_f32_fp8((int)dw, false), hi = __builtin_amdgcn_cvt_pk_f32_fp8((int)dw, true);
  acc = __builtin_elementwise_fma(lo, (f32x2){x[0], x[1]}, acc); acc = __builtin_elementwise_fma(hi, (f32x2){x[2], x[3]}, acc);
}

#ifndef PEER_FP4
#define PEER_FP4 1
#endif
#if PEER_FP4
constexpr float U4_SCALE = 96.f, V4_SCALE = 22.f;
__device__ __forceinline__ void fp4dot(u32 dw, const f32x4& x0, const f32x4& x1, f32x2& acc) {
  acc = __builtin_elementwise_fma(__builtin_amdgcn_cvt_scalef32_pk_f32_fp4(dw, 1.0f, 0), (f32x2){x0[0], x0[1]}, acc);
  acc = __builtin_elementwise_fma(__builtin_amdgcn_cvt_scalef32_pk_f32_fp4(dw, 1.0f, 1), (f32x2){x0[2], x0[3]}, acc);
  acc = __builtin_elementwise_fma(__builtin_amdgcn_cvt_scalef32_pk_f32_fp4(dw, 1.0f, 2), (f32x2){x1[0], x1[1]}, acc);
  acc = __builtin_elementwise_fma(__builtin_amdgcn_cvt_scalef32_pk_f32_fp4(dw, 1.0f, 3), (f32x2){x1[2], x1[3]}, acc);
}
__device__ __forceinline__ void phase_peer_combine(KP p, int layer, char* lds, unsigned* ctr) {
  const bool last = (layer == 3);
  int tid_ = threadIdx.x; asm volatile("" : "+v"(tid_));
  const int tid = tid_, lane = tid & 63, w = tid >> 6;
  int* eL = (int*)(lds + w * 1536); float* gL = (float*)(lds + w * 1536 + 512); float* wL = (float*)(lds + w * 1536 + 1024);
  int ci = 0, cj = 0; bool cvalid = false;
  { int cnt = 0;
#pragma unroll
    for (int i = 0; i < 16; ++i) { const int n = 16 / (i + 1); if (!cvalid && lane < cnt + n) { ci = i; cj = lane - cnt; cvalid = true; } cnt += n; } }
  const unsigned char* U = p.peer_u8 + (long)layer * 16384 * 512; const unsigned char* V = p.peer_v8 + (long)layer * 16384 * 512;
  const int sub = lane & 15, grp = lane >> 4, l32 = lane & 31, hf = lane >> 5;
  __syncthreads();
  for (;;) {
   int base_ = 0; if (lane == 0) base_ = (int)atomicAdd(ctr, 8u);
   base_ = __builtin_amdgcn_readfirstlane(base_);
   if (base_ >= T_TOK) break;
#pragma unroll 1
   for (int t = base_; t < base_ + 8; ++t) {
    float* xr = p.x + (long)t * DM;
    const u32* pk = p.pkeys + (long)t * 256;
    u32 ka[8], kb[8];
#pragma unroll
    for (int hd = 0; hd < 8; ++hd) { ka[hd] = pk[hd * 32 + ci]; kb[hd] = pk[hd * 32 + 16 + cj]; }
    u32 xe[2][4], xo[2][4]; int sumx = 0; float rstd, sx;
    f32x4 xs[2][8];
#pragma unroll
    for (int j = 0; j < 2; ++j)
#pragma unroll
      for (int q = 0; q < 8; ++q) xs[j][q] = *(const f32x4*)(xr + (sub + 16 * j) * 32 + q * 4);
#pragma unroll
    for (int hd = 0; hd < 8; ++hd) {
      const float cand = cvalid ? keyval(ka[hd]) + keyval(kb[hd]) : -3.0e38f;
      u32 ck = __float_as_uint(cand); ck = (ck & 0x80000000u) ? ~ck : (ck | 0x80000000u); ck = (ck & ~63u) | (u32)(63 - lane);
      int rank = 0;
#pragma unroll
      for (int m = 0; m < 50; ++m) { const u32 c = __builtin_amdgcn_readlane(ck, m); rank += (c > ck) ? 1 : 0; }
      const float cmax = __uint_as_float(__builtin_amdgcn_readlane(__float_as_uint(cand), 0));
      if (cvalid && rank < 16) { eL[hd * 16 + rank] = (int)((ka[hd] & 127u) * 128u + (kb[hd] & 127u)); gL[hd * 16 + rank] = __expf(cand - cmax); }
    }
    __builtin_amdgcn_wave_barrier();
    { const float g0 = gL[lane], g1 = gL[lane + 64]; const float s0 = red16(g0), s1 = red16(g1);
      __builtin_amdgcn_wave_barrier();
      gL[lane] = g0 / s0; gL[lane + 64] = g1 / s1; }
    __builtin_amdgcn_wave_barrier();
    u32x4 cA[8], cB[8];
#define LOADU(C, it) do { const int k0_ = (it) * 16 + grp * 4; \
      _Pragma("unroll") for (int rr = 0; rr < 4; ++rr) { const int e_ = eL[k0_ + rr]; const unsigned char* u_ = U + (long)e_ * 512 + sub * 16; \
        C[rr * 2] = *(const u32x4*)u_; C[rr * 2 + 1] = *(const u32x4*)(u_ + 256); } } while (0)
#define COMPU(C, it) do { const int k0_ = (it) * 16 + grp * 4; \
      _Pragma("unroll") for (int rr = 0; rr < 4; ++rr) { int a_ = 0; \
        _Pragma("unroll") for (int j = 0; j < 2; ++j) { _Pragma("unroll") for (int d = 0; d < 4; ++d) { const u32 dw_ = C[rr * 2 + j][d]; \
          a_ = __builtin_amdgcn_sdot4((int)(dw_ & 0x0F0F0F0Fu), (int)xe[j][d], a_, false); a_ = __builtin_amdgcn_sdot4((int)((dw_ >> 4) & 0x0F0F0F0Fu), (int)xo[j][d], a_, false); } } \
        const float r_ = red16((float)(a_ - 8 * sumx)); \
        if (sub == 0) wL[k0_ + rr] = r_; } } while (0)
#define LOADV(C, g) do { _Pragma("unroll") for (int i = 0; i < 8; ++i) { const int e_ = eL[(g) * 16 + 2 * i + hf]; \
      C[i] = *(const u32x4*)(V + (long)e_ * 512 + l32 * 16); } } while (0)
#define COMPV(C, g) do { _Pragma("unroll") for (int i = 0; i < 8; ++i) { const float wk_ = wL[(g) * 16 + 2 * i + hf]; const f32x2 w2_ = {wk_, wk_}; \
      _Pragma("unroll") for (int d = 0; d < 4; ++d) { const u32 dw_ = C[i][d]; \
        out[d * 4 + 0] = __builtin_elementwise_fma(__builtin_amdgcn_cvt_scalef32_pk_f32_fp4(dw_, 1.0f, 0), w2_, out[d * 4 + 0]); \
        out[d * 4 + 1] = __builtin_elementwise_fma(__builtin_amdgcn_cvt_scalef32_pk_f32_fp4(dw_, 1.0f, 1), w2_, out[d * 4 + 1]); \
        out[d * 4 + 2] = __builtin_elementwise_fma(__builtin_amdgcn_cvt_scalef32_pk_f32_fp4(dw_, 1.0f, 2), w2_, out[d * 4 + 2]); \
        out[d * 4 + 3] = __builtin_elementwise_fma(__builtin_amdgcn_cvt_scalef32_pk_f32_fp4(dw_, 1.0f, 3), w2_, out[d * 4 + 3]); } } } while (0)
    LOADU(cA, 0);
    { float ss = 0.f, am = 0.f;
#pragma unroll
      for (int j = 0; j < 2; ++j)
#pragma unroll
        for (int q = 0; q < 8; ++q) { const f32x4 a = xs[j][q]; ss += a[0] * a[0] + a[1] * a[1] + a[2] * a[2] + a[3] * a[3];
          am = fmaxf(fmaxf(am, fmaxf(fabsf(a[0]), fabsf(a[1]))), fmaxf(fabsf(a[2]), fabsf(a[3]))); }
      ss = red16(ss);
      am = fmaxf(am, dppf<0xB1>(am)); am = fmaxf(am, dppf<0x4E>(am)); am = fmaxf(am, dppf<0x141>(am)); am = fmaxf(am, dppf<0x140>(am));
      rstd = rsqrtf(ss * (1.f / DM) + RMS_EPS);
      am = fmaxf(am, 1e-20f); sx = am * (1.f / 127.f); const float inv = 127.f / am;
#pragma unroll
      for (int j = 0; j < 2; ++j)
#pragma unroll
        for (int d = 0; d < 4; ++d) {
          const f32x4 lo4 = xs[j][2 * d], hi4 = xs[j][2 * d + 1];
          const int i0 = (int)__builtin_rintf(lo4[0] * inv), i1 = (int)__builtin_rintf(lo4[1] * inv), i2 = (int)__builtin_rintf(lo4[2] * inv), i3 = (int)__builtin_rintf(lo4[3] * inv);
          const int i4 = (int)__builtin_rintf(hi4[0] * inv), i5 = (int)__builtin_rintf(hi4[1] * inv), i6 = (int)__builtin_rintf(hi4[2] * inv), i7 = (int)__builtin_rintf(hi4[3] * inv);
          sumx += i0 + i1 + i2 + i3 + i4 + i5 + i6 + i7;
          xe[j][d] = (u32)(i0 & 0xFF) | ((u32)(i2 & 0xFF) << 8) | ((u32)(i4 & 0xFF) << 16) | ((u32)i6 << 24);
          xo[j][d] = (u32)(i1 & 0xFF) | ((u32)(i3 & 0xFF) << 8) | ((u32)(i5 & 0xFF) << 16) | ((u32)i7 << 24);
        } }
#pragma unroll 1
    for (int it = 0; it < 6; it += 2) { LOADU(cB, it + 1); COMPU(cA, it); LOADU(cA, it + 2); COMPU(cB, it + 1); }
    LOADU(cB, 7); COMPU(cA, 6);
    LOADV(cA, 0);
    COMPU(cB, 7);
    __builtin_amdgcn_wave_barrier();
    { const float sc_ = rstd * sx * (1.f / U4_SCALE); const float a0 = wL[lane] * sc_, a1 = wL[lane + 64] * sc_;
      const float w0 = gL[lane] * 0.5f * a0 * (1.f + erff(a0 * 0.70710678118654752f)), w1 = gL[lane + 64] * 0.5f * a1 * (1.f + erff(a1 * 0.70710678118654752f));
      __builtin_amdgcn_wave_barrier();
      wL[lane] = w0; wL[lane + 64] = w1; }
    __builtin_amdgcn_wave_barrier();
    f32x2 out[16];
#pragma unroll
    for (int i = 0; i < 16; ++i) out[i] = (f32x2){0.f, 0.f};
#pragma unroll 1
    for (int g = 0; g < 6; g += 2) { LOADV(cB, g + 1); COMPV(cA, g); LOADV(cA, g + 2); COMPV(cB, g + 1); }
    LOADV(cB, 7); COMPV(cA, 6); COMPV(cB, 7);
#undef LOADU
#undef COMPU
#undef LOADV
#undef COMPV
    {
      f32x4 v[4];
#pragma unroll
      for (int q = 0; q < 4; ++q) {
        const f32x2 m0 = hf ? out[8 + 2 * q] : out[2 * q], o0 = hf ? out[2 * q] : out[8 + 2 * q];
        const f32x2 m1 = hf ? out[8 + 2 * q + 1] : out[2 * q + 1], o1 = hf ? out[2 * q + 1] : out[8 + 2 * q + 1];
        v[q] = (f32x4){m0[0] + shx(o0[0], 32), m0[1] + shx(o0[1], 32), m1[0] + shx(o1[0], 32), m1[1] + shx(o1[1], 32)};
      }
      f32x4* xo = (f32x4*)(xr + l32 * 32 + hf * 16);
#pragma unroll
      for (int q = 0; q < 4; ++q) { const f32x4 xv = xo[q]; v[q] = xv + v[q] * (1.f / V4_SCALE); }
      __builtin_amdgcn_wave_barrier();
      if (last) {
        float s2 = 0.f;
#pragma unroll
        for (int q = 0; q < 4; ++q) s2 += v[q][0] * v[q][0] + v[q][1] * v[q][1] + v[q][2] * v[q][2] + v[q][3] * v[q][3];
        s2 = red16(s2); s2 += shx(s2, 16); s2 += shx(s2, 32);
        const float rf = rsqrtf(s2 * (1.f / DM) + RMS_EPS);
#pragma unroll
        for (int q = 0; q < 4; ++q) { const f32x4 gf = *(const f32x4*)(p.norm_final + l32 * 32 + hf * 16 + q * 4); v[q] = v[q] * rf * gf; }
      }
#pragma unroll
      for (int q = 0; q < 4; ++q) xo[q] = v[q];
      u32x4* xbo = (u32x4*)(p.xb + (long)t * DM + l32 * 32 + hf * 16);
      xbo[0] = (u32x4){cvtpk(v[0][0], v[0][1]), cvtpk(v[0][2], v[0][3]), cvtpk(v[1][0], v[1][1]), cvtpk(v[1][2], v[1][3])};
      xbo[1] = (u32x4){cvtpk(v[2][0], v[2][1]), cvtpk(v[2][2], v[2][3]), cvtpk(v[3][0], v[3][1]), cvtpk(v[3][2], v[3][3])}; }
    __builtin_amdgcn_wave_barrier();
   }
  }
}
#else
__device__ __forceinline__ void phase_peer_combine(KP p, int layer, char* lds, unsigned*) {
  const bool last = (layer == 3);
  int tid_ = threadIdx.x; asm volatile("" : "+v"(tid_));
  const int tid = tid_, lane = tid & 63, w = tid >> 6;
  int* eL = (int*)(lds + w * 1536); float* gL = (float*)(lds + w * 1536 + 512); float* wL = (float*)(lds + w * 1536 + 1024);
  int ci = 0, cj = 0; bool cvalid = false;
  { int cnt = 0;
#pragma unroll
    for (int i = 0; i < 16; ++i) { const int n = 16 / (i + 1); if (!cvalid && lane < cnt + n) { ci = i; cj = lane - cnt; cvalid = true; } cnt += n; } }
  const unsigned char* U = p.peer_u8 + (long)layer * 16384 * 1024; const unsigned char* V = p.peer_v8 + (long)layer * 16384 * 1024;
  const int sub = lane & 15, grp = lane >> 4;
  __syncthreads();
  for (int t = blockIdx.x * 4 + w; t < T_TOK; t += gridDim.x * 4) {
    float* xr = p.x + (long)t * DM;
    const u32* pk = p.pkeys + (long)t * 256;
    u32 ka[8], kb[8];
#pragma unroll
    for (int hd = 0; hd < 8; ++hd) { ka[hd] = pk[hd * 32 + ci]; kb[hd] = pk[hd * 32 + 16 + cj]; }
    f32x4 xs[4][4]; float ss = 0.f;
#pragma unroll
    for (int i = 0; i < 4; ++i)
#pragma unroll
      for (int q = 0; q < 4; ++q) { const f32x4 a = *(const f32x4*)(xr + (sub + 16 * i) * 16 + q * 4); xs[i][q] = a; ss += a[0] * a[0] + a[1] * a[1] + a[2] * a[2] + a[3] * a[3]; }
    ss = red16(ss);
    const float rstd = rsqrtf(ss * (1.f / DM) + RMS_EPS);
#pragma unroll
    for (int hd = 0; hd < 8; ++hd) {
      const float cand = cvalid ? keyval(ka[hd]) + keyval(kb[hd]) : -3.0e38f;
      u32 ck = __float_as_uint(cand); ck = (ck & 0x80000000u) ? ~ck : (ck | 0x80000000u); ck = (ck & ~63u) | (u32)(63 - lane);
      int rank = 0;
#pragma unroll
      for (int m = 0; m < 50; ++m) { const u32 c = __builtin_amdgcn_readlane(ck, m); rank += (c > ck) ? 1 : 0; }
      const float cmax = __uint_as_float(__builtin_amdgcn_readlane(__float_as_uint(cand), 0));
      if (cvalid && rank < 16) { eL[hd * 16 + rank] = (int)((ka[hd] & 127u) * 128u + (kb[hd] & 127u)); gL[hd * 16 + rank] = __expf(cand - cmax); }
    }
    __builtin_amdgcn_wave_barrier();
    { const float g0 = gL[lane], g1 = gL[lane + 64]; const float s0 = red16(g0), s1 = red16(g1);
      __builtin_amdgcn_wave_barrier();
      gL[lane] = g0 / s0; gL[lane + 64] = g1 / s1; }
    __builtin_amdgcn_wave_barrier();
    u32x4 cA[8], cB[8];
#define LOADU(C, it) do { const int k0_ = (it) * 8 + grp * 2; const int e0_ = eL[k0_], e1_ = eL[k0_ + 1]; \
      const unsigned char* u0_ = U + (long)e0_ * 1024 + sub * 16; const unsigned char* u1_ = U + (long)e1_ * 1024 + sub * 16; \
      _Pragma("unroll") for (int i = 0; i < 4; ++i) { C[i] = *(const u32x4*)(u0_ + i * 256); C[4 + i] = *(const u32x4*)(u1_ + i * 256); } } while (0)
#define COMPU(C, it) do { const int k0_ = (it) * 8 + grp * 2; f32x2 a0_ = {0.f, 0.f}, a1_ = {0.f, 0.f}; \
      _Pragma("unroll") for (int i = 0; i < 4; ++i) { _Pragma("unroll") for (int q = 0; q < 4; ++q) { fp8dot(C[i][q], xs[i][q], a0_); fp8dot(C[4 + i][q], xs[i][q], a1_); } } \
      const float r0_ = red16(a0_[0] + a0_[1]), r1_ = red16(a1_[0] + a1_[1]); \
      if (sub == 0) { const float aa_ = r0_ * rstd * (1.f / U_SCALE), ab_ = r1_ * rstd * (1.f / U_SCALE); \
        wL[k0_] = gL[k0_] * 0.5f * aa_ * (1.f + erff(aa_ * 0.70710678118654752f)); \
        wL[k0_ + 1] = gL[k0_ + 1] * 0.5f * ab_ * (1.f + erff(ab_ * 0.70710678118654752f)); } } while (0)
#define LOADV(C, g) do { _Pragma("unroll") for (int i = 0; i < 8; ++i) { const int e_ = eL[(g) * 8 + i]; C[i] = *(const u32x4*)(V + (long)e_ * 1024 + lane * 16); } } while (0)
#define COMPV(C, g) do { _Pragma("unroll") for (int i = 0; i < 8; ++i) { const float wk_ = wL[(g) * 8 + i]; const f32x2 w2_ = {wk_, wk_}; \
      _Pragma("unroll") for (int q = 0; q < 4; ++q) { \
        const f32x2 lo_ = __builtin_amdgcn_cvt_pk_f32_fp8((int)C[i][q], false), hi_ = __builtin_amdgcn_cvt_pk_f32_fp8((int)C[i][q], true); \
        out[2 * q] = __builtin_elementwise_fma(lo_, w2_, out[2 * q]); out[2 * q + 1] = __builtin_elementwise_fma(hi_, w2_, out[2 * q + 1]); } } } while (0)
    LOADU(cA, 0);
#pragma unroll 1
    for (int it = 0; it < 14; it += 2) { LOADU(cB, it + 1); COMPU(cA, it); LOADU(cA, it + 2); COMPU(cB, it + 1); }
    LOADU(cB, 15); COMPU(cA, 14);
    LOADV(cA, 0);
    COMPU(cB, 15);
    __builtin_amdgcn_wave_barrier();
    f32x2 out[8];
#pragma unroll
    for (int i = 0; i < 8; ++i) out[i] = (f32x2){0.f, 0.f};
#pragma unroll 1
    for (int g = 0; g < 14; g += 2) { LOADV(cB, g + 1); COMPV(cA, g); LOADV(cA, g + 2); COMPV(cB, g + 1); }
    LOADV(cB, 15); COMPV(cA, 14); COMPV(cB, 15);
#undef LOADU
#undef COMPU
#undef LOADV
#undef COMPV
    { f32x4* xo = (f32x4*)(xr + lane * 16);
      f32x4 v[4];
#pragma unroll
      for (int q = 0; q < 4; ++q) { v[q] = xo[q]; v[q][0] += out[2 * q][0] * (1.f / V_SCALE); v[q][1] += out[2 * q][1] * (1.f / V_SCALE); v[q][2] += out[2 * q + 1][0] * (1.f / V_SCALE); v[q][3] += out[2 * q + 1][1] * (1.f / V_SCALE); }
      __builtin_amdgcn_wave_barrier();
      if (last) {
        float s2 = 0.f;
#pragma unroll
        for (int q = 0; q < 4; ++q) s2 += v[q][0] * v[q][0] + v[q][1] * v[q][1] + v[q][2] * v[q][2] + v[q][3] * v[q][3];
        s2 = red16(s2); s2 += shx(s2, 16); s2 += shx(s2, 32);
        const float rf = rsqrtf(s2 * (1.f / DM) + RMS_EPS);
#pragma unroll
        for (int q = 0; q < 4; ++q) { const f32x4 gf = *(const f32x4*)(p.norm_final + lane * 16 + q * 4); v[q] = v[q] * rf * gf; }
      }
#pragma unroll
      for (int q = 0; q < 4; ++q) xo[q] = v[q];
      u32x4* xbo = (u32x4*)(p.xb + (long)t * DM + lane * 16);
      xbo[0] = (u32x4){cvtpk(v[0][0], v[0][1]), cvtpk(v[0][2], v[0][3]), cvtpk(v[1][0], v[1][1]), cvtpk(v[1][2], v[1][3])};
      xbo[1] = (u32x4){cvtpk(v[2][0], v[2][1]), cvtpk(v[2][2], v[2][3]), cvtpk(v[3][0], v[3][1]), cvtpk(v[3][2], v[3][3])}; }
    __builtin_amdgcn_wave_barrier();
  }
}

#endif

#if PEER_FP4
constexpr long TBL_ITERS = 4L * 16384 * 1024 / 16; constexpr int TBL_NCHUNK = 512; constexpr long TBL_CHUNK = TBL_ITERS / TBL_NCHUNK;
__device__ __forceinline__ void convert_tables_chunk(KP p, int chunk) {
  int tid_ = threadIdx.x; asm volatile("" : "+v"(tid_));
#define Q4(val) ((u32)(int)(fminf(fmaxf(__builtin_rintf((val) * U4_SCALE), -8.f), 7.f) + 8.f))
  for (long i = (long)chunk * TBL_CHUNK + tid_; i < (long)(chunk + 1) * TBL_CHUNK; i += NTHR) {
    const long e = i * 16; const int layer = (int)(e >> 24); const int d = (int)(e & 1023);
    u32 uo[2], vo[2];
#pragma unroll
    for (int h = 0; h < 2; ++h) {
      u32 a = 0, b = 0;
#pragma unroll
      for (int q = 0; q < 2; ++q) {
        const f32x4 g = *(const f32x4*)(p.in_norm_ffn + layer * 1024 + d + h * 8 + q * 4);
        const f32x4 u = *(const f32x4*)(p.in_peer_u + e + h * 8 + q * 4), v = *(const f32x4*)(p.in_peer_v + e + h * 8 + q * 4);
        if (q == 0) {
          a |= Q4(u[0] * g[0]) | (Q4(u[1] * g[1]) << 4) | (Q4(u[2] * g[2]) << 8) | (Q4(u[3] * g[3]) << 12);
          b = __builtin_amdgcn_cvt_scalef32_pk_fp4_f32(b, v[0] * V4_SCALE, v[1] * V4_SCALE, 1.0f, 0); b = __builtin_amdgcn_cvt_scalef32_pk_fp4_f32(b, v[2] * V4_SCALE, v[3] * V4_SCALE, 1.0f, 1);
        } else {
          a |= (Q4(u[0] * g[0]) << 16) | (Q4(u[1] * g[1]) << 20) | (Q4(u[2] * g[2]) << 24) | (Q4(u[3] * g[3]) << 28);
          b = __builtin_amdgcn_cvt_scalef32_pk_fp4_f32(b, v[0] * V4_SCALE, v[1] * V4_SCALE, 1.0f, 2); b = __builtin_amdgcn_cvt_scalef32_pk_fp4_f32(b, v[2] * V4_SCALE, v[3] * V4_SCALE, 1.0f, 3);
        }
      }
      uo[h] = a; vo[h] = b;
    }
    *(u32x2*)(p.peer_u8 + (e >> 1)) = (u32x2){uo[0], uo[1]}; *(u32x2*)(p.peer_v8 + (e >> 1)) = (u32x2){vo[0], vo[1]};
  }
}

#endif
__device__ __forceinline__ void prep_transpose_tile(KP p, int t, char* lds) {
  int tid_ = threadIdx.x; asm volatile("" : "+v"(tid_));
  const int tid = tid_;
  float* tl = (float*)lds;
  int j = 0;
  while (j + 1 < p.njobs && t >= p.jobs[j + 1].tile0) ++j;
  const float* src = p.jobs[j].src; u16* dst = p.jobs[j].dst; const float* gain = p.jobs[j].gain;
  const int K = p.jobs[j].K, N = p.jobs[j].N, scale_cols = p.jobs[j].scale_cols; const float scale = p.jobs[j].scale;
  const int lt = t - p.jobs[j].tile0, ntn = N >> 6, kt = lt / ntn, nt = lt - kt * ntn;
  __syncthreads();
  for (int e = tid; e < 4096; e += 256) { const int kk = e >> 6, nn = e & 63, k = kt * 64 + kk; const float g = gain ? gain[k] : 1.f; tl[kk * 65 + nn] = src[(long)k * N + nt * 64 + nn] * g; }
  __syncthreads();
  for (int e = tid; e < 2048; e += 256) { const int nn = e >> 5, kp = (e & 31) * 2, n = nt * 64 + nn; const float s = (n < scale_cols) ? scale : 1.f;
    *(u32*)(dst + (long)n * K + kt * 64 + kp) = cvtpk(tl[kp * 65 + nn] * s, tl[(kp + 1) * 65 + nn] * s); }
  __syncthreads();
}

__device__ __forceinline__ void phase_prep(KP p, char* lds) {
  int tid_ = threadIdx.x; asm volatile("" : "+v"(tid_));
  const int tid = tid_;
  const long gtid = (long)blockIdx.x * NTHR + tid, gsz = (long)gridDim.x * NTHR;
  float* tl = (float*)lds;
  for (int t = blockIdx.x; t < p.jobs[4].tile0; t += gridDim.x) prep_transpose_tile(p, t, lds);
  for (long i = gtid; i < (long)T_TOK * DM / 4; i += gsz) {
    const long e = i * 4; const f32x4 v = e < (long)T_PROMPT * DM ? *(const f32x4*)(p.xin0 + e) : *(const f32x4*)(p.xin1 + (e - (long)T_PROMPT * DM));
    *(u32*)(p.xb + e) = cvtpk(v[0], v[1]); *(u32*)(p.xb + e + 2) = cvtpk(v[2], v[3]); }
  for (long i = gtid; i < 4L * 8 * 2 * 128 * 128 / 2; i += gsz) { const float a = p.in_sub_keys[2 * i], b = p.in_sub_keys[2 * i + 1]; *(u32*)(p.peer_sk + 2 * i) = cvtpk(a, b); }
#if PEER_FP4
#else
  for (long i = gtid; i < 4L * 16384 * 1024 / 16; i += gsz) {
    const long e = i * 16; const int layer = (int)(e >> 24); const int d = (int)(e & 1023);
    u32x4 uo, vo;
#pragma unroll
    for (int q = 0; q < 4; ++q) {
      const f32x4 g = *(const f32x4*)(p.in_norm_ffn + layer * 1024 + d + q * 4);
      const f32x4 u = *(const f32x4*)(p.in_peer_u + e + q * 4), v = *(const f32x4*)(p.in_peer_v + e + q * 4);
      int a = 0, b = 0;
      a = __builtin_amdgcn_cvt_pk_fp8_f32(u[0] * g[0] * U_SCALE, u[1] * g[1] * U_SCALE, a, false); a = __builtin_amdgcn_cvt_pk_fp8_f32(u[2] * g[2] * U_SCALE, u[3] * g[3] * U_SCALE, a, true);
      b = __builtin_amdgcn_cvt_pk_fp8_f32(v[0] * V_SCALE, v[1] * V_SCALE, b, false); b = __builtin_amdgcn_cvt_pk_fp8_f32(v[2] * V_SCALE, v[3] * V_SCALE, b, true);
      uo[q] = (u32)a; vo[q] = (u32)b;
    }
    *(u32x4*)(p.peer_u8 + e) = uo; *(u32x4*)(p.peer_v8 + e) = vo;
  }
#endif
  for (long i = gtid; i < 2 * 3072; i += gsz) { const int c = (int)(i % 3072); p.na_bias_s[i] = p.in_na_bias[i] * (c < 1024 ? 0.125f * LOG2E : 1.f); }
  for (long i = gtid; i < 2 * 16 * 465; i += gsz) p.na_rpb_s[i] = p.in_na_rpb[i] * LOG2E;
  for (long i = gtid; i < 16384L * 32; i += gsz) {
    const int pos = (int)(i >> 5), jf = (int)(i & 31);
    const double a = (double)pos * p.inv_freq[jf] * 0.15915494309189535;
    const double fr = a - rint(a);
    const float f = (float)fr;
    p.ropeC[i] = __builtin_amdgcn_cosf(f); p.ropeS[i] = __builtin_amdgcn_sinf(f);
  }
  for (long i = gtid; i < 2L * 64 * 1024 / 2; i += gsz) { const int l = (int)(i >> 15); const long e = (i & 32767) * 2; *(u32*)(p.wa_t[l] + 704L * 1024 + e) = 0u; }
}

__device__ __forceinline__ void phase_final(KP p) {
  int tid_ = threadIdx.x; asm volatile("" : "+v"(tid_));
  const int lane = tid_ & 63, w = tid_ >> 6;
  for (int t = blockIdx.x * 4 + w; t < T_TOK; t += gridDim.x * 4) {
    float* xr = p.x + (long)t * DM;
    f32x4 v[4]; float ss = 0.f;
#pragma unroll
    for (int i = 0; i < 4; ++i) { v[i] = *(const f32x4*)(xr + i * 256 + lane * 4); ss += v[i][0] * v[i][0] + v[i][1] * v[i][1] + v[i][2] * v[i][2] + v[i][3] * v[i][3]; }
    ss += shx(ss, 1); ss += shx(ss, 2); ss += shx(ss, 4); ss += shx(ss, 8); ss += shx(ss, 16); ss += shx(ss, 32);
    const float rs = rsqrtf(ss * (1.f / DM) + RMS_EPS);
#pragma unroll
    for (int i = 0; i < 4; ++i) { const f32x4 g = *(const f32x4*)(p.norm_final + i * 256 + lane * 4); f32x4 o_ = {v[i][0] * rs * g[0], v[i][1] * rs * g[1], v[i][2] * rs * g[2], v[i][3] * rs * g[3]}; *(f32x4*)(xr + i * 256 + lane * 4) = o_; }
  }
}

template <int EPI>
__device__ __forceinline__ void gemm_big(KP p, int layer, const u16* Ap, int lda, const u16* Bt, int K, int m0, int n0, char* lds) {
  int tid_ = threadIdx.x; asm volatile("" : "+v"(tid_));
  const int tid = tid_, lane = tid & 63, w = tid >> 6;
  const int wm = w >> 1, wn = w & 1, r32 = lane & 31, hi = lane >> 5;
  constexpr int STG = 24576;
  const int scol = ((lane & 3) ^ ((lane >> 4) & 3)) * 8;
  const u16* Ag = Ap + (long)(m0 + w * 64 + (lane >> 2)) * lda + scol;
  const u16* Bg = Bt + (long)(n0 + w * 32 + (lane >> 2)) * K + scol;
#define GST(st, kt) do { int w_ = w; asm volatile("" : "+v"(w_)); \
    _Pragma("unroll") for (int i = 0; i < 4; ++i) __builtin_amdgcn_global_load_lds((const unsigned*)(Ag + (long)i * 16 * lda + (kt) * 32), (unsigned*)(lds + (st) * STG + (w_ * 4 + i) * 1024), 16, 0, 0); \
    _Pragma("unroll") for (int i = 0; i < 2; ++i) __builtin_amdgcn_global_load_lds((const unsigned*)(Bg + (long)i * 16 * K + (kt) * 32), (unsigned*)(lds + (st) * STG + 16384 + (w_ * 2 + i) * 1024), 16, 0, 0); } while (0)
  f32x16 acc[4][2];
#pragma unroll
  for (int i = 0; i < 4; ++i)
#pragma unroll
    for (int j = 0; j < 2; ++j)
#pragma unroll
      for (int r = 0; r < 16; ++r) acc[i][j][r] = 0.f;
  float ssq[4] = {0.f, 0.f, 0.f, 0.f};
  const int sw = (r32 >> 2) & 3;
  const int arow = (wm * 128 + r32) * 64, brow = 16384 + (wn * 64 + r32) * 64;
  const int nk = K / 32;
  __syncthreads();
  GST(0, 0); GST(1, 1);
  int st = 0;
  for (int kt = 0; kt < nk; ++kt) {
    if (kt + 1 < nk) asm volatile("s_waitcnt vmcnt(6)" ::: "memory"); else asm volatile("s_waitcnt vmcnt(0)" ::: "memory");
    asm volatile("s_waitcnt lgkmcnt(0)" ::: "memory");
    __builtin_amdgcn_s_barrier();
    if (kt + 2 < nk) { const int s2 = st + 2 >= 3 ? st - 1 : st + 2; GST(s2, kt + 2); }
    const char* base = lds + st * STG;
#pragma unroll
    for (int ks = 0; ks < 2; ++ks) {
      const int co = ((ks * 2 + hi) ^ sw) << 4;
      bf16x8 a[4], b[2];
#pragma unroll
      for (int mi = 0; mi < 4; ++mi) a[mi] = *(const bf16x8*)(base + arow + mi * 2048 + co);
#pragma unroll
      for (int ni = 0; ni < 2; ++ni) b[ni] = *(const bf16x8*)(base + brow + ni * 2048 + co);
#pragma unroll
      for (int mi = 0; mi < 4; ++mi) { acc[mi][0] = mfma32(b[0], a[mi], acc[mi][0]); acc[mi][1] = mfma32(b[1], a[mi], acc[mi][1]); }
#pragma unroll
      for (int mi = 0; mi < 4; ++mi) { const u32x4 x = __builtin_bit_cast(u32x4, a[mi]);
#pragma unroll
        for (int q = 0; q < 4; ++q) ssq[mi] = dot2bf(x[q], x[q], ssq[mi]); }
    }
    st = st == 2 ? 0 : st + 1;
  }
#undef GST
  __syncthreads();
  float rs[4];
#pragma unroll
  for (int mi = 0; mi < 4; ++mi) { const float t = ssq[mi] + shx(ssq[mi], 32); rs[mi] = rsqrtf(t / (float)K + RMS_EPS); }
  const int rowb = wm * 128, colb = wn * 64;
  if constexpr (EPI == EPI_A || EPI == EPI_QKV) {
    constexpr int OROW = 272;
    u16* outp; int ldo; bool rope = false;
    if constexpr (EPI == EPI_A) { outp = p.cqkv; ldo = 768; rope = (n0 + colb == 640); }
    else { outp = p.qkv; ldo = 3072; }
#pragma unroll
    for (int mi = 0; mi < 4; ++mi) {
      const int rl = rowb + mi * 32 + r32; const int pos = tok_pos(m0 + rl);
#pragma unroll
      for (int g = 0; g < 4; ++g) {
        f32x4 v0, v1;
#pragma unroll
        for (int e = 0; e < 4; ++e) { v0[e] = acc[mi][0][4 * g + e] * rs[mi]; v1[e] = acc[mi][1][4 * g + e] * rs[mi]; }
        if constexpr (EPI == EPI_QKV) {
          const f32x4 b0 = *(const f32x4*)(p.na_bias_s + layer * 3072 + n0 + colb + 8 * g + 4 * hi), b1 = *(const f32x4*)(p.na_bias_s + layer * 3072 + n0 + colb + 32 + 8 * g + 4 * hi);
          v0 += b0; v1 += b1;
        }
        if (rope) {
          const f32x4 c = *(const f32x4*)(p.ropeC + pos * 32 + 8 * g + 4 * hi), sn = *(const f32x4*)(p.ropeS + pos * 32 + 8 * g + 4 * hi);
          const f32x4 t0 = (v0 * c - v1 * sn) * K8_SCALE, t1 = (v0 * sn + v1 * c) * K8_SCALE;
          unsigned char* kp_ = p.k8 + (long)(m0 + rl) * 1088 + 1024 + 8 * g + 4 * hi;
          *(u32*)kp_ = pack4_fp8(t0[0], t0[1], t0[2], t0[3]); *(u32*)(kp_ + 32) = pack4_fp8(t1[0], t1[1], t1[2], t1[3]);
        }
        char* e_ = lds + rl * OROW + (colb + 8 * g + 4 * hi) * 2;
        *(u32x2*)e_ = (u32x2){cvtpk(v0[0], v0[1]), cvtpk(v0[2], v0[3])};
        *(u32x2*)(e_ + 64) = (u32x2){cvtpk(v1[0], v1[1]), cvtpk(v1[2], v1[3])};
      }
    }
    __syncthreads();
#pragma unroll 4
    for (int i = 0; i < 16; ++i) { const int c = tid + 256 * i, row = c >> 4, ch = c & 15;
      *(u32x4*)(outp + (long)(m0 + row) * ldo + n0 + ch * 8) = *(const u32x4*)(lds + row * OROW + ch * 16); }
  } else {
    constexpr int BROW = 144;
    const bool rope = (EPI == EPI_UQ) && ((n0 + colb) % 192 == 128);
    const float sc = (EPI == EPI_UQ) ? Q8_SCALE : K8_SCALE;
#pragma unroll
    for (int mi = 0; mi < 4; ++mi) {
      const int rl = rowb + mi * 32 + r32; const int pos = tok_pos(m0 + rl);
#pragma unroll
      for (int g = 0; g < 4; ++g) {
        f32x4 v0, v1;
#pragma unroll
        for (int e = 0; e < 4; ++e) { v0[e] = acc[mi][0][4 * g + e] * rs[mi] * sc; v1[e] = acc[mi][1][4 * g + e] * rs[mi] * sc; }
        if (rope) {
          const f32x4 c = *(const f32x4*)(p.ropeC + pos * 32 + 8 * g + 4 * hi), sn = *(const f32x4*)(p.ropeS + pos * 32 + 8 * g + 4 * hi);
          const f32x4 t0 = v0 * c - v1 * sn, t1 = v0 * sn + v1 * c; v0 = t0; v1 = t1;
        }
        char* e_ = lds + rl * BROW + (colb + 8 * g + 4 * hi);
        *(u32*)e_ = pack4_fp8(v0[0], v0[1], v0[2], v0[3]); *(u32*)(e_ + 32) = pack4_fp8(v1[0], v1[1], v1[2], v1[3]);
      }
    }
    __syncthreads();
    unsigned char* outb; long ldo;
    if constexpr (EPI == EPI_UQ) { outb = p.q8 + n0; ldo = 1536; } else { outb = p.k8 + (n0 >> 8) * 128; ldo = 1088; }
#pragma unroll 2
    for (int i = 0; i < 8; ++i) { const int c = tid + 256 * i, row = c >> 3, ch = c & 7;
      *(u32x4*)(outb + (long)(m0 + row) * ldo + ch * 16) = *(const u32x4*)(lds + row * BROW + ch * 16); }
  }
}

__device__ __forceinline__ void ukv_tile(KP p, int j, int mt, int nt, char* lds) {
  if (nt & 1) gemm_tile<EPI_UV, true>(p, j, p.cqkv + 384, 768, p.wukv_t[j], 256, mt * 128, nt * 128, lds);
  else gemm_tile<EPI_UK, true>(p, j, p.cqkv + 384, 768, p.wukv_t[j], 256, mt * 128, nt * 128, lds);
}
#define XB_TMO      128
#define XB_XCNT(j)  (256  + 64 * (j))
#define XB_XSUB(j)  (1280 + 64 * (j))
#define XB_XGEN(j)  (2304 + 64 * (j))
#define XB_TOP      3328
#define XB_TOPGEN   3392
#define XCD_BAR_WORDS 3456
#define XB_SPIN_CAP (1u << 18)
#define LAS __attribute__((address_space(3)))
__device__ __forceinline__ unsigned xb_ld(unsigned* p)              { return __hip_atomic_load(p, __ATOMIC_RELAXED, __HIP_MEMORY_SCOPE_AGENT); }
__device__ __forceinline__ unsigned xb_add(unsigned* p, unsigned v) { return __hip_atomic_fetch_add(p, v, __ATOMIC_RELAXED, __HIP_MEMORY_SCOPE_AGENT); }
__device__ __forceinline__ unsigned xb_xcc_id() { return (unsigned)__builtin_amdgcn_s_getreg((3 << 11) | 20) & 0xFu; }
#define XB_SPIN(cond, bar) do { unsigned _sp = 0; while (cond) { __builtin_amdgcn_s_sleep(1); \
    if ((++_sp & 255u) == 0u) { if (xb_ld(&(bar)[XB_TMO])) break; if (_sp > XB_SPIN_CAP) { atomicAdd(&(bar)[XB_TMO], 1u); break; } } } } while (0)
struct XcdBarrier { unsigned* bar; unsigned x; volatile LAS unsigned* st; };
__device__ __forceinline__ XcdBarrier xcd_barrier_post(unsigned* bar, volatile LAS unsigned* st) {
    XcdBarrier b; b.bar = bar; b.x = xb_xcc_id(); b.st = st;
    if (threadIdx.x == 0) (void)xb_add(&bar[XB_XCNT(b.x)], 1u);
    return b;
}
__device__ __forceinline__ void xcd_barrier_complete(unsigned* bar, unsigned x, unsigned& nloc, unsigned& nx) {
    const unsigned G = gridDim.x * gridDim.y * gridDim.z;
    unsigned sum, cnt, mine, sp = 0u;
    for (;;) {
        sum = 0u; cnt = 0u; mine = 0u;
#pragma unroll
        for (unsigned j = 0; j < 16; ++j) { const unsigned c = xb_ld(&bar[XB_XCNT(j)]); sum += c; cnt += (c > 0u) ? 1u : 0u; mine = (j == x) ? c : mine; }
        if (sum == G) break;
        __builtin_amdgcn_s_sleep(1);
        if ((++sp & 255u) == 0u) { if (xb_ld(&bar[XB_TMO])) break; if (sp > XB_SPIN_CAP) { atomicAdd(&bar[XB_TMO], 1u); break; } }
    }
    nloc = mine > 0u ? mine : 1u; nx = cnt > 0u ? cnt : 1u;
}
__device__ __forceinline__ void xcd_barrier(const XcdBarrier& b) {
    asm volatile("s_waitcnt vmcnt(0)" ::: "memory");
    __syncthreads();
    if (threadIdx.x == 0) {
        unsigned* bar = b.bar;
        __builtin_amdgcn_s_waitcnt(0);
        unsigned nloc = b.st[0], nx = b.st[1];
        if (nloc == 0u) { xcd_barrier_complete(bar, b.x, nloc, nx); b.st[0] = nloc; b.st[1] = nx; }
        const unsigned old = xb_add(&bar[XB_XSUB(b.x)], 1u);
        const unsigned gen = old / nloc;
        if (old + 1u == (gen + 1u) * nloc) {
            __builtin_amdgcn_fence(__ATOMIC_RELEASE, "agent");
            asm volatile("s_waitcnt vmcnt(0)" ::: "memory");
            const unsigned og = xb_add(&bar[XB_TOP], 1u);
            const unsigned tg = og / nx;
            if (og + 1u == (tg + 1u) * nx) xb_add(&bar[XB_TOPGEN], 1u);
            else XB_SPIN(xb_ld(&bar[XB_TOPGEN]) == tg, bar);
            __builtin_amdgcn_fence(__ATOMIC_ACQUIRE, "agent");
            xb_add(&bar[XB_XGEN(b.x)], 1u);
            asm volatile("s_waitcnt vmcnt(0)" ::: "memory");
        } else {
            XB_SPIN(xb_ld(&bar[XB_XGEN(b.x)]) == gen, bar);
            __builtin_amdgcn_fence(__ATOMIC_ACQUIRE, "agent");
            asm volatile("s_waitcnt vmcnt(0)" ::: "memory");
        }
    }
    __syncthreads();
}

#define GEMM_PHASE(SUB, MTILES, NTILES, SM, SN, CALL) do { \
    const int nsn_ = (NTILES) / (SN), nsuper_ = ((MTILES) / (SM)) * nsn_, per_ = (SM) * (SN); \
    const int xcd_ = blockIdx.x & 7; \
    const int total_ = ((nsuper_ - xcd_ + 7) >> 3) * per_;            \
    unsigned* q_ = p.bar + XCD_BAR_WORDS + 64 + (ph * 3 + (SUB)) * 8 + xcd_; \
    for (;;) { \
      if (threadIdx.x == 0) xb_words[2] = atomicAdd(q_, 1u); \
      __syncthreads(); const int idx_ = (int)xb_words[2]; __syncthreads(); \
      if (idx_ >= total_) break; \
      const int r_ = idx_ / per_, l_ = idx_ - r_ * per_, s_ = xcd_ + 8 * r_, sm_ = s_ / nsn_, sn_ = s_ - sm_ * nsn_; \
      const int mt = sm_ * (SM) + l_ / (SN), nt = sn_ * (SN) + l_ % (SN); CALL; } } while (0)

__global__ void __launch_bounds__(NTHR, LB2) mega(const Params p_unused, int ph_lo, int ph_hi) {
  __shared__ __attribute__((aligned(16))) char lds[SMEM_BYTES];
  volatile LAS unsigned* xb_words = (volatile LAS unsigned*)(lds + SMEM_BYTES - 16);
  constexpr int MT = T_TOK / 128;
  XcdBarrier xb;
  { const __attribute__((address_space(4))) Params* pp0 = (const __attribute__((address_space(4))) Params*)__builtin_amdgcn_kernarg_segment_ptr();
    if (threadIdx.x < 4) xb_words[threadIdx.x] = 0u;
    __syncthreads();
    xb = xcd_barrier_post(pp0->bar, xb_words); }
  for (int ph = ph_lo; ph < ph_hi; ++ph) {
    const __attribute__((address_space(4))) Params* pp = (const __attribute__((address_space(4))) Params*)__builtin_amdgcn_kernarg_segment_ptr();
    asm volatile("" : "+s"(pp));
    KP p = *pp;
    const int type = p.prog_type[ph], layer = p.prog_layer[ph];
    const int j = layer >> 1;
    switch (type) {
      case PH_PREP: if (!PHON(PH_PREP)) break; phase_prep(p, lds); break;
      case PH_MLA_A: if (!PHON(PH_MLA_A)) break;
        GEMM_PHASE(0, MT / 2, 6, 8, 6, (gemm_big<EPI_A>(p, j, p.xb, DM, p.wa_t[j], 1024, mt * 256, nt * 128, lds)));
        break;
      case PH_MLA_B: if (!PHON(PH_MLA_B)) break;
        GEMM_PHASE(0, MT / 2, 12, 16, 4, (gemm_big<EPI_UQ>(p, j, p.cqkv, 768, p.wuq_t[j], 384, mt * 256, nt * 128, lds)));
        GEMM_PHASE(1, MT / 2, 8, 8, 8, (gemm_big<EPI_UK>(p, j, p.cqkv + 384, 768, p.wukv_t[j], 256, mt * 256, nt * 256, lds)));
        GEMM_PHASE(2, MT, 8, 8, 8, (gemm_tile<EPI_UV, true>(p, j, p.cqkv + 384, 768, p.wukv_t[j], 256, mt * 128, nt * 256 + 128, lds)));
        break;
      case PH_MLA_ATT: if (!PHON(PH_MLA_ATT)) break;
#ifndef SKEW_BIT
#define SKEW_BIT 256
#endif
        {
          unsigned* ctr = p.bar + XCD_BAR_WORDS + ph;
          for (;;) {
            if (threadIdx.x == 0) xb_words[2] = atomicAdd(ctr, 1u);
            __syncthreads();
            const int t = (int)xb_words[2];
            __syncthreads();
            if (t < 3072) attn_mla(p, t, lds);
            else if (PEER_FP4 && layer == 0 && t < 3072 + TBL_NCHUNK) convert_tables_chunk(p, t - 3072);
            else if (PEER_FP4 && layer == 0 && t < 3072 + TBL_NCHUNK + (p.ntiles_prep - p.jobs[4].tile0)) prep_transpose_tile(p, t - 3072 - TBL_NCHUNK + p.jobs[4].tile0, lds);
            else break;
          } }
        break;
      case PH_MLA_O: if (!PHON(PH_MLA_O)) break;
        GEMM_PHASE(0, MT, 8, 8, 8, (gemm_tile<EPI_O, false>(p, layer == 0 ? -1 : j, p.o, 1024, p.mla_wo_t[j], 1024, mt * 128, nt * 128, lds)));
        break;
      case PH_NA_QKV: if (!PHON(PH_NA_QKV)) break;
        GEMM_PHASE(0, MT / 2, 24, 8, 8, (gemm_big<EPI_QKV>(p, j, p.xb, DM, p.na_wqkv_t[j], 1024, mt * 256, nt * 128, lds)));
        break;
      case PH_NA_ATT: if (!PHON(PH_NA_ATT)) break;
        { unsigned* ctr = p.bar + XCD_BAR_WORDS + ph;
          for (;;) {
            if (threadIdx.x == 0) xb_words[2] = atomicAdd(ctr, 1u);
            __syncthreads();
            const int t = (int)xb_words[2];
            __syncthreads();
            if (t >= 6144) break;
            attn_item<1>(p, j, t, lds);
          } }
        break;
      case PH_NA_O: if (!PHON(PH_NA_O)) break;
        GEMM_PHASE(0, MT, 8, 8, 8, (gemm_tile<EPI_O, false>(p, j, p.o, 1024, p.na_wo_t[j], 1024, mt * 128, nt * 128, lds)));
        break;
      case PH_PEER_Q: if (!PHON(PH_PEER_Q)) break;
        GEMM_PHASE(0, MT, 16, 8, 8, (gemm_tile<EPI_PEER, true>(p, layer, p.xb, DM, p.peer_wq_t[layer], 1024, mt * 128, nt * 128, lds)));
        break;
      case PH_PEER_C: if (!PHON(PH_PEER_C)) break; phase_peer_combine(p, layer, lds, p.bar + XCD_BAR_WORDS + ph); break;
      case PH_FINAL: if (!PHON(PH_FINAL)) break; phase_final(p); break;
      default: break;
    }
    if (ph + 1 < ph_hi) { if (ph_hi > 1000) cg::this_grid().sync(); else xcd_barrier(xb); }
  }
}

extern "C" void kernel_launch(void* const* d_in, const int* in_sizes, int n_in, void* d_out, int out_size, void* d_ws, size_t ws_size, hipStream_t stream) {
  static int grid_blocks = 0, n_cus = 0;
  if (!grid_blocks) {
    int dev = 0, cus = 0;
    (void)hipGetDevice(&dev);
    (void)hipDeviceGetAttribute(&cus, hipDeviceAttributeMultiprocessorCount, dev);
    if (cus < 8) cus = 256;
    n_cus = cus;
    grid_blocks = cus * 2;
  }
  Params p; memset(&p, 0, sizeof(p));
  const float* const* in = (const float* const*)d_in;
  char* ws = (char*)d_ws; size_t off = 0;
  auto alloc = [&](size_t bytes) -> void* { void* r = ws + off; off += (bytes + 255) & ~(size_t)255; return r; };
  p.xin0 = in[0]; p.xin1 = in[1]; p.x = (float*)d_out; p.norm_final = in[4];
  for (int l = 0; l < 2; ++l) {
    p.wa_t[l] = (u16*)alloc(768UL * 1024 * 2); p.wuq_t[l] = (u16*)alloc(1536UL * 384 * 2); p.wukv_t[l] = (u16*)alloc(2048UL * 256 * 2); p.mla_wo_t[l] = (u16*)alloc(1024UL * 1024 * 2);
    p.na_wqkv_t[l] = (u16*)alloc(3072UL * 1024 * 2); p.na_wo_t[l] = (u16*)alloc(1024UL * 1024 * 2);
  }
  for (int l = 0; l < 4; ++l) p.peer_wq_t[l] = (u16*)alloc(2048UL * 1024 * 2);
  p.na_bias_s = (float*)alloc(2 * 3072 * 4); p.na_rpb_s = (float*)alloc(2 * 16 * 465 * 4);
  p.peer_sk = (u16*)alloc(4UL * 8 * 2 * 128 * 128 * 2);
  p.peer_u8 = (unsigned char*)alloc(4UL * 16384 * 1024); p.peer_v8 = (unsigned char*)alloc(4UL * 16384 * 1024);
  p.ropeC = (float*)alloc(16384UL * 32 * 4); p.ropeS = (float*)alloc(16384UL * 32 * 4);
  p.bar = (unsigned*)alloc((XCD_BAR_WORDS + 1024) * 4);
  p.o = (u16*)alloc((size_t)T_TOK * 1024 * 2); p.xb = (u16*)alloc((size_t)T_TOK * 1024 * 2);
  char* un = (char*)alloc((size_t)T_TOK * (768 + 1536 + 2048) * 2);
  p.cqkv = (u16*)un; p.q = (u16*)(un + (size_t)T_TOK * 768 * 2); p.kv = (u16*)(un + (size_t)T_TOK * (768 + 1536) * 2);
  { unsigned char* b8 = (unsigned char*)un + (size_t)T_TOK * 768 * 2; p.q8 = b8; p.k8 = b8 + (size_t)T_TOK * 1536; p.kpe8 = p.k8; p.vT8 = p.k8 + (size_t)T_TOK * 1088; }
  p.qkv = (u16*)un; p.pkeys = (u32*)un;
  if (off > ws_size) { fprintf(stderr, "kernel_launch: workspace too small: need %zu have %zu\n", off, ws_size); return; }
  p.in_sub_keys = in[17]; p.in_peer_u = in[18]; p.in_peer_v = in[19]; p.in_norm_ffn = in[3]; p.in_na_bias = in[13]; p.in_na_rpb = in[14];
  for (int jf = 0; jf < 32; ++jf) p.inv_freq[jf] = pow(10000.0, -(double)(2 * jf) / 64.0);
  int nj = 0, tile = 0;
  auto job = [&](const float* src, u16* dst, const float* gain, int K, int N, float scale, int scale_cols) {
    PrepJob& J = p.jobs[nj++]; J.src = src; J.dst = dst; J.gain = gain; J.K = K; J.N = N; J.tile0 = tile; J.scale = scale; J.scale_cols = scale_cols; J.pad = 0; tile += (K / 64) * (N / 64); };
  const float sc_mla = (float)(pow(192.0, -0.5) * 1.4426950408889634);
  for (int l = 0; l < 2; ++l) {
    job(in[5] + (size_t)l * 1024 * 384, p.wa_t[l], in[2] + (2 * l) * 1024, 1024, 384, 1.f, 0);
    job(in[8] + (size_t)l * 1024 * 320, p.wa_t[l] + 384UL * 1024, in[2] + (2 * l) * 1024, 1024, 320, 1.f, 0);
    job(in[7] + (size_t)l * 384 * 1536, p.wuq_t[l], in[6] + l * 384, 384, 1536, sc_mla, 1536);
    job(in[10] + (size_t)l * 256 * 2048, p.wukv_t[l], in[9] + l * 256, 256, 2048, 1.f, 0);
    job(in[11] + (size_t)l * 1024 * 1024, p.mla_wo_t[l], nullptr, 1024, 1024, 1.f, 0);
    job(in[12] + (size_t)l * 1024 * 3072, p.na_wqkv_t[l], in[2] + (2 * l + 1) * 1024, 1024, 3072, 0.125f * 1.4426950408889634f, 1024);
    job(in[15] + (size_t)l * 1024 * 1024, p.na_wo_t[l], nullptr, 1024, 1024, 1.f, 0);
  }
  for (int l = 0; l < 4; ++l) job(in[16] + (size_t)l * 1024 * 2048, p.peer_wq_t[l], in[3] + l * 1024, 1024, 2048, 1.f, 0);
  p.njobs = nj; p.ntiles_prep = tile;
  int np = 0;
#ifndef DUPMASK
#define DUPMASK 0
#endif
  auto ph = [&](int type, int layer) { p.prog_type[np] = type; p.prog_layer[np] = layer; ++np;
    if ((DUPMASK >> type) & 1) { p.prog_type[np] = type; p.prog_layer[np] = layer; ++np; } };
  ph(PH_PREP, 0);
  for (int i = 0; i < 4; ++i) {
    if ((i & 1) == 0) { ph(PH_MLA_A, i); ph(PH_MLA_B, i); ph(PH_MLA_ATT, i); ph(PH_MLA_O, i); }
    else { ph(PH_NA_QKV, i); ph(PH_NA_ATT, i); ph(PH_NA_O, i); }
    ph(PH_PEER_Q, i); ph(PH_PEER_C, i);
  }
  p.nprog = np;
#if COOP
  (void)hipMemsetAsync(p.bar, 0, (XCD_BAR_WORDS + 1024) * 4, stream);
  int lo = 0, hi = np;
  void* args[] = {(void*)&p, (void*)&lo, (void*)&hi};
  hipError_t e = hipLaunchCooperativeKernel((const void*)mega, dim3(grid_blocks), dim3(NTHR), args, 0, stream);
  if (e != hipSuccess && grid_blocks != n_cus) {
    (void)hipGetLastError(); grid_blocks = n_cus;
    e = hipLaunchCooperativeKernel((const void*)mega, dim3(grid_blocks), dim3(NTHR), args, 0, stream);
  }
  if (e != hipSuccess) fprintf(stderr, "cooperative launch failed: %s (grid %d)\n", hipGetErrorString(e), grid_blocks);
#else
  for (int i = 0; i < np; ++i) hipLaunchKernelGGL(mega, dim3(grid_blocks), dim3(NTHR), 0, stream, p, i, i + 1);
#endif
}
```
